# Optimizing an MI355X kernel written in HIP

```python
import math
import jax
import jax.numpy as jnp
from jax import lax
import numpy as np

D_MODEL = 1024
BATCH = 8
SEQ = 2048
DEPTH = 2

GRID_W = 64
CTX_LEN = 256
N_BRANCH = 4
D_BRANCH = D_MODEL // N_BRANCH
S5_GROUP = 16
S5_GROUPS = D_BRANCH // S5_GROUP
S5_STATE = 64
HG_HEAD = 64
HG_HEADS = D_BRANCH // HG_HEAD
HG_CHUNK = 16
RET_HEAD = 64
RET_HEADS = D_BRANCH // RET_HEAD
RET_CHUNK = 64
ROPE_BASE = 10000.0
RW_HEAD = 64
RW_HEADS = D_BRANCH // RW_HEAD
RW_LORA = 16
RW_SHIFT_W = 3 * D_BRANCH + 4 * RW_LORA
LN_EPS = 1e-5
RMS_EPS = 1e-6
RW_GN_EPS = 64e-5
DEEPNORM_ALPHA = (2 * DEPTH) ** 0.25
DEEPNORM_BETA = (8 * DEPTH) ** -0.25
IN_WIDTHS = (D_BRANCH, D_BRANCH,
             D_BRANCH, 2 * D_BRANCH, D_BRANCH, D_BRANCH,
             D_BRANCH, D_BRANCH, D_BRANCH, D_BRANCH,
             RW_SHIFT_W, D_BRANCH,
             N_BRANCH * D_MODEL)
D_IN = sum(IN_WIDTHS)

kernel_name = 'hybrid_s5_hgrn2_retnet_rwkv7_diffusion_block'


def layer_norm(x):
    xf = x.astype(jnp.float32)
    mu = xf.mean(-1, keepdims=True)
    var = jnp.square(xf - mu).mean(-1, keepdims=True)
    return ((xf - mu) * lax.rsqrt(var + LN_EPS)).astype(x.dtype)


def rms_norm(x):
    xf = x.astype(jnp.float32)
    return xf * lax.rsqrt(jnp.square(xf).mean(-1, keepdims=True) + RMS_EPS)


def split_heads(a, head_dim):
    return a.reshape(*a.shape[:-1], a.shape[-1] // head_dim, head_dim)


def to_dirs(a):
    return jnp.stack([a, jnp.flip(a, axis=1)])


def flip_bwd(a):
    return jnp.stack([a[0], jnp.flip(a[1], axis=1)])


def from_dirs(a):
    return a[0] + jnp.flip(a[1], axis=1)


def _rope_half(x, pos):
    n = x.shape[-1] // 2
    freqs = ROPE_BASE ** (-jnp.arange(n, dtype=jnp.float32) / n)
    ang = pos.astype(jnp.float32)[:, None] * freqs
    cos = jnp.cos(ang)[:, None, :]
    sin = jnp.sin(ang)[:, None, :]
    x1, x2 = x[..., :n], x[..., n:]
    return jnp.concatenate([x1 * cos - x2 * sin, x1 * sin + x2 * cos], axis=-1)


def rotary_2d(x, rows, cols):
    half = x.shape[-1] // 2
    return jnp.concatenate([_rope_half(x[..., :half], rows), _rope_half(x[..., half:], cols)], axis=-1).astype(x.dtype)


def token_shift_centred(x, mu):
    x_prev = jnp.pad(x[:, :-1], ((0, 0), (1, 0), (0, 0)))
    x_next = jnp.pad(x[:, 1:], ((0, 0), (0, 1), (0, 0)))
    return x + mu[0] * (x_prev - x) + mu[1] * (x_next - x)


def _linear_combine(e1, e2):
    a1, b1 = e1
    a2, b2 = e2
    return a1 * a2, a2 * b1 + b2


def s5_mixer(u, lam_re, lam_im, log_dt, b_re, b_im, c_re, c_im, d_skip, h0):
    bsz, t_len, _ = u.shape
    f32 = jnp.float32
    lam = lax.complex(lam_re.astype(f32), lam_im.astype(f32))
    a_bar = jnp.exp(lam * jnp.exp(log_dt.astype(f32))[..., None])
    b_bar = ((a_bar - 1.0) / lam)[..., None] * lax.complex(b_re.astype(f32), b_im.astype(f32))
    ug = to_dirs(u.astype(f32).reshape(bsz, t_len, S5_GROUPS, S5_GROUP)).astype(jnp.complex64)
    bu = jnp.einsum('dgnp,dbtgp->dbtgn', b_bar, ug)
    bu = bu.at[:, :, 0].add(a_bar[:, None] * h0)
    a_seq = jnp.broadcast_to(a_bar[:, None, None], bu.shape)
    _, h = lax.associative_scan(_linear_combine, (a_seq, bu), axis=2)
    c_mat = lax.complex(c_re.astype(f32), c_im.astype(f32))
    y = jnp.einsum('gpn,btgn->btgp', c_mat, from_dirs(h)).real.reshape(bsz, t_len, D_BRANCH)
    return y + d_skip.astype(f32) * u.astype(f32), h[:, :, -1]


def chunk_state_scan(s0, decay, u):
    def step(s, inp):
        dec, uu = inp
        return dec * s + uu, s
    s_last, starts = lax.scan(step, s0, (jnp.moveaxis(decay, 2, 0), jnp.moveaxis(u, 2, 0)))
    return jnp.moveaxis(starts, 0, 2), s_last


def gla_chunkwise(q, k, v, log_f, s0, chunk):
    nd, bsz, t_len, n_h, _ = q.shape
    n = t_len // chunk
    rs = lambda a: a.reshape(nd, bsz, n, chunk, *a.shape[3:])
    q, k, v, log_f = rs(q), rs(k), rs(v), rs(log_f)
    b = jnp.cumsum(log_f, axis=3)
    causal = jnp.tril(jnp.ones((chunk, chunk), dtype=bool))
    diff = b[:, :, :, :, None] - b[:, :, :, None]
    decay = jnp.exp(jnp.where(causal[:, :, None, None], diff, -jnp.inf))
    attn = jnp.einsum('dbntshk,dbnthk,dbnshk->dbntsh', decay, q, k)
    o = jnp.einsum('dbntsh,dbnshv->dbnthv', attn, v)
    b_last = b[:, :, :, -1]
    u = jnp.einsum('dbnshk,dbnshv->dbnhkv', k * jnp.exp(b_last[:, :, :, None] - b), v)
    starts, s_last = chunk_state_scan(s0, jnp.exp(b_last)[..., None], u)
    o = o + jnp.einsum('dbnthk,dbnhkv->dbnthv', q * jnp.exp(b), starts)
    return o.reshape(nd, bsz, t_len, n_h, v.shape[-1]), s_last


def retention_chunkwise(q, k, v, log_gamma, s0):
    nd, bsz, t_len, n_h, _ = q.shape
    L = RET_CHUNK
    n = t_len // L
    rs = lambda a: a.reshape(nd, bsz, n, L, *a.shape[3:])
    q, k, v = rs(q), rs(k), rs(v)
    pos = jnp.arange(L, dtype=jnp.float32)
    rel = pos[:, None] - pos[None, :]
    dmat = jnp.exp(jnp.where((rel >= 0)[None, :, :, None], rel[None, :, :, None] * log_gamma[:, None, None, :], -jnp.inf))
    attn = jnp.einsum('dbnthk,dbnshk->dbntsh', q, k) * dmat[:, None, None]
    o = jnp.einsum('dbntsh,dbnshv->dbnthv', attn, v)
    q_dec = jnp.exp((pos + 1.0)[None, :, None] * log_gamma[:, None, :])
    k_dec = jnp.exp((L - 1.0 - pos)[None, :, None] * log_gamma[:, None, :])
    u = jnp.einsum('dbnshk,dsh,dbnshv->dbnhkv', k, k_dec, v)
    chunk_dec = jnp.broadcast_to(jnp.exp(L * log_gamma)[:, None, None, :, None, None], (nd, 1, n, n_h, 1, 1))
    starts, s_last = chunk_state_scan(s0, chunk_dec, u)
    o = o + jnp.einsum('dbnthk,dth,dbnhkv->dbnthv', q, q_dec, starts)
    return o.reshape(nd, bsz, t_len, n_h, v.shape[-1]), s_last


def _rwkv7_step(s, inp):
    r, w, k, v, kk, a = inp
    sa = jnp.einsum('dbhvk,dbhk->dbhv', s, -kk)
    s = s * w[..., None, :] + sa[..., None] * (kk * a)[..., None, :] + v[..., None] * k[..., None, :]
    return s, jnp.einsum('dbhvk,dbhk->dbhv', s, r)


def rwkv7_mixer(xs, w0, w2, a0, a2, k_k, k_a, r_k, gn_w, gn_b, s0):
    bsz, t_len, _ = xs.shape
    f32 = jnp.float32
    r, k, v, w_lo, a_lo = jnp.split(xs.astype(f32), [D_BRANCH, 2 * D_BRANCH, 3 * D_BRANCH, 3 * D_BRANCH + 2 * RW_LORA], axis=-1)
    w_lo = w_lo.reshape(bsz, t_len, 2, RW_LORA)
    a_lo = a_lo.reshape(bsz, t_len, 2, RW_LORA)
    lw = -jax.nn.softplus(-(w0[:, None, None] + jnp.einsum('btdr,drc->dbtc', jnp.tanh(w_lo), w2))) - 0.5
    decay = jnp.exp(-jnp.exp(lw))
    iclr = jax.nn.sigmoid(a0[:, None, None] + jnp.einsum('btdr,drc->dbtc', a_lo, a2))
    kk = split_heads(k * k_k, RW_HEAD)
    kk = kk / jnp.maximum(jnp.linalg.norm(kk, axis=-1, keepdims=True), 1e-12)
    k_dir = k[None] * (1.0 + (iclr - 1.0) * k_a)
    hs = lambda a: split_heads(a, RW_HEAD)
    seq = (to_dirs(hs(r)), flip_bwd(hs(decay)), flip_bwd(hs(k_dir)), to_dirs(hs(v)), to_dirs(kk), flip_bwd(hs(iclr)))
    s_last, o = lax.scan(_rwkv7_step, s0, tuple(jnp.moveaxis(a, 2, 0) for a in seq))
    o = from_dirs(jnp.moveaxis(o, 0, 2))
    mu = o.mean(-1, keepdims=True)
    var = jnp.square(o - mu).mean(-1, keepdims=True)
    o = ((o - mu) * lax.rsqrt(var + RW_GN_EPS)).reshape(bsz, t_len, D_BRANCH) * gn_w + gn_b
    bonus = (hs(r[None] * k_dir * r_k).sum(-1, keepdims=True) * hs(v)[None]).sum(0)
    return o + bonus.reshape(bsz, t_len, D_BRANCH), s_last


def zero_states(bsz):
    f32 = jnp.float32
    return (jnp.zeros((2, bsz, S5_GROUPS, S5_STATE), jnp.complex64),
            jnp.zeros((2, bsz, HG_HEADS, HG_HEAD, HG_HEAD), f32),
            jnp.zeros((2, bsz, RET_HEADS, RET_HEAD, RET_HEAD), f32),
            jnp.zeros((2, bsz, RW_HEADS, RW_HEAD, RW_HEAD), f32))


def mixer_layer(h, mod, states, grid, lp):
    f32 = jnp.float32
    bsz, t_len, _ = h.shape
    shift, scale, gate = jnp.split(mod, 3, axis=-1)
    u = layer_norm(h) * (1.0 + scale) + shift
    proj = u @ lp['w_in'] + lp['b_in']
    (s5_u, s5_z, hg_q, hg_f, hg_i, hg_z, rt_q, rt_k, rt_v, rt_z, rw_x, rw_z, gate_logits) = jnp.split(
        proj, np.cumsum(IN_WIDTHS)[:-1].tolist(), axis=-1)
    s5_h0, hg_s0, rt_s0, rw_s0 = states

    y, s5_h = s5_mixer(s5_u, lp['s5_lam_re'], lp['s5_lam_im'], lp['s5_log_dt'], lp['s5_b_re'], lp['s5_b_im'],
                       lp['s5_c_re'], lp['s5_c_im'], lp['s5_d'], s5_h0)
    y = jax.nn.gelu(y)
    y_a = y * jax.nn.sigmoid(y @ lp['s5_glu_w'] + lp['s5_glu_b']) * jax.nn.silu(s5_z)

    lb = lp['hg_lb'][:, None, None]
    fgate = lb + (1.0 - lb) * jax.nn.sigmoid(jnp.moveaxis(hg_f.astype(f32).reshape(bsz, t_len, 2, D_BRANCH), 2, 0))
    hh = lambda a: split_heads(a, HG_HEAD)
    o, hg_s = gla_chunkwise(to_dirs(hh(jax.nn.silu(hg_q))), flip_bwd(hh(1.0 - fgate)), to_dirs(hh(hg_i)),
                            flip_bwd(hh(jnp.log(fgate))), hg_s0, HG_CHUNK)
    y_b = rms_norm(from_dirs(o)).reshape(bsz, t_len, D_BRANCH) * lp['hg_norm_w'] * jax.nn.silu(hg_z)

    q = split_heads(rt_q, RET_HEAD)
    k = split_heads(rt_k, RET_HEAD) * RET_HEAD ** -0.5
    if grid is not None:
        q = rotary_2d(q, grid[0], grid[1])
        k = rotary_2d(k, grid[0], grid[1])
    log_gamma = -jnp.exp(lp['ret_decay'].astype(f32))
    o, rt_s = retention_chunkwise(to_dirs(q), to_dirs(k), to_dirs(split_heads(rt_v, RET_HEAD)), log_gamma, rt_s0)
    y_c = rms_norm(from_dirs(o)).reshape(bsz, t_len, D_BRANCH) * jax.nn.silu(rt_z)

    y_d, rw_s = rwkv7_mixer(token_shift_centred(rw_x, lp['rw_mu']), lp['rw_w0'], lp['rw_w2'], lp['rw_a0'],
                            lp['rw_a2'], lp['rw_kk'], lp['rw_ka'], lp['rw_rk'], lp['rw_gn_w'], lp['rw_gn_b'], rw_s0)
    y_d = y_d * jax.nn.silu(rw_z)

    ys = jnp.stack([y_a, y_b, y_c, y_d], axis=-2).astype(h.dtype)
    branch = jnp.einsum('btkw,kwd->btkd', ys, lp['w_branch'])
    merged = jnp.sum(jax.nn.sigmoid(gate_logits.reshape(bsz, t_len, N_BRANCH, D_MODEL)) * branch, axis=-2)
    out = merged @ lp['w_out'] + lp['b_out']
    h_new = layer_norm(DEEPNORM_ALPHA * h + gate * out) * lp['ln_w'] + lp['ln_b']
    return h_new.astype(h.dtype), (s5_h, hg_s, rt_s, rw_s)


def setup_inputs(seed: int = 0) -> dict:
    key = jax.random.key(seed)
    ks = iter(jax.random.split(key, 48))
    f32 = jnp.float32
    W = D_BRANCH

    def nrm(shape, scale=1.0):
        return scale * jax.random.normal(next(ks), shape, f32)

    n_idx = jnp.arange(S5_STATE, dtype=f32)
    gamma = 1.0 - 2.0 ** (-5.0 - jnp.arange(RET_HEADS, dtype=f32))
    decay_speed = -6.0 + 5.0 * (jnp.arange(W, dtype=f32) / (W - 1)) ** 0.85
    return {
        'x': nrm((BATCH, SEQ, D_MODEL)),
        'c': nrm((BATCH, D_MODEL)),
        'ctx': nrm((BATCH, CTX_LEN, D_MODEL)),
        'c_ctx': nrm((D_MODEL,)),
        'ada_w': nrm((DEPTH, D_MODEL, 3 * D_MODEL), D_MODEL ** -0.5),
        'ada_b': nrm((DEPTH, 3 * D_MODEL), 0.01),
        'w_in': nrm((DEPTH, D_MODEL, D_IN), D_MODEL ** -0.5),
        'b_in': nrm((DEPTH, D_IN), 0.01),
        's5_lam_re': -0.5 + nrm((DEPTH, 2, S5_GROUPS, S5_STATE), 0.01),
        's5_lam_im': jnp.pi * n_idx + nrm((DEPTH, 2, S5_GROUPS, S5_STATE), 0.01),
        's5_log_dt': jax.random.uniform(next(ks), (DEPTH, 2, S5_GROUPS), f32, math.log(1e-3), math.log(1e-1)),
        's5_b_re': nrm((DEPTH, S5_GROUPS, S5_STATE, S5_GROUP), (2 * S5_GROUP) ** -0.5),
        's5_b_im': nrm((DEPTH, S5_GROUPS, S5_STATE, S5_GROUP), (2 * S5_GROUP) ** -0.5),
        's5_c_re': nrm((DEPTH, S5_GROUPS, S5_GROUP, S5_STATE), S5_STATE ** -0.5),
        's5_c_im': nrm((DEPTH, S5_GROUPS, S5_GROUP, S5_STATE), S5_STATE ** -0.5),
        's5_d': nrm((DEPTH, W)),
        's5_glu_w': nrm((DEPTH, W, W), W ** -0.5),
        's5_glu_b': nrm((DEPTH, W), 0.01),
        'hg_lb': 1.0 + nrm((DEPTH, 2, W), 0.1),
        'hg_norm_w': 1.0 + nrm((DEPTH, W), 0.01),
        'ret_decay': jnp.log(-jnp.log(gamma)) + nrm((DEPTH, 2, RET_HEADS), 0.01),
        'rw_mu': jax.random.uniform(next(ks), (DEPTH, 2, RW_SHIFT_W), f32, 0.0, 0.5),
        'rw_w0': decay_speed + nrm((DEPTH, 2, W), 0.01),
        'rw_w2': nrm((DEPTH, 2, RW_LORA, W), 0.1),
        'rw_a0': nrm((DEPTH, 2, W), 0.1),
        'rw_a2': nrm((DEPTH, 2, RW_LORA, W), 0.1),
        'rw_kk': 0.85 + nrm((DEPTH, W), 0.01),
        'rw_ka': 1.0 + nrm((DEPTH, W), 0.01),
        'rw_rk': nrm((DEPTH, W), 0.1),
        'rw_gn_w': 1.0 + nrm((DEPTH, W), 0.01),
        'rw_gn_b': nrm((DEPTH, W), 0.01),
        'w_branch': nrm((DEPTH, N_BRANCH, W, D_MODEL), W ** -0.5 * DEEPNORM_BETA),
        'w_out': nrm((DEPTH, D_MODEL, D_MODEL), D_MODEL ** -0.5 * DEEPNORM_BETA),
        'b_out': nrm((DEPTH, D_MODEL), 0.01),
        'ln_w': 1.0 + nrm((DEPTH, D_MODEL), 0.01),
        'ln_b': nrm((DEPTH, D_MODEL), 0.01),
    }


def reference(x, c, ctx, c_ctx, ada_w, ada_b, w_in, b_in, s5_lam_re, s5_lam_im, s5_log_dt, s5_b_re, s5_b_im,
              s5_c_re, s5_c_im, s5_d, s5_glu_w, s5_glu_b, hg_lb, hg_norm_w, ret_decay, rw_mu, rw_w0, rw_w2,
              rw_a0, rw_a2, rw_kk, rw_ka, rw_rk, rw_gn_w, rw_gn_b, w_branch, w_out, b_out, ln_w, ln_b):
    seq_len = x.shape[1]
    ROWS = seq_len // GRID_W
    rows = jnp.repeat(jnp.arange(ROWS, dtype=jnp.int32), GRID_W)
    cols = jnp.tile(jnp.arange(GRID_W, dtype=jnp.int32), ROWS)
    grid = (rows, cols)
    lb_soft = jax.nn.softmax(hg_lb.astype(jnp.float32), axis=0)
    lower_bounds = jnp.cumsum(lb_soft, axis=0) - lb_soft[0]
    h_lat, h_ctx = x, ctx
    for l in range(DEPTH):
        lp = {
            'w_in': w_in[l], 'b_in': b_in[l],
            's5_lam_re': s5_lam_re[l], 's5_lam_im': s5_lam_im[l], 's5_log_dt': s5_log_dt[l],
            's5_b_re': s5_b_re[l], 's5_b_im': s5_b_im[l], 's5_c_re': s5_c_re[l], 's5_c_im': s5_c_im[l],
            's5_d': s5_d[l], 's5_glu_w': s5_glu_w[l], 's5_glu_b': s5_glu_b[l],
            'hg_lb': lower_bounds[l], 'hg_norm_w': hg_norm_w[l], 'ret_decay': ret_decay[l],
            'rw_mu': rw_mu[l], 'rw_w0': rw_w0[l], 'rw_w2': rw_w2[l], 'rw_a0': rw_a0[l], 'rw_a2': rw_a2[l],
            'rw_kk': rw_kk[l], 'rw_ka': rw_ka[l], 'rw_rk': rw_rk[l], 'rw_gn_w': rw_gn_w[l], 'rw_gn_b': rw_gn_b[l],
            'w_branch': w_branch[l], 'w_out': w_out[l], 'b_out': b_out[l], 'ln_w': ln_w[l], 'ln_b': ln_b[l],
        }
        mod_lat = (jax.nn.silu(c) @ ada_w[l] + ada_b[l])[:, None, :]
        mod_ctx = jax.nn.silu(c_ctx) @ ada_w[l] + ada_b[l]
        h_ctx_next, ctx_states = mixer_layer(h_ctx, mod_ctx, zero_states(ctx.shape[0]), None, lp)
        h_lat, _ = mixer_layer(h_lat, mod_lat, ctx_states, grid, lp)
        h_ctx = h_ctx_next
    return h_lat
```

```cpp
#include <hip/hip_runtime.h>
#include <hip/hip_bf16.h>
#include <hip/hip_cooperative_groups.h>
#include <cstdio>
namespace cg = cooperative_groups;

typedef __attribute__((ext_vector_type(8))) short bf16x8;
typedef __attribute__((ext_vector_type(4))) float f32x4;
typedef unsigned short u16;

#define D_ 1024
#define NBATCH 8
#define TT 2304
#define MROWS 18432
#define PC 3904
#define DIN 8000
#define C_S5U 0
#define C_S5Z 256
#define C_HGQ 512
#define C_HGF 768
#define C_HGI 1280
#define C_HGZ 1536
#define C_RTQ 1792
#define C_RTK 2048
#define C_RTV 2304
#define C_RTZ 2560
#define C_RWX 2816
#define C_RWZ 3648

#define OFF_WINT   0ul
#define OFF_WBT    (OFF_WINT + 16384000ul)
#define OFF_WOT    (OFF_WBT + 2097152ul)
#define OFF_GLUT   (OFF_WOT + 2097152ul)
#define OFF_U      (OFF_GLUT + 131072ul)
#define OFF_PROJ   (OFF_U + 37748736ul)
#define OFF_HCTX   (OFF_PROJ + 143917056ul)
#define OFF_SCR    (OFF_HCTX + 8388608ul)
#define OFF_RWO    (OFF_SCR)
#define OFF_HGST   (OFF_SCR + 18874368ul)
#define OFF_RTST   (OFF_HGST + 9437184ul)
#define OFF_RETOF  (OFF_SCR + 37748736ul)
#define OFF_S5ST   (OFF_RETOF + 9437184ul)
#define OFF_MODS   (OFF_S5ST + 4718592ul)
#define OFF_HGP    (OFF_MODS + 221184ul)
#define OFF_BONUS  (OFF_HGP + 147456ul)
#define OFF_ROPE   (OFF_BONUS + 589824ul)
#define OFF_BAR    (OFF_ROPE + 8192ul)
#define WS_NEED    (OFF_BAR + 256ul)

struct Params {
  const float* in[36];
  float* out;
  char* ws;
};

__device__ __forceinline__ int tid_() { int t = __builtin_amdgcn_workitem_id_x(); asm volatile("" : "+v"(t)); return t; }
__device__ __forceinline__ u16 f2bf(float f) {
  unsigned u = __float_as_uint(f);
  u += 0x7fffu + ((u >> 16) & 1u);
  return (u16)(u >> 16);
}
__device__ __forceinline__ float bf2f(u16 h) { return __uint_as_float(((unsigned)h) << 16); }
__device__ __forceinline__ unsigned pack2(float a, float b) { return (unsigned)f2bf(a) | ((unsigned)f2bf(b) << 16); }
__device__ __forceinline__ float sigmoidf_(float x) { return __builtin_amdgcn_rcpf(1.f + __expf(-x)); }
__device__ __forceinline__ float siluf_(float x) { return x * __builtin_amdgcn_rcpf(1.f + __expf(-x)); }
__device__ __forceinline__ float geluf_(float x) {
  float t = tanhf(0.7978845608028654f * (x + 0.044715f * x * x * x));
  return 0.5f * x * (1.f + t);
}
template <int CTRL>
__device__ __forceinline__ float dppf(float x) {
  return __int_as_float(__builtin_amdgcn_update_dpp(0, __float_as_int(x), CTRL, 0xf, 0xf, true));
}
__device__ __forceinline__ float allsum16(float x) {
  x += dppf<0x128>(x);
  x += dppf<0x124>(x);
  x += dppf<0x122>(x);
  x += dppf<0x121>(x);
  return x;
}
__device__ __forceinline__ float wavesum(float x) {
  x = allsum16(x);
  x += __shfl_xor(x, 16, 64);
  x += __shfl_xor(x, 32, 64);
  return x;
}
__device__ __forceinline__ void ld4bf(const u16* p, float (&o)[4]) {
  uint2 v = *(const uint2*)p;
  o[0] = __uint_as_float(v.x << 16); o[1] = __uint_as_float(v.x & 0xffff0000u);
  o[2] = __uint_as_float(v.y << 16); o[3] = __uint_as_float(v.y & 0xffff0000u);
}
__device__ __forceinline__ void st4bf(u16* p, float a, float b, float c, float d) {
  uint2 v; v.x = pack2(a, b); v.y = pack2(c, d);
  *(uint2*)p = v;
}
__device__ __forceinline__ int jmap(int d, int s) { return d == 0 ? s : (s < 256 ? 255 - s : 2559 - s); }
__device__ __forceinline__ bool has_prev(int j) { return j != 0 && j != 256; }
__device__ __forceinline__ bool has_next(int j) { return j != 255 && j != 2303; }

__device__ __forceinline__ const float* hin_ptr(const Params& p, int layer, int row) {
  int b = row / TT, j = row - b * TT;
  if (layer == 0) return j < 256 ? p.in[2] + ((size_t)(b * 256 + j)) * D_ : p.in[0] + ((size_t)(b * 2048 + j - 256)) * D_;
  return j < 256 ? (const float*)(p.ws + OFF_HCTX) + ((size_t)(b * 256 + j)) * D_ : p.out + ((size_t)(b * 2048 + j - 256)) * D_;
}
__device__ __forceinline__ float* hout_ptr(const Params& p, int row) {
  int b = row / TT, j = row - b * TT;
  return j < 256 ? (float*)(p.ws + OFF_HCTX) + ((size_t)(b * 256 + j)) * D_ : p.out + ((size_t)(b * 2048 + j - 256)) * D_;
}
__device__ __forceinline__ int modrow_of(int row) { int b = row / TT, j = row - b * TT; return j < 256 ? 8 : b; }

__device__ void transpose_tile(const float* __restrict__ src, u16* __restrict__ dst, int K, int N, int k0, int n0, float* lds) {
  const int t = tid_();
  __syncthreads();
#pragma unroll
  for (int i = 0; i < 16; i++) {
    int r = i * 4 + (t >> 6), c = t & 63;
    lds[r * 65 + c] = src[(size_t)(k0 + r) * N + n0 + c];
  }
  __syncthreads();
#pragma unroll
  for (int i = 0; i < 16; i++) {
    int r = i * 4 + (t >> 6), c = t & 63;
    dst[(size_t)(n0 + r) * K + k0 + c] = f2bf(lds[c * 65 + r]);
  }
}
__device__ void convert_task(const Params& p, int layer, int task, float* lds) {
  if (task < 2000) {
    int kt = task / 125, nt = task % 125;
    transpose_tile(p.in[6] + (size_t)layer * 1024 * DIN, (u16*)(p.ws + OFF_WINT), 1024, DIN, kt * 64, nt * 64, lds);
  } else if (task < 2256) {
    int q = task - 2000; int br = q >> 6; q &= 63; int kt = q >> 4, nt = q & 15;
    transpose_tile(p.in[31] + ((size_t)layer * 4 + br) * 256 * 1024, (u16*)(p.ws + OFF_WBT) + (size_t)br * 1024 * 256, 256, 1024, kt * 64, nt * 64, lds);
  } else if (task < 2512) {
    int q = task - 2256; int kt = q >> 4, nt = q & 15;
    transpose_tile(p.in[32] + (size_t)layer * 1024 * 1024, (u16*)(p.ws + OFF_WOT), 1024, 1024, kt * 64, nt * 64, lds);
  } else {
    int q = task - 2512; int kt = q >> 2, nt = q & 3;
    transpose_tile(p.in[16] + (size_t)layer * 256 * 256, (u16*)(p.ws + OFF_GLUT), 256, 256, kt * 64, nt * 64, lds);
  }
}
#define N_CONVERT_TASKS 2528

__device__ void mods_task(const Params& p, int task, float* lds) {
  const int t = tid_();
  int layer = task / 48, cgp = task % 48;
  float* sc = lds;
  float* red = lds + 9 * 1024;
  __syncthreads();
  for (int i = t; i < 9 * 1024; i += 256) {
    int r = i >> 10, k = i & 1023;
    float v = r < 8 ? p.in[1][r * 1024 + k] : p.in[3][k];
    sc[i] = siluf_(v);
  }
  __syncthreads();
  int col = cgp * 64 + (t & 63), kq = t >> 6;
  float acc[9];
#pragma unroll
  for (int r = 0; r < 9; r++) acc[r] = 0.f;
  const float* wp = p.in[4] + (size_t)layer * 1024 * 3072 + col;
#pragma unroll 16
  for (int k = kq * 256; k < kq * 256 + 256; k++) {
    float w = wp[(size_t)k * 3072];
#pragma unroll
    for (int r = 0; r < 9; r++) acc[r] += sc[r * 1024 + k] * w;
  }
#pragma unroll
  for (int r = 0; r < 9; r++) red[(kq * 9 + r) * 64 + (t & 63)] = acc[r];
  __syncthreads();
  float* mods = (float*)(p.ws + OFF_MODS);
  for (int i = t; i < 9 * 64; i += 256) {
    int r = i >> 6, c = i & 63;
    float s = red[(0 * 9 + r) * 64 + c] + red[(1 * 9 + r) * 64 + c] + red[(2 * 9 + r) * 64 + c] + red[(3 * 9 + r) * 64 + c];
    int cc = cgp * 64 + c;
    mods[((size_t)layer * 9 + r) * 3072 + cc] = s + p.in[5][layer * 3072 + cc];
  }
}

__device__ void ln_row(const Params& p, int mode, int layer, int row) {
  const int lane = tid_() & 63;
  float v[16];
  if (mode == 0) {
    const float* src = hin_ptr(p, 0, row);
#pragma unroll
    for (int i = 0; i < 4; i++) { float4 q = *(const float4*)(src + i * 256 + lane * 4); v[i*4]=q.x; v[i*4+1]=q.y; v[i*4+2]=q.z; v[i*4+3]=q.w; }
  } else {
    float* src = hout_ptr(p, row);
#pragma unroll
    for (int i = 0; i < 4; i++) { float4 q = *(const float4*)(src + i * 256 + lane * 4); v[i*4]=q.x; v[i*4+1]=q.y; v[i*4+2]=q.z; v[i*4+3]=q.w; }
    float s = 0.f;
#pragma unroll
    for (int i = 0; i < 16; i++) s += v[i];
    float mean = wavesum(s) * (1.f / 1024.f);
    float q2 = 0.f;
#pragma unroll
    for (int i = 0; i < 16; i++) { v[i] -= mean; q2 += v[i] * v[i]; }
    float rstd = rsqrtf(wavesum(q2) * (1.f / 1024.f) + 1e-5f);
    const float* lw = p.in[34] + layer * 1024; const float* lb = p.in[35] + layer * 1024;
#pragma unroll
    for (int i = 0; i < 4; i++) {
      float4 w4 = *(const float4*)(lw + i * 256 + lane * 4), b4 = *(const float4*)(lb + i * 256 + lane * 4);
      v[i*4] = v[i*4] * rstd * w4.x + b4.x; v[i*4+1] = v[i*4+1] * rstd * w4.y + b4.y;
      v[i*4+2] = v[i*4+2] * rstd * w4.z + b4.z; v[i*4+3] = v[i*4+3] * rstd * w4.w + b4.w;
      *(float4*)(src + i * 256 + lane * 4) = make_float4(v[i*4], v[i*4+1], v[i*4+2], v[i*4+3]);
    }
    if (layer == 1) return;
  }
  int ml = mode == 0 ? 0 : 1;
  float s = 0.f;
#pragma unroll
  for (int i = 0; i < 16; i++) s += v[i];
  float mean = wavesum(s) * (1.f / 1024.f);
  float q2 = 0.f;
#pragma unroll
  for (int i = 0; i < 16; i++) { v[i] -= mean; q2 += v[i] * v[i]; }
  float rstd = rsqrtf(wavesum(q2) * (1.f / 1024.f) + 1e-5f);
  const float* md = (const float*)(p.ws + OFF_MODS) + ((size_t)ml * 9 + modrow_of(row)) * 3072;
  u16* up = (u16*)(p.ws + OFF_U) + (size_t)row * 1024;
#pragma unroll
  for (int i = 0; i < 4; i++) {
    float4 sh = *(const float4*)(md + i * 256 + lane * 4), sc = *(const float4*)(md + 1024 + i * 256 + lane * 4);
    st4bf(up + i * 256 + lane * 4, v[i*4] * rstd * (1.f + sc.x) + sh.x, v[i*4+1] * rstd * (1.f + sc.y) + sh.y,
          v[i*4+2] * rstd * (1.f + sc.z) + sh.z, v[i*4+3] * rstd * (1.f + sc.w) + sh.w);
  }
}

#define STAGE_LOAD(P, kk_) do { const unsigned k_ = (kk_); \
  P##a0 = *(const uint4*)(A + (oa + k_)); P##a1 = *(const uint4*)(A + (oa + sa + k_)); \
  P##a2 = *(const uint4*)(A + (oa + 2 * sa + k_)); P##a3 = *(const uint4*)(A + (oa + 3 * sa + k_)); \
  P##b0 = *(const uint4*)(B + (ob + k_)); P##b1 = *(const uint4*)(B + (ob + sb + k_)); \
  if (NT == 4) { P##b2 = *(const uint4*)(B + (ob + 2 * sb + k_)); P##b3 = *(const uint4*)(B + (ob + 3 * sb + k_)); } } while (0)
#define STAGE_WRITE(P, Asw, Bsw) do { \
  *(uint4*)(Asw) = P##a0; *(uint4*)((Asw) + 32 * 72) = P##a1; *(uint4*)((Asw) + 64 * 72) = P##a2; *(uint4*)((Asw) + 96 * 72) = P##a3; \
  *(uint4*)(Bsw) = P##b0; *(uint4*)((Bsw) + 32 * 72) = P##b1; \
  if (NT == 4) { *(uint4*)((Bsw) + 64 * 72) = P##b2; *(uint4*)((Bsw) + 96 * 72) = P##b3; } } while (0)
template <int MT, int NT>
__device__ __forceinline__ void stage_compute(f32x4 (&acc)[MT][NT], const u16* As, const u16* Bs, int lane, int wm, int wn) {
#pragma unroll
  for (int kk = 0; kk < 2; kk++) {
    bf16x8 af[MT], bfr[NT];
#pragma unroll
    for (int mt = 0; mt < MT; mt++) af[mt] = *(const bf16x8*)(As + (wm * MT * 16 + mt * 16 + (lane & 15)) * 72 + kk * 32 + (lane >> 4) * 8);
#pragma unroll
    for (int nt = 0; nt < NT; nt++) bfr[nt] = *(const bf16x8*)(Bs + (wn * NT * 16 + nt * 16 + (lane & 15)) * 72 + kk * 32 + (lane >> 4) * 8);
    __builtin_amdgcn_s_setprio(1);
#pragma unroll
    for (int mt = 0; mt < MT; mt++)
#pragma unroll
      for (int nt = 0; nt < NT; nt++)
        acc[mt][nt] = __builtin_amdgcn_mfma_f32_16x16x32_bf16(af[mt], bfr[nt], acc[mt][nt], 0, 0, 0);
    __builtin_amdgcn_s_setprio(0);
  }
}
template <int MT, int NT>
__device__ __forceinline__ void gemm_kloop(f32x4 (&acc)[MT][NT], const u16* __restrict__ A, int lda,
                                           const u16* __restrict__ B, int ldb, int K, u16* lds) {
  static_assert(MT == 4, "MT");
  constexpr int BM = MT * 32, BN = NT * 32, SS = (BM + BN) * 72;
  const int t = tid_(), lane = t & 63, w = t >> 6, wm = w >> 1, wn = w & 1;
  u16* As0 = lds; u16* Bs0 = lds + BM * 72; u16* As1 = lds + SS; u16* Bs1 = lds + SS + BM * 72;
  const int lr = t >> 3, lc = (t & 7) * 8;
  const unsigned oa = (unsigned)(lr * lda + lc), ob = (unsigned)(lr * ldb + lc);
  const unsigned sa = 32u * (unsigned)lda, sb = 32u * (unsigned)ldb;
  const int swo = lr * 72 + lc;
  const unsigned klast = (unsigned)(K - 64);
  uint4 R0a0, R0a1, R0a2, R0a3, R0b0, R0b1, R0b2, R0b3, R1a0, R1a1, R1a2, R1a3, R1b0, R1b1, R1b2, R1b3;
  STAGE_LOAD(R0, 0u);
  STAGE_LOAD(R1, 64u);
  __syncthreads();
  STAGE_WRITE(R0, As0 + swo, Bs0 + swo);
  STAGE_LOAD(R0, 128u < klast ? 128u : klast);
  __syncthreads();
#pragma unroll 1
  for (int k0 = 0; k0 < K; k0 += 128) {
    STAGE_WRITE(R1, As1 + swo, Bs1 + swo);
    { unsigned kn = (unsigned)k0 + 192u; STAGE_LOAD(R1, kn < klast ? kn : klast); }
    stage_compute<MT, NT>(acc, As0, Bs0, lane, wm, wn);
    __syncthreads();
    STAGE_WRITE(R0, As0 + swo, Bs0 + swo);
    { unsigned kn = (unsigned)k0 + 256u; STAGE_LOAD(R0, kn < klast ? kn : klast); }
    stage_compute<MT, NT>(acc, As1, Bs1, lane, wm, wn);
    __syncthreads();
  }
}
template <int MT, int NT>
__device__ __forceinline__ void zero_acc(f32x4 (&acc)[MT][NT]) {
#pragma unroll
  for (int i = 0; i < MT; i++)
#pragma unroll
    for (int j = 0; j < NT; j++) acc[i][j] = (f32x4){0.f, 0.f, 0.f, 0.f};
}
__device__ __forceinline__ int tile_m0(int latonly, int tm) {
  if (!latonly) return tm * 128;
  int b = tm >> 4; return b * TT + 256 + (tm & 15) * 128;
}

__device__ __forceinline__ bool xcd_tile(int it, int bid, int nb, int NTM, int NTN, int G, int& tm, int& tn) {
  const int xcd = bid & 7, lb = bid >> 3, nlb = nb >> 3, tmx = NTM >> 3;
  const int idx = it * nlb + lb;
  if (idx >= tmx * NTN) return false;
  const int full = tmx / G;
  int g = idx / (G * NTN);
  if (g > full) g = full;
  const int r = idx - g * G * NTN;
  const int gs = (g < full) ? G : (tmx - full * G);
  tn = r / gs;
  tm = xcd * tmx + g * G + (r - tn * gs);
  return true;
}
__device__ void inproj_tile(const Params& p, int layer, int tm, int tn, u16* lds) {
  int m0 = tm * 128, n0 = tn * 128;
  f32x4 acc[4][4]; zero_acc(acc);
  gemm_kloop<4, 4>(acc, (const u16*)(p.ws + OFF_U) + (size_t)m0 * 1024, 1024,
                   (const u16*)(p.ws + OFF_WINT) + (size_t)n0 * 1024, 1024, 1024, lds);
  const int t = tid_(), lane = t & 63, w = t >> 6, wm = w >> 1, wn = w & 1;
  const float* bias = p.in[7] + (size_t)layer * DIN;
  u16* proj = (u16*)(p.ws + OFF_PROJ);
#pragma unroll
  for (int nt = 0; nt < 4; nt++) {
    const int cl = wn * 64 + nt * 16 + (lane & 15);
    const float bv = (n0 + cl < PC) ? bias[n0 + cl] : 0.f;
#pragma unroll
    for (int mt = 0; mt < 4; mt++)
#pragma unroll
      for (int r = 0; r < 4; r++) lds[(wm * 64 + mt * 16 + (lane >> 4) * 4 + r) * 136 + cl] = f2bf(acc[mt][nt][r] + bv);
  }
  __syncthreads();
#pragma unroll
  for (int i = 0; i < 8; i++) {
    const int q = t + 256 * i, row = q >> 4, ch = q & 15;
    if (n0 + ch * 8 < PC) *(uint4*)(proj + (size_t)(m0 + row) * PC + n0 + ch * 8) = *(const uint4*)(lds + row * 136 + ch * 8);
  }
}
__device__ void glu_tile(const Params& p, int layer, int latonly, int tm, int tn, u16* lds) {
  int m0 = tile_m0(latonly, tm), n0 = tn * 128;
  f32x4 acc[4][4]; zero_acc(acc);
  u16* proj = (u16*)(p.ws + OFF_PROJ);
  gemm_kloop<4, 4>(acc, proj + (size_t)m0 * PC + C_S5U, PC, (const u16*)(p.ws + OFF_GLUT) + (size_t)n0 * 256, 256, 256, lds);
  const int t = tid_(), lane = t & 63, w = t >> 6, wm = w >> 1, wn = w & 1;
  const float* bias = p.in[17] + layer * 256;
#pragma unroll
  for (int nt = 0; nt < 4; nt++) {
    const int cl = wn * 64 + nt * 16 + (lane & 15);
    const float bv = bias[n0 + cl];
#pragma unroll
    for (int mt = 0; mt < 4; mt++)
#pragma unroll
      for (int r = 0; r < 4; r++) lds[(wm * 64 + mt * 16 + (lane >> 4) * 4 + r) * 136 + cl] = f2bf(sigmoidf_(acc[mt][nt][r] + bv));
  }
  __syncthreads();
#pragma unroll
  for (int i = 0; i < 8; i++) {
    const int q = t + 256 * i, row = q >> 4, ch = q & 15;
    u16* pr = proj + (size_t)(m0 + row) * PC + n0 + ch * 8;
    uint4 sg = *(const uint4*)(lds + row * 136 + ch * 8);
    uint4 yy = *(const uint4*)(pr + C_S5U), zz = *(const uint4*)(pr + C_S5Z), oo;
    const unsigned* sgp = (const unsigned*)&sg; const unsigned* yp = (const unsigned*)&yy; const unsigned* zp = (const unsigned*)&zz; unsigned* op = (unsigned*)&oo;
#pragma unroll
    for (int e = 0; e < 4; e++) {
      float s0 = __uint_as_float(sgp[e] << 16), s1 = __uint_as_float(sgp[e] & 0xffff0000u);
      float y0 = __uint_as_float(yp[e] << 16), y1 = __uint_as_float(yp[e] & 0xffff0000u);
      float z0 = __uint_as_float(zp[e] << 16), z1 = __uint_as_float(zp[e] & 0xffff0000u);
      op[e] = pack2(y0 * s0 * siluf_(z0), y1 * s1 * siluf_(z1));
    }
    *(uint4*)(pr + C_S5Z) = oo;
  }
}
__device__ void merge_tile(const Params& p, int layer, int latonly, int tm, int tn, u16* lds) {
  int m0 = tile_m0(latonly, tm), n0 = tn * 64;
  f32x4 accm[4][2]; zero_acc(accm);
  const u16* proj = (const u16*)(p.ws + OFF_PROJ);
  const int lane = tid_() & 63, w = tid_() >> 6, wm = w >> 1, wn = w & 1;
  const float* bias = p.in[7] + (size_t)layer * DIN + PC;
#pragma unroll 1
  for (int k = 0; k < 4; k++) {
    const int ycol = k == 0 ? C_S5Z : (k == 1 ? C_HGQ : (k == 2 ? C_RTQ : C_RWZ));
    f32x4 accb[4][2]; zero_acc(accb);
    gemm_kloop<4, 2>(accb, proj + (size_t)m0 * PC + ycol, PC,
                     (const u16*)(p.ws + OFF_WBT) + ((size_t)k * 1024 + n0) * 256, 256, 256, lds);
    f32x4 accg[4][2]; zero_acc(accg);
    gemm_kloop<4, 2>(accg, (const u16*)(p.ws + OFF_U) + (size_t)m0 * 1024, 1024,
                     (const u16*)(p.ws + OFF_WINT) + ((size_t)PC + k * 1024 + n0) * 1024, 1024, 1024, lds);
#pragma unroll
    for (int nt = 0; nt < 2; nt++) {
      float bv = bias[k * 1024 + n0 + wn * 32 + nt * 16 + (lane & 15)];
#pragma unroll
      for (int mt = 0; mt < 4; mt++)
#pragma unroll
        for (int r = 0; r < 4; r++) accm[mt][nt][r] += sigmoidf_(accg[mt][nt][r] + bv) * accb[mt][nt][r];
    }
  }
  u16* mg = (u16*)(p.ws + OFF_SCR);
#pragma unroll
  for (int nt = 0; nt < 2; nt++) {
    const int cl = wn * 32 + nt * 16 + (lane & 15);
#pragma unroll
    for (int mt = 0; mt < 4; mt++)
#pragma unroll
      for (int r = 0; r < 4; r++) lds[(wm * 64 + mt * 16 + (lane >> 4) * 4 + r) * 72 + cl] = f2bf(accm[mt][nt][r]);
  }
  __syncthreads();
  {
    const int t = tid_();
#pragma unroll
    for (int i = 0; i < 4; i++) {
      const int q = t + 256 * i, row = q >> 3, ch = q & 7;
      *(uint4*)(mg + (size_t)(m0 + row) * 1024 + n0 + ch * 8) = *(const uint4*)(lds + row * 72 + ch * 8);
    }
  }
}
__device__ void outproj_tile(const Params& p, int layer, int latonly, int tm, int tn, u16* lds) {
  int m0 = tile_m0(latonly, tm), n0 = tn * 128;
  f32x4 acc[4][4]; zero_acc(acc);
  gemm_kloop<4, 4>(acc, (const u16*)(p.ws + OFF_SCR) + (size_t)m0 * 1024, 1024,
                   (const u16*)(p.ws + OFF_WOT) + (size_t)n0 * 1024, 1024, 1024, lds);
  const int lane = tid_() & 63, w = tid_() >> 6, wm = w >> 1, wn = w & 1;
  const float* bias = p.in[33] + layer * 1024;
  const float* hi0 = hin_ptr(p, layer, m0);
  float* ho0 = hout_ptr(p, m0);
  const float* gate = (const float*)(p.ws + OFF_MODS) + ((size_t)layer * 9 + modrow_of(m0)) * 3072 + 2048;
  float* cs = (float*)lds;
#pragma unroll
  for (int nt = 0; nt < 4; nt++) {
    const int cl = wn * 64 + nt * 16 + (lane & 15);
    const float bv = bias[n0 + cl];
#pragma unroll
    for (int mt = 0; mt < 4; mt++)
#pragma unroll
      for (int r = 0; r < 4; r++) cs[(wm * 64 + mt * 16 + (lane >> 4) * 4 + r) * 132 + cl] = acc[mt][nt][r] + bv;
  }
  __syncthreads();
  {
    const int t = tid_();
#pragma unroll 4
    for (int i = 0; i < 16; i++) {
      const int q = t + 256 * i, row = q >> 5, ch = q & 31;
      const float4 a4 = *(const float4*)(cs + row * 132 + ch * 4);
      const float4 g4 = *(const float4*)(gate + n0 + ch * 4);
      const float4 h4 = *(const float4*)(hi0 + (size_t)row * 1024 + n0 + ch * 4);
      float4 o4;
      o4.x = 1.4142135623730951f * h4.x + g4.x * a4.x; o4.y = 1.4142135623730951f * h4.y + g4.y * a4.y;
      o4.z = 1.4142135623730951f * h4.z + g4.z * a4.z; o4.w = 1.4142135623730951f * h4.w + g4.w * a4.w;
      *(float4*)(ho0 + (size_t)row * 1024 + n0 + ch * 4) = o4;
    }
  }
}

template <bool TWO>
__device__ void rwkv_scan_task(const Params& p, int layer, int task, float* lds) {
  const int t = tid_();
  const int rh = TWO ? (task & 1) : (task & 3), h = TWO ? ((task >> 1) & 3) : ((task >> 2) & 3);
  const int b = TWO ? ((task >> 3) & 7) : ((task >> 4) & 7), d = TWO ? (task >> 6) : (task >> 7);
  constexpr int RPB = TWO ? 32 : 16;
  float* sh_lora = lds;
  float* sh_w2 = sh_lora + 512;
  float* sh_a2 = sh_w2 + 1024;
  float* sh_r = sh_a2 + 1024;
  float* sh_w = sh_r + 1024;
  float* sh_k = sh_w + 1024;
  float* sh_kk = sh_k + 1024;
  float* sh_b = sh_kk + 1024;
  float* sh_v = sh_b + 1024;
  float* sh_o = sh_v + 512;
  const u16* proj = (const u16*)(p.ws + OFF_PROJ);
  u16* rwo = (u16*)(p.ws + OFF_RWO) + (size_t)d * MROWS * 256;
  float* bonus = (float*)(p.ws + OFF_BONUS) + (size_t)d * MROWS * 4;
  const float* mu0 = p.in[21] + (size_t)layer * 2 * 832;
  const float* mu1 = mu0 + 832;
  __syncthreads();
  for (int i = t; i < 1024; i += 256) {
    int rr = i >> 6, c = i & 63;
    sh_w2[i] = p.in[23][(((size_t)layer * 2 + d) * 16 + rr) * 256 + h * 64 + c];
    sh_a2[i] = p.in[25][(((size_t)layer * 2 + d) * 16 + rr) * 256 + h * 64 + c];
  }
  const int pst = t >> 4, cq = t & 15;
  const int ch0 = h * 64 + cq * 4;
  float mur0[4], mur1[4], muk0[4], muk1[4], w0v[4], a0v[4], kkw[4], kaw[4], rkw[4];
#pragma unroll
  for (int i = 0; i < 4; i++) {
    mur0[i] = mu0[ch0 + i]; mur1[i] = mu1[ch0 + i];
    muk0[i] = mu0[256 + ch0 + i]; muk1[i] = mu1[256 + ch0 + i];
    w0v[i] = p.in[22][((size_t)layer * 2 + d) * 256 + ch0 + i];
    a0v[i] = p.in[24][((size_t)layer * 2 + d) * 256 + ch0 + i];
    kkw[i] = p.in[26][layer * 256 + ch0 + i];
    kaw[i] = p.in[27][layer * 256 + ch0 + i];
    rkw[i] = p.in[28][layer * 256 + ch0 + i];
  }
  const int vch = 512 + h * 64 + rh * RPB + cq;
  const float muv0 = mu0[vch], muv1 = mu1[vch], muw0 = TWO ? mu0[vch + 16] : 0.f, muw1 = TWO ? mu1[vch + 16] : 0.f;
  const int lidx0 = t * 2;
  float lmu00, lmu01, lmu10, lmu11;
  {
    int q = lidx0 & 31;
    int col = q < 16 ? (768 + d * 16 + q) : (800 + d * 16 + (q - 16));
    lmu00 = mu0[col]; lmu01 = mu0[col + 1]; lmu10 = mu1[col]; lmu11 = mu1[col + 1];
  }
  const int rl = t >> 4, ks = t & 15;
  float4 S = make_float4(0.f, 0.f, 0.f, 0.f), S2 = make_float4(0.f, 0.f, 0.f, 0.f);
  unsigned lx0 = 0, lx1 = 0, lxp0 = 0, lxp1 = 0, lxn0 = 0, lxn1 = 0;
  uint2 rr_c, rr_p, rr_n, rk_c, rk_p, rk_n;
  unsigned rv_c, rv_p, rv_n, rw_c = 0, rw_p = 0, rw_n = 0;
  auto fetch = [&](int s0) {
    {
      int st2 = lidx0 >> 5, q = lidx0 & 31;
      int j = jmap(d, s0 + st2);
      int col = q < 16 ? (768 + d * 16 + q) : (800 + d * 16 + (q - 16));
      const u16* pr = proj + ((size_t)(b * TT + j)) * PC + C_RWX + col;
      const u16* prp = has_prev(j) ? pr - PC : pr;
      const u16* prn = has_next(j) ? pr + PC : pr;
      lx0 = pr[0]; lx1 = pr[1]; lxp0 = prp[0]; lxp1 = prp[1]; lxn0 = prn[0]; lxn1 = prn[1];
    }
    int j = jmap(d, s0 + pst);
    const u16* pr = proj + ((size_t)(b * TT + j)) * PC + C_RWX;
    const u16* prp = has_prev(j) ? pr - PC : pr;
    const u16* prn = has_next(j) ? pr + PC : pr;
    rr_c = *(const uint2*)(pr + ch0); rr_p = *(const uint2*)(prp + ch0); rr_n = *(const uint2*)(prn + ch0);
    rk_c = *(const uint2*)(pr + 256 + ch0); rk_p = *(const uint2*)(prp + 256 + ch0); rk_n = *(const uint2*)(prn + 256 + ch0);
    rv_c = pr[vch]; rv_p = prp[vch]; rv_n = prn[vch];
    if (TWO) { rw_c = pr[vch + 16]; rw_p = prp[vch + 16]; rw_n = prn[vch + 16]; }
  };
  auto unpack4 = [](uint2 v, float (&o)[4]) {
    o[0] = __uint_as_float(v.x << 16); o[1] = __uint_as_float(v.x & 0xffff0000u);
    o[2] = __uint_as_float(v.y << 16); o[3] = __uint_as_float(v.y & 0xffff0000u);
  };
  fetch(0);
  for (int s0 = 0; s0 < TT; s0 += 16) {
    {
      int st2 = lidx0 >> 5, q = lidx0 & 31;
      int ja = jmap(d, s0 + st2);
      const float hpa = has_prev(ja) ? 1.f : 0.f, hna = has_next(ja) ? 1.f : 0.f;
      float x0 = __uint_as_float(lx0 << 16), x1 = __uint_as_float(lx1 << 16);
      float xs0 = x0 + lmu00 * (__uint_as_float(lxp0 << 16) * hpa - x0) + lmu10 * (__uint_as_float(lxn0 << 16) * hna - x0);
      float xs1 = x1 + lmu01 * (__uint_as_float(lxp1 << 16) * hpa - x1) + lmu11 * (__uint_as_float(lxn1 << 16) * hna - x1);
      if (q < 16) {
        xs0 = 1.f - 2.f * __builtin_amdgcn_rcpf(__expf(2.f * xs0) + 1.f);
        xs1 = 1.f - 2.f * __builtin_amdgcn_rcpf(__expf(2.f * xs1) + 1.f);
      }
      *(float2*)(sh_lora + lidx0) = make_float2(xs0, xs1);
    }
    __syncthreads();
    const int jcur = jmap(d, s0 + pst);
    {
      const float hpf = has_prev(jcur) ? 1.f : 0.f, hnf = has_next(jcur) ? 1.f : 0.f;
      float r4[4], k4[4], t0[4], t1[4];
      unpack4(rr_c, r4); unpack4(rr_p, t0); unpack4(rr_n, t1);
#pragma unroll
      for (int i = 0; i < 4; i++) r4[i] = r4[i] + mur0[i] * (t0[i] * hpf - r4[i]) + mur1[i] * (t1[i] * hnf - r4[i]);
      unpack4(rk_c, k4); unpack4(rk_p, t0); unpack4(rk_n, t1);
#pragma unroll
      for (int i = 0; i < 4; i++) k4[i] = k4[i] + muk0[i] * (t0[i] * hpf - k4[i]) + muk1[i] * (t1[i] * hnf - k4[i]);
      float wl[4], al[4];
#pragma unroll
      for (int i = 0; i < 4; i++) { wl[i] = w0v[i]; al[i] = a0v[i]; }
      float lrow[32];
#pragma unroll
      for (int i4 = 0; i4 < 8; i4++) {
        float4 q4 = *(const float4*)(sh_lora + pst * 32 + i4 * 4);
        lrow[i4 * 4] = q4.x; lrow[i4 * 4 + 1] = q4.y; lrow[i4 * 4 + 2] = q4.z; lrow[i4 * 4 + 3] = q4.w;
      }
#pragma unroll
      for (int rr = 0; rr < 16; rr++) {
        float lw_ = lrow[rr], la_ = lrow[16 + rr];
        float4 w2 = *(const float4*)(sh_w2 + rr * 64 + cq * 4);
        float4 a2 = *(const float4*)(sh_a2 + rr * 64 + cq * 4);
        wl[0] += lw_ * w2.x; wl[1] += lw_ * w2.y; wl[2] += lw_ * w2.z; wl[3] += lw_ * w2.w;
        al[0] += la_ * a2.x; al[1] += la_ * a2.y; al[2] += la_ * a2.z; al[3] += la_ * a2.w;
      }
      float wv[4], kd[4], kk[4], bb[4];
      float ss = 0.f, bon = 0.f;
#pragma unroll
      for (int i = 0; i < 4; i++) {
        float a = wl[i];
        float lw = fminf(a, 0.f) - __logf(1.f + __expf(-fabsf(a))) - 0.5f;
        wv[i] = __expf(-__expf(lw));
        float ic = sigmoidf_(al[i]);
        float kr = k4[i] * kkw[i];
        kk[i] = kr; ss += kr * kr;
        kd[i] = k4[i] * (1.f + (ic - 1.f) * kaw[i]);
        bb[i] = ic;
        bon += r4[i] * kd[i] * rkw[i];
      }
      ss = allsum16(ss); bon = allsum16(bon);
      float inv = rsqrtf(fmaxf(ss, 1e-24f));
#pragma unroll
      for (int i = 0; i < 4; i++) { kk[i] *= inv; bb[i] *= kk[i]; }
      *(float4*)(sh_r + pst * 64 + cq * 4) = make_float4(r4[0], r4[1], r4[2], r4[3]);
      *(float4*)(sh_w + pst * 64 + cq * 4) = make_float4(wv[0], wv[1], wv[2], wv[3]);
      *(float4*)(sh_k + pst * 64 + cq * 4) = make_float4(kd[0], kd[1], kd[2], kd[3]);
      *(float4*)(sh_kk + pst * 64 + cq * 4) = make_float4(kk[0], kk[1], kk[2], kk[3]);
      *(float4*)(sh_b + pst * 64 + cq * 4) = make_float4(bb[0], bb[1], bb[2], bb[3]);
      if (rh == 0 && cq == 0) bonus[(size_t)(b * TT + jcur) * 4 + h] = bon;
      float xv = __uint_as_float(rv_c << 16);
      sh_v[pst * 32 + cq] = xv + muv0 * (__uint_as_float(rv_p << 16) * hpf - xv) + muv1 * (__uint_as_float(rv_n << 16) * hnf - xv);
      float xw = __uint_as_float(rw_c << 16);
      if (TWO) sh_v[pst * 32 + 16 + cq] = xw + muw0 * (__uint_as_float(rw_p << 16) * hpf - xw) + muw1 * (__uint_as_float(rw_n << 16) * hnf - xw);
    }
    __syncthreads();
    if (s0 + 16 < TT) fetch(s0 + 16);
    float oacc = 0.f, oacc2 = 0.f;
    {
      float4 nkk = *(const float4*)(sh_kk + ks * 4), nw = *(const float4*)(sh_w + ks * 4), nb4 = *(const float4*)(sh_b + ks * 4);
      float4 nk = *(const float4*)(sh_k + ks * 4), nr = *(const float4*)(sh_r + ks * 4);
      float nv = sh_v[rl], nv2 = sh_v[16 + rl];
#pragma unroll 2
      for (int st = 0; st < 16; st++) {
        const float4 kk4 = nkk, w4 = nw, b4 = nb4, k4 = nk, r4 = nr; const float vv = nv, vv2 = nv2;
        {
          const int sn = (st + 1) & 15;
          nkk = *(const float4*)(sh_kk + sn * 64 + ks * 4); nw = *(const float4*)(sh_w + sn * 64 + ks * 4);
          nb4 = *(const float4*)(sh_b + sn * 64 + ks * 4); nk = *(const float4*)(sh_k + sn * 64 + ks * 4);
          nr = *(const float4*)(sh_r + sn * 64 + ks * 4); nv = sh_v[sn * 32 + rl]; nv2 = sh_v[sn * 32 + 16 + rl];
        }
        float sa = -((S.x * kk4.x + S.y * kk4.y) + (S.z * kk4.z + S.w * kk4.w));
        float sa2 = 0.f;
        if (TWO) sa2 = -((S2.x * kk4.x + S2.y * kk4.y) + (S2.z * kk4.z + S2.w * kk4.w));
        sa = allsum16(sa); if (TWO) sa2 = allsum16(sa2);
        S.x = S.x * w4.x + (sa * b4.x + vv * k4.x);
        S.y = S.y * w4.y + (sa * b4.y + vv * k4.y);
        S.z = S.z * w4.z + (sa * b4.z + vv * k4.z);
        S.w = S.w * w4.w + (sa * b4.w + vv * k4.w);
        if (TWO) {
          S2.x = S2.x * w4.x + (sa2 * b4.x + vv2 * k4.x);
          S2.y = S2.y * w4.y + (sa2 * b4.y + vv2 * k4.y);
          S2.z = S2.z * w4.z + (sa2 * b4.z + vv2 * k4.z);
          S2.w = S2.w * w4.w + (sa2 * b4.w + vv2 * k4.w);
        }
        float o = (S.x * r4.x + S.y * r4.y) + (S.z * r4.z + S.w * r4.w);
        float o2 = 0.f;
        if (TWO) o2 = (S2.x * r4.x + S2.y * r4.y) + (S2.z * r4.z + S2.w * r4.w);
        o = allsum16(o); if (TWO) o2 = allsum16(o2);
        oacc = (ks == st) ? o : oacc;
        oacc2 = (ks == st) ? o2 : oacc2;
      }
    }
    sh_o[ks * 32 + rl] = oacc;
    if (TWO) sh_o[ks * 32 + 16 + rl] = oacc2;
    __syncthreads();
    {
      u16* op = rwo + (size_t)(b * TT + jcur) * 256 + h * 64 + rh * RPB + cq;
      op[0] = f2bf(sh_o[pst * 32 + cq]);
      if (TWO) op[16] = f2bf(sh_o[pst * 32 + 16 + cq]);
    }
  }
}

__device__ void rwkv_combine_row(const Params& p, int layer, int row) {
  const int lane = tid_() & 63, h = tid_() >> 6;
  const int ch = h * 64 + lane;
  int b = row / TT, j = row - b * TT;
  const u16* rwo = (const u16*)(p.ws + OFF_RWO);
  float o = bf2f(rwo[(size_t)row * 256 + ch]) + bf2f(rwo[(size_t)MROWS * 256 + (size_t)row * 256 + ch]);
  float mean = wavesum(o) * (1.f / 64.f);
  float dlt = o - mean;
  float var = wavesum(dlt * dlt) * (1.f / 64.f);
  float on = dlt * rsqrtf(var + 64e-5f) * p.in[29][layer * 256 + ch] + p.in[30][layer * 256 + ch];
  u16* proj = (u16*)(p.ws + OFF_PROJ);
  u16* pr = proj + (size_t)row * PC;
  const float* mu0 = p.in[21] + (size_t)layer * 2 * 832; const float* mu1 = mu0 + 832;
  int vc = C_RWX + 512 + ch;
  float xv = bf2f(pr[vc]);
  float xvp = has_prev(j) ? bf2f(pr[vc - PC]) : 0.f;
  float xvn = has_next(j) ? bf2f(pr[vc + PC]) : 0.f;
  float v = xv + mu0[512 + ch] * (xvp - xv) + mu1[512 + ch] * (xvn - xv);
  const float* bonus = (const float*)(p.ws + OFF_BONUS);
  float bs = bonus[(size_t)row * 4 + h] + bonus[(size_t)MROWS * 4 + (size_t)row * 4 + h];
  float z = bf2f(pr[C_RWZ + ch]);
  pr[C_RWZ + ch] = f2bf((on + bs * v) * siluf_(z));
}

template <int MX, int PASS>
__device__ __forceinline__ void gla_sweep(const Params& p, int layer, int d, int b, int h, int c, float* lds) {
  const int t = tid_(), w = t >> 6, lane = t & 63;
  float* kbuf = lds;
  float* fbuf = kbuf + 1024;
  float* qbuf = fbuf + 1024;
  float* vbuf = qbuf + 1024;
  float* part = vbuf + 1024;
  u16* proj = (u16*)(p.ws + OFF_PROJ);
  const int dbh = (d * 8 + b) * 4 + h;
  float* stt = (float*)(p.ws + (MX == 0 ? OFF_HGST : OFF_RTST)) + ((size_t)dbh * 9 + c) * 4096;
  float S[16];
#pragma unroll
  for (int i = 0; i < 16; i++) S[i] = PASS == 1 ? 0.f : stt[(w * 16 + i) * 64 + lane];
  float gam = 1.f;
  if (MX == 1) gam = __expf(-__expf(p.in[20][((size_t)layer * 2 + d) * 4 + h]));
  float Pl = 1.f;
  const int pst = t >> 4, c4 = (t & 15) * 4;
  float lb4[4] = {0.f, 0.f, 0.f, 0.f};
  if (MX == 0 && layer == 1) {
#pragma unroll
    for (int i = 0; i < 4; i++) {
      float l0 = p.in[18][(0 * 2 + d) * 256 + h * 64 + c4 + i], l1 = p.in[18][(1 * 2 + d) * 256 + h * 64 + c4 + i];
      float mx = fmaxf(l0, l1);
      float e0 = __expf(l0 - mx), e1 = __expf(l1 - mx);
      lb4[i] = e1 / (e0 + e1);
    }
  }
  const int vcol0 = (MX == 0 ? C_HGI : C_RTV) + h * 64;
  const float* rope = (const float*)(p.ws + OFF_ROPE);
  uint2 r_a, r_b, r_c, r_d, r_v; float4 r_cs0, r_cs1;
  r_a = r_b = r_c = r_d = r_v = make_uint2(0u, 0u); r_cs0 = r_cs1 = make_float4(1.f, 0.f, 1.f, 0.f);
  auto fetch = [&](int s0) {
    int j = jmap(d, s0 + pst);
    const u16* pr = proj + (size_t)(b * TT + j) * PC;
    r_v = *(const uint2*)(pr + vcol0 + c4);
    if (MX == 0) {
      r_a = *(const uint2*)(pr + C_HGF + d * 256 + h * 64 + c4);
      if (PASS == 2) r_b = *(const uint2*)(pr + C_HGQ + h * 64 + c4);
    } else {
      r_a = *(const uint2*)(pr + C_RTK + h * 64 + c4);
      r_c = *(const uint2*)(pr + C_RTK + h * 64 + (c4 ^ 16));
      if (PASS == 2) { r_b = *(const uint2*)(pr + C_RTQ + h * 64 + c4); r_d = *(const uint2*)(pr + C_RTQ + h * 64 + (c4 ^ 16)); }
      if (j >= 256) {
        int tl = j - 256;
        int pos = (c4 & 32) ? (tl & 63) : (tl >> 6);
        const float* rp = rope + (pos * 16 + (c4 & 15)) * 2;
        r_cs0 = *(const float4*)rp; r_cs1 = *(const float4*)(rp + 4);
      } else { r_cs0 = make_float4(1.f, 0.f, 1.f, 0.f); r_cs1 = r_cs0; }
    }
  };
  auto unpack4 = [](uint2 v, float (&o)[4]) {
    o[0] = __uint_as_float(v.x << 16); o[1] = __uint_as_float(v.x & 0xffff0000u);
    o[2] = __uint_as_float(v.y << 16); o[3] = __uint_as_float(v.y & 0xffff0000u);
  };
  u16* ofp; int ofs;
  if (MX == 0) { ofp = proj + C_HGF + h * 64 + lane; ofs = PC; }
  else { ofp = (u16*)(p.ws + OFF_RETOF) + h * 64 + lane; ofs = 256; }
  const int zcol = (MX == 0 ? C_HGZ : C_RTZ) + h * 64 + lane;
  const int ycol = (MX == 0 ? C_HGQ : C_RTQ) + h * 64 + lane;
  float normw = 1.f;
  if (MX == 0 && PASS == 2) normw = p.in[19][layer * 256 + h * 64 + lane];
  fetch(c * 256);
  for (int sub = 0; sub < 16; sub++) {
    const int s0 = c * 256 + sub * 16;
    __syncthreads();
    {
      float va[4], vb[4], vc[4], vd[4], vv4[4];
      unpack4(r_a, va); unpack4(r_v, vv4);
      *(float4*)(vbuf + pst * 64 + c4) = make_float4(vv4[0], vv4[1], vv4[2], vv4[3]);
      if (MX == 0) {
        float f[4], k[4];
#pragma unroll
        for (int i = 0; i < 4; i++) { f[i] = lb4[i] + (1.f - lb4[i]) * sigmoidf_(va[i]); k[i] = 1.f - f[i]; }
        *(float4*)(kbuf + pst * 64 + c4) = make_float4(k[0], k[1], k[2], k[3]);
        *(float4*)(fbuf + pst * 64 + c4) = make_float4(f[0], f[1], f[2], f[3]);
        if (PASS == 2) {
          unpack4(r_b, vb);
          *(float4*)(qbuf + pst * 64 + c4) = make_float4(siluf_(vb[0]), siluf_(vb[1]), siluf_(vb[2]), siluf_(vb[3]));
        }
      } else {
        unpack4(r_c, vc);
        float cs[8] = {r_cs0.x, r_cs0.y, r_cs0.z, r_cs0.w, r_cs1.x, r_cs1.y, r_cs1.z, r_cs1.w};
        float sgn = (c4 & 16) ? 1.f : -1.f;
#pragma unroll
        for (int i = 0; i < 4; i++) va[i] = (va[i] * cs[2 * i] + sgn * vc[i] * cs[2 * i + 1]) * 0.125f;
        *(float4*)(kbuf + pst * 64 + c4) = make_float4(va[0], va[1], va[2], va[3]);
        if (PASS == 2) {
          unpack4(r_b, vb); unpack4(r_d, vd);
#pragma unroll
          for (int i = 0; i < 4; i++) vb[i] = vb[i] * cs[2 * i] + sgn * vd[i] * cs[2 * i + 1];
          *(float4*)(qbuf + pst * 64 + c4) = make_float4(vb[0], vb[1], vb[2], vb[3]);
        }
      }
    }
    __syncthreads();
    if (sub + 1 < 16) fetch(s0 + 16);
    u16 pf_o[4], pf_z[4];
    if (PASS == 2 && d == 1) {
#pragma unroll
      for (int e = 0; e < 4; e++) {
        size_t row = (size_t)(b * TT + jmap(d, s0 + w * 4 + e));
        pf_o[e] = ofp[row * ofs]; pf_z[e] = proj[row * PC + zcol];
      }
    }
#pragma unroll 2
    for (int st = 0; st < 16; st++) {
      const float vv = vbuf[st * 64 + lane];
      float o = 0.f;
#pragma unroll
      for (int i4 = 0; i4 < 4; i4++) {
        float4 kv = *(const float4*)(kbuf + st * 64 + w * 16 + i4 * 4);
        float4 fv = make_float4(gam, gam, gam, gam);
        if (MX == 0) fv = *(const float4*)(fbuf + st * 64 + w * 16 + i4 * 4);
        S[i4*4]   = fv.x * S[i4*4]   + kv.x * vv;
        S[i4*4+1] = fv.y * S[i4*4+1] + kv.y * vv;
        S[i4*4+2] = fv.z * S[i4*4+2] + kv.z * vv;
        S[i4*4+3] = fv.w * S[i4*4+3] + kv.w * vv;
        if (PASS == 2) {
          float4 qv = *(const float4*)(qbuf + st * 64 + w * 16 + i4 * 4);
          o += S[i4*4] * qv.x + S[i4*4+1] * qv.y + S[i4*4+2] * qv.z + S[i4*4+3] * qv.w;
        }
      }
      if (MX == 0 && PASS == 1) { if (lane < 16) Pl *= fbuf[st * 64 + w * 16 + lane]; }
      if (PASS == 2) part[(w * 16 + st) * 64 + lane] = o;
    }
    if (PASS == 2) {
      __syncthreads();
#pragma unroll
      for (int e = 0; e < 4; e++) {
        int st = w * 4 + e;
        float o = part[(0 * 16 + st) * 64 + lane] + part[(1 * 16 + st) * 64 + lane] + part[(2 * 16 + st) * 64 + lane] + part[(3 * 16 + st) * 64 + lane];
        int j = jmap(d, s0 + st);
        size_t row = (size_t)(b * TT + j);
        if (d == 0) {
          ofp[row * ofs] = f2bf(o);
        } else {
          o += bf2f(pf_o[e]);
          float ss = wavesum(o * o);
          float y = o * rsqrtf(ss * (1.f / 64.f) + 1e-6f) * normw;
          proj[row * PC + ycol] = f2bf(y * siluf_(bf2f(pf_z[e])));
        }
      }
    }
  }
  if (PASS == 1) {
#pragma unroll
    for (int i = 0; i < 16; i++) stt[(w * 16 + i) * 64 + lane] = S[i];
    if (MX == 0 && lane < 16) ((float*)(p.ws + OFF_HGP))[((size_t)dbh * 9 + c) * 64 + w * 16 + lane] = Pl;
  }
}

#define RS 72
template <int PASS>
__device__ __forceinline__ void ret_sweep(const Params& p, int layer, int d, int b, int h, int nc, int cstep, u16* lds) {
  const int t = tid_(), lane = t & 63, w4 = t >> 6;
  u16* Qs = lds;
  u16* Ks = Qs + 64 * RS;
  u16* Kt = Ks + 64 * RS;
  u16* Vt = Kt + 64 * RS;
  u16* Vd = Vt + 64 * RS;
  u16* Ps = Vd + 64 * RS;
  u16* St = Ps + 64 * RS;
  u16* proj = (u16*)(p.ws + OFF_PROJ);
  const float* rope = (const float*)(p.ws + OFF_ROPE);
  const float lg = -__expf(p.in[20][((size_t)layer * 2 + d) * 4 + h]) * 1.4426950408889634f;
  const float g64 = exp2f(64.f * lg);
  const int dbh = (d * 8 + b) * 4 + h;
  float* stt = (float*)(p.ws + OFF_RTST) + ((size_t)dbh * 9 + cstep) * 4096;
  f32x4 accS[4];
#pragma unroll
  for (int nt = 0; nt < 4; nt++)
#pragma unroll
    for (int r = 0; r < 4; r++)
      accS[nt][r] = PASS == 1 ? 0.f : stt[(w4 * 16 + (lane >> 4) * 4 + r) * 64 + nt * 16 + (lane & 15)];
  uint4 rq[2], rqp[2], rk[2], rkp[2], rv[2];
  auto fetch = [&](int w) {
#pragma unroll
    for (int e = 0; e < 2; e++) {
      const int q = t + 256 * e, sl = q & 63, c8 = (q >> 6) * 8;
      const u16* pr = proj + (size_t)(b * TT + nc * 256 + w * 64 + sl) * PC + h * 64;
      rk[e] = *(const uint4*)(pr + C_RTK + c8); rkp[e] = *(const uint4*)(pr + C_RTK + (c8 ^ 16));
      rv[e] = *(const uint4*)(pr + C_RTV + c8);
      if (PASS == 2) { rq[e] = *(const uint4*)(pr + C_RTQ + c8); rqp[e] = *(const uint4*)(pr + C_RTQ + (c8 ^ 16)); }
    }
  };
  auto up = [](uint4 v, float (&o)[8]) {
    const unsigned* u = (const unsigned*)&v;
#pragma unroll
    for (int i = 0; i < 4; i++) { o[2 * i] = __uint_as_float(u[i] << 16); o[2 * i + 1] = __uint_as_float(u[i] & 0xffff0000u); }
  };
  fetch(d == 0 ? 0 : 3);
  for (int wi = 0; wi < 4; wi++) {
    const int w = d == 0 ? wi : 3 - wi;
    __syncthreads();
    if (PASS == 2 && wi == 0) {
#pragma unroll
      for (int nt = 0; nt < 4; nt++)
        *(uint2*)(St + (nt * 16 + (lane & 15)) * RS + w4 * 16 + (lane >> 4) * 4) =
            make_uint2(pack2(accS[nt][0], accS[nt][1]), pack2(accS[nt][2], accS[nt][3]));
    }
#pragma unroll
    for (int e = 0; e < 2; e++) {
      const int q = t + 256 * e, sl = q & 63, c8 = (q >> 6) * 8;
      const int j = nc * 256 + w * 64 + sl;
      float kx[8], kp[8], vx[8], qx[8], qp[8];
      up(rk[e], kx); up(rkp[e], kp); up(rv[e], vx);
      if (PASS == 2) { up(rq[e], qx); up(rqp[e], qp); }
      if (j >= 256) {
        const int tl = j - 256;
        const int pos = (c8 & 32) ? (tl & 63) : (tl >> 6);
        const float* rp = rope + (pos * 16 + (c8 & 15)) * 2;
        const float sgn = (c8 & 16) ? 1.f : -1.f;
#pragma unroll
        for (int i2 = 0; i2 < 4; i2++) {
          const float4 cs = *(const float4*)(rp + i2 * 4);
          kx[2 * i2] = kx[2 * i2] * cs.x + sgn * kp[2 * i2] * cs.y;
          kx[2 * i2 + 1] = kx[2 * i2 + 1] * cs.z + sgn * kp[2 * i2 + 1] * cs.w;
          if (PASS == 2) {
            qx[2 * i2] = qx[2 * i2] * cs.x + sgn * qp[2 * i2] * cs.y;
            qx[2 * i2 + 1] = qx[2 * i2 + 1] * cs.z + sgn * qp[2 * i2 + 1] * cs.w;
          }
        }
      }
      const float dec = exp2f((float)(d == 0 ? 63 - sl : sl) * lg);
      u16 kb[8];
#pragma unroll
      for (int i = 0; i < 8; i++) {
        kb[i] = f2bf(kx[i] * 0.125f);
        Kt[(c8 + i) * RS + sl] = kb[i];
        Vd[(c8 + i) * RS + sl] = f2bf(vx[i] * dec);
      }
      if (PASS == 2) {
        uint4 kk4, qq4;
        kk4.x = kb[0] | ((unsigned)kb[1] << 16); kk4.y = kb[2] | ((unsigned)kb[3] << 16);
        kk4.z = kb[4] | ((unsigned)kb[5] << 16); kk4.w = kb[6] | ((unsigned)kb[7] << 16);
        qq4.x = pack2(qx[0], qx[1]); qq4.y = pack2(qx[2], qx[3]); qq4.z = pack2(qx[4], qx[5]); qq4.w = pack2(qx[6], qx[7]);
        *(uint4*)(Ks + sl * RS + c8) = kk4;
        *(uint4*)(Qs + sl * RS + c8) = qq4;
        const unsigned short* vraw = (const unsigned short*)&rv[e];
#pragma unroll
        for (int i = 0; i < 8; i++) Vt[(c8 + i) * RS + sl] = vraw[i];
      }
    }
    __syncthreads();
    if (wi + 1 < 4) fetch(d == 0 ? wi + 1 : 2 - wi);
    if (PASS == 2) {
      f32x4 accP[4];
#pragma unroll
      for (int nt = 0; nt < 4; nt++) accP[nt] = (f32x4){0.f, 0.f, 0.f, 0.f};
      bf16x8 aq[2];
#pragma unroll
      for (int kk = 0; kk < 2; kk++) aq[kk] = *(const bf16x8*)(Qs + (w4 * 16 + (lane & 15)) * RS + kk * 32 + (lane >> 4) * 8);
#pragma unroll
      for (int kk = 0; kk < 2; kk++)
#pragma unroll
        for (int nt = 0; nt < 4; nt++) {
          bf16x8 bk = *(const bf16x8*)(Ks + (nt * 16 + (lane & 15)) * RS + kk * 32 + (lane >> 4) * 8);
          accP[nt] = __builtin_amdgcn_mfma_f32_16x16x32_bf16(aq[kk], bk, accP[nt], 0, 0, 0);
        }
#pragma unroll
      for (int nt = 0; nt < 4; nt++)
#pragma unroll
        for (int r = 0; r < 4; r++) {
          const int il = w4 * 16 + (lane >> 4) * 4 + r, sl = nt * 16 + (lane & 15);
          const int e = d == 0 ? il - sl : sl - il;
          const float f = e >= 0 ? exp2f((float)e * lg) : 0.f;
          Ps[il * RS + sl] = f2bf(accP[nt][r] * f);
        }
      __syncthreads();
      f32x4 accO[4], accI[4];
#pragma unroll
      for (int nt = 0; nt < 4; nt++) { accO[nt] = (f32x4){0.f, 0.f, 0.f, 0.f}; accI[nt] = (f32x4){0.f, 0.f, 0.f, 0.f}; }
#pragma unroll
      for (int kk = 0; kk < 2; kk++) {
        bf16x8 ap = *(const bf16x8*)(Ps + (w4 * 16 + (lane & 15)) * RS + kk * 32 + (lane >> 4) * 8);
#pragma unroll
        for (int nt = 0; nt < 4; nt++) {
          bf16x8 bv = *(const bf16x8*)(Vt + (nt * 16 + (lane & 15)) * RS + kk * 32 + (lane >> 4) * 8);
          accO[nt] = __builtin_amdgcn_mfma_f32_16x16x32_bf16(ap, bv, accO[nt], 0, 0, 0);
          bf16x8 bs = *(const bf16x8*)(St + (nt * 16 + (lane & 15)) * RS + kk * 32 + (lane >> 4) * 8);
          accI[nt] = __builtin_amdgcn_mfma_f32_16x16x32_bf16(aq[kk], bs, accI[nt], 0, 0, 0);
        }
      }
      u16* ofp = (u16*)(p.ws + OFF_RETOF);
#pragma unroll
      for (int r = 0; r < 4; r++) {
        const int il = w4 * 16 + (lane >> 4) * 4 + r;
        const size_t row = (size_t)(b * TT + nc * 256 + w * 64 + il);
        const float rho = exp2f((float)(d == 0 ? il + 1 : 64 - il) * lg);
        float o[4], ss = 0.f;
#pragma unroll
        for (int nt = 0; nt < 4; nt++) {
          o[nt] = accO[nt][r] + rho * accI[nt][r];
          if (d == 1) o[nt] += bf2f(ofp[row * 256 + h * 64 + nt * 16 + (lane & 15)]);
          ss += o[nt] * o[nt];
        }
        if (d == 0) {
#pragma unroll
          for (int nt = 0; nt < 4; nt++) ofp[row * 256 + h * 64 + nt * 16 + (lane & 15)] = f2bf(o[nt]);
        } else {
          ss = allsum16(ss);
          const float sc = rsqrtf(ss * (1.f / 64.f) + 1e-6f);
#pragma unroll
          for (int nt = 0; nt < 4; nt++) {
            const int cv = h * 64 + nt * 16 + (lane & 15);
            const float z = bf2f(proj[row * PC + C_RTZ + cv]);
            proj[row * PC + C_RTQ + cv] = f2bf(o[nt] * sc * siluf_(z));
          }
        }
      }
    }
#pragma unroll
    for (int nt = 0; nt < 4; nt++)
#pragma unroll
      for (int r = 0; r < 4; r++) accS[nt][r] *= g64;
#pragma unroll
    for (int kk = 0; kk < 2; kk++) {
      bf16x8 ak = *(const bf16x8*)(Kt + (w4 * 16 + (lane & 15)) * RS + kk * 32 + (lane >> 4) * 8);
#pragma unroll
      for (int nt = 0; nt < 4; nt++) {
        bf16x8 bv = *(const bf16x8*)(Vd + (nt * 16 + (lane & 15)) * RS + kk * 32 + (lane >> 4) * 8);
        accS[nt] = __builtin_amdgcn_mfma_f32_16x16x32_bf16(ak, bv, accS[nt], 0, 0, 0);
      }
    }
    __syncthreads();
    if (PASS == 2 && wi + 1 < 4) {
#pragma unroll
      for (int nt = 0; nt < 4; nt++)
        *(uint2*)(St + (nt * 16 + (lane & 15)) * RS + w4 * 16 + (lane >> 4) * 4) =
            make_uint2(pack2(accS[nt][0], accS[nt][1]), pack2(accS[nt][2], accS[nt][3]));
    }
  }
  if (PASS == 1) {
#pragma unroll
    for (int nt = 0; nt < 4; nt++)
#pragma unroll
      for (int r = 0; r < 4; r++) stt[(w4 * 16 + (lane >> 4) * 4 + r) * 64 + nt * 16 + (lane & 15)] = accS[nt][r];
  }
}
__device__ void gla_p1_task(const Params& p, int layer, int task, float* lds) {
  int c = task % 9; int q = task / 9; int h = q & 3; q >>= 2; int b = q & 7; q >>= 3; int d = q & 1; int mx = q >> 1;
  if (mx == 0) gla_sweep<0, 1>(p, layer, d, b, h, c, lds);
  else { const int nc = d == 0 ? c : (c == 0 ? 0 : 9 - c); ret_sweep<1>(p, layer, d, b, h, nc, c, (u16*)lds); }
}
__device__ void gla_p2_task(const Params& p, int layer, int mx, int b, int h, int nc, float* lds) {
  int cb = nc == 0 ? 0 : 9 - nc;
  if (mx == 0) { gla_sweep<0, 2>(p, layer, 0, b, h, nc, lds); __threadfence_block(); gla_sweep<0, 2>(p, layer, 1, b, h, cb, lds); }
  else { ret_sweep<2>(p, layer, 0, b, h, nc, nc, (u16*)lds); __threadfence_block(); ret_sweep<2>(p, layer, 1, b, h, nc, cb, (u16*)lds); }
}
__device__ void gla_carry_task(const Params& p, int layer, int task) {
  int e = task * 256 + tid_();
  int v = e & 63, k = (e >> 6) & 63, dbh = (e >> 12) & 63, mx = e >> 18;
  float* stt = (float*)(p.ws + (mx == 0 ? OFF_HGST : OFF_RTST)) + (size_t)dbh * 9 * 4096 + k * 64 + v;
  const float* P = (const float*)(p.ws + OFF_HGP) + (size_t)dbh * 9 * 64 + k;
  float pg = 1.f;
  if (mx == 1) { int d = dbh >> 5, h = dbh & 3; pg = __expf(-256.f * __expf(p.in[20][((size_t)layer * 2 + d) * 4 + h])); }
  float S = 0.f;
  for (int c = 0; c < 9; c++) {
    float E = stt[(size_t)c * 4096];
    stt[(size_t)c * 4096] = S;
    float pp = mx == 0 ? P[c * 64] : pg;
    S = pp * S + E;
  }
}

__device__ __forceinline__ int s5_bwd_chunk(int nc) { return nc < 4 ? 3 - nc : 39 - nc; }
template <int PASS>
__device__ void s5_task(const Params& p, int layer, int task, float* lds) {
  const int t = tid_(), w = t >> 6, lane = t & 63;
  int gq = task & 3; int q = task >> 2; int nc = q % 36; int b = q / 36;
  const int g = gq * 4 + w;
  float* ubuf = lds + w * 256;
  u16* hbuf = (u16*)(lds + 1024) + w * (16 * 136);
  float* ybuf = lds + 1024 + 4352 + w * 1024;
  u16* proj = (u16*)(p.ws + OFF_PROJ);
  float2* st5 = (float2*)(p.ws + OFF_S5ST);
  bf16x8 cfrag[4];
  if (PASS == 2) {
    const float* cre = p.in[13] + ((size_t)layer * 16 + g) * 16 * 64;
    const float* cim = p.in[14] + ((size_t)layer * 16 + g) * 16 * 64;
    int pp = lane & 15;
#pragma unroll
    for (int ks = 0; ks < 4; ks++)
#pragma unroll
      for (int i = 0; i < 8; i++) {
        int kidx = ks * 32 + (lane >> 4) * 8 + i; int n = kidx >> 1;
        float val = (kidx & 1) ? -cim[pp * 64 + n] : cre[pp * 64 + n];
        cfrag[ks][i] = (short)f2bf(val);
      }
  }
  for (int d = 0; d < 2; d++) {
    float lre = p.in[8][(((size_t)layer * 2 + d) * 16 + g) * 64 + lane];
    float lim = p.in[9][(((size_t)layer * 2 + d) * 16 + g) * 64 + lane];
    float dt = __expf(p.in[10][((size_t)layer * 2 + d) * 16 + g]);
    float mag = __expf(lre * dt);
    float sn, cs; sincosf(lim * dt, &sn, &cs);
    float are = mag * cs, aim = mag * sn;
    float den = 1.f / (lre * lre + lim * lim);
    float cre_ = ((are - 1.f) * lre + aim * lim) * den;
    float cim_ = (aim * lre - (are - 1.f) * lim) * den;
    float bbr[16], bbi[16];
    {
      const float* br = p.in[11] + (((size_t)layer * 16 + g) * 64 + lane) * 16;
      const float* bi = p.in[12] + (((size_t)layer * 16 + g) * 64 + lane) * 16;
#pragma unroll
      for (int i = 0; i < 16; i++) {
        float x = br[i], y = bi[i];
        bbr[i] = cre_ * x - cim_ * y; bbi[i] = cre_ * y + cim_ * x;
      }
    }
    int cstep = d == 0 ? nc : s5_bwd_chunk(nc);
    size_t sidx = ((((size_t)d * 8 + b) * 16 + g) * 36 + cstep) * 64 + lane;
    float hre = 0.f, him = 0.f;
    if (PASS == 2) { float2 h0 = st5[sidx]; hre = h0.x; him = h0.y; }
    uint2 ru;
    auto fetchu = [&](int sub) {
      int st = lane >> 2, p4 = (lane & 3) * 4;
      int jl = d == 0 ? sub * 16 + st : 63 - (sub * 16 + st);
      ru = *(const uint2*)(proj + (size_t)(b * TT + nc * 64 + jl) * PC + C_S5U + g * 16 + p4);
    };
    fetchu(0);
    for (int sub = 0; sub < 4; sub++) {
      __syncthreads();
      {
        int st = lane >> 2, p4 = (lane & 3) * 4;
        *(float4*)(ubuf + st * 16 + p4) = make_float4(__uint_as_float(ru.x << 16), __uint_as_float(ru.x & 0xffff0000u),
                                                       __uint_as_float(ru.y << 16), __uint_as_float(ru.y & 0xffff0000u));
      }
      __syncthreads();
      if (sub + 1 < 4) fetchu(sub + 1);
#pragma unroll 2
      for (int st = 0; st < 16; st++) {
        float bur = 0.f, bui = 0.f;
#pragma unroll
        for (int i4 = 0; i4 < 4; i4++) {
          float4 uu = *(const float4*)(ubuf + st * 16 + i4 * 4);
          bur += bbr[i4*4] * uu.x + bbr[i4*4+1] * uu.y + bbr[i4*4+2] * uu.z + bbr[i4*4+3] * uu.w;
          bui += bbi[i4*4] * uu.x + bbi[i4*4+1] * uu.y + bbi[i4*4+2] * uu.z + bbi[i4*4+3] * uu.w;
        }
        float nre = are * hre - aim * him + bur;
        float nim = are * him + aim * hre + bui;
        hre = nre; him = nim;
        if (PASS == 2) *(unsigned*)(hbuf + st * 136 + lane * 2) = pack2(hre, him);
      }
      if (PASS == 2) {
        __syncthreads();
        f32x4 acc = (f32x4){0.f, 0.f, 0.f, 0.f};
#pragma unroll
        for (int ks = 0; ks < 4; ks++) {
          bf16x8 af = *(const bf16x8*)(hbuf + (lane & 15) * 136 + ks * 32 + (lane >> 4) * 8);
          acc = __builtin_amdgcn_mfma_f32_16x16x32_bf16(af, cfrag[ks], acc, 0, 0, 0);
        }
#pragma unroll
        for (int r = 0; r < 4; r++) {
          int st = (lane >> 4) * 4 + r;
          int jl = d == 0 ? sub * 16 + st : 63 - (sub * 16 + st);
          float* yp = ybuf + jl * 16 + (lane & 15);
          if (d == 0) *yp = acc[r]; else *yp += acc[r];
        }
      }
    }
    if (PASS == 1) st5[sidx] = make_float2(hre, him);
  }
  if (PASS == 2) {
    __syncthreads();
    const float* dsk = p.in[15] + layer * 256 + g * 16;
#pragma unroll
    for (int i = 0; i < 16; i++) {
      int idx = lane + 64 * i; int jl = idx >> 4, pp = idx & 15;
      u16* up = proj + (size_t)(b * TT + nc * 64 + jl) * PC + C_S5U + g * 16 + pp;
      float y = ybuf[jl * 16 + pp] + dsk[pp] * bf2f(*up);
      *up = f2bf(geluf_(y));
    }
  }
}
__device__ void s5_carry_task(const Params& p, int layer, int task) {
  int e = task * 256 + tid_();
  int n = e & 63, g = (e >> 6) & 15, d = e >> 13;
  float lre = p.in[8][(((size_t)layer * 2 + d) * 16 + g) * 64 + n];
  float lim = p.in[9][(((size_t)layer * 2 + d) * 16 + g) * 64 + n];
  float dt = __expf(p.in[10][((size_t)layer * 2 + d) * 16 + g]);
  float mag = __expf(lre * dt * 64.f);
  float sn, cs; sincosf(lim * dt * 64.f, &sn, &cs);
  float are = mag * cs, aim = mag * sn;
  float2* st5 = (float2*)(p.ws + OFF_S5ST) + (size_t)(e >> 6) * 36 * 64 + n;
  float sre = 0.f, sim = 0.f;
  for (int c = 0; c < 36; c++) {
    float2 E = st5[(size_t)c * 64];
    st5[(size_t)c * 64] = make_float2(sre, sim);
    float nre = are * sre - aim * sim + E.x;
    float nim = are * sim + aim * sre + E.y;
    sre = nre; sim = nim;
  }
}

__device__ __forceinline__ void group_barrier(unsigned* cnt, unsigned target) {
  asm volatile("s_waitcnt vmcnt(0)" ::: "memory");
  __threadfence();
  __syncthreads();
  if (tid_() == 0) {
    __hip_atomic_fetch_add(cnt, 1u, __ATOMIC_RELAXED, __HIP_MEMORY_SCOPE_AGENT);
    while (__hip_atomic_load(cnt, __ATOMIC_RELAXED, __HIP_MEMORY_SCOPE_AGENT) < target) __builtin_amdgcn_s_sleep(2);
  }
  __syncthreads();
  __threadfence();
}
#define LDS_FLOATS 18432
#define SYNC() grid.sync()
#define RW_TWO false
#define NRW (RW_TWO ? 128 : 256)

__global__ void __launch_bounds__(256, 2) fwd_megakernel(Params p) {
  cg::grid_group grid = cg::this_grid();
  __shared__ __attribute__((aligned(16))) float lds[LDS_FLOATS];
  const int bid = blockIdx.x, nb = gridDim.x, t = tid_();

  for (int task = bid; task < N_CONVERT_TASKS + 96 + 1; task += nb) {
    if (task < 96) mods_task(p, task, lds);
    else if (task == 96) {
      if (t < 4) ((unsigned*)(p.ws + OFF_BAR))[t] = 0u;
      float* rope = (float*)(p.ws + OFF_ROPE);
      for (int i = t; i < 1024; i += 256) {
        int pos = i >> 4, fi = i & 15;
        float fr = powf(10000.f, -(float)fi / 16.f);
        float ang = (float)pos * fr;
        rope[i * 2] = cosf(ang); rope[i * 2 + 1] = sinf(ang);
      }
    } else convert_task(p, 0, task - 97, lds);
  }
  SYNC();
  for (int task = bid; task < MROWS / 4; task += nb) ln_row(p, 0, 0, task * 4 + (t >> 6));
  SYNC();

  for (int layer = 0; layer < 2; layer++) {
    const int latonly = layer;
    if ((nb & 7) == 0) { int tm, tn; for (int it = 0; xcd_tile(it, bid, nb, 144, 31, 6, tm, tn); it++) inproj_tile(p, layer, tm, tn, (u16*)lds); }
    else for (int task = bid; task < 144 * 31; task += nb) inproj_tile(p, layer, task / 31, task % 31, (u16*)lds);
    SYNC();
    {
      const int ncg = latonly ? 8 : 9, ncs = latonly ? 32 : 36;
      const int NG = 64 * ncg, NS = 32 * ncs;
      auto p2_task = [&](int task) {
        if (task < NG) {
          int nc = task % ncg + (latonly ? 1 : 0); int q = task / ncg; int h = q & 3; q >>= 2; int b = q & 7; int mx = q >> 3;
          gla_p2_task(p, layer, mx, b, h, nc, lds);
        } else {
          int q = task - NG; int gq = q & 3; q >>= 2; int nc = q % ncs + (latonly ? 4 : 0); int b = q / ncs;
          s5_task<2>(p, layer, ((b * 36 + nc) << 2) | gq, lds);
        }
      };
      if (nb >= NRW + 128) {
        unsigned* bar = (unsigned*)(p.ws + OFF_BAR);
        const int ng = nb - NRW;
        if (bid < NRW) {
          rwkv_scan_task<RW_TWO>(p, layer, bid, lds);
          if (t == 0) {
            while (__hip_atomic_load(bar, __ATOMIC_RELAXED, __HIP_MEMORY_SCOPE_AGENT) < (unsigned)ng * (2u * layer + 2u)) __builtin_amdgcn_s_sleep(8);
          }
          __syncthreads();
          __threadfence();
        } else {
          const int gb = bid - NRW;
          for (int task = gb; task < 2304; task += ng) {
            if (task < 1152) gla_p1_task(p, layer, task, lds); else s5_task<1>(p, layer, task - 1152, lds);
          }
          group_barrier(bar, (unsigned)ng * (2u * layer + 1u));
          for (int task = gb; task < 2048 + 64; task += ng) {
            if (task < 2048) gla_carry_task(p, layer, task); else s5_carry_task(p, layer, task - 2048);
          }
          group_barrier(bar, (unsigned)ng * (2u * layer + 2u));
        }
        int* shq = (int*)(lds + LDS_FLOATS - 4);
        for (;;) {
          __syncthreads();
          if (t == 0) *shq = (int)__hip_atomic_fetch_add(bar + 1 + layer, 1u, __ATOMIC_RELAXED, __HIP_MEMORY_SCOPE_AGENT);
          __syncthreads();
          const int task = *shq;
          if (task >= NG + NS) break;
          p2_task(task);
        }
        SYNC();
      } else {
        for (int task = bid; task < NRW + 2304; task += nb) {
          if (task < NRW) rwkv_scan_task<RW_TWO>(p, layer, task, lds);
          else if (task < NRW + 1152) gla_p1_task(p, layer, task - NRW, lds);
          else s5_task<1>(p, layer, task - NRW - 1152, lds);
        }
        SYNC();
        for (int task = bid; task < 2048 + 64; task += nb) {
          if (task < 2048) gla_carry_task(p, layer, task); else s5_carry_task(p, layer, task - 2048);
        }
        SYNC();
        for (int task = bid; task < NG + NS; task += nb) p2_task(task);
        SYNC();
      }
    }
    {
      const int ntm = latonly ? 128 : 144;
      for (int task = bid; task < ntm * 2 + MROWS; task += nb) {
        if (task < ntm * 2) glu_tile(p, layer, latonly, task >> 1, task & 1, (u16*)lds);
        else {
          int row = task - ntm * 2;
          if (!(latonly && (row % TT) < 256)) rwkv_combine_row(p, layer, row);
        }
      }
    }
    SYNC();
    {
      const int ntm = latonly ? 128 : 144;
      if ((nb & 7) == 0) { int tm, tn; for (int it = 0; xcd_tile(it, bid, nb, ntm, 16, 8, tm, tn); it++) merge_tile(p, layer, latonly, tm, tn, (u16*)lds); }
      else for (int task = bid; task < ntm * 16; task += nb) merge_tile(p, layer, latonly, task >> 4, task & 15, (u16*)lds);
    }
    SYNC();
    {
      const int ntm = latonly ? 128 : 144;
      if ((nb & 7) == 0) { int tm, tn; for (int it = 0; xcd_tile(it, bid, nb, ntm, 8, 8, tm, tn); it++) outproj_tile(p, layer, latonly, tm, tn, (u16*)lds); }
      else for (int task = bid; task < ntm * 8; task += nb) outproj_tile(p, layer, latonly, task >> 3, task & 7, (u16*)lds);
    }
    SYNC();
    if (layer == 0) {
      for (int task = bid; task < MROWS / 4 + N_CONVERT_TASKS; task += nb) {
        if (task < N_CONVERT_TASKS) convert_task(p, 1, task, lds);
        else ln_row(p, 1, 0, (task - N_CONVERT_TASKS) * 4 + (t >> 6));
      }
      SYNC();
    } else {
      for (int task = bid; task < NBATCH * 2048 / 4; task += nb) {
        int r = task * 4 + (t >> 6); int b = r >> 11, tl = r & 2047;
        ln_row(p, 1, 1, b * TT + 256 + tl);
      }
    }
  }
}

extern "C" void kernel_launch(void* const* d_in, const int* in_sizes, int n_in,
                              void* d_out, int out_size, void* d_ws, size_t ws_size,
                              hipStream_t stream) {
  static int grid_blocks = 0;
  if (!grid_blocks) {
    int dev = 0, cus = 0, per_cu = 0;
    (void)hipGetDevice(&dev);
    (void)hipDeviceGetAttribute(&cus, hipDeviceAttributeMultiprocessorCount, dev);
    (void)hipOccupancyMaxActiveBlocksPerMultiprocessor(&per_cu, fwd_megakernel, 256, 0);
    if (per_cu > 2) per_cu = 2;
    if (per_cu < 1) per_cu = 1;
    grid_blocks = cus * per_cu;
  }
  if (ws_size < WS_NEED) { fprintf(stderr, "workspace too small\n"); return; }
  Params p{};
  for (int i = 0; i < 36; i++) p.in[i] = (const float*)d_in[i];
  p.out = (float*)d_out;
  p.ws = (char*)d_ws;
  void* args[] = {&p};
  hipError_t e = hipLaunchCooperativeKernel((void*)fwd_megakernel, dim3(grid_blocks), dim3(256), args, 0, stream);
  if (e != hipSuccess) fprintf(stderr, "cooperative launch failed: %s (grid %d)\n", hipGetErrorString(e), grid_blocks);
}
```

```cpp
#include <hip/hip_runtime.h>
#include <hip/hip_bf16.h>
#include <hip/hip_cooperative_groups.h>
#include <cstdio>
namespace cg = cooperative_groups;

typedef __attribute__((ext_vector_type(8))) short bf16x8;
typedef __attribute__((ext_vector_type(4))) float f32x4;
typedef unsigned short u16;

#define D_ 1024
#define NBATCH 8
#define TT 2304
#define MROWS 18432
#define PC 3904
#define DIN 8000
#define C_S5U 0
#define C_S5Z 256
#define C_HGQ 512
#define C_HGF 768
#define C_HGI 1280
#define C_HGZ 1536
#define C_RTQ 1792
#define C_RTK 2048
#define C_RTV 2304
#define C_RTZ 2560
#define C_RWX 2816
#define C_RWZ 3648

#define OFF_WINT   0ul
#define OFF_WBT    (OFF_WINT + 16384000ul)
#define OFF_WOT    (OFF_WBT + 2097152ul)
#define OFF_GLUT   (OFF_WOT + 2097152ul)
#define OFF_U      (OFF_GLUT + 131072ul)
#define OFF_PROJ   (OFF_U + 37748736ul)
#define OFF_HCTX   (OFF_PROJ + 143917056ul)
#define OFF_SCR    (OFF_HCTX + 8388608ul)
#define OFF_RWO    (OFF_SCR)
#define OFF_HGST   (OFF_SCR + 18874368ul)
#define OFF_RTST   (OFF_HGST + 9437184ul)
#define OFF_RETOF  (OFF_SCR + 37748736ul)
#define OFF_S5ST   (OFF_RETOF + 9437184ul)
#define OFF_MODS   (OFF_S5ST + 4718592ul)
#define OFF_HGP    (OFF_MODS + 221184ul)
#define OFF_BONUS  (OFF_HGP + 147456ul)
#define OFF_ROPE   (OFF_BONUS + 589824ul)
#define OFF_BAR    (OFF_ROPE + 8192ul)
#define WS_NEED    (OFF_BAR + 256ul)

struct Params {
  const float* in[36];
  float* out;
  char* ws;
};

__device__ __forceinline__ int tid_() { int t = __builtin_amdgcn_workitem_id_x(); asm volatile("" : "+v"(t)); return t; }
__device__ __forceinline__ u16 f2bf(float f) {
  unsigned u = __float_as_uint(f);
  u += 0x7fffu + ((u >> 16) & 1u);
  return (u16)(u >> 16);
}
__device__ __forceinline__ float bf2f(u16 h) { return __uint_as_float(((unsigned)h) << 16); }
__device__ __forceinline__ unsigned pack2(float a, float b) { return (unsigned)f2bf(a) | ((unsigned)f2bf(b) << 16); }
__device__ __forceinline__ float sigmoidf_(float x) { return __builtin_amdgcn_rcpf(1.f + __expf(-x)); }
__device__ __forceinline__ float siluf_(float x) { return x * __builtin_amdgcn_rcpf(1.f + __expf(-x)); }
__device__ __forceinline__ float geluf_(float x) {
  float t = tanhf(0.7978845608028654f * (x + 0.044715f * x * x * x));
  return 0.5f * x * (1.f + t);
}
template <int CTRL>
__device__ __forceinline__ float dppf(float x) {
  return __int_as_float(__builtin_amdgcn_update_dpp(0, __float_as_int(x), CTRL, 0xf, 0xf, true));
}
__device__ __forceinline__ float allsum16(float x) {
  x += dppf<0x128>(x);
  x += dppf<0x124>(x);
  x += dppf<0x122>(x);
  x += dppf<0x121>(x);
  return x;
}
__device__ __forceinline__ float wavesum(float x) {
  x = allsum16(x);
  x += __shfl_xor(x, 16, 64);
  x += __shfl_xor(x, 32, 64);
  return x;
}
__device__ __forceinline__ void ld4bf(const u16* p, float (&o)[4]) {
  uint2 v = *(const uint2*)p;
  o[0] = __uint_as_float(v.x << 16); o[1] = __uint_as_float(v.x & 0xffff0000u);
  o[2] = __uint_as_float(v.y << 16); o[3] = __uint_as_float(v.y & 0xffff0000u);
}
__device__ __forceinline__ void st4bf(u16* p, float a, float b, float c, float d) {
  uint2 v; v.x = pack2(a, b); v.y = pack2(c, d);
  *(uint2*)p = v;
}
__device__ __forceinline__ int jmap(int d, int s) { return d == 0 ? s : (s < 256 ? 255 - s : 2559 - s); }
__device__ __forceinline__ bool has_prev(int j) { return j != 0 && j != 256; }
__device__ __forceinline__ bool has_next(int j) { return j != 255 && j != 2303; }

__device__ __forceinline__ const float* hin_ptr(const Params& p, int layer, int row) {
  int b = row / TT, j = row - b * TT;
  if (layer == 0) return j < 256 ? p.in[2] + ((size_t)(b * 256 + j)) * D_ : p.in[0] + ((size_t)(b * 2048 + j - 256)) * D_;
  return j < 256 ? (const float*)(p.ws + OFF_HCTX) + ((size_t)(b * 256 + j)) * D_ : p.out + ((size_t)(b * 2048 + j - 256)) * D_;
}
__device__ __forceinline__ float* hout_ptr(const Params& p, int row) {
  int b = row / TT, j = row - b * TT;
  return j < 256 ? (float*)(p.ws + OFF_HCTX) + ((size_t)(b * 256 + j)) * D_ : p.out + ((size_t)(b * 2048 + j - 256)) * D_;
}
__device__ __forceinline__ int modrow_of(int row) { int b = row / TT, j = row - b * TT; return j < 256 ? 8 : b; }

__device__ void transpose_tile(const float* __restrict__ src, u16* __restrict__ dst, int K, int N, int k0, int n0, float* lds) {
  const int t = tid_();
  __syncthreads();
#pragma unroll
  for (int i = 0; i < 16; i++) {
    int r = i * 4 + (t >> 6), c = t & 63;
    lds[r * 65 + c] = src[(size_t)(k0 + r) * N + n0 + c];
  }
  __syncthreads();
#pragma unroll
  for (int i = 0; i < 16; i++) {
    int r = i * 4 + (t >> 6), c = t & 63;
    dst[(size_t)(n0 + r) * K + k0 + c] = f2bf(lds[c * 65 + r]);
  }
}
__device__ void convert_task(const Params& p, int layer, int task, float* lds) {
  if (task < 2000) {
    int kt = task / 125, nt = task % 125;
    transpose_tile(p.in[6] + (size_t)layer * 1024 * DIN, (u16*)(p.ws + OFF_WINT), 1024, DIN, kt * 64, nt * 64, lds);
  } else if (task < 2256) {
    int q = task - 2000; int br = q >> 6; q &= 63; int kt = q >> 4, nt = q & 15;
    transpose_tile(p.in[31] + ((size_t)layer * 4 + br) * 256 * 1024, (u16*)(p.ws + OFF_WBT) + (size_t)br * 1024 * 256, 256, 1024, kt * 64, nt * 64, lds);
  } else if (task < 2512) {
    int q = task - 2256; int kt = q >> 4, nt = q & 15;
    transpose_tile(p.in[32] + (size_t)layer * 1024 * 1024, (u16*)(p.ws + OFF_WOT), 1024, 1024, kt * 64, nt * 64, lds);
  } else {
    int q = task - 2512; int kt = q >> 2, nt = q & 3;
    transpose_tile(p.in[16] + (size_t)layer * 256 * 256, (u16*)(p.ws + OFF_GLUT), 256, 256, kt * 64, nt * 64, lds);
  }
}
#define N_CONVERT_TASKS 2528

__device__ void mods_task(const Params& p, int task, float* lds) {
  const int t = tid_();
  int layer = task / 48, cgp = task % 48;
  float* sc = lds;
  float* red = lds + 9 * 1024;
  __syncthreads();
  for (int i = t; i < 9 * 1024; i += 256) {
    int r = i >> 10, k = i & 1023;
    float v = r < 8 ? p.in[1][r * 1024 + k] : p.in[3][k];
    sc[i] = siluf_(v);
  }
  __syncthreads();
  int col = cgp * 64 + (t & 63), kq = t >> 6;
  float acc[9];
#pragma unroll
  for (int r = 0; r < 9; r++) acc[r] = 0.f;
  const float* wp = p.in[4] + (size_t)layer * 1024 * 3072 + col;
#pragma unroll 16
  for (int k = kq * 256; k < kq * 256 + 256; k++) {
    float w = wp[(size_t)k * 3072];
#pragma unroll
    for (int r = 0; r < 9; r++) acc[r] += sc[r * 1024 + k] * w;
  }
#pragma unroll
  for (int r = 0; r < 9; r++) red[(kq * 9 + r) * 64 + (t & 63)] = acc[r];
  __syncthreads();
  float* mods = (float*)(p.ws + OFF_MODS);
  for (int i = t; i < 9 * 64; i += 256) {
    int r = i >> 6, c = i & 63;
    float s = red[(0 * 9 + r) * 64 + c] + red[(1 * 9 + r) * 64 + c] + red[(2 * 9 + r) * 64 + c] + red[(3 * 9 + r) * 64 + c];
    int cc = cgp * 64 + c;
    mods[((size_t)layer * 9 + r) * 3072 + cc] = s + p.in[5][layer * 3072 + cc];
  }
}

__device__ void ln_row(const Params& p, int mode, int layer, int row) {
  const int lane = tid_() & 63;
  float v[16];
  if (mode == 0) {
    const float* src = hin_ptr(p, 0, row);
#pragma unroll
    for (int i = 0; i < 4; i++) { float4 q = *(const float4*)(src + i * 256 + lane * 4); v[i*4]=q.x; v[i*4+1]=q.y; v[i*4+2]=q.z; v[i*4+3]=q.w; }
  } else {
    float* src = hout_ptr(p, row);
#pragma unroll
    for (int i = 0; i < 4; i++) { float4 q = *(const float4*)(src + i * 256 + lane * 4); v[i*4]=q.x; v[i*4+1]=q.y; v[i*4+2]=q.z; v[i*4+3]=q.w; }
    float s = 0.f;
#pragma unroll
    for (int i = 0; i < 16; i++) s += v[i];
    float mean = wavesum(s) * (1.f / 1024.f);
    float q2 = 0.f;
#pragma unroll
    for (int i = 0; i < 16; i++) { v[i] -= mean; q2 += v[i] * v[i]; }
    float rstd = rsqrtf(wavesum(q2) * (1.f / 1024.f) + 1e-5f);
    const float* lw = p.in[34] + layer * 1024; const float* lb = p.in[35] + layer * 1024;
#pragma unroll
    for (int i = 0; i < 4; i++) {
      float4 w4 = *(const float4*)(lw + i * 256 + lane * 4), b4 = *(const float4*)(lb + i * 256 + lane * 4);
      v[i*4] = v[i*4] * rstd * w4.x + b4.x; v[i*4+1] = v[i*4+1] * rstd * w4.y + b4.y;
      v[i*4+2] = v[i*4+2] * rstd * w4.z + b4.z; v[i*4+3] = v[i*4+3] * rstd * w4.w + b4.w;
      *(float4*)(src + i * 256 + lane * 4) = make_float4(v[i*4], v[i*4+1], v[i*4+2], v[i*4+3]);
    }
    if (layer == 1) return;
  }
  int ml = mode == 0 ? 0 : 1;
  float s = 0.f;
#pragma unroll
  for (int i = 0; i < 16; i++) s += v[i];
  float mean = wavesum(s) * (1.f / 1024.f);
  float q2 = 0.f;
#pragma unroll
  for (int i = 0; i < 16; i++) { v[i] -= mean; q2 += v[i] * v[i]; }
  float rstd = rsqrtf(wavesum(q2) * (1.f / 1024.f) + 1e-5f);
  const float* md = (const float*)(p.ws + OFF_MODS) + ((size_t)ml * 9 + modrow_of(row)) * 3072;
  u16* up = (u16*)(p.ws + OFF_U) + (size_t)row * 1024;
#pragma unroll
  for (int i = 0; i < 4; i++) {
    float4 sh = *(const float4*)(md + i * 256 + lane * 4), sc = *(const float4*)(md + 1024 + i * 256 + lane * 4);
    st4bf(up + i * 256 + lane * 4, v[i*4] * rstd * (1.f + sc.x) + sh.x, v[i*4+1] * rstd * (1.f + sc.y) + sh.y,
          v[i*4+2] * rstd * (1.f + sc.z) + sh.z, v[i*4+3] * rstd * (1.f + sc.w) + sh.w);
  }
}

#define STAGE_LOAD(P, kk_) do { const unsigned k_ = (kk_); \
  P##a0 = *(const uint4*)(A + (oa + k_)); P##a1 = *(const uint4*)(A + (oa + sa + k_)); \
  P##a2 = *(const uint4*)(A + (oa + 2 * sa + k_)); P##a3 = *(const uint4*)(A + (oa + 3 * sa + k_)); \
  P##b0 = *(const uint4*)(B + (ob + k_)); P##b1 = *(const uint4*)(B + (ob + sb + k_)); \
  if (NT == 4) { P##b2 = *(const uint4*)(B + (ob + 2 * sb + k_)); P##b3 = *(const uint4*)(B + (ob + 3 * sb + k_)); } } while (0)
#define STAGE_WRITE(P, Asw, Bsw) do { \
  *(uint4*)(Asw) = P##a0; *(uint4*)((Asw) + 32 * 72) = P##a1; *(uint4*)((Asw) + 64 * 72) = P##a2; *(uint4*)((Asw) + 96 * 72) = P##a3; \
  *(uint4*)(Bsw) = P##b0; *(uint4*)((Bsw) + 32 * 72) = P##b1; \
  if (NT == 4) { *(uint4*)((Bsw) + 64 * 72) = P##b2; *(uint4*)((Bsw) + 96 * 72) = P##b3; } } while (0)
template <int MT, int NT>
__device__ __forceinline__ void stage_compute(f32x4 (&acc)[MT][NT], const u16* As, const u16* Bs, int lane, int wm, int wn) {
#pragma unroll
  for (int kk = 0; kk < 2; kk++) {
    bf16x8 af[MT], bfr[NT];
#pragma unroll
    for (int mt = 0; mt < MT; mt++) af[mt] = *(const bf16x8*)(As + (wm * MT * 16 + mt * 16 + (lane & 15)) * 72 + kk * 32 + (lane >> 4) * 8);
#pragma unroll
    for (int nt = 0; nt < NT; nt++) bfr[nt] = *(const bf16x8*)(Bs + (wn * NT * 16 + nt * 16 + (lane & 15)) * 72 + kk * 32 + (lane >> 4) * 8);
    __builtin_amdgcn_s_setprio(1);
#pragma unroll
    for (int mt = 0; mt < MT; mt++)
#pragma unroll
      for (int nt = 0; nt < NT; nt++)
        acc[mt][nt] = __builtin_amdgcn_mfma_f32_16x16x32_bf16(af[mt], bfr[nt], acc[mt][nt], 0, 0, 0);
    __builtin_amdgcn_s_setprio(0);
  }
}
template <int MT, int NT>
__device__ __forceinline__ void gemm_kloop(f32x4 (&acc)[MT][NT], const u16* __restrict__ A, int lda,
                                           const u16* __restrict__ B, int ldb, int K, u16* lds) {
  static_assert(MT == 4, "MT");
  constexpr int BM = MT * 32, BN = NT * 32, SS = (BM + BN) * 72;
  const int t = tid_(), lane = t & 63, w = t >> 6, wm = w >> 1, wn = w & 1;
  u16* As0 = lds; u16* Bs0 = lds + BM * 72; u16* As1 = lds + SS; u16* Bs1 = lds + SS + BM * 72;
  const int lr = t >> 3, lc = (t & 7) * 8;
  const unsigned oa = (unsigned)(lr * lda + lc), ob = (unsigned)(lr * ldb + lc);
  const unsigned sa = 32u * (unsigned)lda, sb = 32u * (unsigned)ldb;
  const int swo = lr * 72 + lc;
  const unsigned klast = (unsigned)(K - 64);
  uint4 R0a0, R0a1, R0a2, R0a3, R0b0, R0b1, R0b2, R0b3, R1a0, R1a1, R1a2, R1a3, R1b0, R1b1, R1b2, R1b3;
  STAGE_LOAD(R0, 0u);
  STAGE_LOAD(R1, 64u);
  __syncthreads();
  STAGE_WRITE(R0, As0 + swo, Bs0 + swo);
  STAGE_LOAD(R0, 128u < klast ? 128u : klast);
  __syncthreads();
#pragma unroll 1
  for (int k0 = 0; k0 < K; k0 += 128) {
    STAGE_WRITE(R1, As1 + swo, Bs1 + swo);
    { unsigned kn = (unsigned)k0 + 192u; STAGE_LOAD(R1, kn < klast ? kn : klast); }
    stage_compute<MT, NT>(acc, As0, Bs0, lane, wm, wn);
    __syncthreads();
    STAGE_WRITE(R0, As0 + swo, Bs0 + swo);
    { unsigned kn = (unsigned)k0 + 256u; STAGE_LOAD(R0, kn < klast ? kn : klast); }
    stage_compute<MT, NT>(acc, As1, Bs1, lane, wm, wn);
    __syncthreads();
  }
}
template <int MT, int NT>
__device__ __forceinline__ void zero_acc(f32x4 (&acc)[MT][NT]) {
#pragma unroll
  for (int i = 0; i < MT; i++)
#pragma unroll
    for (int j = 0; j < NT; j++) acc[i][j] = (f32x4){0.f, 0.f, 0.f, 0.f};
}
__device__ __forceinline__ int tile_m0(int latonly, int tm) {
  if (!latonly) return tm * 128;
  int b = tm >> 4; return b * TT + 256 + (tm & 15) * 128;
}

__device__ __forceinline__ bool xcd_tile(int it, int bid, int nb, int NTM, int NTN, int G, int& tm, int& tn) {
  const int xcd = bid & 7, lb = bid >> 3, nlb = nb >> 3, tmx = NTM >> 3;
  const int idx = it * nlb + lb;
  if (idx >= tmx * NTN) return false;
  const int full = tmx / G;
  int g = idx / (G * NTN);
  if (g > full) g = full;
  const int r = idx - g * G * NTN;
  const int gs = (g < full) ? G : (tmx - full * G);
  tn = r / gs;
  tm = xcd * tmx + g * G + (r - tn * gs);
  return true;
}
__device__ void inproj_tile(const Params& p, int layer, int tm, int tn, u16* lds) {
  int m0 = tm * 128, n0 = tn * 128;
  f32x4 acc[4][4]; zero_acc(acc);
  gemm_kloop<4, 4>(acc, (const u16*)(p.ws + OFF_U) + (size_t)m0 * 1024, 1024,
                   (const u16*)(p.ws + OFF_WINT) + (size_t)n0 * 1024, 1024, 1024, lds);
  const int t = tid_(), lane = t & 63, w = t >> 6, wm = w >> 1, wn = w & 1;
  const float* bias = p.in[7] + (size_t)layer * DIN;
  u16* proj = (u16*)(p.ws + OFF_PROJ);
#pragma unroll
  for (int nt = 0; nt < 4; nt++) {
    const int cl = wn * 64 + nt * 16 + (lane & 15);
    const float bv = (n0 + cl < PC) ? bias[n0 + cl] : 0.f;
#pragma unroll
    for (int mt = 0; mt < 4; mt++)
#pragma unroll
      for (int r = 0; r < 4; r++) lds[(wm * 64 + mt * 16 + (lane >> 4) * 4 + r) * 136 + cl] = f2bf(acc[mt][nt][r] + bv);
  }
  __syncthreads();
#pragma unroll
  for (int i = 0; i < 8; i++) {
    const int q = t + 256 * i, row = q >> 4, ch = q & 15;
    if (n0 + ch * 8 < PC) *(uint4*)(proj + (size_t)(m0 + row) * PC + n0 + ch * 8) = *(const uint4*)(lds + row * 136 + ch * 8);
  }
}
__device__ void glu_tile(const Params& p, int layer, int latonly, int tm, int tn, u16* lds) {
  int m0 = tile_m0(latonly, tm), n0 = tn * 128;
  f32x4 acc[4][4]; zero_acc(acc);
  u16* proj = (u16*)(p.ws + OFF_PROJ);
  gemm_kloop<4, 4>(acc, proj + (size_t)m0 * PC + C_S5U, PC, (const u16*)(p.ws + OFF_GLUT) + (size_t)n0 * 256, 256, 256, lds);
  const int t = tid_(), lane = t & 63, w = t >> 6, wm = w >> 1, wn = w & 1;
  const float* bias = p.in[17] + layer * 256;
#pragma unroll
  for (int nt = 0; nt < 4; nt++) {
    const int cl = wn * 64 + nt * 16 + (lane & 15);
    const float bv = bias[n0 + cl];
#pragma unroll
    for (int mt = 0; mt < 4; mt++)
#pragma unroll
      for (int r = 0; r < 4; r++) lds[(wm * 64 + mt * 16 + (lane >> 4) * 4 + r) * 136 + cl] = f2bf(sigmoidf_(acc[mt][nt][r] + bv));
  }
  __syncthreads();
#pragma unroll
  for (int i = 0; i < 8; i++) {
    const int q = t + 256 * i, row = q >> 4, ch = q & 15;
    u16* pr = proj + (size_t)(m0 + row) * PC + n0 + ch * 8;
    uint4 sg = *(const uint4*)(lds + row * 136 + ch * 8);
    uint4 yy = *(const uint4*)(pr + C_S5U), zz = *(const uint4*)(pr + C_S5Z), oo;
    const unsigned* sgp = (const unsigned*)&sg; const unsigned* yp = (const unsigned*)&yy; const unsigned* zp = (const unsigned*)&zz; unsigned* op = (unsigned*)&oo;
#pragma unroll
    for (int e = 0; e < 4; e++) {
      float s0 = __uint_as_float(sgp[e] << 16), s1 = __uint_as_float(sgp[e] & 0xffff0000u);
      float y0 = __uint_as_float(yp[e] << 16), y1 = __uint_as_float(yp[e] & 0xffff0000u);
      float z0 = __uint_as_float(zp[e] << 16), z1 = __uint_as_float(zp[e] & 0xffff0000u);
      op[e] = pack2(y0 * s0 * siluf_(z0), y1 * s1 * siluf_(z1));
    }
    *(uint4*)(pr + C_S5Z) = oo;
  }
}
__device__ void merge_tile(const Params& p, int layer, int latonly, int tm, int tn, u16* lds) {
  int m0 = tile_m0(latonly, tm), n0 = tn * 64;
  f32x4 accm[4][2]; zero_acc(accm);
  const u16* proj = (const u16*)(p.ws + OFF_PROJ);
  const int lane = tid_() & 63, w = tid_() >> 6, wm = w >> 1, wn = w & 1;
  const float* bias = p.in[7] + (size_t)layer * DIN + PC;
#pragma unroll 1
  for (int k = 0; k < 4; k++) {
    const int ycol = k == 0 ? C_S5Z : (k == 1 ? C_HGQ : (k == 2 ? C_RTQ : C_RWZ));
    f32x4 accb[4][2]; zero_acc(accb);
    gemm_kloop<4, 2>(accb, proj + (size_t)m0 * PC + ycol, PC,
                     (const u16*)(p.ws + OFF_WBT) + ((size_t)k * 1024 + n0) * 256, 256, 256, lds);
    f32x4 accg[4][2]; zero_acc(accg);
    gemm_kloop<4, 2>(accg, (const u16*)(p.ws + OFF_U) + (size_t)m0 * 1024, 1024,
                     (const u16*)(p.ws + OFF_WINT) + ((size_t)PC + k * 1024 + n0) * 1024, 1024, 1024, lds);
#pragma unroll
    for (int nt = 0; nt < 2; nt++) {
      float bv = bias[k * 1024 + n0 + wn * 32 + nt * 16 + (lane & 15)];
#pragma unroll
      for (int mt = 0; mt < 4; mt++)
#pragma unroll
        for (int r = 0; r < 4; r++) accm[mt][nt][r] += sigmoidf_(accg[mt][nt][r] + bv) * accb[mt][nt][r];
    }
  }
  u16* mg = (u16*)(p.ws + OFF_SCR);
#pragma unroll
  for (int nt = 0; nt < 2; nt++) {
    const int cl = wn * 32 + nt * 16 + (lane & 15);
#pragma unroll
    for (int mt = 0; mt < 4; mt++)
#pragma unroll
      for (int r = 0; r < 4; r++) lds[(wm * 64 + mt * 16 + (lane >> 4) * 4 + r) * 72 + cl] = f2bf(accm[mt][nt][r]);
  }
  __syncthreads();
  {
    const int t = tid_();
#pragma unroll
    for (int i = 0; i < 4; i++) {
      const int q = t + 256 * i, row = q >> 3, ch = q & 7;
      *(uint4*)(mg + (size_t)(m0 + row) * 1024 + n0 + ch * 8) = *(const uint4*)(lds + row * 72 + ch * 8);
    }
  }
}
__device__ void outproj_tile(const Params& p, int layer, int latonly, int tm, int tn, u16* lds) {
  int m0 = tile_m0(latonly, tm), n0 = tn * 128;
  f32x4 acc[4][4]; zero_acc(acc);
  gemm_kloop<4, 4>(acc, (const u16*)(p.ws + OFF_SCR) + (size_t)m0 * 1024, 1024,
                   (const u16*)(p.ws + OFF_WOT) + (size_t)n0 * 1024, 1024, 1024, lds);
  const int lane = tid_() & 63, w = tid_() >> 6, wm = w >> 1, wn = w & 1;
  const float* bias = p.in[33] + layer * 1024;
  const float* hi0 = hin_ptr(p, layer, m0);
  float* ho0 = hout_ptr(p, m0);
  const float* gate = (const float*)(p.ws + OFF_MODS) + ((size_t)layer * 9 + modrow_of(m0)) * 3072 + 2048;
  float* cs = (float*)lds;
#pragma unroll
  for (int nt = 0; nt < 4; nt++) {
    const int cl = wn * 64 + nt * 16 + (lane & 15);
    const float bv = bias[n0 + cl];
#pragma unroll
    for (int mt = 0; mt < 4; mt++)
#pragma unroll
      for (int r = 0; r < 4; r++) cs[(wm * 64 + mt * 16 + (lane >> 4) * 4 + r) * 132 + cl] = acc[mt][nt][r] + bv;
  }
  __syncthreads();
  {
    const int t = tid_();
#pragma unroll 4
    for (int i = 0; i < 16; i++) {
      const int q = t + 256 * i, row = q >> 5, ch = q & 31;
      const float4 a4 = *(const float4*)(cs + row * 132 + ch * 4);
      const float4 g4 = *(const float4*)(gate + n0 + ch * 4);
      const float4 h4 = *(const float4*)(hi0 + (size_t)row * 1024 + n0 + ch * 4);
      float4 o4;
      o4.x = 1.4142135623730951f * h4.x + g4.x * a4.x; o4.y = 1.4142135623730951f * h4.y + g4.y * a4.y;
      o4.z = 1.4142135623730951f * h4.z + g4.z * a4.z; o4.w = 1.4142135623730951f * h4.w + g4.w * a4.w;
      *(float4*)(ho0 + (size_t)row * 1024 + n0 + ch * 4) = o4;
    }
  }
}

template <bool TWO>
__device__ void rwkv_scan_task(const Params& p, int layer, int task, float* lds) {
  const int t = tid_();
  const int rh = TWO ? (task & 1) : (task & 3), h = TWO ? ((task >> 1) & 3) : ((task >> 2) & 3);
  const int b = TWO ? ((task >> 3) & 7) : ((task >> 4) & 7), d = TWO ? (task >> 6) : (task >> 7);
  constexpr int RPB = TWO ? 32 : 16;
  float* sh_lora = lds;
  float* sh_w2 = sh_lora + 512;
  float* sh_a2 = sh_w2 + 1024;
  float* sh_r = sh_a2 + 1024;
  float* sh_w = sh_r + 1024;
  float* sh_k = sh_w + 1024;
  float* sh_kk = sh_k + 1024;
  float* sh_b = sh_kk + 1024;
  float* sh_v = sh_b + 1024;
  float* sh_o = sh_v + 512;
  const u16* proj = (const u16*)(p.ws + OFF_PROJ);
  u16* rwo = (u16*)(p.ws + OFF_RWO) + (size_t)d * MROWS * 256;
  float* bonus = (float*)(p.ws + OFF_BONUS) + (size_t)d * MROWS * 4;
  const float* mu0 = p.in[21] + (size_t)layer * 2 * 832;
  const float* mu1 = mu0 + 832;
  __syncthreads();
  for (int i = t; i < 1024; i += 256) {
    int rr = i >> 6, c = i & 63;
    sh_w2[i] = p.in[23][(((size_t)layer * 2 + d) * 16 + rr) * 256 + h * 64 + c];
    sh_a2[i] = p.in[25][(((size_t)layer * 2 + d) * 16 + rr) * 256 + h * 64 + c];
  }
  const int pst = t >> 4, cq = t & 15;
  const int ch0 = h * 64 + cq * 4;
  float mur0[4], mur1[4], muk0[4], muk1[4], w0v[4], a0v[4], kkw[4], kaw[4], rkw[4];
#pragma unroll
  for (int i = 0; i < 4; i++) {
    mur0[i] = mu0[ch0 + i]; mur1[i] = mu1[ch0 + i];
    muk0[i] = mu0[256 + ch0 + i]; muk1[i] = mu1[256 + ch0 + i];
    w0v[i] = p.in[22][((size_t)layer * 2 + d) * 256 + ch0 + i];
    a0v[i] = p.in[24][((size_t)layer * 2 + d) * 256 + ch0 + i];
    kkw[i] = p.in[26][layer * 256 + ch0 + i];
    kaw[i] = p.in[27][layer * 256 + ch0 + i];
    rkw[i] = p.in[28][layer * 256 + ch0 + i];
  }
  const int vch = 512 + h * 64 + rh * RPB + cq;
  const float muv0 = mu0[vch], muv1 = mu1[vch], muw0 = TWO ? mu0[vch + 16] : 0.f, muw1 = TWO ? mu1[vch + 16] : 0.f;
  const int lidx0 = t * 2;
  float lmu00, lmu01, lmu10, lmu11;
  {
    int q = lidx0 & 31;
    int col = q < 16 ? (768 + d * 16 + q) : (800 + d * 16 + (q - 16));
    lmu00 = mu0[col]; lmu01 = mu0[col + 1]; lmu10 = mu1[col]; lmu11 = mu1[col + 1];
  }
  const int rl = t >> 4, ks = t & 15;
  float4 S = make_float4(0.f, 0.f, 0.f, 0.f), S2 = make_float4(0.f, 0.f, 0.f, 0.f);
  unsigned lx0 = 0, lx1 = 0, lxp0 = 0, lxp1 = 0, lxn0 = 0, lxn1 = 0;
  uint2 rr_c, rr_p, rr_n, rk_c, rk_p, rk_n;
  unsigned rv_c, rv_p, rv_n, rw_c = 0, rw_p = 0, rw_n = 0;
  auto fetch = [&](int s0) {
    {
      int st2 = lidx0 >> 5, q = lidx0 & 31;
      int j = jmap(d, s0 + st2);
      int col = q < 16 ? (768 + d * 16 + q) : (800 + d * 16 + (q - 16));
      const u16* pr = proj + ((size_t)(b * TT + j)) * PC + C_RWX + col;
      const u16* prp = has_prev(j) ? pr - PC : pr;
      const u16* prn = has_next(j) ? pr + PC : pr;
      lx0 = pr[0]; lx1 = pr[1]; lxp0 = prp[0]; lxp1 = prp[1]; lxn0 = prn[0]; lxn1 = prn[1];
    }
    int j = jmap(d, s0 + pst);
    const u16* pr = proj + ((size_t)(b * TT + j)) * PC + C_RWX;
    const u16* prp = has_prev(j) ? pr - PC : pr;
    const u16* prn = has_next(j) ? pr + PC : pr;
    rr_c = *(const uint2*)(pr + ch0); rr_p = *(const uint2*)(prp + ch0); rr_n = *(const uint2*)(prn + ch0);
    rk_c = *(const uint2*)(pr + 256 + ch0); rk_p = *(const uint2*)(prp + 256 + ch0); rk_n = *(const uint2*)(prn + 256 + ch0);
    rv_c = pr[vch]; rv_p = prp[vch]; rv_n = prn[vch];
    if (TWO) { rw_c = pr[vch + 16]; rw_p = prp[vch + 16]; rw_n = prn[vch + 16]; }
  };
  auto unpack4 = [](uint2 v, float (&o)[4]) {
    o[0] = __uint_as_float(v.x << 16); o[1] = __uint_as_float(v.x & 0xffff0000u);
    o[2] = __uint_as_float(v.y << 16); o[3] = __uint_as_float(v.y & 0xffff0000u);
  };
  fetch(0);
  for (int s0 = 0; s0 < TT; s0 += 16) {
    {
      int st2 = lidx0 >> 5, q = lidx0 & 31;
      int ja = jmap(d, s0 + st2);
      const float hpa = has_prev(ja) ? 1.f : 0.f, hna = has_next(ja) ? 1.f : 0.f;
      float x0 = __uint_as_float(lx0 << 16), x1 = __uint_as_float(lx1 << 16);
      float xs0 = x0 + lmu00 * (__uint_as_float(lxp0 << 16) * hpa - x0) + lmu10 * (__uint_as_float(lxn0 << 16) * hna - x0);
      float xs1 = x1 + lmu01 * (__uint_as_float(lxp1 << 16) * hpa - x1) + lmu11 * (__uint_as_float(lxn1 << 16) * hna - x1);
      if (q < 16) {
        xs0 = 1.f - 2.f * __builtin_amdgcn_rcpf(__expf(2.f * xs0) + 1.f);
        xs1 = 1.f - 2.f * __builtin_amdgcn_rcpf(__expf(2.f * xs1) + 1.f);
      }
      *(float2*)(sh_lora + lidx0) = make_float2(xs0, xs1);
    }
    __syncthreads();
    const int jcur = jmap(d, s0 + pst);
    {
      const float hpf = has_prev(jcur) ? 1.f : 0.f, hnf = has_next(jcur) ? 1.f : 0.f;
      float r4[4], k4[4], t0[4], t1[4];
      unpack4(rr_c, r4); unpack4(rr_p, t0); unpack4(rr_n, t1);
#pragma unroll
      for (int i = 0; i < 4; i++) r4[i] = r4[i] + mur0[i] * (t0[i] * hpf - r4[i]) + mur1[i] * (t1[i] * hnf - r4[i]);
      unpack4(rk_c, k4); unpack4(rk_p, t0); unpack4(rk_n, t1);
#pragma unroll
      for (int i = 0; i < 4; i++) k4[i] = k4[i] + muk0[i] * (t0[i] * hpf - k4[i]) + muk1[i] * (t1[i] * hnf - k4[i]);
      float wl[4], al[4];
#pragma unroll
      for (int i = 0; i < 4; i++) { wl[i] = w0v[i]; al[i] = a0v[i]; }
      float lrow[32];
#pragma unroll
      for (int i4 = 0; i4 < 8; i4++) {
        float4 q4 = *(const float4*)(sh_lora + pst * 32 + i4 * 4);
        lrow[i4 * 4] = q4.x; lrow[i4 * 4 + 1] = q4.y; lrow[i4 * 4 + 2] = q4.z; lrow[i4 * 4 + 3] = q4.w;
      }
#pragma unroll
      for (int rr = 0; rr < 16; rr++) {
        float lw_ = lrow[rr], la_ = lrow[16 + rr];
        float4 w2 = *(const float4*)(sh_w2 + rr * 64 + cq * 4);
        float4 a2 = *(const float4*)(sh_a2 + rr * 64 + cq * 4);
        wl[0] += lw_ * w2.x; wl[1] += lw_ * w2.y; wl[2] += lw_ * w2.z; wl[3] += lw_ * w2.w;
        al[0] += la_ * a2.x; al[1] += la_ * a2.y; al[2] += la_ * a2.z; al[3] += la_ * a2.w;
      }
      float wv[4], kd[4], kk[4], bb[4];
      float ss = 0.f, bon = 0.f;
#pragma unroll
      for (int i = 0; i < 4; i++) {
        float a = wl[i];
        float lw = fminf(a, 0.f) - __logf(1.f + __expf(-fabsf(a))) - 0.5f;
        wv[i] = __expf(-__expf(lw));
        float ic = sigmoidf_(al[i]);
        float kr = k4[i] * kkw[i];
        kk[i] = kr; ss += kr * kr;
        kd[i] = k4[i] * (1.f + (ic - 1.f) * kaw[i]);
        bb[i] = ic;
        bon += r4[i] * kd[i] * rkw[i];
      }
      ss = allsum16(ss); bon = allsum16(bon);
      float inv = rsqrtf(fmaxf(ss, 1e-24f));
#pragma unroll
      for (int i = 0; i < 4; i++) { kk[i] *= inv; bb[i] *= kk[i]; }
      *(float4*)(sh_r + pst * 64 + cq * 4) = make_float4(r4[0], r4[1], r4[2], r4[3]);
      *(float4*)(sh_w + pst * 64 + cq * 4) = make_float4(wv[0], wv[1], wv[2], wv[3]);
      *(float4*)(sh_k + pst * 64 + cq * 4) = make_float4(kd[0], kd[1], kd[2], kd[3]);
      *(float4*)(sh_kk + pst * 64 + cq * 4) = make_float4(kk[0], kk[1], kk[2], kk[3]);
      *(float4*)(sh_b + pst * 64 + cq * 4) = make_float4(bb[0], bb[1], bb[2], bb[3]);
      if (rh == 0 && cq == 0) bonus[(size_t)(b * TT + jcur) * 4 + h] = bon;
      float xv = __uint_as_float(rv_c << 16);
      sh_v[pst * 32 + cq] = xv + muv0 * (__uint_as_float(rv_p << 16) * hpf - xv) + muv1 * (__uint_as_float(rv_n << 16) * hnf - xv);
      float xw = __uint_as_float(rw_c << 16);
      if (TWO) sh_v[pst * 32 + 16 + cq] = xw + muw0 * (__uint_as_float(rw_p << 16) * hpf - xw) + muw1 * (__uint_as_float(rw_n << 16) * hnf - xw);
    }
    __syncthreads();
    if (s0 + 16 < TT) fetch(s0 + 16);
    float oacc = 0.f, oacc2 = 0.f;
    {
      float4 nkk = *(const float4*)(sh_kk + ks * 4), nw = *(const float4*)(sh_w + ks * 4), nb4 = *(const float4*)(sh_b + ks * 4);
      float4 nk = *(const float4*)(sh_k + ks * 4), nr = *(const float4*)(sh_r + ks * 4);
      float nv = sh_v[rl], nv2 = sh_v[16 + rl];
#pragma unroll 2
      for (int st = 0; st < 16; st++) {
        const float4 kk4 = nkk, w4 = nw, b4 = nb4, k4 = nk, r4 = nr; const float vv = nv, vv2 = nv2;
        {
          const int sn = (st + 1) & 15;
          nkk = *(const float4*)(sh_kk + sn * 64 + ks * 4); nw = *(const float4*)(sh_w + sn * 64 + ks * 4);
          nb4 = *(const float4*)(sh_b + sn * 64 + ks * 4); nk = *(const float4*)(sh_k + sn * 64 + ks * 4);
          nr = *(const float4*)(sh_r + sn * 64 + ks * 4); nv = sh_v[sn * 32 + rl]; nv2 = sh_v[sn * 32 + 16 + rl];
        }
        float sa = -((S.x * kk4.x + S.y * kk4.y) + (S.z * kk4.z + S.w * kk4.w));
        float sa2 = 0.f;
        if (TWO) sa2 = -((S2.x * kk4.x + S2.y * kk4.y) + (S2.z * kk4.z + S2.w * kk4.w));
        sa = allsum16(sa); if (TWO) sa2 = allsum16(sa2);
        S.x = S.x * w4.x + (sa * b4.x + vv * k4.x);
        S.y = S.y * w4.y + (sa * b4.y + vv * k4.y);
        S.z = S.z * w4.z + (sa * b4.z + vv * k4.z);
        S.w = S.w * w4.w + (sa * b4.w + vv * k4.w);
        if (TWO) {
          S2.x = S2.x * w4.x + (sa2 * b4.x + vv2 * k4.x);
          S2.y = S2.y * w4.y + (sa2 * b4.y + vv2 * k4.y);
          S2.z = S2.z * w4.z + (sa2 * b4.z + vv2 * k4.z);
          S2.w = S2.w * w4.w + (sa2 * b4.w + vv2 * k4.w);
        }
        float o = (S.x * r4.x + S.y * r4.y) + (S.z * r4.z + S.w * r4.w);
        float o2 = 0.f;
        if (TWO) o2 = (S2.x * r4.x + S2.y * r4.y) + (S2.z * r4.z + S2.w * r4.w);
        o = allsum16(o); if (TWO) o2 = allsum16(o2);
        oacc = (ks == st) ? o : oacc;
        oacc2 = (ks == st) ? o2 : oacc2;
      }
    }
    sh_o[ks * 32 + rl] = oacc;
    if (TWO) sh_o[ks * 32 + 16 + rl] = oacc2;
    __syncthreads();
    {
      u16* op = rwo + (size_t)(b * TT + jcur) * 256 + h * 64 + rh * RPB + cq;
      op[0] = f2bf(sh_o[pst * 32 + cq]);
      if (TWO) op[16] = f2bf(sh_o[pst * 32 + 16 + cq]);
    }
  }
}

__device__ void rwkv_combine_row(const Params& p, int layer, int row) {
  const int lane = tid_() & 63, h = tid_() >> 6;
  const int ch = h * 64 + lane;
  int b = row / TT, j = row - b * TT;
  const u16* rwo = (const u16*)(p.ws + OFF_RWO);
  float o = bf2f(rwo[(size_t)row * 256 + ch]) + bf2f(rwo[(size_t)MROWS * 256 + (size_t)row * 256 + ch]);
  float mean = wavesum(o) * (1.f / 64.f);
  float dlt = o - mean;
  float var = wavesum(dlt * dlt) * (1.f / 64.f);
  float on = dlt * rsqrtf(var + 64e-5f) * p.in[29][layer * 256 + ch] + p.in[30][layer * 256 + ch];
  u16* proj = (u16*)(p.ws + OFF_PROJ);
  u16* pr = proj + (size_t)row * PC;
  const float* mu0 = p.in[21] + (size_t)layer * 2 * 832; const float* mu1 = mu0 + 832;
  int vc = C_RWX + 512 + ch;
  float xv = bf2f(pr[vc]);
  float xvp = has_prev(j) ? bf2f(pr[vc - PC]) : 0.f;
  float xvn = has_next(j) ? bf2f(pr[vc + PC]) : 0.f;
  float v = xv + mu0[512 + ch] * (xvp - xv) + mu1[512 + ch] * (xvn - xv);
  const float* bonus = (const float*)(p.ws + OFF_BONUS);
  float bs = bonus[(size_t)row * 4 + h] + bonus[(size_t)MROWS * 4 + (size_t)row * 4 + h];
  float z = bf2f(pr[C_RWZ + ch]);
  pr[C_RWZ + ch] = f2bf((on + bs * v) * siluf_(z));
}

template <int MX, int PASS>
__device__ __forceinline__ void gla_sweep(const Params& p, int layer, int d, int b, int h, int c, float* lds) {
  const int t = tid_(), w = t >> 6, lane = t & 63;
  float* kbuf = lds;
  float* fbuf = kbuf + 1024;
  float* qbuf = fbuf + 1024;
  float* vbuf = qbuf + 1024;
  float* part = vbuf + 1024;
  u16* proj = (u16*)(p.ws + OFF_PROJ);
  const int dbh = (d * 8 + b) * 4 + h;
  float* stt = (float*)(p.ws + (MX == 0 ? OFF_HGST : OFF_RTST)) + ((size_t)dbh * 9 + c) * 4096;
  float S[16];
#pragma unroll
  for (int i = 0; i < 16; i++) S[i] = PASS == 1 ? 0.f : stt[(w * 16 + i) * 64 + lane];
  float gam = 1.f;
  if (MX == 1) gam = __expf(-__expf(p.in[20][((size_t)layer * 2 + d) * 4 + h]));
  float Pl = 1.f;
  const int pst = t >> 4, c4 = (t & 15) * 4;
  float lb4[4] = {0.f, 0.f, 0.f, 0.f};
  if (MX == 0 && layer == 1) {
#pragma unroll
    for (int i = 0; i < 4; i++) {
      float l0 = p.in[18][(0 * 2 + d) * 256 + h * 64 + c4 + i], l1 = p.in[18][(1 * 2 + d) * 256 + h * 64 + c4 + i];
      float mx = fmaxf(l0, l1);
      float e0 = __expf(l0 - mx), e1 = __expf(l1 - mx);
      lb4[i] = e1 / (e0 + e1);
    }
  }
  const int vcol0 = (MX == 0 ? C_HGI : C_RTV) + h * 64;
  const float* rope = (const float*)(p.ws + OFF_ROPE);
  uint2 r_a, r_b, r_c, r_d, r_v; float4 r_cs0, r_cs1;
  r_a = r_b = r_c = r_d = r_v = make_uint2(0u, 0u); r_cs0 = r_cs1 = make_float4(1.f, 0.f, 1.f, 0.f);
  auto fetch = [&](int s0) {
    int j = jmap(d, s0 + pst);
    const u16* pr = proj + (size_t)(b * TT + j) * PC;
    r_v = *(const uint2*)(pr + vcol0 + c4);
    if (MX == 0) {
      r_a = *(const uint2*)(pr + C_HGF + d * 256 + h * 64 + c4);
      if (PASS == 2) r_b = *(const uint2*)(pr + C_HGQ + h * 64 + c4);
    } else {
      r_a = *(const uint2*)(pr + C_RTK + h * 64 + c4);
      r_c = *(const uint2*)(pr + C_RTK + h * 64 + (c4 ^ 16));
      if (PASS == 2) { r_b = *(const uint2*)(pr + C_RTQ + h * 64 + c4); r_d = *(const uint2*)(pr + C_RTQ + h * 64 + (c4 ^ 16)); }
      if (j >= 256) {
        int tl = j - 256;
        int pos = (c4 & 32) ? (tl & 63) : (tl >> 6);
        const float* rp = rope + (pos * 16 + (c4 & 15)) * 2;
        r_cs0 = *(const float4*)rp; r_cs1 = *(const float4*)(rp + 4);
      } else { r_cs0 = make_float4(1.f, 0.f, 1.f, 0.f); r_cs1 = r_cs0; }
    }
  };
  auto unpack4 = [](uint2 v, float (&o)[4]) {
    o[0] = __uint_as_float(v.x << 16); o[1] = __uint_as_float(v.x & 0xffff0000u);
    o[2] = __uint_as_float(v.y << 16); o[3] = __uint_as_float(v.y & 0xffff0000u);
  };
  u16* ofp; int ofs;
  if (MX == 0) { ofp = proj + C_HGF + h * 64 + lane; ofs = PC; }
  else { ofp = (u16*)(p.ws + OFF_RETOF) + h * 64 + lane; ofs = 256; }
  const int zcol = (MX == 0 ? C_HGZ : C_RTZ) + h * 64 + lane;
  const int ycol = (MX == 0 ? C_HGQ : C_RTQ) + h * 64 + lane;
  float normw = 1.f;
  if (MX == 0 && PASS == 2) normw = p.in[19][layer * 256 + h * 64 + lane];
  fetch(c * 256);
  for (int sub = 0; sub < 16; sub++) {
    const int s0 = c * 256 + sub * 16;
    __syncthreads();
    {
      float va[4], vb[4], vc[4], vd[4], vv4[4];
      unpack4(r_a, va); unpack4(r_v, vv4);
      *(float4*)(vbuf + pst * 64 + c4) = make_float4(vv4[0], vv4[1], vv4[2], vv4[3]);
      if (MX == 0) {
        float f[4], k[4];
#pragma unroll
        for (int i = 0; i < 4; i++) { f[i] = lb4[i] + (1.f - lb4[i]) * sigmoidf_(va[i]); k[i] = 1.f - f[i]; }
        *(float4*)(kbuf + pst * 64 + c4) = make_float4(k[0], k[1], k[2], k[3]);
        *(float4*)(fbuf + pst * 64 + c4) = make_float4(f[0], f[1], f[2], f[3]);
        if (PASS == 2) {
          unpack4(r_b, vb);
          *(float4*)(qbuf + pst * 64 + c4) = make_float4(siluf_(vb[0]), siluf_(vb[1]), siluf_(vb[2]), siluf_(vb[3]));
        }
      } else {
        unpack4(r_c, vc);
        float cs[8] = {r_cs0.x, r_cs0.y, r_cs0.z, r_cs0.w, r_cs1.x, r_cs1.y, r_cs1.z, r_cs1.w};
        float sgn = (c4 & 16) ? 1.f : -1.f;
#pragma unroll
        for (int i = 0; i < 4; i++) va[i] = (va[i] * cs[2 * i] + sgn * vc[i] * cs[2 * i + 1]) * 0.125f;
        *(float4*)(kbuf + pst * 64 + c4) = make_float4(va[0], va[1], va[2], va[3]);
        if (PASS == 2) {
          unpack4(r_b, vb); unpack4(r_d, vd);
#pragma unroll
          for (int i = 0; i < 4; i++) vb[i] = vb[i] * cs[2 * i] + sgn * vd[i] * cs[2 * i + 1];
          *(float4*)(qbuf + pst * 64 + c4) = make_float4(vb[0], vb[1], vb[2], vb[3]);
        }
      }
    }
    __syncthreads();
    if (sub + 1 < 16) fetch(s0 + 16);
    u16 pf_o[4], pf_z[4];
    if (PASS == 2 && d == 1) {
#pragma unroll
      for (int e = 0; e < 4; e++) {
        size_t row = (size_t)(b * TT + jmap(d, s0 + w * 4 + e));
        pf_o[e] = ofp[row * ofs]; pf_z[e] = proj[row * PC + zcol];
      }
    }
#pragma unroll 2
    for (int st = 0; st < 16; st++) {
      const float vv = vbuf[st * 64 + lane];
      float o = 0.f;
#pragma unroll
      for (int i4 = 0; i4 < 4; i4++) {
        float4 kv = *(const float4*)(kbuf + st * 64 + w * 16 + i4 * 4);
        float4 fv = make_float4(gam, gam, gam, gam);
        if (MX == 0) fv = *(const float4*)(fbuf + st * 64 + w * 16 + i4 * 4);
        S[i4*4]   = fv.x * S[i4*4]   + kv.x * vv;
        S[i4*4+1] = fv.y * S[i4*4+1] + kv.y * vv;
        S[i4*4+2] = fv.z * S[i4*4+2] + kv.z * vv;
        S[i4*4+3] = fv.w * S[i4*4+3] + kv.w * vv;
        if (PASS == 2) {
          float4 qv = *(const float4*)(qbuf + st * 64 + w * 16 + i4 * 4);
          o += S[i4*4] * qv.x + S[i4*4+1] * qv.y + S[i4*4+2] * qv.z + S[i4*4+3] * qv.w;
        }
      }
      if (MX == 0 && PASS == 1) { if (lane < 16) Pl *= fbuf[st * 64 + w * 16 + lane]; }
      if (PASS == 2) part[(w * 16 + st) * 64 + lane] = o;
    }
    if (PASS == 2) {
      __syncthreads();
#pragma unroll
      for (int e = 0; e < 4; e++) {
        int st = w * 4 + e;
        float o = part[(0 * 16 + st) * 64 + lane] + part[(1 * 16 + st) * 64 + lane] + part[(2 * 16 + st) * 64 + lane] + part[(3 * 16 + st) * 64 + lane];
        int j = jmap(d, s0 + st);
        size_t row = (size_t)(b * TT + j);
        if (d == 0) {
          ofp[row * ofs] = f2bf(o);
        } else {
          o += bf2f(pf_o[e]);
          float ss = wavesum(o * o);
          float y = o * rsqrtf(ss * (1.f / 64.f) + 1e-6f) * normw;
          proj[row * PC + ycol] = f2bf(y * siluf_(bf2f(pf_z[e])));
        }
      }
    }
  }
  if (PASS == 1) {
#pragma unroll
    for (int i = 0; i < 16; i++) stt[(w * 16 + i) * 64 + lane] = S[i];
    if (MX == 0 && lane < 16) ((float*)(p.ws + OFF_HGP))[((size_t)dbh * 9 + c) * 64 + w * 16 + lane] = Pl;
  }
}

#define RS 72
template <int PASS>
__device__ __forceinline__ void ret_sweep(const Params& p, int layer, int d, int b, int h, int nc, int cstep, u16* lds) {
  const int t = tid_(), lane = t & 63, w4 = t >> 6;
  u16* Qs = lds;
  u16* Ks = Qs + 64 * RS;
  u16* Kt = Ks + 64 * RS;
  u16* Vt = Kt + 64 * RS;
  u16* Vd = Vt + 64 * RS;
  u16* Ps = Vd + 64 * RS;
  u16* St = Ps + 64 * RS;
  u16* proj = (u16*)(p.ws + OFF_PROJ);
  const float* rope = (const float*)(p.ws + OFF_ROPE);
  const float lg = -__expf(p.in[20][((size_t)layer * 2 + d) * 4 + h]) * 1.4426950408889634f;
  const float g64 = exp2f(64.f * lg);
  const int dbh = (d * 8 + b) * 4 + h;
  float* stt = (float*)(p.ws + OFF_RTST) + ((size_t)dbh * 9 + cstep) * 4096;
  f32x4 accS[4];
#pragma unroll
  for (int nt = 0; nt < 4; nt++)
#pragma unroll
    for (int r = 0; r < 4; r++)
      accS[nt][r] = PASS == 1 ? 0.f : stt[(w4 * 16 + (lane >> 4) * 4 + r) * 64 + nt * 16 + (lane & 15)];
  uint4 rq[2], rqp[2], rk[2], rkp[2], rv[2];
  auto fetch = [&](int w) {
#pragma unroll
    for (int e = 0; e < 2; e++) {
      const int q = t + 256 * e, sl = q & 63, c8 = (q >> 6) * 8;
      const u16* pr = proj + (size_t)(b * TT + nc * 256 + w * 64 + sl) * PC + h * 64;
      rk[e] = *(const uint4*)(pr + C_RTK + c8); rkp[e] = *(const uint4*)(pr + C_RTK + (c8 ^ 16));
      rv[e] = *(const uint4*)(pr + C_RTV + c8);
      if (PASS == 2) { rq[e] = *(const uint4*)(pr + C_RTQ + c8); rqp[e] = *(const uint4*)(pr + C_RTQ + (c8 ^ 16)); }
    }
  };
  auto up = [](uint4 v, float (&o)[8]) {
    const unsigned* u = (const unsigned*)&v;
#pragma unroll
    for (int i = 0; i < 4; i++) { o[2 * i] = __uint_as_float(u[i] << 16); o[2 * i + 1] = __uint_as_float(u[i] & 0xffff0000u); }
  };
  fetch(d == 0 ? 0 : 3);
  for (int wi = 0; wi < 4; wi++) {
    const int w = d == 0 ? wi : 3 - wi;
    __syncthreads();
    if (PASS == 2 && wi == 0) {
#pragma unroll
      for (int nt = 0; nt < 4; nt++)
        *(uint2*)(St + (nt * 16 + (lane & 15)) * RS + w4 * 16 + (lane >> 4) * 4) =
            make_uint2(pack2(accS[nt][0], accS[nt][1]), pack2(accS[nt][2], accS[nt][3]));
    }
#pragma unroll
    for (int e = 0; e < 2; e++) {
      const int q = t + 256 * e, sl = q & 63, c8 = (q >> 6) * 8;
      const int j = nc * 256 + w * 64 + sl;
      float kx[8], kp[8], vx[8], qx[8], qp[8];
      up(rk[e], kx); up(rkp[e], kp); up(rv[e], vx);
      if (PASS == 2) { up(rq[e], qx); up(rqp[e], qp); }
      if (j >= 256) {
        const int tl = j - 256;
        const int pos = (c8 & 32) ? (tl & 63) : (tl >> 6);
        const float* rp = rope + (pos * 16 + (c8 & 15)) * 2;
        const float sgn = (c8 & 16) ? 1.f : -1.f;
#pragma unroll
        for (int i2 = 0; i2 < 4; i2++) {
          const float4 cs = *(const float4*)(rp + i2 * 4);
          kx[2 * i2] = kx[2 * i2] * cs.x + sgn * kp[2 * i2] * cs.y;
          kx[2 * i2 + 1] = kx[2 * i2 + 1] * cs.z + sgn * kp[2 * i2 + 1] * cs.w;
          if (PASS == 2) {
            qx[2 * i2] = qx[2 * i2] * cs.x + sgn * qp[2 * i2] * cs.y;
            qx[2 * i2 + 1] = qx[2 * i2 + 1] * cs.z + sgn * qp[2 * i2 + 1] * cs.w;
          }
        }
      }
      const float dec = exp2f((float)(d == 0 ? 63 - sl : sl) * lg);
      u16 kb[8];
#pragma unroll
      for (int i = 0; i < 8; i++) {
        kb[i] = f2bf(kx[i] * 0.125f);
        Kt[(c8 + i) * RS + sl] = kb[i];
        Vd[(c8 + i) * RS + sl] = f2bf(vx[i] * dec);
      }
      if (PASS == 2) {
        uint4 kk4, qq4;
        kk4.x = kb[0] | ((unsigned)kb[1] << 16); kk4.y = kb[2] | ((unsigned)kb[3] << 16);
        kk4.z = kb[4] | ((unsigned)kb[5] << 16); kk4.w = kb[6] | ((unsigned)kb[7] << 16);
        qq4.x = pack2(qx[0], qx[1]); qq4.y = pack2(qx[2], qx[3]); qq4.z = pack2(qx[4], qx[5]); qq4.w = pack2(qx[6], qx[7]);
        *(uint4*)(Ks + sl * RS + c8) = kk4;
        *(uint4*)(Qs + sl * RS + c8) = qq4;
        const unsigned short* vraw = (const unsigned short*)&rv[e];
#pragma unroll
        for (int i = 0; i < 8; i++) Vt[(c8 + i) * RS + sl] = vraw[i];
      }
    }
    __syncthreads();
    if (wi + 1 < 4) fetch(d == 0 ? wi + 1 : 2 - wi);
    if (PASS == 2) {
      f32x4 accP[4];
#pragma unroll
      for (int nt = 0; nt < 4; nt++) accP[nt] = (f32x4){0.f, 0.f, 0.f, 0.f};
      bf16x8 aq[2];
#pragma unroll
      for (int kk = 0; kk < 2; kk++) aq[kk] = *(const bf16x8*)(Qs + (w4 * 16 + (lane & 15)) * RS + kk * 32 + (lane >> 4) * 8);
#pragma unroll
      for (int kk = 0; kk < 2; kk++)
#pragma unroll
        for (int nt = 0; nt < 4; nt++) {
          bf16x8 bk = *(const bf16x8*)(Ks + (nt * 16 + (lane & 15)) * RS + kk * 32 + (lane >> 4) * 8);
          accP[nt] = __builtin_amdgcn_mfma_f32_16x16x32_bf16(aq[kk], bk, accP[nt], 0, 0, 0);
        }
#pragma unroll
      for (int nt = 0; nt < 4; nt++)
#pragma unroll
        for (int r = 0; r < 4; r++) {
          const int il = w4 * 16 + (lane >> 4) * 4 + r, sl = nt * 16 + (lane & 15);
          const int e = d == 0 ? il - sl : sl - il;
          const float f = e >= 0 ? exp2f((float)e * lg) : 0.f;
          Ps[il * RS + sl] = f2bf(accP[nt][r] * f);
        }
      __syncthreads();
      f32x4 accO[4], accI[4];
#pragma unroll
      for (int nt = 0; nt < 4; nt++) { accO[nt] = (f32x4){0.f, 0.f, 0.f, 0.f}; accI[nt] = (f32x4){0.f, 0.f, 0.f, 0.f}; }
#pragma unroll
      for (int kk = 0; kk < 2; kk++) {
        bf16x8 ap = *(const bf16x8*)(Ps + (w4 * 16 + (lane & 15)) * RS + kk * 32 + (lane >> 4) * 8);
#pragma unroll
        for (int nt = 0; nt < 4; nt++) {
          bf16x8 bv = *(const bf16x8*)(Vt + (nt * 16 + (lane & 15)) * RS + kk * 32 + (lane >> 4) * 8);
          accO[nt] = __builtin_amdgcn_mfma_f32_16x16x32_bf16(ap, bv, accO[nt], 0, 0, 0);
          bf16x8 bs = *(const bf16x8*)(St + (nt * 16 + (lane & 15)) * RS + kk * 32 + (lane >> 4) * 8);
          accI[nt] = __builtin_amdgcn_mfma_f32_16x16x32_bf16(aq[kk], bs, accI[nt], 0, 0, 0);
        }
      }
      u16* ofp = (u16*)(p.ws + OFF_RETOF);
#pragma unroll
      for (int r = 0; r < 4; r++) {
        const int il = w4 * 16 + (lane >> 4) * 4 + r;
        const size_t row = (size_t)(b * TT + nc * 256 + w * 64 + il);
        const float rho = exp2f((float)(d == 0 ? il + 1 : 64 - il) * lg);
        float o[4], ss = 0.f;
#pragma unroll
        for (int nt = 0; nt < 4; nt++) {
          o[nt] = accO[nt][r] + rho * accI[nt][r];
          if (d == 1) o[nt] += bf2f(ofp[row * 256 + h * 64 + nt * 16 + (lane & 15)]);
          ss += o[nt] * o[nt];
        }
        if (d == 0) {
#pragma unroll
          for (int nt = 0; nt < 4; nt++) ofp[row * 256 + h * 64 + nt * 16 + (lane & 15)] = f2bf(o[nt]);
        } else {
          ss = allsum16(ss);
          const float sc = rsqrtf(ss * (1.f / 64.f) + 1e-6f);
#pragma unroll
          for (int nt = 0; nt < 4; nt++) {
            const int cv = h * 64 + nt * 16 + (lane & 15);
            const float z = bf2f(proj[row * PC + C_RTZ + cv]);
            proj[row * PC + C_RTQ + cv] = f2bf(o[nt] * sc * siluf_(z));
          }
        }
      }
    }
#pragma unroll
    for (int nt = 0; nt < 4; nt++)
#pragma unroll
      for (int r = 0; r < 4; r++) accS[nt][r] *= g64;
#pragma unroll
    for (int kk = 0; kk < 2; kk++) {
      bf16x8 ak = *(const bf16x8*)(Kt + (w4 * 16 + (lane & 15)) * RS + kk * 32 + (lane >> 4) * 8);
#pragma unroll
      for (int nt = 0; nt < 4; nt++) {
        bf16x8 bv = *(const bf16x8*)(Vd + (nt * 16 + (lane & 15)) * RS + kk * 32 + (lane >> 4) * 8);
        accS[nt] = __builtin_amdgcn_mfma_f32_16x16x32_bf16(ak, bv, accS[nt], 0, 0, 0);
      }
    }
    __syncthreads();
    if (PASS == 2 && wi + 1 < 4) {
#pragma unroll
      for (int nt = 0; nt < 4; nt++)
        *(uint2*)(St + (nt * 16 + (lane & 15)) * RS + w4 * 16 + (lane >> 4) * 4) =
            make_uint2(pack2(accS[nt][0], accS[nt][1]), pack2(accS[nt][2], accS[nt][3]));
    }
  }
  if (PASS == 1) {
#pragma unroll
    for (int nt = 0; nt < 4; nt++)
#pragma unroll
      for (int r = 0; r < 4; r++) stt[(w4 * 16 + (lane >> 4) * 4 + r) * 64 + nt * 16 + (lane & 15)] = accS[nt][r];
  }
}
__device__ void gla_p1_task(const Params& p, int layer, int task, float* lds) {
  int c = task % 9; int q = task / 9; int h = q & 3; q >>= 2; int b = q & 7; q >>= 3; int d = q & 1; int mx = q >> 1;
  if (mx == 0) gla_sweep<0, 1>(p, layer, d, b, h, c, lds);
  else { const int nc = d == 0 ? c : (c == 0 ? 0 : 9 - c); ret_sweep<1>(p, layer, d, b, h, nc, c, (u16*)lds); }
}
__device__ void gla_p2_task(const Params& p, int layer, int mx, int b, int h, int nc, float* lds) {
  int cb = nc == 0 ? 0 : 9 - nc;
  if (mx == 0) { gla_sweep<0, 2>(p, layer, 0, b, h, nc, lds); __threadfence_block(); gla_sweep<0, 2>(p, layer, 1, b, h, cb, lds); }
  else { ret_sweep<2>(p, layer, 0, b, h, nc, nc, (u16*)lds); __threadfence_block(); ret_sweep<2>(p, layer, 1, b, h, nc, cb, (u16*)lds); }
}
__device__ void gla_carry_task(const Params& p, int layer, int task) {
  int e = task * 256 + tid_();
  int v = e & 63, k = (e >> 6) & 63, dbh = (e >> 12) & 63, mx = e >> 18;
  float* stt = (float*)(p.ws + (mx == 0 ? OFF_HGST : OFF_RTST)) + (size_t)dbh * 9 * 4096 + k * 64 + v;
  const float* P = (const float*)(p.ws + OFF_HGP) + (size_t)dbh * 9 * 64 + k;
  float pg = 1.f;
  if (mx == 1) { int d = dbh >> 5, h = dbh & 3; pg = __expf(-256.f * __expf(p.in[20][((size_t)layer * 2 + d) * 4 + h])); }
  float S = 0.f;
  for (int c = 0; c < 9; c++) {
    float E = stt[(size_t)c * 4096];
    stt[(size_t)c * 4096] = S;
    float pp = mx == 0 ? P[c * 64] : pg;
    S = pp * S + E;
  }
}

__device__ __forceinline__ int s5_bwd_chunk(int nc) { return nc < 4 ? 3 - nc : 39 - nc; }
template <int PASS>
__device__ void s5_task(const Params& p, int layer, int task, float* lds) {
  const int t = tid_(), w = t >> 6, lane = t & 63;
  int gq = task & 3; int q = task >> 2; int nc = q % 36; int b = q / 36;
  const int g = gq * 4 + w;
  float* ubuf = lds + w * 256;
  u16* hbuf = (u16*)(lds + 1024) + w * (16 * 136);
  float* ybuf = lds + 1024 + 4352 + w * 1024;
  u16* proj = (u16*)(p.ws + OFF_PROJ);
  float2* st5 = (float2*)(p.ws + OFF_S5ST);
  bf16x8 cfrag[4];
  if (PASS == 2) {
    const float* cre = p.in[13] + ((size_t)layer * 16 + g) * 16 * 64;
    const float* cim = p.in[14] + ((size_t)layer * 16 + g) * 16 * 64;
    int pp = lane & 15;
#pragma unroll
    for (int ks = 0; ks < 4; ks++)
#pragma unroll
      for (int i = 0; i < 8; i++) {
        int kidx = ks * 32 + (lane >> 4) * 8 + i; int n = kidx >> 1;
        float val = (kidx & 1) ? -cim[pp * 64 + n] : cre[pp * 64 + n];
        cfrag[ks][i] = (short)f2bf(val);
      }
  }
  for (int d = 0; d < 2; d++) {
    float lre = p.in[8][(((size_t)layer * 2 + d) * 16 + g) * 64 + lane];
    float lim = p.in[9][(((size_t)layer * 2 + d) * 16 + g) * 64 + lane];
    float dt = __expf(p.in[10][((size_t)layer * 2 + d) * 16 + g]);
    float mag = __expf(lre * dt);
    float sn, cs; sincosf(lim * dt, &sn, &cs);
    float are = mag * cs, aim = mag * sn;
    float den = 1.f / (lre * lre + lim * lim);
    float cre_ = ((are - 1.f) * lre + aim * lim) * den;
    float cim_ = (aim * lre - (are - 1.f) * lim) * den;
    float bbr[16], bbi[16];
    {
      const float* br = p.in[11] + (((size_t)layer * 16 + g) * 64 + lane) * 16;
      const float* bi = p.in[12] + (((size_t)layer * 16 + g) * 64 + lane) * 16;
#pragma unroll
      for (int i = 0; i < 16; i++) {
        float x = br[i], y = bi[i];
        bbr[i] = cre_ * x - cim_ * y; bbi[i] = cre_ * y + cim_ * x;
      }
    }
    int cstep = d == 0 ? nc : s5_bwd_chunk(nc);
    size_t sidx = ((((size_t)d * 8 + b) * 16 + g) * 36 + cstep) * 64 + lane;
    float hre = 0.f, him = 0.f;
    if (PASS == 2) { float2 h0 = st5[sidx]; hre = h0.x; him = h0.y; }
    uint2 ru;
    auto fetchu = [&](int sub) {
      int st = lane >> 2, p4 = (lane & 3) * 4;
      int jl = d == 0 ? sub * 16 + st : 63 - (sub * 16 + st);
      ru = *(const uint2*)(proj + (size_t)(b * TT + nc * 64 + jl) * PC + C_S5U + g * 16 + p4);
    };
    fetchu(0);
    for (int sub = 0; sub < 4; sub++) {
      __syncthreads();
      {
        int st = lane >> 2, p4 = (lane & 3) * 4;
        *(float4*)(ubuf + st * 16 + p4) = make_float4(__uint_as_float(ru.x << 16), __uint_as_float(ru.x & 0xffff0000u),
                                                       __uint_as_float(ru.y << 16), __uint_as_float(ru.y & 0xffff0000u));
      }
      __syncthreads();
      if (sub + 1 < 4) fetchu(sub + 1);
#pragma unroll 2
      for (int st = 0; st < 16; st++) {
        float bur = 0.f, bui = 0.f;
#pragma unroll
        for (int i4 = 0; i4 < 4; i4++) {
          float4 uu = *(const float4*)(ubuf + st * 16 + i4 * 4);
          bur += bbr[i4*4] * uu.x + bbr[i4*4+1] * uu.y + bbr[i4*4+2] * uu.z + bbr[i4*4+3] * uu.w;
          bui += bbi[i4*4] * uu.x + bbi[i4*4+1] * uu.y + bbi[i4*4+2] * uu.z + bbi[i4*4+3] * uu.w;
        }
        float nre = are * hre - aim * him + bur;
        float nim = are * him + aim * hre + bui;
        hre = nre; him = nim;
        if (PASS == 2) *(unsigned*)(hbuf + st * 136 + lane * 2) = pack2(hre, him);
      }
      if (PASS == 2) {
        __syncthreads();
        f32x4 acc = (f32x4){0.f, 0.f, 0.f, 0.f};
#pragma unroll
        for (int ks = 0; ks < 4; ks++) {
          bf16x8 af = *(const bf16x8*)(hbuf + (lane & 15) * 136 + ks * 32 + (lane >> 4) * 8);
          acc = __builtin_amdgcn_mfma_f32_16x16x32_bf16(af, cfrag[ks], acc, 0, 0, 0);
        }
#pragma unroll
        for (int r = 0; r < 4; r++) {
          int st = (lane >> 4) * 4 + r;
          int jl = d == 0 ? sub * 16 + st : 63 - (sub * 16 + st);
          float* yp = ybuf + jl * 16 + (lane & 15);
          if (d == 0) *yp = acc[r]; else *yp += acc[r];
        }
      }
    }
    if (PASS == 1) st5[sidx] = make_float2(hre, him);
  }
  if (PASS == 2) {
    __syncthreads();
    const float* dsk = p.in[15] + layer * 256 + g * 16;
#pragma unroll
    for (int i = 0; i < 16; i++) {
      int idx = lane + 64 * i; int jl = idx >> 4, pp = idx & 15;
      u16* up = proj + (size_t)(b * TT + nc * 64 + jl) * PC + C_S5U + g * 16 + pp;
      float y = ybuf[jl * 16 + pp] + dsk[pp] * bf2f(*up);
      *up = f2bf(geluf_(y));
    }
  }
}
__device__ void s5_carry_task(const Params& p, int layer, int task) {
  int e = task * 256 + tid_();
  int n = e & 63, g = (e >> 6) & 15, d = e >> 13;
  float lre = p.in[8][(((size_t)layer * 2 + d) * 16 + g) * 64 + n];
  float lim = p.in[9][(((size_t)layer * 2 + d) * 16 + g) * 64 + n];
  float dt = __expf(p.in[10][((size_t)layer * 2 + d) * 16 + g]);
  float mag = __expf(lre * dt * 64.f);
  float sn, cs; sincosf(lim * dt * 64.f, &sn, &cs);
  float are = mag * cs, aim = mag * sn;
  float2* st5 = (float2*)(p.ws + OFF_S5ST) + (size_t)(e >> 6) * 36 * 64 + n;
  float sre = 0.f, sim = 0.f;
  for (int c = 0; c < 36; c++) {
    float2 E = st5[(size_t)c * 64];
    st5[(size_t)c * 64] = make_float2(sre, sim);
    float nre = are * sre - aim * sim + E.x;
    float nim = are * sim + aim * sre + E.y;
    sre = nre; sim = nim;
  }
}

__device__ __forceinline__ void group_barrier(unsigned* cnt, unsigned target) {
  asm volatile("s_waitcnt vmcnt(0)" ::: "memory");
  __syncthreads();
  if (tid_() == 0) {
    __threadfence();
    __hip_atomic_fetch_add(cnt, 1u, __ATOMIC_RELAXED, __HIP_MEMORY_SCOPE_AGENT);
    while (__hip_atomic_load(cnt, __ATOMIC_RELAXED, __HIP_MEMORY_SCOPE_AGENT) < target) __builtin_amdgcn_s_sleep(2);
    __threadfence();
  }
  __syncthreads();
}
#define LDS_FLOATS 18432
#define SYNC() grid.sync()
#define RW_TWO false
#define NRW (RW_TWO ? 128 : 256)

__global__ void __launch_bounds__(256, 2) fwd_megakernel(Params p) {
  cg::grid_group grid = cg::this_grid();
  __shared__ __attribute__((aligned(16))) float lds[LDS_FLOATS];
  const int bid = blockIdx.x, nb = gridDim.x, t = tid_();

  for (int task = bid; task < N_CONVERT_TASKS + 96 + 1; task += nb) {
    if (task < 96) mods_task(p, task, lds);
    else if (task == 96) {
      if (t < 4) ((unsigned*)(p.ws + OFF_BAR))[t] = 0u;
      float* rope = (float*)(p.ws + OFF_ROPE);
      for (int i = t; i < 1024; i += 256) {
        int pos = i >> 4, fi = i & 15;
        float fr = powf(10000.f, -(float)fi / 16.f);
        float ang = (float)pos * fr;
        rope[i * 2] = cosf(ang); rope[i * 2 + 1] = sinf(ang);
      }
    } else convert_task(p, 0, task - 97, lds);
  }
  SYNC();
  for (int task = bid; task < MROWS / 4; task += nb) ln_row(p, 0, 0, task * 4 + (t >> 6));
  SYNC();

  for (int layer = 0; layer < 2; layer++) {
    const int latonly = layer;
    if ((nb & 7) == 0) { int tm, tn; for (int it = 0; xcd_tile(it, bid, nb, 144, 31, 6, tm, tn); it++) inproj_tile(p, layer, tm, tn, (u16*)lds); }
    else for (int task = bid; task < 144 * 31; task += nb) inproj_tile(p, layer, task / 31, task % 31, (u16*)lds);
    SYNC();
    {
      const int ncg = latonly ? 8 : 9, ncs = latonly ? 32 : 36;
      const int NG = 64 * ncg, NS = 32 * ncs;
      auto p2_task = [&](int task) {
        if (task < NG) {
          int nc = task % ncg + (latonly ? 1 : 0); int q = task / ncg; int h = q & 3; q >>= 2; int b = q & 7; int mx = q >> 3;
          gla_p2_task(p, layer, mx, b, h, nc, lds);
        } else {
          int q = task - NG; int gq = q & 3; q >>= 2; int nc = q % ncs + (latonly ? 4 : 0); int b = q / ncs;
          s5_task<2>(p, layer, ((b * 36 + nc) << 2) | gq, lds);
        }
      };
      if (nb >= NRW + 128) {
        unsigned* bar = (unsigned*)(p.ws + OFF_BAR);
        const int ng = nb - NRW;
        if (bid < NRW) {
          rwkv_scan_task<RW_TWO>(p, layer, bid, lds);
          if (t == 0) {
            while (__hip_atomic_load(bar, __ATOMIC_RELAXED, __HIP_MEMORY_SCOPE_AGENT) < (unsigned)ng * (2u * layer + 2u)) __builtin_amdgcn_s_sleep(8);
            __threadfence();
          }
          __syncthreads();
        } else {
          const int gb = bid - NRW;
          for (int task = gb; task < 2304; task += ng) {
            if (task < 1152) gla_p1_task(p, layer, task, lds); else s5_task<1>(p, layer, task - 1152, lds);
          }
          group_barrier(bar, (unsigned)ng * (2u * layer + 1u));
          for (int task = gb; task < 2048 + 64; task += ng) {
            if (task < 2048) gla_carry_task(p, layer, task); else s5_carry_task(p, layer, task - 2048);
          }
          group_barrier(bar, (unsigned)ng * (2u * layer + 2u));
        }
        int* shq = (int*)(lds + LDS_FLOATS - 4);
        for (;;) {
          __syncthreads();
          if (t == 0) *shq = (int)__hip_atomic_fetch_add(bar + 1 + layer, 1u, __ATOMIC_RELAXED, __HIP_MEMORY_SCOPE_AGENT);
          __syncthreads();
          const int task = *shq;
          if (task >= NG + NS) break;
          p2_task(task);
        }
        SYNC();
      } else {
        for (int task = bid; task < NRW + 2304; task += nb) {
          if (task < NRW) rwkv_scan_task<RW_TWO>(p, layer, task, lds);
          else if (task < NRW + 1152) gla_p1_task(p, layer, task - NRW, lds);
          else s5_task<1>(p, layer, task - NRW - 1152, lds);
        }
        SYNC();
        for (int task = bid; task < 2048 + 64; task += nb) {
          if (task < 2048) gla_carry_task(p, layer, task); else s5_carry_task(p, layer, task - 2048);
        }
        SYNC();
        for (int task = bid; task < NG + NS; task += nb) p2_task(task);
        SYNC();
      }
    }
    {
      const int ntm = latonly ? 128 : 144;
      for (int task = bid; task < ntm * 2 + MROWS; task += nb) {
        if (task < ntm * 2) glu_tile(p, layer, latonly, task >> 1, task & 1, (u16*)lds);
        else {
          int row = task - ntm * 2;
          if (!(latonly && (row % TT) < 256)) rwkv_combine_row(p, layer, row);
        }
      }
    }
    SYNC();
    {
      const int ntm = latonly ? 128 : 144;
      if ((nb & 7) == 0) { int tm, tn; for (int it = 0; xcd_tile(it, bid, nb, ntm, 16, 8, tm, tn); it++) merge_tile(p, layer, latonly, tm, tn, (u16*)lds); }
      else for (int task = bid; task < ntm * 16; task += nb) merge_tile(p, layer, latonly, task >> 4, task & 15, (u16*)lds);
    }
    SYNC();
    {
      const int ntm = latonly ? 128 : 144;
      if ((nb & 7) == 0) { int tm, tn; for (int it = 0; xcd_tile(it, bid, nb, ntm, 8, 8, tm, tn); it++) outproj_tile(p, layer, latonly, tm, tn, (u16*)lds); }
      else for (int task = bid; task < ntm * 8; task += nb) outproj_tile(p, layer, latonly, task >> 3, task & 7, (u16*)lds);
    }
    SYNC();
    if (layer == 0) {
      for (int task = bid; task < MROWS / 4 + N_CONVERT_TASKS; task += nb) {
        if (task < N_CONVERT_TASKS) convert_task(p, 1, task, lds);
        else ln_row(p, 1, 0, (task - N_CONVERT_TASKS) * 4 + (t >> 6));
      }
      SYNC();
    } else {
      for (int task = bid; task < NBATCH * 2048 / 4; task += nb) {
        int r = task * 4 + (t >> 6); int b = r >> 11, tl = r & 2047;
        ln_row(p, 1, 1, b * TT + 256 + tl);
      }
    }
  }
}

extern "C" void kernel_launch(void* const* d_in, const int* in_sizes, int n_in,
                              void* d_out, int out_size, void* d_ws, size_t ws_size,
                              hipStream_t stream) {
  static int grid_blocks = 0;
  if (!grid_blocks) {
    int dev = 0, cus = 0, per_cu = 0;
    (void)hipGetDevice(&dev);
    (void)hipDeviceGetAttribute(&cus, hipDeviceAttributeMultiprocessorCount, dev);
    (void)hipOccupancyMaxActiveBlocksPerMultiprocessor(&per_cu, fwd_megakernel, 256, 0);
    if (per_cu > 2) per_cu = 2;
    if (per_cu < 1) per_cu = 1;
    grid_blocks = cus * per_cu;
  }
  if (ws_size < WS_NEED) { fprintf(stderr, "workspace too small\n"); return; }
  Params p{};
  for (int i = 0; i < 36; i++) p.in[i] = (const float*)d_in[i];
  p.out = (float*)d_out;
  p.ws = (char*)d_ws;
  void* args[] = {&p};
  hipError_t e = hipLaunchCooperativeKernel((void*)fwd_megakernel, dim3(grid_blocks), dim3(256), args, 0, stream);
  if (e != hipSuccess) fprintf(stderr, "cooperative launch failed: %s (grid %d)\n", hipGetErrorString(e), grid_blocks);
}
```

```cpp
#include <hip/hip_runtime.h>
#include <hip/hip_bf16.h>
#include <hip/hip_cooperative_groups.h>
#include <cstdio>
namespace cg = cooperative_groups;

typedef __attribute__((ext_vector_type(8))) short bf16x8;
typedef __attribute__((ext_vector_type(4))) float f32x4;
typedef unsigned short u16;

#define D_ 1024
#define NBATCH 8
#define TT 2304
#define MROWS 18432
#define PC 3904
#define DIN 8000
#define C_S5U 0
#define C_S5Z 256
#define C_HGQ 512
#define C_HGF 768
#define C_HGI 1280
#define C_HGZ 1536
#define C_RTQ 1792
#define C_RTK 2048
#define C_RTV 2304
#define C_RTZ 2560
#define C_RWX 2816
#define C_RWZ 3648

#define OFF_WINT   0ul
#define OFF_WBT    (OFF_WINT + 16384000ul)
#define OFF_WOT    (OFF_WBT + 2097152ul)
#define OFF_GLUT   (OFF_WOT + 2097152ul)
#define OFF_U      (OFF_GLUT + 131072ul)
#define OFF_PROJ   (OFF_U + 37748736ul)
#define OFF_HCTX   (OFF_PROJ + 143917056ul)
#define OFF_SCR    (OFF_HCTX + 8388608ul)
#define OFF_RWO    (OFF_SCR)
#define OFF_HGST   (OFF_SCR + 18874368ul)
#define OFF_RTST   (OFF_HGST + 9437184ul)
#define OFF_RETOF  (OFF_SCR + 37748736ul)
#define OFF_S5ST   (OFF_RETOF + 9437184ul)
#define OFF_MODS   (OFF_S5ST + 4718592ul)
#define OFF_HGP    (OFF_MODS + 221184ul)
#define OFF_BONUS  (OFF_HGP + 147456ul)
#define OFF_ROPE   (OFF_BONUS + 589824ul)
#define OFF_BAR    (OFF_ROPE + 8192ul)
#define OFF_XB     (OFF_BAR + 256ul)
#define WS_NEED    (OFF_XB + 16384ul)

struct Params {
  const float* in[36];
  float* out;
  char* ws;
};

__device__ __forceinline__ int tid_() { int t = __builtin_amdgcn_workitem_id_x(); asm volatile("" : "+v"(t)); return t; }
__device__ __forceinline__ u16 f2bf(float f) {
  unsigned u = __float_as_uint(f);
  u += 0x7fffu + ((u >> 16) & 1u);
  return (u16)(u >> 16);
}
__device__ __forceinline__ float bf2f(u16 h) { return __uint_as_float(((unsigned)h) << 16); }
__device__ __forceinline__ unsigned pack2(float a, float b) { return (unsigned)f2bf(a) | ((unsigned)f2bf(b) << 16); }
__device__ __forceinline__ float sigmoidf_(float x) { return __builtin_amdgcn_rcpf(1.f + __expf(-x)); }
__device__ __forceinline__ float siluf_(float x) { return x * __builtin_amdgcn_rcpf(1.f + __expf(-x)); }
__device__ __forceinline__ float geluf_(float x) {
  float t = tanhf(0.7978845608028654f * (x + 0.044715f * x * x * x));
  return 0.5f * x * (1.f + t);
}
template <int CTRL>
__device__ __forceinline__ float dppf(float x) {
  return __int_as_float(__builtin_amdgcn_update_dpp(0, __float_as_int(x), CTRL, 0xf, 0xf, true));
}
__device__ __forceinline__ float allsum16(float x) {
  x += dppf<0x128>(x);
  x += dppf<0x124>(x);
  x += dppf<0x122>(x);
  x += dppf<0x121>(x);
  return x;
}
__device__ __forceinline__ float wavesum(float x) {
  x = allsum16(x);
  x += __shfl_xor(x, 16, 64);
  x += __shfl_xor(x, 32, 64);
  return x;
}
__device__ __forceinline__ void ld4bf(const u16* p, float (&o)[4]) {
  uint2 v = *(const uint2*)p;
  o[0] = __uint_as_float(v.x << 16); o[1] = __uint_as_float(v.x & 0xffff0000u);
  o[2] = __uint_as_float(v.y << 16); o[3] = __uint_as_float(v.y & 0xffff0000u);
}
__device__ __forceinline__ void st4bf(u16* p, float a, float b, float c, float d) {
  uint2 v; v.x = pack2(a, b); v.y = pack2(c, d);
  *(uint2*)p = v;
}
__device__ __forceinline__ int jmap(int d, int s) { return d == 0 ? s : (s < 256 ? 255 - s : 2559 - s); }
__device__ __forceinline__ bool has_prev(int j) { return j != 0 && j != 256; }
__device__ __forceinline__ bool has_next(int j) { return j != 255 && j != 2303; }

__device__ __forceinline__ const float* hin_ptr(const Params& p, int layer, int row) {
  int b = row / TT, j = row - b * TT;
  if (layer == 0) return j < 256 ? p.in[2] + ((size_t)(b * 256 + j)) * D_ : p.in[0] + ((size_t)(b * 2048 + j - 256)) * D_;
  return j < 256 ? (const float*)(p.ws + OFF_HCTX) + ((size_t)(b * 256 + j)) * D_ : p.out + ((size_t)(b * 2048 + j - 256)) * D_;
}
__device__ __forceinline__ float* hout_ptr(const Params& p, int row) {
  int b = row / TT, j = row - b * TT;
  return j < 256 ? (float*)(p.ws + OFF_HCTX) + ((size_t)(b * 256 + j)) * D_ : p.out + ((size_t)(b * 2048 + j - 256)) * D_;
}
__device__ __forceinline__ int modrow_of(int row) { int b = row / TT, j = row - b * TT; return j < 256 ? 8 : b; }

__device__ void transpose_tile(const float* __restrict__ src, u16* __restrict__ dst, int K, int N, int k0, int n0, float* lds) {
  const int t = tid_();
  __syncthreads();
#pragma unroll
  for (int i = 0; i < 16; i++) {
    int r = i * 4 + (t >> 6), c = t & 63;
    lds[r * 65 + c] = src[(size_t)(k0 + r) * N + n0 + c];
  }
  __syncthreads();
#pragma unroll
  for (int i = 0; i < 16; i++) {
    int r = i * 4 + (t >> 6), c = t & 63;
    dst[(size_t)(n0 + r) * K + k0 + c] = f2bf(lds[c * 65 + r]);
  }
}
__device__ void convert_task(const Params& p, int layer, int task, float* lds) {
  if (task < 2000) {
    int kt = task / 125, nt = task % 125;
    transpose_tile(p.in[6] + (size_t)layer * 1024 * DIN, (u16*)(p.ws + OFF_WINT), 1024, DIN, kt * 64, nt * 64, lds);
  } else if (task < 2256) {
    int q = task - 2000; int br = q >> 6; q &= 63; int kt = q >> 4, nt = q & 15;
    transpose_tile(p.in[31] + ((size_t)layer * 4 + br) * 256 * 1024, (u16*)(p.ws + OFF_WBT) + (size_t)br * 1024 * 256, 256, 1024, kt * 64, nt * 64, lds);
  } else if (task < 2512) {
    int q = task - 2256; int kt = q >> 4, nt = q & 15;
    transpose_tile(p.in[32] + (size_t)layer * 1024 * 1024, (u16*)(p.ws + OFF_WOT), 1024, 1024, kt * 64, nt * 64, lds);
  } else {
    int q = task - 2512; int kt = q >> 2, nt = q & 3;
    transpose_tile(p.in[16] + (size_t)layer * 256 * 256, (u16*)(p.ws + OFF_GLUT), 256, 256, kt * 64, nt * 64, lds);
  }
}
#define N_CONVERT_TASKS 2528

__device__ void mods_task(const Params& p, int task, float* lds) {
  const int t = tid_();
  int layer = task / 48, cgp = task % 48;
  float* sc = lds;
  float* red = lds + 9 * 1024;
  __syncthreads();
  for (int i = t; i < 9 * 1024; i += 256) {
    int r = i >> 10, k = i & 1023;
    float v = r < 8 ? p.in[1][r * 1024 + k] : p.in[3][k];
    sc[i] = siluf_(v);
  }
  __syncthreads();
  int col = cgp * 64 + (t & 63), kq = t >> 6;
  float acc[9];
#pragma unroll
  for (int r = 0; r < 9; r++) acc[r] = 0.f;
  const float* wp = p.in[4] + (size_t)layer * 1024 * 3072 + col;
#pragma unroll 16
  for (int k = kq * 256; k < kq * 256 + 256; k++) {
    float w = wp[(size_t)k * 3072];
#pragma unroll
    for (int r = 0; r < 9; r++) acc[r] += sc[r * 1024 + k] * w;
  }
#pragma unroll
  for (int r = 0; r < 9; r++) red[(kq * 9 + r) * 64 + (t & 63)] = acc[r];
  __syncthreads();
  float* mods = (float*)(p.ws + OFF_MODS);
  for (int i = t; i < 9 * 64; i += 256) {
    int r = i >> 6, c = i & 63;
    float s = red[(0 * 9 + r) * 64 + c] + red[(1 * 9 + r) * 64 + c] + red[(2 * 9 + r) * 64 + c] + red[(3 * 9 + r) * 64 + c];
    int cc = cgp * 64 + c;
    mods[((size_t)layer * 9 + r) * 3072 + cc] = s + p.in[5][layer * 3072 + cc];
  }
}

__device__ void ln_row(const Params& p, int mode, int layer, int row) {
  const int lane = tid_() & 63;
  float v[16];
  if (mode == 0) {
    const float* src = hin_ptr(p, 0, row);
#pragma unroll
    for (int i = 0; i < 4; i++) { float4 q = *(const float4*)(src + i * 256 + lane * 4); v[i*4]=q.x; v[i*4+1]=q.y; v[i*4+2]=q.z; v[i*4+3]=q.w; }
  } else {
    float* src = hout_ptr(p, row);
#pragma unroll
    for (int i = 0; i < 4; i++) { float4 q = *(const float4*)(src + i * 256 + lane * 4); v[i*4]=q.x; v[i*4+1]=q.y; v[i*4+2]=q.z; v[i*4+3]=q.w; }
    float s = 0.f;
#pragma unroll
    for (int i = 0; i < 16; i++) s += v[i];
    float mean = wavesum(s) * (1.f / 1024.f);
    float q2 = 0.f;
#pragma unroll
    for (int i = 0; i < 16; i++) { v[i] -= mean; q2 += v[i] * v[i]; }
    float rstd = rsqrtf(wavesum(q2) * (1.f / 1024.f) + 1e-5f);
    const float* lw = p.in[34] + layer * 1024; const float* lb = p.in[35] + layer * 1024;
#pragma unroll
    for (int i = 0; i < 4; i++) {
      float4 w4 = *(const float4*)(lw + i * 256 + lane * 4), b4 = *(const float4*)(lb + i * 256 + lane * 4);
      v[i*4] = v[i*4] * rstd * w4.x + b4.x; v[i*4+1] = v[i*4+1] * rstd * w4.y + b4.y;
      v[i*4+2] = v[i*4+2] * rstd * w4.z + b4.z; v[i*4+3] = v[i*4+3] * rstd * w4.w + b4.w;
      *(float4*)(src + i * 256 + lane * 4) = make_float4(v[i*4], v[i*4+1], v[i*4+2], v[i*4+3]);
    }
    if (layer == 1) return;
  }
  int ml = mode == 0 ? 0 : 1;
  float s = 0.f;
#pragma unroll
  for (int i = 0; i < 16; i++) s += v[i];
  float mean = wavesum(s) * (1.f / 1024.f);
  float q2 = 0.f;
#pragma unroll
  for (int i = 0; i < 16; i++) { v[i] -= mean; q2 += v[i] * v[i]; }
  float rstd = rsqrtf(wavesum(q2) * (1.f / 1024.f) + 1e-5f);
  const float* md = (const float*)(p.ws + OFF_MODS) + ((size_t)ml * 9 + modrow_of(row)) * 3072;
  u16* up = (u16*)(p.ws + OFF_U) + (size_t)row * 1024;
#pragma unroll
  for (int i = 0; i < 4; i++) {
    float4 sh = *(const float4*)(md + i * 256 + lane * 4), sc = *(const float4*)(md + 1024 + i * 256 + lane * 4);
    st4bf(up + i * 256 + lane * 4, v[i*4] * rstd * (1.f + sc.x) + sh.x, v[i*4+1] * rstd * (1.f + sc.y) + sh.y,
          v[i*4+2] * rstd * (1.f + sc.z) + sh.z, v[i*4+3] * rstd * (1.f + sc.w) + sh.w);
  }
}

#define STAGE_LOAD(P, kk_) do { const unsigned k_ = (kk_); \
  P##a0 = *(const uint4*)(A + (oa + k_)); P##a1 = *(const uint4*)(A + (oa + sa + k_)); \
  P##a2 = *(const uint4*)(A + (oa + 2 * sa + k_)); P##a3 = *(const uint4*)(A + (oa + 3 * sa + k_)); \
  P##b0 = *(const uint4*)(B + (ob + k_)); P##b1 = *(const uint4*)(B + (ob + sb + k_)); \
  if (NT == 4) { P##b2 = *(const uint4*)(B + (ob + 2 * sb + k_)); P##b3 = *(const uint4*)(B + (ob + 3 * sb + k_)); } } while (0)
#define STAGE_WRITE(P, Asw, Bsw) do { \
  *(uint4*)(Asw) = P##a0; *(uint4*)((Asw) + 32 * 72) = P##a1; *(uint4*)((Asw) + 64 * 72) = P##a2; *(uint4*)((Asw) + 96 * 72) = P##a3; \
  *(uint4*)(Bsw) = P##b0; *(uint4*)((Bsw) + 32 * 72) = P##b1; \
  if (NT == 4) { *(uint4*)((Bsw) + 64 * 72) = P##b2; *(uint4*)((Bsw) + 96 * 72) = P##b3; } } while (0)
template <int MT, int NT>
__device__ __forceinline__ void stage_compute(f32x4 (&acc)[MT][NT], const u16* As, const u16* Bs, int lane, int wm, int wn) {
#pragma unroll
  for (int kk = 0; kk < 2; kk++) {
    bf16x8 af[MT], bfr[NT];
#pragma unroll
    for (int mt = 0; mt < MT; mt++) af[mt] = *(const bf16x8*)(As + (wm * MT * 16 + mt * 16 + (lane & 15)) * 72 + kk * 32 + (lane >> 4) * 8);
#pragma unroll
    for (int nt = 0; nt < NT; nt++) bfr[nt] = *(const bf16x8*)(Bs + (wn * NT * 16 + nt * 16 + (lane & 15)) * 72 + kk * 32 + (lane >> 4) * 8);
    __builtin_amdgcn_s_setprio(1);
#pragma unroll
    for (int mt = 0; mt < MT; mt++)
#pragma unroll
      for (int nt = 0; nt < NT; nt++)
        acc[mt][nt] = __builtin_amdgcn_mfma_f32_16x16x32_bf16(af[mt], bfr[nt], acc[mt][nt], 0, 0, 0);
    __builtin_amdgcn_s_setprio(0);
  }
}
template <int MT, int NT>
__device__ __forceinline__ void gemm_kloop(f32x4 (&acc)[MT][NT], const u16* __restrict__ A, int lda,
                                           const u16* __restrict__ B, int ldb, int K, u16* lds) {
  static_assert(MT == 4, "MT");
  constexpr int BM = MT * 32, BN = NT * 32, SS = (BM + BN) * 72;
  const int t = tid_(), lane = t & 63, w = t >> 6, wm = w >> 1, wn = w & 1;
  u16* As0 = lds; u16* Bs0 = lds + BM * 72; u16* As1 = lds + SS; u16* Bs1 = lds + SS + BM * 72;
  const int lr = t >> 3, lc = (t & 7) * 8;
  const unsigned oa = (unsigned)(lr * lda + lc), ob = (unsigned)(lr * ldb + lc);
  const unsigned sa = 32u * (unsigned)lda, sb = 32u * (unsigned)ldb;
  const int swo = lr * 72 + lc;
  const unsigned klast = (unsigned)(K - 64);
  uint4 R0a0, R0a1, R0a2, R0a3, R0b0, R0b1, R0b2, R0b3, R1a0, R1a1, R1a2, R1a3, R1b0, R1b1, R1b2, R1b3;
  STAGE_LOAD(R0, 0u);
  STAGE_LOAD(R1, 64u);
  __syncthreads();
  STAGE_WRITE(R0, As0 + swo, Bs0 + swo);
  STAGE_LOAD(R0, 128u < klast ? 128u : klast);
  __syncthreads();
#pragma unroll 1
  for (int k0 = 0; k0 < K; k0 += 128) {
    STAGE_WRITE(R1, As1 + swo, Bs1 + swo);
    { unsigned kn = (unsigned)k0 + 192u; STAGE_LOAD(R1, kn < klast ? kn : klast); }
    stage_compute<MT, NT>(acc, As0, Bs0, lane, wm, wn);
    __syncthreads();
    STAGE_WRITE(R0, As0 + swo, Bs0 + swo);
    { unsigned kn = (unsigned)k0 + 256u; STAGE_LOAD(R0, kn < klast ? kn : klast); }
    stage_compute<MT, NT>(acc, As1, Bs1, lane, wm, wn);
    __syncthreads();
  }
}
template <int MT, int NT>
__device__ __forceinline__ void zero_acc(f32x4 (&acc)[MT][NT]) {
#pragma unroll
  for (int i = 0; i < MT; i++)
#pragma unroll
    for (int j = 0; j < NT; j++) acc[i][j] = (f32x4){0.f, 0.f, 0.f, 0.f};
}
__device__ __forceinline__ int tile_m0(int latonly, int tm) {
  if (!latonly) return tm * 128;
  int b = tm >> 4; return b * TT + 256 + (tm & 15) * 128;
}

__device__ __forceinline__ bool xcd_tile(int it, int bid, int nb, int NTM, int NTN, int G, int& tm, int& tn) {
  const int xcd = bid & 7, lb = bid >> 3, nlb = nb >> 3, tmx = NTM >> 3;
  const int idx = it * nlb + lb;
  if (idx >= tmx * NTN) return false;
  const int full = tmx / G;
  int g = idx / (G * NTN);
  if (g > full) g = full;
  const int r = idx - g * G * NTN;
  const int gs = (g < full) ? G : (tmx - full * G);
  tn = r / gs;
  tm = xcd * tmx + g * G + (r - tn * gs);
  return true;
}
__device__ void inproj_tile(const Params& p, int layer, int tm, int tn, u16* lds) {
  int m0 = tm * 128, n0 = tn * 128;
  f32x4 acc[4][4]; zero_acc(acc);
  gemm_kloop<4, 4>(acc, (const u16*)(p.ws + OFF_U) + (size_t)m0 * 1024, 1024,
                   (const u16*)(p.ws + OFF_WINT) + (size_t)n0 * 1024, 1024, 1024, lds);
  const int t = tid_(), lane = t & 63, w = t >> 6, wm = w >> 1, wn = w & 1;
  const float* bias = p.in[7] + (size_t)layer * DIN;
  u16* proj = (u16*)(p.ws + OFF_PROJ);
#pragma unroll
  for (int nt = 0; nt < 4; nt++) {
    const int cl = wn * 64 + nt * 16 + (lane & 15);
    const float bv = (n0 + cl < PC) ? bias[n0 + cl] : 0.f;
#pragma unroll
    for (int mt = 0; mt < 4; mt++)
#pragma unroll
      for (int r = 0; r < 4; r++) lds[(wm * 64 + mt * 16 + (lane >> 4) * 4 + r) * 136 + cl] = f2bf(acc[mt][nt][r] + bv);
  }
  __syncthreads();
#pragma unroll
  for (int i = 0; i < 8; i++) {
    const int q = t + 256 * i, row = q >> 4, ch = q & 15;
    if (n0 + ch * 8 < PC) *(uint4*)(proj + (size_t)(m0 + row) * PC + n0 + ch * 8) = *(const uint4*)(lds + row * 136 + ch * 8);
  }
}
__device__ void glu_tile(const Params& p, int layer, int latonly, int tm, int tn, u16* lds) {
  int m0 = tile_m0(latonly, tm), n0 = tn * 128;
  f32x4 acc[4][4]; zero_acc(acc);
  u16* proj = (u16*)(p.ws + OFF_PROJ);
  gemm_kloop<4, 4>(acc, proj + (size_t)m0 * PC + C_S5U, PC, (const u16*)(p.ws + OFF_GLUT) + (size_t)n0 * 256, 256, 256, lds);
  const int t = tid_(), lane = t & 63, w = t >> 6, wm = w >> 1, wn = w & 1;
  const float* bias = p.in[17] + layer * 256;
#pragma unroll
  for (int nt = 0; nt < 4; nt++) {
    const int cl = wn * 64 + nt * 16 + (lane & 15);
    const float bv = bias[n0 + cl];
#pragma unroll
    for (int mt = 0; mt < 4; mt++)
#pragma unroll
      for (int r = 0; r < 4; r++) lds[(wm * 64 + mt * 16 + (lane >> 4) * 4 + r) * 136 + cl] = f2bf(sigmoidf_(acc[mt][nt][r] + bv));
  }
  __syncthreads();
#pragma unroll
  for (int i = 0; i < 8; i++) {
    const int q = t + 256 * i, row = q >> 4, ch = q & 15;
    u16* pr = proj + (size_t)(m0 + row) * PC + n0 + ch * 8;
    uint4 sg = *(const uint4*)(lds + row * 136 + ch * 8);
    uint4 yy = *(const uint4*)(pr + C_S5U), zz = *(const uint4*)(pr + C_S5Z), oo;
    const unsigned* sgp = (const unsigned*)&sg; const unsigned* yp = (const unsigned*)&yy; const unsigned* zp = (const unsigned*)&zz; unsigned* op = (unsigned*)&oo;
#pragma unroll
    for (int e = 0; e < 4; e++) {
      float s0 = __uint_as_float(sgp[e] << 16), s1 = __uint_as_float(sgp[e] & 0xffff0000u);
      float y0 = __uint_as_float(yp[e] << 16), y1 = __uint_as_float(yp[e] & 0xffff0000u);
      float z0 = __uint_as_float(zp[e] << 16), z1 = __uint_as_float(zp[e] & 0xffff0000u);
      op[e] = pack2(y0 * s0 * siluf_(z0), y1 * s1 * siluf_(z1));
    }
    *(uint4*)(pr + C_S5Z) = oo;
  }
}
__device__ void merge_tile(const Params& p, int layer, int latonly, int tm, int tn, u16* lds) {
  int m0 = tile_m0(latonly, tm), n0 = tn * 64;
  f32x4 accm[4][2]; zero_acc(accm);
  const u16* proj = (const u16*)(p.ws + OFF_PROJ);
  const int lane = tid_() & 63, w = tid_() >> 6, wm = w >> 1, wn = w & 1;
  const float* bias = p.in[7] + (size_t)layer * DIN + PC;
#pragma unroll 1
  for (int k = 0; k < 4; k++) {
    const int ycol = k == 0 ? C_S5Z : (k == 1 ? C_HGQ : (k == 2 ? C_RTQ : C_RWZ));
    f32x4 accb[4][2]; zero_acc(accb);
    gemm_kloop<4, 2>(accb, proj + (size_t)m0 * PC + ycol, PC,
                     (const u16*)(p.ws + OFF_WBT) + ((size_t)k * 1024 + n0) * 256, 256, 256, lds);
    f32x4 accg[4][2]; zero_acc(accg);
    gemm_kloop<4, 2>(accg, (const u16*)(p.ws + OFF_U) + (size_t)m0 * 1024, 1024,
                     (const u16*)(p.ws + OFF_WINT) + ((size_t)PC + k * 1024 + n0) * 1024, 1024, 1024, lds);
#pragma unroll
    for (int nt = 0; nt < 2; nt++) {
      float bv = bias[k * 1024 + n0 + wn * 32 + nt * 16 + (lane & 15)];
#pragma unroll
      for (int mt = 0; mt < 4; mt++)
#pragma unroll
        for (int r = 0; r < 4; r++) accm[mt][nt][r] += sigmoidf_(accg[mt][nt][r] + bv) * accb[mt][nt][r];
    }
  }
  u16* mg = (u16*)(p.ws + OFF_SCR);
#pragma unroll
  for (int nt = 0; nt < 2; nt++) {
    const int cl = wn * 32 + nt * 16 + (lane & 15);
#pragma unroll
    for (int mt = 0; mt < 4; mt++)
#pragma unroll
      for (int r = 0; r < 4; r++) lds[(wm * 64 + mt * 16 + (lane >> 4) * 4 + r) * 72 + cl] = f2bf(accm[mt][nt][r]);
  }
  __syncthreads();
  {
    const int t = tid_();
#pragma unroll
    for (int i = 0; i < 4; i++) {
      const int q = t + 256 * i, row = q >> 3, ch = q & 7;
      *(uint4*)(mg + (size_t)(m0 + row) * 1024 + n0 + ch * 8) = *(const uint4*)(lds + row * 72 + ch * 8);
    }
  }
}
__device__ void outproj_tile(const Params& p, int layer, int latonly, int tm, int tn, u16* lds) {
  int m0 = tile_m0(latonly, tm), n0 = tn * 128;
  f32x4 acc[4][4]; zero_acc(acc);
  gemm_kloop<4, 4>(acc, (const u16*)(p.ws + OFF_SCR) + (size_t)m0 * 1024, 1024,
                   (const u16*)(p.ws + OFF_WOT) + (size_t)n0 * 1024, 1024, 1024, lds);
  const int lane = tid_() & 63, w = tid_() >> 6, wm = w >> 1, wn = w & 1;
  const float* bias = p.in[33] + layer * 1024;
  const float* hi0 = hin_ptr(p, layer, m0);
  float* ho0 = hout_ptr(p, m0);
  const float* gate = (const float*)(p.ws + OFF_MODS) + ((size_t)layer * 9 + modrow_of(m0)) * 3072 + 2048;
  float* cs = (float*)lds;
#pragma unroll
  for (int nt = 0; nt < 4; nt++) {
    const int cl = wn * 64 + nt * 16 + (lane & 15);
    const float bv = bias[n0 + cl];
#pragma unroll
    for (int mt = 0; mt < 4; mt++)
#pragma unroll
      for (int r = 0; r < 4; r++) cs[(wm * 64 + mt * 16 + (lane >> 4) * 4 + r) * 132 + cl] = acc[mt][nt][r] + bv;
  }
  __syncthreads();
  {
    const int t = tid_();
#pragma unroll 4
    for (int i = 0; i < 16; i++) {
      const int q = t + 256 * i, row = q >> 5, ch = q & 31;
      const float4 a4 = *(const float4*)(cs + row * 132 + ch * 4);
      const float4 g4 = *(const float4*)(gate + n0 + ch * 4);
      const float4 h4 = *(const float4*)(hi0 + (size_t)row * 1024 + n0 + ch * 4);
      float4 o4;
      o4.x = 1.4142135623730951f * h4.x + g4.x * a4.x; o4.y = 1.4142135623730951f * h4.y + g4.y * a4.y;
      o4.z = 1.4142135623730951f * h4.z + g4.z * a4.z; o4.w = 1.4142135623730951f * h4.w + g4.w * a4.w;
      *(float4*)(ho0 + (size_t)row * 1024 + n0 + ch * 4) = o4;
    }
  }
}

template <bool TWO>
__device__ void rwkv_scan_task(const Params& p, int layer, int task, float* lds) {
  const int t = tid_();
  const int rh = TWO ? (task & 1) : (task & 3), h = TWO ? ((task >> 1) & 3) : ((task >> 2) & 3);
  const int b = TWO ? ((task >> 3) & 7) : ((task >> 4) & 7), d = TWO ? (task >> 6) : (task >> 7);
  constexpr int RPB = TWO ? 32 : 16;
  float* sh_lora = lds;
  float* sh_w2 = sh_lora + 512;
  float* sh_a2 = sh_w2 + 1024;
  float* sh_r = sh_a2 + 1024;
  float* sh_w = sh_r + 1024;
  float* sh_k = sh_w + 1024;
  float* sh_kk = sh_k + 1024;
  float* sh_b = sh_kk + 1024;
  float* sh_v = sh_b + 1024;
  float* sh_o = sh_v + 512;
  const u16* proj = (const u16*)(p.ws + OFF_PROJ);
  u16* rwo = (u16*)(p.ws + OFF_RWO) + (size_t)d * MROWS * 256;
  float* bonus = (float*)(p.ws + OFF_BONUS) + (size_t)d * MROWS * 4;
  const float* mu0 = p.in[21] + (size_t)layer * 2 * 832;
  const float* mu1 = mu0 + 832;
  __syncthreads();
  for (int i = t; i < 1024; i += 256) {
    int rr = i >> 6, c = i & 63;
    sh_w2[i] = p.in[23][(((size_t)layer * 2 + d) * 16 + rr) * 256 + h * 64 + c];
    sh_a2[i] = p.in[25][(((size_t)layer * 2 + d) * 16 + rr) * 256 + h * 64 + c];
  }
  const int pst = t >> 4, cq = t & 15;
  const int ch0 = h * 64 + cq * 4;
  float mur0[4], mur1[4], muk0[4], muk1[4], w0v[4], a0v[4], kkw[4], kaw[4], rkw[4];
#pragma unroll
  for (int i = 0; i < 4; i++) {
    mur0[i] = mu0[ch0 + i]; mur1[i] = mu1[ch0 + i];
    muk0[i] = mu0[256 + ch0 + i]; muk1[i] = mu1[256 + ch0 + i];
    w0v[i] = p.in[22][((size_t)layer * 2 + d) * 256 + ch0 + i];
    a0v[i] = p.in[24][((size_t)layer * 2 + d) * 256 + ch0 + i];
    kkw[i] = p.in[26][layer * 256 + ch0 + i];
    kaw[i] = p.in[27][layer * 256 + ch0 + i];
    rkw[i] = p.in[28][layer * 256 + ch0 + i];
  }
  const int vch = 512 + h * 64 + rh * RPB + cq;
  const float muv0 = mu0[vch], muv1 = mu1[vch], muw0 = TWO ? mu0[vch + 16] : 0.f, muw1 = TWO ? mu1[vch + 16] : 0.f;
  const int lidx0 = t * 2;
  float lmu00, lmu01, lmu10, lmu11;
  {
    int q = lidx0 & 31;
    int col = q < 16 ? (768 + d * 16 + q) : (800 + d * 16 + (q - 16));
    lmu00 = mu0[col]; lmu01 = mu0[col + 1]; lmu10 = mu1[col]; lmu11 = mu1[col + 1];
  }
  const int rl = t >> 4, ks = t & 15;
  float4 S = make_float4(0.f, 0.f, 0.f, 0.f), S2 = make_float4(0.f, 0.f, 0.f, 0.f);
  unsigned lx0 = 0, lx1 = 0, lxp0 = 0, lxp1 = 0, lxn0 = 0, lxn1 = 0;
  uint2 rr_c, rr_p, rr_n, rk_c, rk_p, rk_n;
  unsigned rv_c, rv_p, rv_n, rw_c = 0, rw_p = 0, rw_n = 0;
  auto fetch = [&](int s0) {
    {
      int st2 = lidx0 >> 5, q = lidx0 & 31;
      int j = jmap(d, s0 + st2);
      int col = q < 16 ? (768 + d * 16 + q) : (800 + d * 16 + (q - 16));
      const u16* pr = proj + ((size_t)(b * TT + j)) * PC + C_RWX + col;
      const u16* prp = has_prev(j) ? pr - PC : pr;
      const u16* prn = has_next(j) ? pr + PC : pr;
      lx0 = pr[0]; lx1 = pr[1]; lxp0 = prp[0]; lxp1 = prp[1]; lxn0 = prn[0]; lxn1 = prn[1];
    }
    int j = jmap(d, s0 + pst);
    const u16* pr = proj + ((size_t)(b * TT + j)) * PC + C_RWX;
    const u16* prp = has_prev(j) ? pr - PC : pr;
    const u16* prn = has_next(j) ? pr + PC : pr;
    rr_c = *(const uint2*)(pr + ch0); rr_p = *(const uint2*)(prp + ch0); rr_n = *(const uint2*)(prn + ch0);
    rk_c = *(const uint2*)(pr + 256 + ch0); rk_p = *(const uint2*)(prp + 256 + ch0); rk_n = *(const uint2*)(prn + 256 + ch0);
    rv_c = pr[vch]; rv_p = prp[vch]; rv_n = prn[vch];
    if (TWO) { rw_c = pr[vch + 16]; rw_p = prp[vch + 16]; rw_n = prn[vch + 16]; }
  };
  auto unpack4 = [](uint2 v, float (&o)[4]) {
    o[0] = __uint_as_float(v.x << 16); o[1] = __uint_as_float(v.x & 0xffff0000u);
    o[2] = __uint_as_float(v.y << 16); o[3] = __uint_as_float(v.y & 0xffff0000u);
  };
  fetch(0);
  for (int s0 = 0; s0 < TT; s0 += 16) {
    {
      int st2 = lidx0 >> 5, q = lidx0 & 31;
      int ja = jmap(d, s0 + st2);
      const float hpa = has_prev(ja) ? 1.f : 0.f, hna = has_next(ja) ? 1.f : 0.f;
      float x0 = __uint_as_float(lx0 << 16), x1 = __uint_as_float(lx1 << 16);
      float xs0 = x0 + lmu00 * (__uint_as_float(lxp0 << 16) * hpa - x0) + lmu10 * (__uint_as_float(lxn0 << 16) * hna - x0);
      float xs1 = x1 + lmu01 * (__uint_as_float(lxp1 << 16) * hpa - x1) + lmu11 * (__uint_as_float(lxn1 << 16) * hna - x1);
      if (q < 16) {
        xs0 = 1.f - 2.f * __builtin_amdgcn_rcpf(__expf(2.f * xs0) + 1.f);
        xs1 = 1.f - 2.f * __builtin_amdgcn_rcpf(__expf(2.f * xs1) + 1.f);
      }
      *(float2*)(sh_lora + lidx0) = make_float2(xs0, xs1);
    }
    __syncthreads();
    const int jcur = jmap(d, s0 + pst);
    {
      const float hpf = has_prev(jcur) ? 1.f : 0.f, hnf = has_next(jcur) ? 1.f : 0.f;
      float r4[4], k4[4], t0[4], t1[4];
      unpack4(rr_c, r4); unpack4(rr_p, t0); unpack4(rr_n, t1);
#pragma unroll
      for (int i = 0; i < 4; i++) r4[i] = r4[i] + mur0[i] * (t0[i] * hpf - r4[i]) + mur1[i] * (t1[i] * hnf - r4[i]);
      unpack4(rk_c, k4); unpack4(rk_p, t0); unpack4(rk_n, t1);
#pragma unroll
      for (int i = 0; i < 4; i++) k4[i] = k4[i] + muk0[i] * (t0[i] * hpf - k4[i]) + muk1[i] * (t1[i] * hnf - k4[i]);
      float wl[4], al[4];
#pragma unroll
      for (int i = 0; i < 4; i++) { wl[i] = w0v[i]; al[i] = a0v[i]; }
      float lrow[32];
#pragma unroll
      for (int i4 = 0; i4 < 8; i4++) {
        float4 q4 = *(const float4*)(sh_lora + pst * 32 + i4 * 4);
        lrow[i4 * 4] = q4.x; lrow[i4 * 4 + 1] = q4.y; lrow[i4 * 4 + 2] = q4.z; lrow[i4 * 4 + 3] = q4.w;
      }
#pragma unroll
      for (int rr = 0; rr < 16; rr++) {
        float lw_ = lrow[rr], la_ = lrow[16 + rr];
        float4 w2 = *(const float4*)(sh_w2 + rr * 64 + cq * 4);
        float4 a2 = *(const float4*)(sh_a2 + rr * 64 + cq * 4);
        wl[0] += lw_ * w2.x; wl[1] += lw_ * w2.y; wl[2] += lw_ * w2.z; wl[3] += lw_ * w2.w;
        al[0] += la_ * a2.x; al[1] += la_ * a2.y; al[2] += la_ * a2.z; al[3] += la_ * a2.w;
      }
      float wv[4], kd[4], kk[4], bb[4];
      float ss = 0.f, bon = 0.f;
#pragma unroll
      for (int i = 0; i < 4; i++) {
        float a = wl[i];
        float lw = fminf(a, 0.f) - __logf(1.f + __expf(-fabsf(a))) - 0.5f;
        wv[i] = __expf(-__expf(lw));
        float ic = sigmoidf_(al[i]);
        float kr = k4[i] * kkw[i];
        kk[i] = kr; ss += kr * kr;
        kd[i] = k4[i] * (1.f + (ic - 1.f) * kaw[i]);
        bb[i] = ic;
        bon += r4[i] * kd[i] * rkw[i];
      }
      ss = allsum16(ss); bon = allsum16(bon);
      float inv = rsqrtf(fmaxf(ss, 1e-24f));
#pragma unroll
      for (int i = 0; i < 4; i++) { kk[i] *= inv; bb[i] *= kk[i]; }
      *(float4*)(sh_r + pst * 64 + cq * 4) = make_float4(r4[0], r4[1], r4[2], r4[3]);
      *(float4*)(sh_w + pst * 64 + cq * 4) = make_float4(wv[0], wv[1], wv[2], wv[3]);
      *(float4*)(sh_k + pst * 64 + cq * 4) = make_float4(kd[0], kd[1], kd[2], kd[3]);
      *(float4*)(sh_kk + pst * 64 + cq * 4) = make_float4(kk[0], kk[1], kk[2], kk[3]);
      *(float4*)(sh_b + pst * 64 + cq * 4) = make_float4(bb[0], bb[1], bb[2], bb[3]);
      if (rh == 0 && cq == 0) bonus[(size_t)(b * TT + jcur) * 4 + h] = bon;
      float xv = __uint_as_float(rv_c << 16);
      sh_v[pst * 32 + cq] = xv + muv0 * (__uint_as_float(rv_p << 16) * hpf - xv) + muv1 * (__uint_as_float(rv_n << 16) * hnf - xv);
      float xw = __uint_as_float(rw_c << 16);
      if (TWO) sh_v[pst * 32 + 16 + cq] = xw + muw0 * (__uint_as_float(rw_p << 16) * hpf - xw) + muw1 * (__uint_as_float(rw_n << 16) * hnf - xw);
    }
    __syncthreads();
    if (s0 + 16 < TT) fetch(s0 + 16);
    float oacc = 0.f, oacc2 = 0.f;
    {
      float4 nkk = *(const float4*)(sh_kk + ks * 4), nw = *(const float4*)(sh_w + ks * 4), nb4 = *(const float4*)(sh_b + ks * 4);
      float4 nk = *(const float4*)(sh_k + ks * 4), nr = *(const float4*)(sh_r + ks * 4);
      float nv = sh_v[rl], nv2 = sh_v[16 + rl];
#pragma unroll 2
      for (int st = 0; st < 16; st++) {
        const float4 kk4 = nkk, w4 = nw, b4 = nb4, k4 = nk, r4 = nr; const float vv = nv, vv2 = nv2;
        {
          const int sn = (st + 1) & 15;
          nkk = *(const float4*)(sh_kk + sn * 64 + ks * 4); nw = *(const float4*)(sh_w + sn * 64 + ks * 4);
          nb4 = *(const float4*)(sh_b + sn * 64 + ks * 4); nk = *(const float4*)(sh_k + sn * 64 + ks * 4);
          nr = *(const float4*)(sh_r + sn * 64 + ks * 4); nv = sh_v[sn * 32 + rl]; nv2 = sh_v[sn * 32 + 16 + rl];
        }
        float sa = -((S.x * kk4.x + S.y * kk4.y) + (S.z * kk4.z + S.w * kk4.w));
        float sa2 = 0.f;
        if (TWO) sa2 = -((S2.x * kk4.x + S2.y * kk4.y) + (S2.z * kk4.z + S2.w * kk4.w));
        sa = allsum16(sa); if (TWO) sa2 = allsum16(sa2);
        S.x = S.x * w4.x + (sa * b4.x + vv * k4.x);
        S.y = S.y * w4.y + (sa * b4.y + vv * k4.y);
        S.z = S.z * w4.z + (sa * b4.z + vv * k4.z);
        S.w = S.w * w4.w + (sa * b4.w + vv * k4.w);
        if (TWO) {
          S2.x = S2.x * w4.x + (sa2 * b4.x + vv2 * k4.x);
          S2.y = S2.y * w4.y + (sa2 * b4.y + vv2 * k4.y);
          S2.z = S2.z * w4.z + (sa2 * b4.z + vv2 * k4.z);
          S2.w = S2.w * w4.w + (sa2 * b4.w + vv2 * k4.w);
        }
        float o = (S.x * r4.x + S.y * r4.y) + (S.z * r4.z + S.w * r4.w);
        float o2 = 0.f;
        if (TWO) o2 = (S2.x * r4.x + S2.y * r4.y) + (S2.z * r4.z + S2.w * r4.w);
        o = allsum16(o); if (TWO) o2 = allsum16(o2);
        oacc = (ks == st) ? o : oacc;
        oacc2 = (ks == st) ? o2 : oacc2;
      }
    }
    sh_o[ks * 32 + rl] = oacc;
    if (TWO) sh_o[ks * 32 + 16 + rl] = oacc2;
    __syncthreads();
    {
      u16* op = rwo + (size_t)(b * TT + jcur) * 256 + h * 64 + rh * RPB + cq;
      op[0] = f2bf(sh_o[pst * 32 + cq]);
      if (TWO) op[16] = f2bf(sh_o[pst * 32 + 16 + cq]);
    }
  }
}

__device__ void rwkv_combine_rows(const Params& p, int layer, int row0, int latonly) {
  const int lane = tid_() & 63, h = tid_() >> 6;
  const int ch = h * 64 + lane;
  const u16* rwo = (const u16*)(p.ws + OFF_RWO);
  u16* proj = (u16*)(p.ws + OFF_PROJ);
  const float* mu0 = p.in[21] + (size_t)layer * 2 * 832; const float* mu1 = mu0 + 832;
  const float* bonus = (const float*)(p.ws + OFF_BONUS);
  const float gw = p.in[29][layer * 256 + ch], gb = p.in[30][layer * 256 + ch];
  const float m0 = mu0[512 + ch], m1 = mu1[512 + ch];
  const int vc = C_RWX + 512 + ch;
  float o[8], xv[8], xp[8], xn[8], bs[8], z[8];
#pragma unroll
  for (int i = 0; i < 8; i++) {
    const int row = row0 + i;
    const int j = row % TT;
    const u16* pr = proj + (size_t)row * PC;
    o[i] = bf2f(rwo[(size_t)row * 256 + ch]) + bf2f(rwo[(size_t)MROWS * 256 + (size_t)row * 256 + ch]);
    xv[i] = bf2f(pr[vc]);
    xp[i] = has_prev(j) ? bf2f(pr[vc - PC]) : 0.f;
    xn[i] = has_next(j) ? bf2f(pr[vc + PC]) : 0.f;
    bs[i] = bonus[(size_t)row * 4 + h] + bonus[(size_t)MROWS * 4 + (size_t)row * 4 + h];
    z[i] = bf2f(pr[C_RWZ + ch]);
  }
#pragma unroll
  for (int i = 0; i < 8; i++) {
    const int row = row0 + i;
    if (latonly && (row % TT) < 256) continue;
    float mean = wavesum(o[i]) * (1.f / 64.f);
    float dlt = o[i] - mean;
    float var = wavesum(dlt * dlt) * (1.f / 64.f);
    float on = dlt * rsqrtf(var + 64e-5f) * gw + gb;
    float v = xv[i] + m0 * (xp[i] - xv[i]) + m1 * (xn[i] - xv[i]);
    proj[(size_t)row * PC + C_RWZ + ch] = f2bf((on + bs[i] * v) * siluf_(z[i]));
  }
}

template <int MX, int PASS>
__device__ __forceinline__ void gla_sweep(const Params& p, int layer, int d, int b, int h, int c, float* lds) {
  const int t = tid_(), w = t >> 6, lane = t & 63;
  float* kbuf = lds;
  float* fbuf = kbuf + 1024;
  float* qbuf = fbuf + 1024;
  float* vbuf = qbuf + 1024;
  float* part = vbuf + 1024;
  u16* proj = (u16*)(p.ws + OFF_PROJ);
  const int dbh = (d * 8 + b) * 4 + h;
  float* stt = (float*)(p.ws + (MX == 0 ? OFF_HGST : OFF_RTST)) + ((size_t)dbh * 9 + c) * 4096;
  float S[16];
#pragma unroll
  for (int i = 0; i < 16; i++) S[i] = PASS == 1 ? 0.f : stt[(w * 16 + i) * 64 + lane];
  float gam = 1.f;
  if (MX == 1) gam = __expf(-__expf(p.in[20][((size_t)layer * 2 + d) * 4 + h]));
  float Pl = 1.f;
  const int pst = t >> 4, c4 = (t & 15) * 4;
  float lb4[4] = {0.f, 0.f, 0.f, 0.f};
  if (MX == 0 && layer == 1) {
#pragma unroll
    for (int i = 0; i < 4; i++) {
      float l0 = p.in[18][(0 * 2 + d) * 256 + h * 64 + c4 + i], l1 = p.in[18][(1 * 2 + d) * 256 + h * 64 + c4 + i];
      float mx = fmaxf(l0, l1);
      float e0 = __expf(l0 - mx), e1 = __expf(l1 - mx);
      lb4[i] = e1 / (e0 + e1);
    }
  }
  const int vcol0 = (MX == 0 ? C_HGI : C_RTV) + h * 64;
  const float* rope = (const float*)(p.ws + OFF_ROPE);
  uint2 r_a, r_b, r_c, r_d, r_v; float4 r_cs0, r_cs1;
  r_a = r_b = r_c = r_d = r_v = make_uint2(0u, 0u); r_cs0 = r_cs1 = make_float4(1.f, 0.f, 1.f, 0.f);
  auto fetch = [&](int s0) {
    int j = jmap(d, s0 + pst);
    const u16* pr = proj + (size_t)(b * TT + j) * PC;
    r_v = *(const uint2*)(pr + vcol0 + c4);
    if (MX == 0) {
      r_a = *(const uint2*)(pr + C_HGF + d * 256 + h * 64 + c4);
      if (PASS == 2) r_b = *(const uint2*)(pr + C_HGQ + h * 64 + c4);
    } else {
      r_a = *(const uint2*)(pr + C_RTK + h * 64 + c4);
      r_c = *(const uint2*)(pr + C_RTK + h * 64 + (c4 ^ 16));
      if (PASS == 2) { r_b = *(const uint2*)(pr + C_RTQ + h * 64 + c4); r_d = *(const uint2*)(pr + C_RTQ + h * 64 + (c4 ^ 16)); }
      if (j >= 256) {
        int tl = j - 256;
        int pos = (c4 & 32) ? (tl & 63) : (tl >> 6);
        const float* rp = rope + (pos * 16 + (c4 & 15)) * 2;
        r_cs0 = *(const float4*)rp; r_cs1 = *(const float4*)(rp + 4);
      } else { r_cs0 = make_float4(1.f, 0.f, 1.f, 0.f); r_cs1 = r_cs0; }
    }
  };
  auto unpack4 = [](uint2 v, float (&o)[4]) {
    o[0] = __uint_as_float(v.x << 16); o[1] = __uint_as_float(v.x & 0xffff0000u);
    o[2] = __uint_as_float(v.y << 16); o[3] = __uint_as_float(v.y & 0xffff0000u);
  };
  u16* ofp; int ofs;
  if (MX == 0) { ofp = proj + C_HGF + h * 64 + lane; ofs = PC; }
  else { ofp = (u16*)(p.ws + OFF_RETOF) + h * 64 + lane; ofs = 256; }
  const int zcol = (MX == 0 ? C_HGZ : C_RTZ) + h * 64 + lane;
  const int ycol = (MX == 0 ? C_HGQ : C_RTQ) + h * 64 + lane;
  float normw = 1.f;
  if (MX == 0 && PASS == 2) normw = p.in[19][layer * 256 + h * 64 + lane];
  fetch(c * 256);
  for (int sub = 0; sub < 16; sub++) {
    const int s0 = c * 256 + sub * 16;
    __syncthreads();
    {
      float va[4], vb[4], vc[4], vd[4], vv4[4];
      unpack4(r_a, va); unpack4(r_v, vv4);
      *(float4*)(vbuf + pst * 64 + c4) = make_float4(vv4[0], vv4[1], vv4[2], vv4[3]);
      if (MX == 0) {
        float f[4], k[4];
#pragma unroll
        for (int i = 0; i < 4; i++) { f[i] = lb4[i] + (1.f - lb4[i]) * sigmoidf_(va[i]); k[i] = 1.f - f[i]; }
        *(float4*)(kbuf + pst * 64 + c4) = make_float4(k[0], k[1], k[2], k[3]);
        *(float4*)(fbuf + pst * 64 + c4) = make_float4(f[0], f[1], f[2], f[3]);
        if (PASS == 2) {
          unpack4(r_b, vb);
          *(float4*)(qbuf + pst * 64 + c4) = make_float4(siluf_(vb[0]), siluf_(vb[1]), siluf_(vb[2]), siluf_(vb[3]));
        }
      } else {
        unpack4(r_c, vc);
        float cs[8] = {r_cs0.x, r_cs0.y, r_cs0.z, r_cs0.w, r_cs1.x, r_cs1.y, r_cs1.z, r_cs1.w};
        float sgn = (c4 & 16) ? 1.f : -1.f;
#pragma unroll
        for (int i = 0; i < 4; i++) va[i] = (va[i] * cs[2 * i] + sgn * vc[i] * cs[2 * i + 1]) * 0.125f;
        *(float4*)(kbuf + pst * 64 + c4) = make_float4(va[0], va[1], va[2], va[3]);
        if (PASS == 2) {
          unpack4(r_b, vb); unpack4(r_d, vd);
#pragma unroll
          for (int i = 0; i < 4; i++) vb[i] = vb[i] * cs[2 * i] + sgn * vd[i] * cs[2 * i + 1];
          *(float4*)(qbuf + pst * 64 + c4) = make_float4(vb[0], vb[1], vb[2], vb[3]);
        }
      }
    }
    __syncthreads();
    if (sub + 1 < 16) fetch(s0 + 16);
    u16 pf_o[4], pf_z[4];
    if (PASS == 2 && d == 1) {
#pragma unroll
      for (int e = 0; e < 4; e++) {
        size_t row = (size_t)(b * TT + jmap(d, s0 + w * 4 + e));
        pf_o[e] = ofp[row * ofs]; pf_z[e] = proj[row * PC + zcol];
      }
    }
#pragma unroll 2
    for (int st = 0; st < 16; st++) {
      const float vv = vbuf[st * 64 + lane];
      float o = 0.f;
#pragma unroll
      for (int i4 = 0; i4 < 4; i4++) {
        float4 kv = *(const float4*)(kbuf + st * 64 + w * 16 + i4 * 4);
        float4 fv = make_float4(gam, gam, gam, gam);
        if (MX == 0) fv = *(const float4*)(fbuf + st * 64 + w * 16 + i4 * 4);
        S[i4*4]   = fv.x * S[i4*4]   + kv.x * vv;
        S[i4*4+1] = fv.y * S[i4*4+1] + kv.y * vv;
        S[i4*4+2] = fv.z * S[i4*4+2] + kv.z * vv;
        S[i4*4+3] = fv.w * S[i4*4+3] + kv.w * vv;
        if (PASS == 2) {
          float4 qv = *(const float4*)(qbuf + st * 64 + w * 16 + i4 * 4);
          o += S[i4*4] * qv.x + S[i4*4+1] * qv.y + S[i4*4+2] * qv.z + S[i4*4+3] * qv.w;
        }
      }
      if (MX == 0 && PASS == 1) { if (lane < 16) Pl *= fbuf[st * 64 + w * 16 + lane]; }
      if (PASS == 2) part[(w * 16 + st) * 64 + lane] = o;
    }
    if (PASS == 2) {
      __syncthreads();
#pragma unroll
      for (int e = 0; e < 4; e++) {
        int st = w * 4 + e;
        float o = part[(0 * 16 + st) * 64 + lane] + part[(1 * 16 + st) * 64 + lane] + part[(2 * 16 + st) * 64 + lane] + part[(3 * 16 + st) * 64 + lane];
        int j = jmap(d, s0 + st);
        size_t row = (size_t)(b * TT + j);
        if (d == 0) {
          ofp[row * ofs] = f2bf(o);
        } else {
          o += bf2f(pf_o[e]);
          float ss = wavesum(o * o);
          float y = o * rsqrtf(ss * (1.f / 64.f) + 1e-6f) * normw;
          proj[row * PC + ycol] = f2bf(y * siluf_(bf2f(pf_z[e])));
        }
      }
    }
  }
  if (PASS == 1) {
#pragma unroll
    for (int i = 0; i < 16; i++) stt[(w * 16 + i) * 64 + lane] = S[i];
    if (MX == 0 && lane < 16) ((float*)(p.ws + OFF_HGP))[((size_t)dbh * 9 + c) * 64 + w * 16 + lane] = Pl;
  }
}

#define RS 72
template <int PASS>
__device__ __forceinline__ void ret_sweep(const Params& p, int layer, int d, int b, int h, int nc, int cstep, u16* lds) {
  const int t = tid_(), lane = t & 63, w4 = t >> 6;
  u16* Qs = lds;
  u16* Ks = Qs + 64 * RS;
  u16* Kt = Ks + 64 * RS;
  u16* Vt = Kt + 64 * RS;
  u16* Vd = Vt + 64 * RS;
  u16* Ps = Vd + 64 * RS;
  u16* St = Ps + 64 * RS;
  u16* proj = (u16*)(p.ws + OFF_PROJ);
  const float* rope = (const float*)(p.ws + OFF_ROPE);
  const float lg = -__expf(p.in[20][((size_t)layer * 2 + d) * 4 + h]) * 1.4426950408889634f;
  const float g64 = exp2f(64.f * lg);
  const int dbh = (d * 8 + b) * 4 + h;
  float* stt = (float*)(p.ws + OFF_RTST) + ((size_t)dbh * 9 + cstep) * 4096;
  f32x4 accS[4];
#pragma unroll
  for (int nt = 0; nt < 4; nt++)
#pragma unroll
    for (int r = 0; r < 4; r++)
      accS[nt][r] = PASS == 1 ? 0.f : stt[(w4 * 16 + (lane >> 4) * 4 + r) * 64 + nt * 16 + (lane & 15)];
  uint4 rq[2], rqp[2], rk[2], rkp[2], rv[2];
  auto fetch = [&](int w) {
#pragma unroll
    for (int e = 0; e < 2; e++) {
      const int q = t + 256 * e, sl = q & 63, c8 = (q >> 6) * 8;
      const u16* pr = proj + (size_t)(b * TT + nc * 256 + w * 64 + sl) * PC + h * 64;
      rk[e] = *(const uint4*)(pr + C_RTK + c8); rkp[e] = *(const uint4*)(pr + C_RTK + (c8 ^ 16));
      rv[e] = *(const uint4*)(pr + C_RTV + c8);
      if (PASS == 2) { rq[e] = *(const uint4*)(pr + C_RTQ + c8); rqp[e] = *(const uint4*)(pr + C_RTQ + (c8 ^ 16)); }
    }
  };
  auto up = [](uint4 v, float (&o)[8]) {
    const unsigned* u = (const unsigned*)&v;
#pragma unroll
    for (int i = 0; i < 4; i++) { o[2 * i] = __uint_as_float(u[i] << 16); o[2 * i + 1] = __uint_as_float(u[i] & 0xffff0000u); }
  };
  fetch(d == 0 ? 0 : 3);
  for (int wi = 0; wi < 4; wi++) {
    const int w = d == 0 ? wi : 3 - wi;
    __syncthreads();
    if (PASS == 2 && wi == 0) {
#pragma unroll
      for (int nt = 0; nt < 4; nt++)
        *(uint2*)(St + (nt * 16 + (lane & 15)) * RS + w4 * 16 + (lane >> 4) * 4) =
            make_uint2(pack2(accS[nt][0], accS[nt][1]), pack2(accS[nt][2], accS[nt][3]));
    }
#pragma unroll
    for (int e = 0; e < 2; e++) {
      const int q = t + 256 * e, sl = q & 63, c8 = (q >> 6) * 8;
      const int j = nc * 256 + w * 64 + sl;
      float kx[8], kp[8], vx[8], qx[8], qp[8];
      up(rk[e], kx); up(rkp[e], kp); up(rv[e], vx);
      if (PASS == 2) { up(rq[e], qx); up(rqp[e], qp); }
      if (j >= 256) {
        const int tl = j - 256;
        const int pos = (c8 & 32) ? (tl & 63) : (tl >> 6);
        const float* rp = rope + (pos * 16 + (c8 & 15)) * 2;
        const float sgn = (c8 & 16) ? 1.f : -1.f;
#pragma unroll
        for (int i2 = 0; i2 < 4; i2++) {
          const float4 cs = *(const float4*)(rp + i2 * 4);
          kx[2 * i2] = kx[2 * i2] * cs.x + sgn * kp[2 * i2] * cs.y;
          kx[2 * i2 + 1] = kx[2 * i2 + 1] * cs.z + sgn * kp[2 * i2 + 1] * cs.w;
          if (PASS == 2) {
            qx[2 * i2] = qx[2 * i2] * cs.x + sgn * qp[2 * i2] * cs.y;
            qx[2 * i2 + 1] = qx[2 * i2 + 1] * cs.z + sgn * qp[2 * i2 + 1] * cs.w;
          }
        }
      }
      const float dec = exp2f((float)(d == 0 ? 63 - sl : sl) * lg);
      u16 kb[8];
#pragma unroll
      for (int i = 0; i < 8; i++) {
        kb[i] = f2bf(kx[i] * 0.125f);
        Kt[(c8 + i) * RS + sl] = kb[i];
        Vd[(c8 + i) * RS + sl] = f2bf(vx[i] * dec);
      }
      if (PASS == 2) {
        uint4 kk4, qq4;
        kk4.x = kb[0] | ((unsigned)kb[1] << 16); kk4.y = kb[2] | ((unsigned)kb[3] << 16);
        kk4.z = kb[4] | ((unsigned)kb[5] << 16); kk4.w = kb[6] | ((unsigned)kb[7] << 16);
        qq4.x = pack2(qx[0], qx[1]); qq4.y = pack2(qx[2], qx[3]); qq4.z = pack2(qx[4], qx[5]); qq4.w = pack2(qx[6], qx[7]);
        *(uint4*)(Ks + sl * RS + c8) = kk4;
        *(uint4*)(Qs + sl * RS + c8) = qq4;
        const unsigned short* vraw = (const unsigned short*)&rv[e];
#pragma unroll
        for (int i = 0; i < 8; i++) Vt[(c8 + i) * RS + sl] = vraw[i];
      }
    }
    __syncthreads();
    if (wi + 1 < 4) fetch(d == 0 ? wi + 1 : 2 - wi);
    if (PASS == 2) {
      f32x4 accP[4];
#pragma unroll
      for (int nt = 0; nt < 4; nt++) accP[nt] = (f32x4){0.f, 0.f, 0.f, 0.f};
      bf16x8 aq[2];
#pragma unroll
      for (int kk = 0; kk < 2; kk++) aq[kk] = *(const bf16x8*)(Qs + (w4 * 16 + (lane & 15)) * RS + kk * 32 + (lane >> 4) * 8);
#pragma unroll
      for (int kk = 0; kk < 2; kk++)
#pragma unroll
        for (int nt = 0; nt < 4; nt++) {
          bf16x8 bk = *(const bf16x8*)(Ks + (nt * 16 + (lane & 15)) * RS + kk * 32 + (lane >> 4) * 8);
          accP[nt] = __builtin_amdgcn_mfma_f32_16x16x32_bf16(aq[kk], bk, accP[nt], 0, 0, 0);
        }
#pragma unroll
      for (int nt = 0; nt < 4; nt++)
#pragma unroll
        for (int r = 0; r < 4; r++) {
          const int il = w4 * 16 + (lane >> 4) * 4 + r, sl = nt * 16 + (lane & 15);
          const int e = d == 0 ? il - sl : sl - il;
          const float f = e >= 0 ? exp2f((float)e * lg) : 0.f;
          Ps[il * RS + sl] = f2bf(accP[nt][r] * f);
        }
      __syncthreads();
      f32x4 accO[4], accI[4];
#pragma unroll
      for (int nt = 0; nt < 4; nt++) { accO[nt] = (f32x4){0.f, 0.f, 0.f, 0.f}; accI[nt] = (f32x4){0.f, 0.f, 0.f, 0.f}; }
#pragma unroll
      for (int kk = 0; kk < 2; kk++) {
        bf16x8 ap = *(const bf16x8*)(Ps + (w4 * 16 + (lane & 15)) * RS + kk * 32 + (lane >> 4) * 8);
#pragma unroll
        for (int nt = 0; nt < 4; nt++) {
          bf16x8 bv = *(const bf16x8*)(Vt + (nt * 16 + (lane & 15)) * RS + kk * 32 + (lane >> 4) * 8);
          accO[nt] = __builtin_amdgcn_mfma_f32_16x16x32_bf16(ap, bv, accO[nt], 0, 0, 0);
          bf16x8 bs = *(const bf16x8*)(St + (nt * 16 + (lane & 15)) * RS + kk * 32 + (lane >> 4) * 8);
          accI[nt] = __builtin_amdgcn_mfma_f32_16x16x32_bf16(aq[kk], bs, accI[nt], 0, 0, 0);
        }
      }
      u16* ofp = (u16*)(p.ws + OFF_RETOF);
#pragma unroll
      for (int r = 0; r < 4; r++) {
        const int il = w4 * 16 + (lane >> 4) * 4 + r;
        const size_t row = (size_t)(b * TT + nc * 256 + w * 64 + il);
        const float rho = exp2f((float)(d == 0 ? il + 1 : 64 - il) * lg);
        float o[4], ss = 0.f;
#pragma unroll
        for (int nt = 0; nt < 4; nt++) {
          o[nt] = accO[nt][r] + rho * accI[nt][r];
          if (d == 1) o[nt] += bf2f(ofp[row * 256 + h * 64 + nt * 16 + (lane & 15)]);
          ss += o[nt] * o[nt];
        }
        if (d == 0) {
#pragma unroll
          for (int nt = 0; nt < 4; nt++) ofp[row * 256 + h * 64 + nt * 16 + (lane & 15)] = f2bf(o[nt]);
        } else {
          ss = allsum16(ss);
          const float sc = rsqrtf(ss * (1.f / 64.f) + 1e-6f);
#pragma unroll
          for (int nt = 0; nt < 4; nt++) {
            const int cv = h * 64 + nt * 16 + (lane & 15);
            const float z = bf2f(proj[row * PC + C_RTZ + cv]);
            proj[row * PC + C_RTQ + cv] = f2bf(o[nt] * sc * siluf_(z));
          }
        }
      }
    }
#pragma unroll
    for (int nt = 0; nt < 4; nt++)
#pragma unroll
      for (int r = 0; r < 4; r++) accS[nt][r] *= g64;
#pragma unroll
    for (int kk = 0; kk < 2; kk++) {
      bf16x8 ak = *(const bf16x8*)(Kt + (w4 * 16 + (lane & 15)) * RS + kk * 32 + (lane >> 4) * 8);
#pragma unroll
      for (int nt = 0; nt < 4; nt++) {
        bf16x8 bv = *(const bf16x8*)(Vd + (nt * 16 + (lane & 15)) * RS + kk * 32 + (lane >> 4) * 8);
        accS[nt] = __builtin_amdgcn_mfma_f32_16x16x32_bf16(ak, bv, accS[nt], 0, 0, 0);
      }
    }
    __syncthreads();
    if (PASS == 2 && wi + 1 < 4) {
#pragma unroll
      for (int nt = 0; nt < 4; nt++)
        *(uint2*)(St + (nt * 16 + (lane & 15)) * RS + w4 * 16 + (lane >> 4) * 4) =
            make_uint2(pack2(accS[nt][0], accS[nt][1]), pack2(accS[nt][2], accS[nt][3]));
    }
  }
  if (PASS == 1) {
#pragma unroll
    for (int nt = 0; nt < 4; nt++)
#pragma unroll
      for (int r = 0; r < 4; r++) stt[(w4 * 16 + (lane >> 4) * 4 + r) * 64 + nt * 16 + (lane & 15)] = accS[nt][r];
  }
}
__device__ void gla_p1_task(const Params& p, int layer, int task, float* lds) {
  int c = task % 9; int q = task / 9; int h = q & 3; q >>= 2; int b = q & 7; q >>= 3; int d = q & 1; int mx = q >> 1;
  if (mx == 0) gla_sweep<0, 1>(p, layer, d, b, h, c, lds);
  else { const int nc = d == 0 ? c : (c == 0 ? 0 : 9 - c); ret_sweep<1>(p, layer, d, b, h, nc, c, (u16*)lds); }
}
__device__ void gla_p2_task(const Params& p, int layer, int mx, int b, int h, int nc, float* lds) {
  int cb = nc == 0 ? 0 : 9 - nc;
  if (mx == 0) { gla_sweep<0, 2>(p, layer, 0, b, h, nc, lds); __threadfence_block(); gla_sweep<0, 2>(p, layer, 1, b, h, cb, lds); }
  else { ret_sweep<2>(p, layer, 0, b, h, nc, nc, (u16*)lds); __threadfence_block(); ret_sweep<2>(p, layer, 1, b, h, nc, cb, (u16*)lds); }
}
__device__ void gla_carry_task(const Params& p, int layer, int task) {
  int e = task * 256 + tid_();
  int v = e & 63, k = (e >> 6) & 63, dbh = (e >> 12) & 63, mx = e >> 18;
  float* stt = (float*)(p.ws + (mx == 0 ? OFF_HGST : OFF_RTST)) + (size_t)dbh * 9 * 4096 + k * 64 + v;
  const float* P = (const float*)(p.ws + OFF_HGP) + (size_t)dbh * 9 * 64 + k;
  float pg = 1.f;
  if (mx == 1) { int d = dbh >> 5, h = dbh & 3; pg = __expf(-256.f * __expf(p.in[20][((size_t)layer * 2 + d) * 4 + h])); }
  float S = 0.f;
  for (int c = 0; c < 9; c++) {
    float E = stt[(size_t)c * 4096];
    stt[(size_t)c * 4096] = S;
    float pp = mx == 0 ? P[c * 64] : pg;
    S = pp * S + E;
  }
}

__device__ __forceinline__ int s5_bwd_chunk(int nc) { return nc < 4 ? 3 - nc : 39 - nc; }
template <int PASS>
__device__ void s5_task(const Params& p, int layer, int task, float* lds) {
  const int t = tid_(), w = t >> 6, lane = t & 63;
  int gq = task & 3; int q = task >> 2; int nc = q % 36; int b = q / 36;
  const int g = gq * 4 + w;
  float* ubuf = lds + w * 256;
  u16* hbuf = (u16*)(lds + 1024) + w * (16 * 136);
  float* ybuf = lds + 1024 + 4352 + w * 1024;
  u16* proj = (u16*)(p.ws + OFF_PROJ);
  float2* st5 = (float2*)(p.ws + OFF_S5ST);
  bf16x8 cfrag[4];
  if (PASS == 2) {
    const float* cre = p.in[13] + ((size_t)layer * 16 + g) * 16 * 64;
    const float* cim = p.in[14] + ((size_t)layer * 16 + g) * 16 * 64;
    int pp = lane & 15;
#pragma unroll
    for (int ks = 0; ks < 4; ks++)
#pragma unroll
      for (int i = 0; i < 8; i++) {
        int kidx = ks * 32 + (lane >> 4) * 8 + i; int n = kidx >> 1;
        float val = (kidx & 1) ? -cim[pp * 64 + n] : cre[pp * 64 + n];
        cfrag[ks][i] = (short)f2bf(val);
      }
  }
  for (int d = 0; d < 2; d++) {
    float lre = p.in[8][(((size_t)layer * 2 + d) * 16 + g) * 64 + lane];
    float lim = p.in[9][(((size_t)layer * 2 + d) * 16 + g) * 64 + lane];
    float dt = __expf(p.in[10][((size_t)layer * 2 + d) * 16 + g]);
    float mag = __expf(lre * dt);
    float sn, cs; sincosf(lim * dt, &sn, &cs);
    float are = mag * cs, aim = mag * sn;
    float den = 1.f / (lre * lre + lim * lim);
    float cre_ = ((are - 1.f) * lre + aim * lim) * den;
    float cim_ = (aim * lre - (are - 1.f) * lim) * den;
    float bbr[16], bbi[16];
    {
      const float* br = p.in[11] + (((size_t)layer * 16 + g) * 64 + lane) * 16;
      const float* bi = p.in[12] + (((size_t)layer * 16 + g) * 64 + lane) * 16;
#pragma unroll
      for (int i = 0; i < 16; i++) {
        float x = br[i], y = bi[i];
        bbr[i] = cre_ * x - cim_ * y; bbi[i] = cre_ * y + cim_ * x;
      }
    }
    int cstep = d == 0 ? nc : s5_bwd_chunk(nc);
    size_t sidx = ((((size_t)d * 8 + b) * 16 + g) * 36 + cstep) * 64 + lane;
    float hre = 0.f, him = 0.f;
    if (PASS == 2) { float2 h0 = st5[sidx]; hre = h0.x; him = h0.y; }
    uint2 ru;
    auto fetchu = [&](int sub) {
      int st = lane >> 2, p4 = (lane & 3) * 4;
      int jl = d == 0 ? sub * 16 + st : 63 - (sub * 16 + st);
      ru = *(const uint2*)(proj + (size_t)(b * TT + nc * 64 + jl) * PC + C_S5U + g * 16 + p4);
    };
    fetchu(0);
    for (int sub = 0; sub < 4; sub++) {
      __syncthreads();
      {
        int st = lane >> 2, p4 = (lane & 3) * 4;
        *(float4*)(ubuf + st * 16 + p4) = make_float4(__uint_as_float(ru.x << 16), __uint_as_float(ru.x & 0xffff0000u),
                                                       __uint_as_float(ru.y << 16), __uint_as_float(ru.y & 0xffff0000u));
      }
      __syncthreads();
      if (sub + 1 < 4) fetchu(sub + 1);
#pragma unroll 2
      for (int st = 0; st < 16; st++) {
        float bur = 0.f, bui = 0.f;
#pragma unroll
        for (int i4 = 0; i4 < 4; i4++) {
          float4 uu = *(const float4*)(ubuf + st * 16 + i4 * 4);
          bur += bbr[i4*4] * uu.x + bbr[i4*4+1] * uu.y + bbr[i4*4+2] * uu.z + bbr[i4*4+3] * uu.w;
          bui += bbi[i4*4] * uu.x + bbi[i4*4+1] * uu.y + bbi[i4*4+2] * uu.z + bbi[i4*4+3] * uu.w;
        }
        float nre = are * hre - aim * him + bur;
        float nim = are * him + aim * hre + bui;
        hre = nre; him = nim;
        if (PASS == 2) *(unsigned*)(hbuf + st * 136 + lane * 2) = pack2(hre, him);
      }
      if (PASS == 2) {
        __syncthreads();
        f32x4 acc = (f32x4){0.f, 0.f, 0.f, 0.f};
#pragma unroll
        for (int ks = 0; ks < 4; ks++) {
          bf16x8 af = *(const bf16x8*)(hbuf + (lane & 15) * 136 + ks * 32 + (lane >> 4) * 8);
          acc = __builtin_amdgcn_mfma_f32_16x16x32_bf16(af, cfrag[ks], acc, 0, 0, 0);
        }
#pragma unroll
        for (int r = 0; r < 4; r++) {
          int st = (lane >> 4) * 4 + r;
          int jl = d == 0 ? sub * 16 + st : 63 - (sub * 16 + st);
          float* yp = ybuf + jl * 16 + (lane & 15);
          if (d == 0) *yp = acc[r]; else *yp += acc[r];
        }
      }
    }
    if (PASS == 1) st5[sidx] = make_float2(hre, him);
  }
  if (PASS == 2) {
    __syncthreads();
    const float* dsk = p.in[15] + layer * 256 + g * 16;
#pragma unroll
    for (int i = 0; i < 16; i++) {
      int idx = lane + 64 * i; int jl = idx >> 4, pp = idx & 15;
      u16* up = proj + (size_t)(b * TT + nc * 64 + jl) * PC + C_S5U + g * 16 + pp;
      float y = ybuf[jl * 16 + pp] + dsk[pp] * bf2f(*up);
      *up = f2bf(geluf_(y));
    }
  }
}
__device__ void s5_carry_task(const Params& p, int layer, int task) {
  int e = task * 256 + tid_();
  int n = e & 63, g = (e >> 6) & 15, d = e >> 13;
  float lre = p.in[8][(((size_t)layer * 2 + d) * 16 + g) * 64 + n];
  float lim = p.in[9][(((size_t)layer * 2 + d) * 16 + g) * 64 + n];
  float dt = __expf(p.in[10][((size_t)layer * 2 + d) * 16 + g]);
  float mag = __expf(lre * dt * 64.f);
  float sn, cs; sincosf(lim * dt * 64.f, &sn, &cs);
  float are = mag * cs, aim = mag * sn;
  float2* st5 = (float2*)(p.ws + OFF_S5ST) + (size_t)(e >> 6) * 36 * 64 + n;
  float sre = 0.f, sim = 0.f;
  for (int c = 0; c < 36; c++) {
    float2 E = st5[(size_t)c * 64];
    st5[(size_t)c * 64] = make_float2(sre, sim);
    float nre = are * sre - aim * sim + E.x;
    float nim = are * sim + aim * sre + E.y;
    sre = nre; sim = nim;
  }
}

__device__ __forceinline__ void group_barrier(unsigned* cnt, unsigned target) {
  asm volatile("s_waitcnt vmcnt(0)" ::: "memory");
  __syncthreads();
  if (tid_() == 0) {
    __threadfence();
    asm volatile("s_waitcnt vmcnt(0)" ::: "memory");
    __hip_atomic_fetch_add(cnt, 1u, __ATOMIC_RELAXED, __HIP_MEMORY_SCOPE_AGENT);
    while (__hip_atomic_load(cnt, __ATOMIC_RELAXED, __HIP_MEMORY_SCOPE_AGENT) < target) __builtin_amdgcn_s_sleep(2);
    __threadfence();
    asm volatile("s_waitcnt vmcnt(0)" ::: "memory");
  }
  __syncthreads();
}
#define XB_XCNT(j) (64 * (j))
#define XB_XSUB(j) (1024 + 64 * (j))
#define XB_XGEN(j) (2048 + 64 * (j))
#define XB_TOP     3072
#define XB_TOPGEN  3136
#define XB_WORDS   3200
struct XcdBar { unsigned* bar; unsigned x, nloc, nx; };
__device__ __forceinline__ unsigned xb_ld(unsigned* q) { return __hip_atomic_load(q, __ATOMIC_RELAXED, __HIP_MEMORY_SCOPE_AGENT); }
__device__ __forceinline__ unsigned xb_add(unsigned* q, unsigned v) { return __hip_atomic_fetch_add(q, v, __ATOMIC_RELAXED, __HIP_MEMORY_SCOPE_AGENT); }
__device__ __forceinline__ void xcd_barrier(const XcdBar& b) {
  asm volatile("s_waitcnt vmcnt(0)" ::: "memory");
  __syncthreads();
  if (tid_() == 0) {
    unsigned* bar = b.bar;
    __builtin_amdgcn_s_waitcnt(0);
    const unsigned old = xb_add(&bar[XB_XSUB(b.x)], 1u);
    const unsigned gen = old / b.nloc;
    if (old + 1u == (gen + 1u) * b.nloc) {
      __builtin_amdgcn_fence(__ATOMIC_RELEASE, "agent");
      asm volatile("s_waitcnt vmcnt(0)" ::: "memory");
      const unsigned og = xb_add(&bar[XB_TOP], 1u);
      const unsigned tg = og / b.nx;
      if (og + 1u == (tg + 1u) * b.nx) xb_add(&bar[XB_TOPGEN], 1u);
      else while (xb_ld(&bar[XB_TOPGEN]) == tg) __builtin_amdgcn_s_sleep(1);
      __builtin_amdgcn_fence(__ATOMIC_ACQUIRE, "agent");
      xb_add(&bar[XB_XGEN(b.x)], 1u);
      asm volatile("s_waitcnt vmcnt(0)" ::: "memory");
    } else {
      while (xb_ld(&bar[XB_XGEN(b.x)]) == gen) __builtin_amdgcn_s_sleep(1);
      __builtin_amdgcn_fence(__ATOMIC_ACQUIRE, "agent");
      asm volatile("s_waitcnt vmcnt(0)" ::: "memory");
    }
  }
  __syncthreads();
}
#define LDS_FLOATS 18432
#define SYNC() xcd_barrier(xbar)
#define RW_TWO false
#define NRW (RW_TWO ? 128 : 256)

__global__ void __launch_bounds__(256, 2) fwd_megakernel(Params p) {
  cg::grid_group grid = cg::this_grid();
  __shared__ __attribute__((aligned(16))) float lds[LDS_FLOATS];
  const int bid = blockIdx.x, nb = gridDim.x, t = tid_();
  XcdBar xbar; xbar.bar = (unsigned*)(p.ws + OFF_XB); xbar.x = 0; xbar.nloc = 1; xbar.nx = 1;

  for (int task = bid; task < N_CONVERT_TASKS + 96 + 1; task += nb) {
    if (task < 96) mods_task(p, task, lds);
    else if (task == 96) {
      if (t < 4) ((unsigned*)(p.ws + OFF_BAR))[t] = 0u;
      for (int i = t; i < XB_WORDS; i += 256) ((unsigned*)(p.ws + OFF_XB))[i] = 0u;
      float* rope = (float*)(p.ws + OFF_ROPE);
      for (int i = t; i < 1024; i += 256) {
        int pos = i >> 4, fi = i & 15;
        float fr = powf(10000.f, -(float)fi / 16.f);
        float ang = (float)pos * fr;
        rope[i * 2] = cosf(ang); rope[i * 2 + 1] = sinf(ang);
      }
    } else convert_task(p, 0, task - 97, lds);
  }
  grid.sync();
  {
    unsigned xr; asm volatile("s_getreg_b32 %0, hwreg(HW_REG_XCC_ID)" : "=s"(xr));
    xbar.x = xr & 15u;
    if (t == 0) xb_add(&xbar.bar[XB_XCNT(xbar.x)], 1u);
  }
  for (int task = bid; task < MROWS / 4; task += nb) ln_row(p, 0, 0, task * 4 + (t >> 6));
  grid.sync();
  {
    unsigned nx = 0;
#pragma unroll
    for (int j = 0; j < 16; j++) { const unsigned c = xb_ld(&xbar.bar[XB_XCNT(j)]); nx += c > 0u ? 1u : 0u; if ((unsigned)j == xbar.x) xbar.nloc = c; }
    xbar.nx = nx;
  }

  for (int layer = 0; layer < 2; layer++) {
    const int latonly = layer;
    if ((nb & 7) == 0) { int tm, tn; for (int it = 0; xcd_tile(it, bid, nb, 144, 31, 6, tm, tn); it++) inproj_tile(p, layer, tm, tn, (u16*)lds); }
    else for (int task = bid; task < 144 * 31; task += nb) inproj_tile(p, layer, task / 31, task % 31, (u16*)lds);
    SYNC();
    {
      const int ncg = latonly ? 8 : 9, ncs = latonly ? 32 : 36;
      const int NG = 64 * ncg, NS = 32 * ncs;
      auto p2_task = [&](int task) {
        if (task < NG) {
          int nc = task % ncg + (latonly ? 1 : 0); int q = task / ncg; int h = q & 3; q >>= 2; int b = q & 7; int mx = q >> 3;
          gla_p2_task(p, layer, mx, b, h, nc, lds);
        } else {
          int q = task - NG; int gq = q & 3; q >>= 2; int nc = q % ncs + (latonly ? 4 : 0); int b = q / ncs;
          s5_task<2>(p, layer, ((b * 36 + nc) << 2) | gq, lds);
        }
      };
      if (nb >= NRW + 128) {
        unsigned* bar = (unsigned*)(p.ws + OFF_BAR);
        const int ng = nb - NRW;
        if (bid < NRW) {
          rwkv_scan_task<RW_TWO>(p, layer, bid, lds);
          if (t == 0) {
            while (__hip_atomic_load(bar, __ATOMIC_RELAXED, __HIP_MEMORY_SCOPE_AGENT) < (unsigned)ng * (2u * layer + 2u)) __builtin_amdgcn_s_sleep(8);
            __threadfence();
          }
          __syncthreads();
        } else {
          const int gb = bid - NRW;
          for (int task = gb; task < 2304; task += ng) {
            if (task < 1152) gla_p1_task(p, layer, task, lds); else s5_task<1>(p, layer, task - 1152, lds);
          }
          group_barrier(bar, (unsigned)ng * (2u * layer + 1u));
          for (int task = gb; task < 2048 + 64; task += ng) {
            if (task < 2048) gla_carry_task(p, layer, task); else s5_carry_task(p, layer, task - 2048);
          }
          group_barrier(bar, (unsigned)ng * (2u * layer + 2u));
        }
        int* shq = (int*)(lds + LDS_FLOATS - 4);
        for (;;) {
          __syncthreads();
          if (t == 0) *shq = (int)__hip_atomic_fetch_add(bar + 1 + layer, 1u, __ATOMIC_RELAXED, __HIP_MEMORY_SCOPE_AGENT);
          __syncthreads();
          const int task = *shq;
          if (task >= NG + NS) break;
          p2_task(task);
        }
        SYNC();
      } else {
        for (int task = bid; task < NRW + 2304; task += nb) {
          if (task < NRW) rwkv_scan_task<RW_TWO>(p, layer, task, lds);
          else if (task < NRW + 1152) gla_p1_task(p, layer, task - NRW, lds);
          else s5_task<1>(p, layer, task - NRW - 1152, lds);
        }
        SYNC();
        for (int task = bid; task < 2048 + 64; task += nb) {
          if (task < 2048) gla_carry_task(p, layer, task); else s5_carry_task(p, layer, task - 2048);
        }
        SYNC();
        for (int task = bid; task < NG + NS; task += nb) p2_task(task);
        SYNC();
      }
    }
    {
      const int ntm = latonly ? 128 : 144;
      for (int task = bid; task < ntm * 2 + MROWS / 8; task += nb) {
        if (task < ntm * 2) glu_tile(p, layer, latonly, task >> 1, task & 1, (u16*)lds);
        else rwkv_combine_rows(p, layer, (task - ntm * 2) * 8, latonly);
      }
    }
    SYNC();
    {
      const int ntm = latonly ? 128 : 144;
      if ((nb & 7) == 0) { int tm, tn; for (int it = 0; xcd_tile(it, bid, nb, ntm, 16, 8, tm, tn); it++) merge_tile(p, layer, latonly, tm, tn, (u16*)lds); }
      else for (int task = bid; task < ntm * 16; task += nb) merge_tile(p, layer, latonly, task >> 4, task & 15, (u16*)lds);
    }
    SYNC();
    {
      const int ntm = latonly ? 128 : 144;
      if ((nb & 7) == 0) { int tm, tn; for (int it = 0; xcd_tile(it, bid, nb, ntm, 8, 8, tm, tn); it++) outproj_tile(p, layer, latonly, tm, tn, (u16*)lds); }
      else for (int task = bid; task < ntm * 8; task += nb) outproj_tile(p, layer, latonly, task >> 3, task & 7, (u16*)lds);
    }
    SYNC();
    if (layer == 0) {
      for (int task = bid; task < MROWS / 4 + N_CONVERT_TASKS; task += nb) {
        if (task < N_CONVERT_TASKS) convert_task(p, 1, task, lds);
        else ln_row(p, 1, 0, (task - N_CONVERT_TASKS) * 4 + (t >> 6));
      }
      SYNC();
    } else {
      for (int task = bid; task < NBATCH * 2048 / 4; task += nb) {
        int r = task * 4 + (t >> 6); int b = r >> 11, tl = r & 2047;
        ln_row(p, 1, 1, b * TT + 256 + tl);
      }
    }
  }
}

extern "C" void kernel_launch(void* const* d_in, const int* in_sizes, int n_in,
                              void* d_out, int out_size, void* d_ws, size_t ws_size,
                              hipStream_t stream) {
  static int grid_blocks = 0;
  if (!grid_blocks) {
    int dev = 0, cus = 0, per_cu = 0;
    (void)hipGetDevice(&dev);
    (void)hipDeviceGetAttribute(&cus, hipDeviceAttributeMultiprocessorCount, dev);
    (void)hipOccupancyMaxActiveBlocksPerMultiprocessor(&per_cu, fwd_megakernel, 256, 0);
    if (per_cu > 2) per_cu = 2;
    if (per_cu < 1) per_cu = 1;
    grid_blocks = cus * per_cu;
  }
  if (ws_size < WS_NEED) { fprintf(stderr, "workspace too small\n"); return; }
  Params p{};
  for (int i = 0; i < 36; i++) p.in[i] = (const float*)d_in[i];
  p.out = (float*)d_out;
  p.ws = (char*)d_ws;
  void* args[] = {&p};
  hipError_t e = hipLaunchCooperativeKernel((void*)fwd_megakernel, dim3(grid_blocks), dim3(256), args, 0, stream);
  if (e != hipSuccess) fprintf(stderr, "cooperative launch failed: %s (grid %d)\n", hipGetErrorString(e), grid_blocks);
}
```

```cpp
#include <hip/hip_runtime.h>
#include <hip/hip_bf16.h>
#include <hip/hip_cooperative_groups.h>
#include <cstdio>
namespace cg = cooperative_groups;

typedef __attribute__((ext_vector_type(8))) short bf16x8;
typedef __attribute__((ext_vector_type(4))) float f32x4;
typedef unsigned short u16;

#define D_ 1024
#define NBATCH 8
#define TT 2304
#define MROWS 18432
#define PC 3904
#define DIN 8000
#define C_S5U 0
#define C_S5Z 256
#define C_HGQ 512
#define C_HGF 768
#define C_HGI 1280
#define C_HGZ 1536
#define C_RTQ 1792
#define C_RTK 2048
#define C_RTV 2304
#define C_RTZ 2560
#define C_RWX 2816
#define C_RWZ 3648

#define OFF_WINT   0ul
#define OFF_WBT    (OFF_WINT + 16384000ul)
#define OFF_WOT    (OFF_WBT + 2097152ul)
#define OFF_GLUT   (OFF_WOT + 2097152ul)
#define OFF_U      (OFF_GLUT + 131072ul)
#define OFF_PROJ   (OFF_U + 37748736ul)
#define OFF_HCTX   (OFF_PROJ + 143917056ul)
#define OFF_SCR    (OFF_HCTX + 8388608ul)
#define OFF_RWO    (OFF_SCR)
#define OFF_HGST   (OFF_SCR + 18874368ul)
#define OFF_RTST   (OFF_HGST + 9437184ul)
#define OFF_RETOF  (OFF_SCR + 37748736ul)
#define OFF_S5ST   (OFF_RETOF + 9437184ul)
#define OFF_MODS   (OFF_S5ST + 4718592ul)
#define OFF_HGP    (OFF_MODS + 221184ul)
#define OFF_BONUS  (OFF_HGP + 147456ul)
#define OFF_ROPE   (OFF_BONUS + 589824ul)
#define OFF_BAR    (OFF_ROPE + 8192ul)
#define OFF_XB     (OFF_BAR + 256ul)
#define WS_NEED    (OFF_XB + 32768ul)

struct Params {
  const float* in[36];
  float* out;
  char* ws;
};

__device__ __forceinline__ int tid_() { int t = __builtin_amdgcn_workitem_id_x(); asm volatile("" : "+v"(t)); return t; }
__device__ __forceinline__ u16 f2bf(float f) {
  unsigned u = __float_as_uint(f);
  u += 0x7fffu + ((u >> 16) & 1u);
  return (u16)(u >> 16);
}
__device__ __forceinline__ float bf2f(u16 h) { return __uint_as_float(((unsigned)h) << 16); }
__device__ __forceinline__ unsigned pack2(float a, float b) { return (unsigned)f2bf(a) | ((unsigned)f2bf(b) << 16); }
__device__ __forceinline__ float sigmoidf_(float x) { return __builtin_amdgcn_rcpf(1.f + __expf(-x)); }
__device__ __forceinline__ float siluf_(float x) { return x * __builtin_amdgcn_rcpf(1.f + __expf(-x)); }
__device__ __forceinline__ float geluf_(float x) {
  float t = tanhf(0.7978845608028654f * (x + 0.044715f * x * x * x));
  return 0.5f * x * (1.f + t);
}
template <int CTRL>
__device__ __forceinline__ float dppf(float x) {
  return __int_as_float(__builtin_amdgcn_update_dpp(0, __float_as_int(x), CTRL, 0xf, 0xf, true));
}
__device__ __forceinline__ float allsum16(float x) {
  x += dppf<0x128>(x);
  x += dppf<0x124>(x);
  x += dppf<0x122>(x);
  x += dppf<0x121>(x);
  return x;
}
__device__ __forceinline__ float wavesum(float x) {
  x = allsum16(x);
  x += __shfl_xor(x, 16, 64);
  x += __shfl_xor(x, 32, 64);
  return x;
}
__device__ __forceinline__ void ld4bf(const u16* p, float (&o)[4]) {
  uint2 v = *(const uint2*)p;
  o[0] = __uint_as_float(v.x << 16); o[1] = __uint_as_float(v.x & 0xffff0000u);
  o[2] = __uint_as_float(v.y << 16); o[3] = __uint_as_float(v.y & 0xffff0000u);
}
__device__ __forceinline__ void st4bf(u16* p, float a, float b, float c, float d) {
  uint2 v; v.x = pack2(a, b); v.y = pack2(c, d);
  *(uint2*)p = v;
}
__device__ __forceinline__ int jmap(int d, int s) { return d == 0 ? s : (s < 256 ? 255 - s : 2559 - s); }
__device__ __forceinline__ bool has_prev(int j) { return j != 0 && j != 256; }
__device__ __forceinline__ bool has_next(int j) { return j != 255 && j != 2303; }

__device__ __forceinline__ const float* hin_ptr(const Params& p, int layer, int row) {
  int b = row / TT, j = row - b * TT;
  if (layer == 0) return j < 256 ? p.in[2] + ((size_t)(b * 256 + j)) * D_ : p.in[0] + ((size_t)(b * 2048 + j - 256)) * D_;
  return j < 256 ? (const float*)(p.ws + OFF_HCTX) + ((size_t)(b * 256 + j)) * D_ : p.out + ((size_t)(b * 2048 + j - 256)) * D_;
}
__device__ __forceinline__ float* hout_ptr(const Params& p, int row) {
  int b = row / TT, j = row - b * TT;
  return j < 256 ? (float*)(p.ws + OFF_HCTX) + ((size_t)(b * 256 + j)) * D_ : p.out + ((size_t)(b * 2048 + j - 256)) * D_;
}
__device__ __forceinline__ int modrow_of(int row) { int b = row / TT, j = row - b * TT; return j < 256 ? 8 : b; }

__device__ void transpose_tile(const float* __restrict__ src, u16* __restrict__ dst, int K, int N, int k0, int n0, float* lds) {
  const int t = tid_();
  __syncthreads();
#pragma unroll
  for (int i = 0; i < 16; i++) {
    int r = i * 4 + (t >> 6), c = t & 63;
    lds[r * 65 + c] = src[(size_t)(k0 + r) * N + n0 + c];
  }
  __syncthreads();
#pragma unroll
  for (int i = 0; i < 16; i++) {
    int r = i * 4 + (t >> 6), c = t & 63;
    dst[(size_t)(n0 + r) * K + k0 + c] = f2bf(lds[c * 65 + r]);
  }
}
__device__ void convert_task(const Params& p, int layer, int task, float* lds) {
  if (task < 2000) {
    int kt = task / 125, nt = task % 125;
    transpose_tile(p.in[6] + (size_t)layer * 1024 * DIN, (u16*)(p.ws + OFF_WINT), 1024, DIN, kt * 64, nt * 64, lds);
  } else if (task < 2256) {
    int q = task - 2000; int br = q >> 6; q &= 63; int kt = q >> 4, nt = q & 15;
    transpose_tile(p.in[31] + ((size_t)layer * 4 + br) * 256 * 1024, (u16*)(p.ws + OFF_WBT) + (size_t)br * 1024 * 256, 256, 1024, kt * 64, nt * 64, lds);
  } else if (task < 2512) {
    int q = task - 2256; int kt = q >> 4, nt = q & 15;
    transpose_tile(p.in[32] + (size_t)layer * 1024 * 1024, (u16*)(p.ws + OFF_WOT), 1024, 1024, kt * 64, nt * 64, lds);
  } else {
    int q = task - 2512; int kt = q >> 2, nt = q & 3;
    transpose_tile(p.in[16] + (size_t)layer * 256 * 256, (u16*)(p.ws + OFF_GLUT), 256, 256, kt * 64, nt * 64, lds);
  }
}
#define N_CONVERT_TASKS 2528

__device__ void mods_task(const Params& p, int task, float* lds) {
  const int t = tid_();
  int layer = task / 48, cgp = task % 48;
  float* sc = lds;
  float* red = lds + 9 * 1024;
  __syncthreads();
  for (int i = t; i < 9 * 1024; i += 256) {
    int r = i >> 10, k = i & 1023;
    float v = r < 8 ? p.in[1][r * 1024 + k] : p.in[3][k];
    sc[i] = siluf_(v);
  }
  __syncthreads();
  int col = cgp * 64 + (t & 63), kq = t >> 6;
  float acc[9];
#pragma unroll
  for (int r = 0; r < 9; r++) acc[r] = 0.f;
  const float* wp = p.in[4] + (size_t)layer * 1024 * 3072 + col;
#pragma unroll 16
  for (int k = kq * 256; k < kq * 256 + 256; k++) {
    float w = wp[(size_t)k * 3072];
#pragma unroll
    for (int r = 0; r < 9; r++) acc[r] += sc[r * 1024 + k] * w;
  }
#pragma unroll
  for (int r = 0; r < 9; r++) red[(kq * 9 + r) * 64 + (t & 63)] = acc[r];
  __syncthreads();
  float* mods = (float*)(p.ws + OFF_MODS);
  for (int i = t; i < 9 * 64; i += 256) {
    int r = i >> 6, c = i & 63;
    float s = red[(0 * 9 + r) * 64 + c] + red[(1 * 9 + r) * 64 + c] + red[(2 * 9 + r) * 64 + c] + red[(3 * 9 + r) * 64 + c];
    int cc = cgp * 64 + c;
    mods[((size_t)layer * 9 + r) * 3072 + cc] = s + p.in[5][layer * 3072 + cc];
  }
}

__device__ void ln_row(const Params& p, int mode, int layer, int row) {
  const int lane = tid_() & 63;
  float v[16];
  if (mode == 0) {
    const float* src = hin_ptr(p, 0, row);
#pragma unroll
    for (int i = 0; i < 4; i++) { float4 q = *(const float4*)(src + i * 256 + lane * 4); v[i*4]=q.x; v[i*4+1]=q.y; v[i*4+2]=q.z; v[i*4+3]=q.w; }
  } else {
    float* src = hout_ptr(p, row);
#pragma unroll
    for (int i = 0; i < 4; i++) { float4 q = *(const float4*)(src + i * 256 + lane * 4); v[i*4]=q.x; v[i*4+1]=q.y; v[i*4+2]=q.z; v[i*4+3]=q.w; }
    float s = 0.f;
#pragma unroll
    for (int i = 0; i < 16; i++) s += v[i];
    float mean = wavesum(s) * (1.f / 1024.f);
    float q2 = 0.f;
#pragma unroll
    for (int i = 0; i < 16; i++) { v[i] -= mean; q2 += v[i] * v[i]; }
    float rstd = rsqrtf(wavesum(q2) * (1.f / 1024.f) + 1e-5f);
    const float* lw = p.in[34] + layer * 1024; const float* lb = p.in[35] + layer * 1024;
#pragma unroll
    for (int i = 0; i < 4; i++) {
      float4 w4 = *(const float4*)(lw + i * 256 + lane * 4), b4 = *(const float4*)(lb + i * 256 + lane * 4);
      v[i*4] = v[i*4] * rstd * w4.x + b4.x; v[i*4+1] = v[i*4+1] * rstd * w4.y + b4.y;
      v[i*4+2] = v[i*4+2] * rstd * w4.z + b4.z; v[i*4+3] = v[i*4+3] * rstd * w4.w + b4.w;
      *(float4*)(src + i * 256 + lane * 4) = make_float4(v[i*4], v[i*4+1], v[i*4+2], v[i*4+3]);
    }
    if (layer == 1) return;
  }
  int ml = mode == 0 ? 0 : 1;
  float s = 0.f;
#pragma unroll
  for (int i = 0; i < 16; i++) s += v[i];
  float mean = wavesum(s) * (1.f / 1024.f);
  float q2 = 0.f;
#pragma unroll
  for (int i = 0; i < 16; i++) { v[i] -= mean; q2 += v[i] * v[i]; }
  float rstd = rsqrtf(wavesum(q2) * (1.f / 1024.f) + 1e-5f);
  const float* md = (const float*)(p.ws + OFF_MODS) + ((size_t)ml * 9 + modrow_of(row)) * 3072;
  u16* up = (u16*)(p.ws + OFF_U) + (size_t)row * 1024;
#pragma unroll
  for (int i = 0; i < 4; i++) {
    float4 sh = *(const float4*)(md + i * 256 + lane * 4), sc = *(const float4*)(md + 1024 + i * 256 + lane * 4);
    st4bf(up + i * 256 + lane * 4, v[i*4] * rstd * (1.f + sc.x) + sh.x, v[i*4+1] * rstd * (1.f + sc.y) + sh.y,
          v[i*4+2] * rstd * (1.f + sc.z) + sh.z, v[i*4+3] * rstd * (1.f + sc.w) + sh.w);
  }
}

#define STAGE_LOAD(P, kk_) do { const unsigned k_ = (kk_); \
  P##a0 = *(const uint4*)(A + (oa + k_)); P##a1 = *(const uint4*)(A + (oa + sa + k_)); \
  P##a2 = *(const uint4*)(A + (oa + 2 * sa + k_)); P##a3 = *(const uint4*)(A + (oa + 3 * sa + k_)); \
  P##b0 = *(const uint4*)(B + (ob + k_)); P##b1 = *(const uint4*)(B + (ob + sb + k_)); \
  if (NT == 4) { P##b2 = *(const uint4*)(B + (ob + 2 * sb + k_)); P##b3 = *(const uint4*)(B + (ob + 3 * sb + k_)); } } while (0)
#define STAGE_WRITE(P, Asw, Bsw) do { \
  *(uint4*)(Asw) = P##a0; *(uint4*)((Asw) + 32 * 72) = P##a1; *(uint4*)((Asw) + 64 * 72) = P##a2; *(uint4*)((Asw) + 96 * 72) = P##a3; \
  *(uint4*)(Bsw) = P##b0; *(uint4*)((Bsw) + 32 * 72) = P##b1; \
  if (NT == 4) { *(uint4*)((Bsw) + 64 * 72) = P##b2; *(uint4*)((Bsw) + 96 * 72) = P##b3; } } while (0)
template <int MT, int NT>
__device__ __forceinline__ void stage_compute(f32x4 (&acc)[MT][NT], const u16* As, const u16* Bs, int lane, int wm, int wn) {
#pragma unroll
  for (int kk = 0; kk < 2; kk++) {
    bf16x8 af[MT], bfr[NT];
#pragma unroll
    for (int mt = 0; mt < MT; mt++) af[mt] = *(const bf16x8*)(As + (wm * MT * 16 + mt * 16 + (lane & 15)) * 72 + kk * 32 + (lane >> 4) * 8);
#pragma unroll
    for (int nt = 0; nt < NT; nt++) bfr[nt] = *(const bf16x8*)(Bs + (wn * NT * 16 + nt * 16 + (lane & 15)) * 72 + kk * 32 + (lane >> 4) * 8);
    __builtin_amdgcn_s_setprio(1);
#pragma unroll
    for (int mt = 0; mt < MT; mt++)
#pragma unroll
      for (int nt = 0; nt < NT; nt++)
        acc[mt][nt] = __builtin_amdgcn_mfma_f32_16x16x32_bf16(af[mt], bfr[nt], acc[mt][nt], 0, 0, 0);
    __builtin_amdgcn_s_setprio(0);
  }
}
template <int MT, int NT>
__device__ __forceinline__ void gemm_kloop(f32x4 (&acc)[MT][NT], const u16* __restrict__ A, int lda,
                                           const u16* __restrict__ B, int ldb, int K, u16* lds) {
  static_assert(MT == 4, "MT");
  constexpr int BM = MT * 32, BN = NT * 32, SS = (BM + BN) * 72;
  const int t = tid_(), lane = t & 63, w = t >> 6, wm = w >> 1, wn = w & 1;
  u16* As0 = lds; u16* Bs0 = lds + BM * 72; u16* As1 = lds + SS; u16* Bs1 = lds + SS + BM * 72;
  const int lr = t >> 3, lc = (t & 7) * 8;
  const unsigned oa = (unsigned)(lr * lda + lc), ob = (unsigned)(lr * ldb + lc);
  const unsigned sa = 32u * (unsigned)lda, sb = 32u * (unsigned)ldb;
  const int swo = lr * 72 + lc;
  const unsigned klast = (unsigned)(K - 64);
  uint4 R0a0, R0a1, R0a2, R0a3, R0b0, R0b1, R0b2, R0b3, R1a0, R1a1, R1a2, R1a3, R1b0, R1b1, R1b2, R1b3;
  STAGE_LOAD(R0, 0u);
  STAGE_LOAD(R1, 64u);
  __syncthreads();
  STAGE_WRITE(R0, As0 + swo, Bs0 + swo);
  STAGE_LOAD(R0, 128u < klast ? 128u : klast);
  __syncthreads();
#pragma unroll 1
  for (int k0 = 0; k0 < K; k0 += 128) {
    STAGE_WRITE(R1, As1 + swo, Bs1 + swo);
    { unsigned kn = (unsigned)k0 + 192u; STAGE_LOAD(R1, kn < klast ? kn : klast); }
    stage_compute<MT, NT>(acc, As0, Bs0, lane, wm, wn);
    __syncthreads();
    STAGE_WRITE(R0, As0 + swo, Bs0 + swo);
    { unsigned kn = (unsigned)k0 + 256u; STAGE_LOAD(R0, kn < klast ? kn : klast); }
    stage_compute<MT, NT>(acc, As1, Bs1, lane, wm, wn);
    __syncthreads();
  }
}
template <int MT, int NT>
__device__ __forceinline__ void zero_acc(f32x4 (&acc)[MT][NT]) {
#pragma unroll
  for (int i = 0; i < MT; i++)
#pragma unroll
    for (int j = 0; j < NT; j++) acc[i][j] = (f32x4){0.f, 0.f, 0.f, 0.f};
}
__device__ __forceinline__ int tile_m0(int latonly, int tm) {
  if (!latonly) return tm * 128;
  int b = tm >> 4; return b * TT + 256 + (tm & 15) * 128;
}

__device__ __forceinline__ bool xcd_tile(int it, int bid, int nb, int NTM, int NTN, int G, int& tm, int& tn) {
  const int xcd = bid & 7, lb = bid >> 3, nlb = nb >> 3, tmx = NTM >> 3;
  const int idx = it * nlb + lb;
  if (idx >= tmx * NTN) return false;
  const int full = tmx / G;
  int g = idx / (G * NTN);
  if (g > full) g = full;
  const int r = idx - g * G * NTN;
  const int gs = (g < full) ? G : (tmx - full * G);
  tn = r / gs;
  tm = xcd * tmx + g * G + (r - tn * gs);
  return true;
}
__device__ void inproj_tile(const Params& p, int layer, int tm, int tn, u16* lds) {
  int m0 = tm * 128, n0 = tn * 128;
  f32x4 acc[4][4]; zero_acc(acc);
  gemm_kloop<4, 4>(acc, (const u16*)(p.ws + OFF_U) + (size_t)m0 * 1024, 1024,
                   (const u16*)(p.ws + OFF_WINT) + (size_t)n0 * 1024, 1024, 1024, lds);
  const int t = tid_(), lane = t & 63, w = t >> 6, wm = w >> 1, wn = w & 1;
  const float* bias = p.in[7] + (size_t)layer * DIN;
  u16* proj = (u16*)(p.ws + OFF_PROJ);
#pragma unroll
  for (int nt = 0; nt < 4; nt++) {
    const int cl = wn * 64 + nt * 16 + (lane & 15);
    const float bv = (n0 + cl < PC) ? bias[n0 + cl] : 0.f;
#pragma unroll
    for (int mt = 0; mt < 4; mt++)
#pragma unroll
      for (int r = 0; r < 4; r++) lds[(wm * 64 + mt * 16 + (lane >> 4) * 4 + r) * 136 + cl] = f2bf(acc[mt][nt][r] + bv);
  }
  __syncthreads();
#pragma unroll
  for (int i = 0; i < 8; i++) {
    const int q = t + 256 * i, row = q >> 4, ch = q & 15;
    if (n0 + ch * 8 < PC) *(uint4*)(proj + (size_t)(m0 + row) * PC + n0 + ch * 8) = *(const uint4*)(lds + row * 136 + ch * 8);
  }
}
__device__ void glu_tile(const Params& p, int layer, int latonly, int tm, int tn, u16* lds) {
  int m0 = tile_m0(latonly, tm), n0 = tn * 128;
  f32x4 acc[4][4]; zero_acc(acc);
  u16* proj = (u16*)(p.ws + OFF_PROJ);
  gemm_kloop<4, 4>(acc, proj + (size_t)m0 * PC + C_S5U, PC, (const u16*)(p.ws + OFF_GLUT) + (size_t)n0 * 256, 256, 256, lds);
  const int t = tid_(), lane = t & 63, w = t >> 6, wm = w >> 1, wn = w & 1;
  const float* bias = p.in[17] + layer * 256;
#pragma unroll
  for (int nt = 0; nt < 4; nt++) {
    const int cl = wn * 64 + nt * 16 + (lane & 15);
    const float bv = bias[n0 + cl];
#pragma unroll
    for (int mt = 0; mt < 4; mt++)
#pragma unroll
      for (int r = 0; r < 4; r++) lds[(wm * 64 + mt * 16 + (lane >> 4) * 4 + r) * 136 + cl] = f2bf(sigmoidf_(acc[mt][nt][r] + bv));
  }
  __syncthreads();
#pragma unroll
  for (int i = 0; i < 8; i++) {
    const int q = t + 256 * i, row = q >> 4, ch = q & 15;
    u16* pr = proj + (size_t)(m0 + row) * PC + n0 + ch * 8;
    uint4 sg = *(const uint4*)(lds + row * 136 + ch * 8);
    uint4 yy = *(const uint4*)(pr + C_S5U), zz = *(const uint4*)(pr + C_S5Z), oo;
    const unsigned* sgp = (const unsigned*)&sg; const unsigned* yp = (const unsigned*)&yy; const unsigned* zp = (const unsigned*)&zz; unsigned* op = (unsigned*)&oo;
#pragma unroll
    for (int e = 0; e < 4; e++) {
      float s0 = __uint_as_float(sgp[e] << 16), s1 = __uint_as_float(sgp[e] & 0xffff0000u);
      float y0 = __uint_as_float(yp[e] << 16), y1 = __uint_as_float(yp[e] & 0xffff0000u);
      float z0 = __uint_as_float(zp[e] << 16), z1 = __uint_as_float(zp[e] & 0xffff0000u);
      op[e] = pack2(y0 * s0 * siluf_(z0), y1 * s1 * siluf_(z1));
    }
    *(uint4*)(pr + C_S5Z) = oo;
  }
}
__device__ void merge_tile(const Params& p, int layer, int latonly, int tm, int tn, u16* lds) {
  int m0 = tile_m0(latonly, tm), n0 = tn * 64;
  f32x4 accm[4][2]; zero_acc(accm);
  const u16* proj = (const u16*)(p.ws + OFF_PROJ);
  const int lane = tid_() & 63, w = tid_() >> 6, wm = w >> 1, wn = w & 1;
  const float* bias = p.in[7] + (size_t)layer * DIN + PC;
#pragma unroll 1
  for (int k = 0; k < 4; k++) {
    const int ycol = k == 0 ? C_S5Z : (k == 1 ? C_HGQ : (k == 2 ? C_RTQ : C_RWZ));
    f32x4 accb[4][2]; zero_acc(accb);
    gemm_kloop<4, 2>(accb, proj + (size_t)m0 * PC + ycol, PC,
                     (const u16*)(p.ws + OFF_WBT) + ((size_t)k * 1024 + n0) * 256, 256, 256, lds);
    f32x4 accg[4][2]; zero_acc(accg);
    gemm_kloop<4, 2>(accg, (const u16*)(p.ws + OFF_U) + (size_t)m0 * 1024, 1024,
                     (const u16*)(p.ws + OFF_WINT) + ((size_t)PC + k * 1024 + n0) * 1024, 1024, 1024, lds);
#pragma unroll
    for (int nt = 0; nt < 2; nt++) {
      float bv = bias[k * 1024 + n0 + wn * 32 + nt * 16 + (lane & 15)];
#pragma unroll
      for (int mt = 0; mt < 4; mt++)
#pragma unroll
        for (int r = 0; r < 4; r++) accm[mt][nt][r] += sigmoidf_(accg[mt][nt][r] + bv) * accb[mt][nt][r];
    }
  }
  u16* mg = (u16*)(p.ws + OFF_SCR);
#pragma unroll
  for (int nt = 0; nt < 2; nt++) {
    const int cl = wn * 32 + nt * 16 + (lane & 15);
#pragma unroll
    for (int mt = 0; mt < 4; mt++)
#pragma unroll
      for (int r = 0; r < 4; r++) lds[(wm * 64 + mt * 16 + (lane >> 4) * 4 + r) * 72 + cl] = f2bf(accm[mt][nt][r]);
  }
  __syncthreads();
  {
    const int t = tid_();
#pragma unroll
    for (int i = 0; i < 4; i++) {
      const int q = t + 256 * i, row = q >> 3, ch = q & 7;
      *(uint4*)(mg + (size_t)(m0 + row) * 1024 + n0 + ch * 8) = *(const uint4*)(lds + row * 72 + ch * 8);
    }
  }
}
__device__ void outproj_tile(const Params& p, int layer, int latonly, int tm, int tn, u16* lds) {
  int m0 = tile_m0(latonly, tm), n0 = tn * 128;
  f32x4 acc[4][4]; zero_acc(acc);
  gemm_kloop<4, 4>(acc, (const u16*)(p.ws + OFF_SCR) + (size_t)m0 * 1024, 1024,
                   (const u16*)(p.ws + OFF_WOT) + (size_t)n0 * 1024, 1024, 1024, lds);
  const int lane = tid_() & 63, w = tid_() >> 6, wm = w >> 1, wn = w & 1;
  const float* bias = p.in[33] + layer * 1024;
  const float* hi0 = hin_ptr(p, layer, m0);
  float* ho0 = hout_ptr(p, m0);
  const float* gate = (const float*)(p.ws + OFF_MODS) + ((size_t)layer * 9 + modrow_of(m0)) * 3072 + 2048;
  float* cs = (float*)lds;
#pragma unroll
  for (int nt = 0; nt < 4; nt++) {
    const int cl = wn * 64 + nt * 16 + (lane & 15);
    const float bv = bias[n0 + cl];
#pragma unroll
    for (int mt = 0; mt < 4; mt++)
#pragma unroll
      for (int r = 0; r < 4; r++) cs[(wm * 64 + mt * 16 + (lane >> 4) * 4 + r) * 132 + cl] = acc[mt][nt][r] + bv;
  }
  __syncthreads();
  {
    const int t = tid_();
#pragma unroll 4
    for (int i = 0; i < 16; i++) {
      const int q = t + 256 * i, row = q >> 5, ch = q & 31;
      const float4 a4 = *(const float4*)(cs + row * 132 + ch * 4);
      const float4 g4 = *(const float4*)(gate + n0 + ch * 4);
      const float4 h4 = *(const float4*)(hi0 + (size_t)row * 1024 + n0 + ch * 4);
      float4 o4;
      o4.x = 1.4142135623730951f * h4.x + g4.x * a4.x; o4.y = 1.4142135623730951f * h4.y + g4.y * a4.y;
      o4.z = 1.4142135623730951f * h4.z + g4.z * a4.z; o4.w = 1.4142135623730951f * h4.w + g4.w * a4.w;
      *(float4*)(ho0 + (size_t)row * 1024 + n0 + ch * 4) = o4;
    }
  }
}

template <bool TWO>
__device__ void rwkv_scan_task(const Params& p, int layer, int task, float* lds) {
  const int t = tid_();
  const int rh = TWO ? (task & 1) : (task & 3), h = TWO ? ((task >> 1) & 3) : ((task >> 2) & 3);
  const int b = TWO ? ((task >> 3) & 7) : ((task >> 4) & 7), d = TWO ? (task >> 6) : (task >> 7);
  constexpr int RPB = TWO ? 32 : 16;
  float* sh_lora = lds;
  float* sh_w2 = sh_lora + 512;
  float* sh_a2 = sh_w2 + 1024;
  float* sh_r = sh_a2 + 1024;
  float* sh_w = sh_r + 1024;
  float* sh_k = sh_w + 1024;
  float* sh_kk = sh_k + 1024;
  float* sh_b = sh_kk + 1024;
  float* sh_v = sh_b + 1024;
  float* sh_o = sh_v + 512;
  const u16* proj = (const u16*)(p.ws + OFF_PROJ);
  u16* rwo = (u16*)(p.ws + OFF_RWO) + (size_t)d * MROWS * 256;
  float* bonus = (float*)(p.ws + OFF_BONUS) + (size_t)d * MROWS * 4;
  const float* mu0 = p.in[21] + (size_t)layer * 2 * 832;
  const float* mu1 = mu0 + 832;
  __syncthreads();
  for (int i = t; i < 1024; i += 256) {
    int rr = i >> 6, c = i & 63;
    sh_w2[i] = p.in[23][(((size_t)layer * 2 + d) * 16 + rr) * 256 + h * 64 + c];
    sh_a2[i] = p.in[25][(((size_t)layer * 2 + d) * 16 + rr) * 256 + h * 64 + c];
  }
  const int pst = t >> 4, cq = t & 15;
  const int ch0 = h * 64 + cq * 4;
  float mur0[4], mur1[4], muk0[4], muk1[4], w0v[4], a0v[4], kkw[4], kaw[4], rkw[4];
#pragma unroll
  for (int i = 0; i < 4; i++) {
    mur0[i] = mu0[ch0 + i]; mur1[i] = mu1[ch0 + i];
    muk0[i] = mu0[256 + ch0 + i]; muk1[i] = mu1[256 + ch0 + i];
    w0v[i] = p.in[22][((size_t)layer * 2 + d) * 256 + ch0 + i];
    a0v[i] = p.in[24][((size_t)layer * 2 + d) * 256 + ch0 + i];
    kkw[i] = p.in[26][layer * 256 + ch0 + i];
    kaw[i] = p.in[27][layer * 256 + ch0 + i];
    rkw[i] = p.in[28][layer * 256 + ch0 + i];
  }
  const int vch = 512 + h * 64 + rh * RPB + cq;
  const float muv0 = mu0[vch], muv1 = mu1[vch], muw0 = TWO ? mu0[vch + 16] : 0.f, muw1 = TWO ? mu1[vch + 16] : 0.f;
  const int lidx0 = t * 2;
  float lmu00, lmu01, lmu10, lmu11;
  {
    int q = lidx0 & 31;
    int col = q < 16 ? (768 + d * 16 + q) : (800 + d * 16 + (q - 16));
    lmu00 = mu0[col]; lmu01 = mu0[col + 1]; lmu10 = mu1[col]; lmu11 = mu1[col + 1];
  }
  const int rl = t >> 4, ks = t & 15;
  float4 S = make_float4(0.f, 0.f, 0.f, 0.f), S2 = make_float4(0.f, 0.f, 0.f, 0.f);
  unsigned lx0 = 0, lx1 = 0, lxp0 = 0, lxp1 = 0, lxn0 = 0, lxn1 = 0;
  uint2 rr_c, rr_p, rr_n, rk_c, rk_p, rk_n;
  unsigned rv_c, rv_p, rv_n, rw_c = 0, rw_p = 0, rw_n = 0;
  auto fetch = [&](int s0) {
    {
      int st2 = lidx0 >> 5, q = lidx0 & 31;
      int j = jmap(d, s0 + st2);
      int col = q < 16 ? (768 + d * 16 + q) : (800 + d * 16 + (q - 16));
      const u16* pr = proj + ((size_t)(b * TT + j)) * PC + C_RWX + col;
      const u16* prp = has_prev(j) ? pr - PC : pr;
      const u16* prn = has_next(j) ? pr + PC : pr;
      lx0 = pr[0]; lx1 = pr[1]; lxp0 = prp[0]; lxp1 = prp[1]; lxn0 = prn[0]; lxn1 = prn[1];
    }
    int j = jmap(d, s0 + pst);
    const u16* pr = proj + ((size_t)(b * TT + j)) * PC + C_RWX;
    const u16* prp = has_prev(j) ? pr - PC : pr;
    const u16* prn = has_next(j) ? pr + PC : pr;
    rr_c = *(const uint2*)(pr + ch0); rr_p = *(const uint2*)(prp + ch0); rr_n = *(const uint2*)(prn + ch0);
    rk_c = *(const uint2*)(pr + 256 + ch0); rk_p = *(const uint2*)(prp + 256 + ch0); rk_n = *(const uint2*)(prn + 256 + ch0);
    rv_c = pr[vch]; rv_p = prp[vch]; rv_n = prn[vch];
    if (TWO) { rw_c = pr[vch + 16]; rw_p = prp[vch + 16]; rw_n = prn[vch + 16]; }
  };
  auto unpack4 = [](uint2 v, float (&o)[4]) {
    o[0] = __uint_as_float(v.x << 16); o[1] = __uint_as_float(v.x & 0xffff0000u);
    o[2] = __uint_as_float(v.y << 16); o[3] = __uint_as_float(v.y & 0xffff0000u);
  };
  fetch(0);
  for (int s0 = 0; s0 < TT; s0 += 16) {
    {
      int st2 = lidx0 >> 5, q = lidx0 & 31;
      int ja = jmap(d, s0 + st2);
      const float hpa = has_prev(ja) ? 1.f : 0.f, hna = has_next(ja) ? 1.f : 0.f;
      float x0 = __uint_as_float(lx0 << 16), x1 = __uint_as_float(lx1 << 16);
      float xs0 = x0 + lmu00 * (__uint_as_float(lxp0 << 16) * hpa - x0) + lmu10 * (__uint_as_float(lxn0 << 16) * hna - x0);
      float xs1 = x1 + lmu01 * (__uint_as_float(lxp1 << 16) * hpa - x1) + lmu11 * (__uint_as_float(lxn1 << 16) * hna - x1);
      if (q < 16) {
        xs0 = 1.f - 2.f * __builtin_amdgcn_rcpf(__expf(2.f * xs0) + 1.f);
        xs1 = 1.f - 2.f * __builtin_amdgcn_rcpf(__expf(2.f * xs1) + 1.f);
      }
      *(float2*)(sh_lora + lidx0) = make_float2(xs0, xs1);
    }
    __syncthreads();
    const int jcur = jmap(d, s0 + pst);
    {
      const float hpf = has_prev(jcur) ? 1.f : 0.f, hnf = has_next(jcur) ? 1.f : 0.f;
      float r4[4], k4[4], t0[4], t1[4];
      unpack4(rr_c, r4); unpack4(rr_p, t0); unpack4(rr_n, t1);
#pragma unroll
      for (int i = 0; i < 4; i++) r4[i] = r4[i] + mur0[i] * (t0[i] * hpf - r4[i]) + mur1[i] * (t1[i] * hnf - r4[i]);
      unpack4(rk_c, k4); unpack4(rk_p, t0); unpack4(rk_n, t1);
#pragma unroll
      for (int i = 0; i < 4; i++) k4[i] = k4[i] + muk0[i] * (t0[i] * hpf - k4[i]) + muk1[i] * (t1[i] * hnf - k4[i]);
      float wl[4], al[4];
#pragma unroll
      for (int i = 0; i < 4; i++) { wl[i] = w0v[i]; al[i] = a0v[i]; }
      float lrow[32];
#pragma unroll
      for (int i4 = 0; i4 < 8; i4++) {
        float4 q4 = *(const float4*)(sh_lora + pst * 32 + i4 * 4);
        lrow[i4 * 4] = q4.x; lrow[i4 * 4 + 1] = q4.y; lrow[i4 * 4 + 2] = q4.z; lrow[i4 * 4 + 3] = q4.w;
      }
#pragma unroll
      for (int rr = 0; rr < 16; rr++) {
        float lw_ = lrow[rr], la_ = lrow[16 + rr];
        float4 w2 = *(const float4*)(sh_w2 + rr * 64 + cq * 4);
        float4 a2 = *(const float4*)(sh_a2 + rr * 64 + cq * 4);
        wl[0] += lw_ * w2.x; wl[1] += lw_ * w2.y; wl[2] += lw_ * w2.z; wl[3] += lw_ * w2.w;
        al[0] += la_ * a2.x; al[1] += la_ * a2.y; al[2] += la_ * a2.z; al[3] += la_ * a2.w;
      }
      float wv[4], kd[4], kk[4], bb[4];
      float ss = 0.f, bon = 0.f;
#pragma unroll
      for (int i = 0; i < 4; i++) {
        float a = wl[i];
        float lw = fminf(a, 0.f) - __logf(1.f + __expf(-fabsf(a))) - 0.5f;
        wv[i] = __expf(-__expf(lw));
        float ic = sigmoidf_(al[i]);
        float kr = k4[i] * kkw[i];
        kk[i] = kr; ss += kr * kr;
        kd[i] = k4[i] * (1.f + (ic - 1.f) * kaw[i]);
        bb[i] = ic;
        bon += r4[i] * kd[i] * rkw[i];
      }
      ss = allsum16(ss); bon = allsum16(bon);
      float inv = rsqrtf(fmaxf(ss, 1e-24f));
#pragma unroll
      for (int i = 0; i < 4; i++) { kk[i] *= inv; bb[i] *= kk[i]; }
      *(float4*)(sh_r + pst * 64 + cq * 4) = make_float4(r4[0], r4[1], r4[2], r4[3]);
      *(float4*)(sh_w + pst * 64 + cq * 4) = make_float4(wv[0], wv[1], wv[2], wv[3]);
      *(float4*)(sh_k + pst * 64 + cq * 4) = make_float4(kd[0], kd[1], kd[2], kd[3]);
      *(float4*)(sh_kk + pst * 64 + cq * 4) = make_float4(kk[0], kk[1], kk[2], kk[3]);
      *(float4*)(sh_b + pst * 64 + cq * 4) = make_float4(bb[0], bb[1], bb[2], bb[3]);
      if (rh == 0 && cq == 0) bonus[(size_t)(b * TT + jcur) * 4 + h] = bon;
      float xv = __uint_as_float(rv_c << 16);
      sh_v[pst * 32 + cq] = xv + muv0 * (__uint_as_float(rv_p << 16) * hpf - xv) + muv1 * (__uint_as_float(rv_n << 16) * hnf - xv);
      float xw = __uint_as_float(rw_c << 16);
      if (TWO) sh_v[pst * 32 + 16 + cq] = xw + muw0 * (__uint_as_float(rw_p << 16) * hpf - xw) + muw1 * (__uint_as_float(rw_n << 16) * hnf - xw);
    }
    __syncthreads();
    if (s0 + 16 < TT) fetch(s0 + 16);
    float oacc = 0.f, oacc2 = 0.f;
    {
      float4 nkk = *(const float4*)(sh_kk + ks * 4), nw = *(const float4*)(sh_w + ks * 4), nb4 = *(const float4*)(sh_b + ks * 4);
      float4 nk = *(const float4*)(sh_k + ks * 4), nr = *(const float4*)(sh_r + ks * 4);
      float nv = sh_v[rl], nv2 = sh_v[16 + rl];
#pragma unroll 2
      for (int st = 0; st < 16; st++) {
        const float4 kk4 = nkk, w4 = nw, b4 = nb4, k4 = nk, r4 = nr; const float vv = nv, vv2 = nv2;
        {
          const int sn = (st + 1) & 15;
          nkk = *(const float4*)(sh_kk + sn * 64 + ks * 4); nw = *(const float4*)(sh_w + sn * 64 + ks * 4);
          nb4 = *(const float4*)(sh_b + sn * 64 + ks * 4); nk = *(const float4*)(sh_k + sn * 64 + ks * 4);
          nr = *(const float4*)(sh_r + sn * 64 + ks * 4); nv = sh_v[sn * 32 + rl]; nv2 = sh_v[sn * 32 + 16 + rl];
        }
        float sa = -((S.x * kk4.x + S.y * kk4.y) + (S.z * kk4.z + S.w * kk4.w));
        float sa2 = 0.f;
        if (TWO) sa2 = -((S2.x * kk4.x + S2.y * kk4.y) + (S2.z * kk4.z + S2.w * kk4.w));
        sa = allsum16(sa); if (TWO) sa2 = allsum16(sa2);
        S.x = S.x * w4.x + (sa * b4.x + vv * k4.x);
        S.y = S.y * w4.y + (sa * b4.y + vv * k4.y);
        S.z = S.z * w4.z + (sa * b4.z + vv * k4.z);
        S.w = S.w * w4.w + (sa * b4.w + vv * k4.w);
        if (TWO) {
          S2.x = S2.x * w4.x + (sa2 * b4.x + vv2 * k4.x);
          S2.y = S2.y * w4.y + (sa2 * b4.y + vv2 * k4.y);
          S2.z = S2.z * w4.z + (sa2 * b4.z + vv2 * k4.z);
          S2.w = S2.w * w4.w + (sa2 * b4.w + vv2 * k4.w);
        }
        float o = (S.x * r4.x + S.y * r4.y) + (S.z * r4.z + S.w * r4.w);
        float o2 = 0.f;
        if (TWO) o2 = (S2.x * r4.x + S2.y * r4.y) + (S2.z * r4.z + S2.w * r4.w);
        o = allsum16(o); if (TWO) o2 = allsum16(o2);
        oacc = (ks == st) ? o : oacc;
        oacc2 = (ks == st) ? o2 : oacc2;
      }
    }
    sh_o[ks * 32 + rl] = oacc;
    if (TWO) sh_o[ks * 32 + 16 + rl] = oacc2;
    __syncthreads();
    {
      u16* op = rwo + (size_t)(b * TT + jcur) * 256 + h * 64 + rh * RPB + cq;
      op[0] = f2bf(sh_o[pst * 32 + cq]);
      if (TWO) op[16] = f2bf(sh_o[pst * 32 + 16 + cq]);
    }
  }
}

__device__ void rwkv_combine_rows(const Params& p, int layer, int row0, int latonly) {
  const int lane = tid_() & 63, h = tid_() >> 6;
  const int ch = h * 64 + lane;
  const u16* rwo = (const u16*)(p.ws + OFF_RWO);
  u16* proj = (u16*)(p.ws + OFF_PROJ);
  const float* mu0 = p.in[21] + (size_t)layer * 2 * 832; const float* mu1 = mu0 + 832;
  const float* bonus = (const float*)(p.ws + OFF_BONUS);
  const float gw = p.in[29][layer * 256 + ch], gb = p.in[30][layer * 256 + ch];
  const float m0 = mu0[512 + ch], m1 = mu1[512 + ch];
  const int vc = C_RWX + 512 + ch;
  float o[8], xv[8], xp[8], xn[8], bs[8], z[8];
#pragma unroll
  for (int i = 0; i < 8; i++) {
    const int row = row0 + i;
    const int j = row % TT;
    const u16* pr = proj + (size_t)row * PC;
    o[i] = bf2f(rwo[(size_t)row * 256 + ch]) + bf2f(rwo[(size_t)MROWS * 256 + (size_t)row * 256 + ch]);
    xv[i] = bf2f(pr[vc]);
    xp[i] = has_prev(j) ? bf2f(pr[vc - PC]) : 0.f;
    xn[i] = has_next(j) ? bf2f(pr[vc + PC]) : 0.f;
    bs[i] = bonus[(size_t)row * 4 + h] + bonus[(size_t)MROWS * 4 + (size_t)row * 4 + h];
    z[i] = bf2f(pr[C_RWZ + ch]);
  }
#pragma unroll
  for (int i = 0; i < 8; i++) {
    const int row = row0 + i;
    if (latonly && (row % TT) < 256) continue;
    float mean = wavesum(o[i]) * (1.f / 64.f);
    float dlt = o[i] - mean;
    float var = wavesum(dlt * dlt) * (1.f / 64.f);
    float on = dlt * rsqrtf(var + 64e-5f) * gw + gb;
    float v = xv[i] + m0 * (xp[i] - xv[i]) + m1 * (xn[i] - xv[i]);
    proj[(size_t)row * PC + C_RWZ + ch] = f2bf((on + bs[i] * v) * siluf_(z[i]));
  }
}

template <int MX, int PASS>
__device__ __forceinline__ void gla_sweep(const Params& p, int layer, int d, int b, int h, int c, float* lds) {
  const int t = tid_(), w = t >> 6, lane = t & 63;
  float* kbuf = lds;
  float* fbuf = kbuf + 1024;
  float* qbuf = fbuf + 1024;
  float* vbuf = qbuf + 1024;
  float* part = vbuf + 1024;
  u16* proj = (u16*)(p.ws + OFF_PROJ);
  const int dbh = (d * 8 + b) * 4 + h;
  float* stt = (float*)(p.ws + (MX == 0 ? OFF_HGST : OFF_RTST)) + ((size_t)dbh * 9 + c) * 4096;
  float S[16];
#pragma unroll
  for (int i = 0; i < 16; i++) S[i] = PASS == 1 ? 0.f : stt[(w * 16 + i) * 64 + lane];
  float gam = 1.f;
  if (MX == 1) gam = __expf(-__expf(p.in[20][((size_t)layer * 2 + d) * 4 + h]));
  float Pl = 1.f;
  const int pst = t >> 4, c4 = (t & 15) * 4;
  float lb4[4] = {0.f, 0.f, 0.f, 0.f};
  if (MX == 0 && layer == 1) {
#pragma unroll
    for (int i = 0; i < 4; i++) {
      float l0 = p.in[18][(0 * 2 + d) * 256 + h * 64 + c4 + i], l1 = p.in[18][(1 * 2 + d) * 256 + h * 64 + c4 + i];
      float mx = fmaxf(l0, l1);
      float e0 = __expf(l0 - mx), e1 = __expf(l1 - mx);
      lb4[i] = e1 / (e0 + e1);
    }
  }
  const int vcol0 = (MX == 0 ? C_HGI : C_RTV) + h * 64;
  const float* rope = (const float*)(p.ws + OFF_ROPE);
  uint2 r_a, r_b, r_c, r_d, r_v; float4 r_cs0, r_cs1;
  r_a = r_b = r_c = r_d = r_v = make_uint2(0u, 0u); r_cs0 = r_cs1 = make_float4(1.f, 0.f, 1.f, 0.f);
  auto fetch = [&](int s0) {
    int j = jmap(d, s0 + pst);
    const u16* pr = proj + (size_t)(b * TT + j) * PC;
    r_v = *(const uint2*)(pr + vcol0 + c4);
    if (MX == 0) {
      r_a = *(const uint2*)(pr + C_HGF + d * 256 + h * 64 + c4);
      if (PASS == 2) r_b = *(const uint2*)(pr + C_HGQ + h * 64 + c4);
    } else {
      r_a = *(const uint2*)(pr + C_RTK + h * 64 + c4);
      r_c = *(const uint2*)(pr + C_RTK + h * 64 + (c4 ^ 16));
      if (PASS == 2) { r_b = *(const uint2*)(pr + C_RTQ + h * 64 + c4); r_d = *(const uint2*)(pr + C_RTQ + h * 64 + (c4 ^ 16)); }
      if (j >= 256) {
        int tl = j - 256;
        int pos = (c4 & 32) ? (tl & 63) : (tl >> 6);
        const float* rp = rope + (pos * 16 + (c4 & 15)) * 2;
        r_cs0 = *(const float4*)rp; r_cs1 = *(const float4*)(rp + 4);
      } else { r_cs0 = make_float4(1.f, 0.f, 1.f, 0.f); r_cs1 = r_cs0; }
    }
  };
  auto unpack4 = [](uint2 v, float (&o)[4]) {
    o[0] = __uint_as_float(v.x << 16); o[1] = __uint_as_float(v.x & 0xffff0000u);
    o[2] = __uint_as_float(v.y << 16); o[3] = __uint_as_float(v.y & 0xffff0000u);
  };
  u16* ofp; int ofs;
  if (MX == 0) { ofp = proj + C_HGF + h * 64 + lane; ofs = PC; }
  else { ofp = (u16*)(p.ws + OFF_RETOF) + h * 64 + lane; ofs = 256; }
  const int zcol = (MX == 0 ? C_HGZ : C_RTZ) + h * 64 + lane;
  const int ycol = (MX == 0 ? C_HGQ : C_RTQ) + h * 64 + lane;
  float normw = 1.f;
  if (MX == 0 && PASS == 2) normw = p.in[19][layer * 256 + h * 64 + lane];
  fetch(c * 256);
  for (int sub = 0; sub < 16; sub++) {
    const int s0 = c * 256 + sub * 16;
    __syncthreads();
    {
      float va[4], vb[4], vc[4], vd[4], vv4[4];
      unpack4(r_a, va); unpack4(r_v, vv4);
      *(float4*)(vbuf + pst * 64 + c4) = make_float4(vv4[0], vv4[1], vv4[2], vv4[3]);
      if (MX == 0) {
        float f[4], k[4];
#pragma unroll
        for (int i = 0; i < 4; i++) { f[i] = lb4[i] + (1.f - lb4[i]) * sigmoidf_(va[i]); k[i] = 1.f - f[i]; }
        *(float4*)(kbuf + pst * 64 + c4) = make_float4(k[0], k[1], k[2], k[3]);
        *(float4*)(fbuf + pst * 64 + c4) = make_float4(f[0], f[1], f[2], f[3]);
        if (PASS == 2) {
          unpack4(r_b, vb);
          *(float4*)(qbuf + pst * 64 + c4) = make_float4(siluf_(vb[0]), siluf_(vb[1]), siluf_(vb[2]), siluf_(vb[3]));
        }
      } else {
        unpack4(r_c, vc);
        float cs[8] = {r_cs0.x, r_cs0.y, r_cs0.z, r_cs0.w, r_cs1.x, r_cs1.y, r_cs1.z, r_cs1.w};
        float sgn = (c4 & 16) ? 1.f : -1.f;
#pragma unroll
        for (int i = 0; i < 4; i++) va[i] = (va[i] * cs[2 * i] + sgn * vc[i] * cs[2 * i + 1]) * 0.125f;
        *(float4*)(kbuf + pst * 64 + c4) = make_float4(va[0], va[1], va[2], va[3]);
        if (PASS == 2) {
          unpack4(r_b, vb); unpack4(r_d, vd);
#pragma unroll
          for (int i = 0; i < 4; i++) vb[i] = vb[i] * cs[2 * i] + sgn * vd[i] * cs[2 * i + 1];
          *(float4*)(qbuf + pst * 64 + c4) = make_float4(vb[0], vb[1], vb[2], vb[3]);
        }
      }
    }
    __syncthreads();
    if (sub + 1 < 16) fetch(s0 + 16);
    u16 pf_o[4], pf_z[4];
    if (PASS == 2 && d == 1) {
#pragma unroll
      for (int e = 0; e < 4; e++) {
        size_t row = (size_t)(b * TT + jmap(d, s0 + w * 4 + e));
        pf_o[e] = ofp[row * ofs]; pf_z[e] = proj[row * PC + zcol];
      }
    }
#pragma unroll 2
    for (int st = 0; st < 16; st++) {
      const float vv = vbuf[st * 64 + lane];
      float o = 0.f;
#pragma unroll
      for (int i4 = 0; i4 < 4; i4++) {
        float4 kv = *(const float4*)(kbuf + st * 64 + w * 16 + i4 * 4);
        float4 fv = make_float4(gam, gam, gam, gam);
        if (MX == 0) fv = *(const float4*)(fbuf + st * 64 + w * 16 + i4 * 4);
        S[i4*4]   = fv.x * S[i4*4]   + kv.x * vv;
        S[i4*4+1] = fv.y * S[i4*4+1] + kv.y * vv;
        S[i4*4+2] = fv.z * S[i4*4+2] + kv.z * vv;
        S[i4*4+3] = fv.w * S[i4*4+3] + kv.w * vv;
        if (PASS == 2) {
          float4 qv = *(const float4*)(qbuf + st * 64 + w * 16 + i4 * 4);
          o += S[i4*4] * qv.x + S[i4*4+1] * qv.y + S[i4*4+2] * qv.z + S[i4*4+3] * qv.w;
        }
      }
      if (MX == 0 && PASS == 1) { if (lane < 16) Pl *= fbuf[st * 64 + w * 16 + lane]; }
      if (PASS == 2) part[(w * 16 + st) * 64 + lane] = o;
    }
    if (PASS == 2) {
      __syncthreads();
#pragma unroll
      for (int e = 0; e < 4; e++) {
        int st = w * 4 + e;
        float o = part[(0 * 16 + st) * 64 + lane] + part[(1 * 16 + st) * 64 + lane] + part[(2 * 16 + st) * 64 + lane] + part[(3 * 16 + st) * 64 + lane];
        int j = jmap(d, s0 + st);
        size_t row = (size_t)(b * TT + j);
        if (d == 0) {
          ofp[row * ofs] = f2bf(o);
        } else {
          o += bf2f(pf_o[e]);
          float ss = wavesum(o * o);
          float y = o * rsqrtf(ss * (1.f / 64.f) + 1e-6f) * normw;
          proj[row * PC + ycol] = f2bf(y * siluf_(bf2f(pf_z[e])));
        }
      }
    }
  }
  if (PASS == 1) {
#pragma unroll
    for (int i = 0; i < 16; i++) stt[(w * 16 + i) * 64 + lane] = S[i];
    if (MX == 0 && lane < 16) ((float*)(p.ws + OFF_HGP))[((size_t)dbh * 9 + c) * 64 + w * 16 + lane] = Pl;
  }
}

#define RS 72
template <int PASS>
__device__ __forceinline__ void ret_sweep(const Params& p, int layer, int d, int b, int h, int nc, int cstep, u16* lds) {
  const int t = tid_(), lane = t & 63, w4 = t >> 6;
  u16* Qs = lds;
  u16* Ks = Qs + 64 * RS;
  u16* Kt = Ks + 64 * RS;
  u16* Vt = Kt + 64 * RS;
  u16* Vd = Vt + 64 * RS;
  u16* Ps = Vd + 64 * RS;
  u16* St = Ps + 64 * RS;
  u16* proj = (u16*)(p.ws + OFF_PROJ);
  const float* rope = (const float*)(p.ws + OFF_ROPE);
  const float lg = -__expf(p.in[20][((size_t)layer * 2 + d) * 4 + h]) * 1.4426950408889634f;
  const float g64 = exp2f(64.f * lg);
  const int dbh = (d * 8 + b) * 4 + h;
  float* stt = (float*)(p.ws + OFF_RTST) + ((size_t)dbh * 9 + cstep) * 4096;
  f32x4 accS[4];
#pragma unroll
  for (int nt = 0; nt < 4; nt++)
#pragma unroll
    for (int r = 0; r < 4; r++)
      accS[nt][r] = PASS == 1 ? 0.f : stt[(w4 * 16 + (lane >> 4) * 4 + r) * 64 + nt * 16 + (lane & 15)];
  uint4 rq[2], rqp[2], rk[2], rkp[2], rv[2];
  auto fetch = [&](int w) {
#pragma unroll
    for (int e = 0; e < 2; e++) {
      const int q = t + 256 * e, sl = q & 63, c8 = (q >> 6) * 8;
      const u16* pr = proj + (size_t)(b * TT + nc * 256 + w * 64 + sl) * PC + h * 64;
      rk[e] = *(const uint4*)(pr + C_RTK + c8); rkp[e] = *(const uint4*)(pr + C_RTK + (c8 ^ 16));
      rv[e] = *(const uint4*)(pr + C_RTV + c8);
      if (PASS == 2) { rq[e] = *(const uint4*)(pr + C_RTQ + c8); rqp[e] = *(const uint4*)(pr + C_RTQ + (c8 ^ 16)); }
    }
  };
  auto up = [](uint4 v, float (&o)[8]) {
    const unsigned* u = (const unsigned*)&v;
#pragma unroll
    for (int i = 0; i < 4; i++) { o[2 * i] = __uint_as_float(u[i] << 16); o[2 * i + 1] = __uint_as_float(u[i] & 0xffff0000u); }
  };
  fetch(d == 0 ? 0 : 3);
  for (int wi = 0; wi < 4; wi++) {
    const int w = d == 0 ? wi : 3 - wi;
    __syncthreads();
    if (PASS == 2 && wi == 0) {
#pragma unroll
      for (int nt = 0; nt < 4; nt++)
        *(uint2*)(St + (nt * 16 + (lane & 15)) * RS + w4 * 16 + (lane >> 4) * 4) =
            make_uint2(pack2(accS[nt][0], accS[nt][1]), pack2(accS[nt][2], accS[nt][3]));
    }
#pragma unroll
    for (int e = 0; e < 2; e++) {
      const int q = t + 256 * e, sl = q & 63, c8 = (q >> 6) * 8;
      const int j = nc * 256 + w * 64 + sl;
      float kx[8], kp[8], vx[8], qx[8], qp[8];
      up(rk[e], kx); up(rkp[e], kp); up(rv[e], vx);
      if (PASS == 2) { up(rq[e], qx); up(rqp[e], qp); }
      if (j >= 256) {
        const int tl = j - 256;
        const int pos = (c8 & 32) ? (tl & 63) : (tl >> 6);
        const float* rp = rope + (pos * 16 + (c8 & 15)) * 2;
        const float sgn = (c8 & 16) ? 1.f : -1.f;
#pragma unroll
        for (int i2 = 0; i2 < 4; i2++) {
          const float4 cs = *(const float4*)(rp + i2 * 4);
          kx[2 * i2] = kx[2 * i2] * cs.x + sgn * kp[2 * i2] * cs.y;
          kx[2 * i2 + 1] = kx[2 * i2 + 1] * cs.z + sgn * kp[2 * i2 + 1] * cs.w;
          if (PASS == 2) {
            qx[2 * i2] = qx[2 * i2] * cs.x + sgn * qp[2 * i2] * cs.y;
            qx[2 * i2 + 1] = qx[2 * i2 + 1] * cs.z + sgn * qp[2 * i2 + 1] * cs.w;
          }
        }
      }
      const float dec = exp2f((float)(d == 0 ? 63 - sl : sl) * lg);
      u16 kb[8];
#pragma unroll
      for (int i = 0; i < 8; i++) {
        kb[i] = f2bf(kx[i] * 0.125f);
        Kt[(c8 + i) * RS + sl] = kb[i];
        Vd[(c8 + i) * RS + sl] = f2bf(vx[i] * dec);
      }
      if (PASS == 2) {
        uint4 kk4, qq4;
        kk4.x = kb[0] | ((unsigned)kb[1] << 16); kk4.y = kb[2] | ((unsigned)kb[3] << 16);
        kk4.z = kb[4] | ((unsigned)kb[5] << 16); kk4.w = kb[6] | ((unsigned)kb[7] << 16);
        qq4.x = pack2(qx[0], qx[1]); qq4.y = pack2(qx[2], qx[3]); qq4.z = pack2(qx[4], qx[5]); qq4.w = pack2(qx[6], qx[7]);
        *(uint4*)(Ks + sl * RS + c8) = kk4;
        *(uint4*)(Qs + sl * RS + c8) = qq4;
        const unsigned short* vraw = (const unsigned short*)&rv[e];
#pragma unroll
        for (int i = 0; i < 8; i++) Vt[(c8 + i) * RS + sl] = vraw[i];
      }
    }
    __syncthreads();
    if (wi + 1 < 4) fetch(d == 0 ? wi + 1 : 2 - wi);
    if (PASS == 2) {
      f32x4 accP[4];
#pragma unroll
      for (int nt = 0; nt < 4; nt++) accP[nt] = (f32x4){0.f, 0.f, 0.f, 0.f};
      bf16x8 aq[2];
#pragma unroll
      for (int kk = 0; kk < 2; kk++) aq[kk] = *(const bf16x8*)(Qs + (w4 * 16 + (lane & 15)) * RS + kk * 32 + (lane >> 4) * 8);
#pragma unroll
      for (int kk = 0; kk < 2; kk++)
#pragma unroll
        for (int nt = 0; nt < 4; nt++) {
          bf16x8 bk = *(const bf16x8*)(Ks + (nt * 16 + (lane & 15)) * RS + kk * 32 + (lane >> 4) * 8);
          accP[nt] = __builtin_amdgcn_mfma_f32_16x16x32_bf16(aq[kk], bk, accP[nt], 0, 0, 0);
        }
#pragma unroll
      for (int nt = 0; nt < 4; nt++)
#pragma unroll
        for (int r = 0; r < 4; r++) {
          const int il = w4 * 16 + (lane >> 4) * 4 + r, sl = nt * 16 + (lane & 15);
          const int e = d == 0 ? il - sl : sl - il;
          const float f = e >= 0 ? exp2f((float)e * lg) : 0.f;
          Ps[il * RS + sl] = f2bf(accP[nt][r] * f);
        }
      __syncthreads();
      f32x4 accO[4], accI[4];
#pragma unroll
      for (int nt = 0; nt < 4; nt++) { accO[nt] = (f32x4){0.f, 0.f, 0.f, 0.f}; accI[nt] = (f32x4){0.f, 0.f, 0.f, 0.f}; }
#pragma unroll
      for (int kk = 0; kk < 2; kk++) {
        bf16x8 ap = *(const bf16x8*)(Ps + (w4 * 16 + (lane & 15)) * RS + kk * 32 + (lane >> 4) * 8);
#pragma unroll
        for (int nt = 0; nt < 4; nt++) {
          bf16x8 bv = *(const bf16x8*)(Vt + (nt * 16 + (lane & 15)) * RS + kk * 32 + (lane >> 4) * 8);
          accO[nt] = __builtin_amdgcn_mfma_f32_16x16x32_bf16(ap, bv, accO[nt], 0, 0, 0);
          bf16x8 bs = *(const bf16x8*)(St + (nt * 16 + (lane & 15)) * RS + kk * 32 + (lane >> 4) * 8);
          accI[nt] = __builtin_amdgcn_mfma_f32_16x16x32_bf16(aq[kk], bs, accI[nt], 0, 0, 0);
        }
      }
      u16* ofp = (u16*)(p.ws + OFF_RETOF);
#pragma unroll
      for (int r = 0; r < 4; r++) {
        const int il = w4 * 16 + (lane >> 4) * 4 + r;
        const size_t row = (size_t)(b * TT + nc * 256 + w * 64 + il);
        const float rho = exp2f((float)(d == 0 ? il + 1 : 64 - il) * lg);
        float o[4], ss = 0.f;
#pragma unroll
        for (int nt = 0; nt < 4; nt++) {
          o[nt] = accO[nt][r] + rho * accI[nt][r];
          if (d == 1) o[nt] += bf2f(ofp[row * 256 + h * 64 + nt * 16 + (lane & 15)]);
          ss += o[nt] * o[nt];
        }
        if (d == 0) {
#pragma unroll
          for (int nt = 0; nt < 4; nt++) ofp[row * 256 + h * 64 + nt * 16 + (lane & 15)] = f2bf(o[nt]);
        } else {
          ss = allsum16(ss);
          const float sc = rsqrtf(ss * (1.f / 64.f) + 1e-6f);
#pragma unroll
          for (int nt = 0; nt < 4; nt++) {
            const int cv = h * 64 + nt * 16 + (lane & 15);
            const float z = bf2f(proj[row * PC + C_RTZ + cv]);
            proj[row * PC + C_RTQ + cv] = f2bf(o[nt] * sc * siluf_(z));
          }
        }
      }
    }
#pragma unroll
    for (int nt = 0; nt < 4; nt++)
#pragma unroll
      for (int r = 0; r < 4; r++) accS[nt][r] *= g64;
#pragma unroll
    for (int kk = 0; kk < 2; kk++) {
      bf16x8 ak = *(const bf16x8*)(Kt + (w4 * 16 + (lane & 15)) * RS + kk * 32 + (lane >> 4) * 8);
#pragma unroll
      for (int nt = 0; nt < 4; nt++) {
        bf16x8 bv = *(const bf16x8*)(Vd + (nt * 16 + (lane & 15)) * RS + kk * 32 + (lane >> 4) * 8);
        accS[nt] = __builtin_amdgcn_mfma_f32_16x16x32_bf16(ak, bv, accS[nt], 0, 0, 0);
      }
    }
    __syncthreads();
    if (PASS == 2 && wi + 1 < 4) {
#pragma unroll
      for (int nt = 0; nt < 4; nt++)
        *(uint2*)(St + (nt * 16 + (lane & 15)) * RS + w4 * 16 + (lane >> 4) * 4) =
            make_uint2(pack2(accS[nt][0], accS[nt][1]), pack2(accS[nt][2], accS[nt][3]));
    }
  }
  if (PASS == 1) {
#pragma unroll
    for (int nt = 0; nt < 4; nt++)
#pragma unroll
      for (int r = 0; r < 4; r++) stt[(w4 * 16 + (lane >> 4) * 4 + r) * 64 + nt * 16 + (lane & 15)] = accS[nt][r];
  }
}
__device__ void gla_p1_task(const Params& p, int layer, int task, float* lds) {
  int c = task % 9; int q = task / 9; int h = q & 3; q >>= 2; int b = q & 7; q >>= 3; int d = q & 1; int mx = q >> 1;
  if (mx == 0) gla_sweep<0, 1>(p, layer, d, b, h, c, lds);
  else { const int nc = d == 0 ? c : (c == 0 ? 0 : 9 - c); ret_sweep<1>(p, layer, d, b, h, nc, c, (u16*)lds); }
}
__device__ void gla_p2_task(const Params& p, int layer, int mx, int b, int h, int nc, float* lds) {
  int cb = nc == 0 ? 0 : 9 - nc;
  if (mx == 0) { gla_sweep<0, 2>(p, layer, 0, b, h, nc, lds); __threadfence_block(); gla_sweep<0, 2>(p, layer, 1, b, h, cb, lds); }
  else { ret_sweep<2>(p, layer, 0, b, h, nc, nc, (u16*)lds); __threadfence_block(); ret_sweep<2>(p, layer, 1, b, h, nc, cb, (u16*)lds); }
}
__device__ void gla_carry_task(const Params& p, int layer, int task) {
  int e = task * 256 + tid_();
  int v = e & 63, k = (e >> 6) & 63, dbh = (e >> 12) & 63, mx = e >> 18;
  float* stt = (float*)(p.ws + (mx == 0 ? OFF_HGST : OFF_RTST)) + (size_t)dbh * 9 * 4096 + k * 64 + v;
  const float* P = (const float*)(p.ws + OFF_HGP) + (size_t)dbh * 9 * 64 + k;
  float pg = 1.f;
  if (mx == 1) { int d = dbh >> 5, h = dbh & 3; pg = __expf(-256.f * __expf(p.in[20][((size_t)layer * 2 + d) * 4 + h])); }
  float S = 0.f;
  for (int c = 0; c < 9; c++) {
    float E = stt[(size_t)c * 4096];
    stt[(size_t)c * 4096] = S;
    float pp = mx == 0 ? P[c * 64] : pg;
    S = pp * S + E;
  }
}

__device__ __forceinline__ int s5_bwd_chunk(int nc) { return nc < 4 ? 3 - nc : 39 - nc; }
template <int PASS>
__device__ void s5_task(const Params& p, int layer, int task, float* lds) {
  const int t = tid_(), w = t >> 6, lane = t & 63;
  int gq = task & 3; int q = task >> 2; int nc = q % 36; int b = q / 36;
  const int g = gq * 4 + w;
  float* ubuf = lds + w * 256;
  u16* hbuf = (u16*)(lds + 1024) + w * (16 * 136);
  float* ybuf = lds + 1024 + 4352 + w * 1024;
  u16* proj = (u16*)(p.ws + OFF_PROJ);
  float2* st5 = (float2*)(p.ws + OFF_S5ST);
  bf16x8 cfrag[4];
  if (PASS == 2) {
    const float* cre = p.in[13] + ((size_t)layer * 16 + g) * 16 * 64;
    const float* cim = p.in[14] + ((size_t)layer * 16 + g) * 16 * 64;
    int pp = lane & 15;
#pragma unroll
    for (int ks = 0; ks < 4; ks++)
#pragma unroll
      for (int i = 0; i < 8; i++) {
        int kidx = ks * 32 + (lane >> 4) * 8 + i; int n = kidx >> 1;
        float val = (kidx & 1) ? -cim[pp * 64 + n] : cre[pp * 64 + n];
        cfrag[ks][i] = (short)f2bf(val);
      }
  }
  for (int d = 0; d < 2; d++) {
    float lre = p.in[8][(((size_t)layer * 2 + d) * 16 + g) * 64 + lane];
    float lim = p.in[9][(((size_t)layer * 2 + d) * 16 + g) * 64 + lane];
    float dt = __expf(p.in[10][((size_t)layer * 2 + d) * 16 + g]);
    float mag = __expf(lre * dt);
    float sn, cs; sincosf(lim * dt, &sn, &cs);
    float are = mag * cs, aim = mag * sn;
    float den = 1.f / (lre * lre + lim * lim);
    float cre_ = ((are - 1.f) * lre + aim * lim) * den;
    float cim_ = (aim * lre - (are - 1.f) * lim) * den;
    float bbr[16], bbi[16];
    {
      const float* br = p.in[11] + (((size_t)layer * 16 + g) * 64 + lane) * 16;
      const float* bi = p.in[12] + (((size_t)layer * 16 + g) * 64 + lane) * 16;
#pragma unroll
      for (int i = 0; i < 16; i++) {
        float x = br[i], y = bi[i];
        bbr[i] = cre_ * x - cim_ * y; bbi[i] = cre_ * y + cim_ * x;
      }
    }
    int cstep = d == 0 ? nc : s5_bwd_chunk(nc);
    size_t sidx = ((((size_t)d * 8 + b) * 16 + g) * 36 + cstep) * 64 + lane;
    float hre = 0.f, him = 0.f;
    if (PASS == 2) { float2 h0 = st5[sidx]; hre = h0.x; him = h0.y; }
    uint2 ru;
    auto fetchu = [&](int sub) {
      int st = lane >> 2, p4 = (lane & 3) * 4;
      int jl = d == 0 ? sub * 16 + st : 63 - (sub * 16 + st);
      ru = *(const uint2*)(proj + (size_t)(b * TT + nc * 64 + jl) * PC + C_S5U + g * 16 + p4);
    };
    fetchu(0);
    for (int sub = 0; sub < 4; sub++) {
      __syncthreads();
      {
        int st = lane >> 2, p4 = (lane & 3) * 4;
        *(float4*)(ubuf + st * 16 + p4) = make_float4(__uint_as_float(ru.x << 16), __uint_as_float(ru.x & 0xffff0000u),
                                                       __uint_as_float(ru.y << 16), __uint_as_float(ru.y & 0xffff0000u));
      }
      __syncthreads();
      if (sub + 1 < 4) fetchu(sub + 1);
#pragma unroll 2
      for (int st = 0; st < 16; st++) {
        float bur = 0.f, bui = 0.f;
#pragma unroll
        for (int i4 = 0; i4 < 4; i4++) {
          float4 uu = *(const float4*)(ubuf + st * 16 + i4 * 4);
          bur += bbr[i4*4] * uu.x + bbr[i4*4+1] * uu.y + bbr[i4*4+2] * uu.z + bbr[i4*4+3] * uu.w;
          bui += bbi[i4*4] * uu.x + bbi[i4*4+1] * uu.y + bbi[i4*4+2] * uu.z + bbi[i4*4+3] * uu.w;
        }
        float nre = are * hre - aim * him + bur;
        float nim = are * him + aim * hre + bui;
        hre = nre; him = nim;
        if (PASS == 2) *(unsigned*)(hbuf + st * 136 + lane * 2) = pack2(hre, him);
      }
      if (PASS == 2) {
        __syncthreads();
        f32x4 acc = (f32x4){0.f, 0.f, 0.f, 0.f};
#pragma unroll
        for (int ks = 0; ks < 4; ks++) {
          bf16x8 af = *(const bf16x8*)(hbuf + (lane & 15) * 136 + ks * 32 + (lane >> 4) * 8);
          acc = __builtin_amdgcn_mfma_f32_16x16x32_bf16(af, cfrag[ks], acc, 0, 0, 0);
        }
#pragma unroll
        for (int r = 0; r < 4; r++) {
          int st = (lane >> 4) * 4 + r;
          int jl = d == 0 ? sub * 16 + st : 63 - (sub * 16 + st);
          float* yp = ybuf + jl * 16 + (lane & 15);
          if (d == 0) *yp = acc[r]; else *yp += acc[r];
        }
      }
    }
    if (PASS == 1) st5[sidx] = make_float2(hre, him);
  }
  if (PASS == 2) {
    __syncthreads();
    const float* dsk = p.in[15] + layer * 256 + g * 16;
#pragma unroll
    for (int i = 0; i < 16; i++) {
      int idx = lane + 64 * i; int jl = idx >> 4, pp = idx & 15;
      u16* up = proj + (size_t)(b * TT + nc * 64 + jl) * PC + C_S5U + g * 16 + pp;
      float y = ybuf[jl * 16 + pp] + dsk[pp] * bf2f(*up);
      *up = f2bf(geluf_(y));
    }
  }
}
__device__ void s5_carry_task(const Params& p, int layer, int task) {
  int e = task * 256 + tid_();
  int n = e & 63, g = (e >> 6) & 15, d = e >> 13;
  float lre = p.in[8][(((size_t)layer * 2 + d) * 16 + g) * 64 + n];
  float lim = p.in[9][(((size_t)layer * 2 + d) * 16 + g) * 64 + n];
  float dt = __expf(p.in[10][((size_t)layer * 2 + d) * 16 + g]);
  float mag = __expf(lre * dt * 64.f);
  float sn, cs; sincosf(lim * dt * 64.f, &sn, &cs);
  float are = mag * cs, aim = mag * sn;
  float2* st5 = (float2*)(p.ws + OFF_S5ST) + (size_t)(e >> 6) * 36 * 64 + n;
  float sre = 0.f, sim = 0.f;
  for (int c = 0; c < 36; c++) {
    float2 E = st5[(size_t)c * 64];
    st5[(size_t)c * 64] = make_float2(sre, sim);
    float nre = are * sre - aim * sim + E.x;
    float nim = are * sim + aim * sre + E.y;
    sre = nre; sim = nim;
  }
}

__device__ __forceinline__ void group_barrier(unsigned* cnt, unsigned target) {
  asm volatile("s_waitcnt vmcnt(0)" ::: "memory");
  __syncthreads();
  if (tid_() == 0) {
    __threadfence();
    asm volatile("s_waitcnt vmcnt(0)" ::: "memory");
    __hip_atomic_fetch_add(cnt, 1u, __ATOMIC_RELAXED, __HIP_MEMORY_SCOPE_AGENT);
    while (__hip_atomic_load(cnt, __ATOMIC_RELAXED, __HIP_MEMORY_SCOPE_AGENT) < target) __builtin_amdgcn_s_sleep(2);
    __threadfence();
    asm volatile("s_waitcnt vmcnt(0)" ::: "memory");
  }
  __syncthreads();
}
#define XB_XCNT(j) (64 * (j))
#define XB_XSUB(j) (1024 + 64 * (j))
#define XB_XGEN(j) (2048 + 64 * (j))
#define XB_TOP     3072
#define XB_TOPGEN  3136
#define XB_WORDS   8192
struct XcdBar { unsigned* bar; unsigned x, nloc, nx; };
__device__ __forceinline__ unsigned xb_ld(unsigned* q) { return __hip_atomic_load(q, __ATOMIC_RELAXED, __HIP_MEMORY_SCOPE_AGENT); }
__device__ __forceinline__ unsigned xb_add(unsigned* q, unsigned v) { return __hip_atomic_fetch_add(q, v, __ATOMIC_RELAXED, __HIP_MEMORY_SCOPE_AGENT); }
__device__ __forceinline__ void xcd_barrier(const XcdBar& b) {
  asm volatile("s_waitcnt vmcnt(0)" ::: "memory");
  __syncthreads();
  if (tid_() == 0) {
    unsigned* bar = b.bar;
    __builtin_amdgcn_s_waitcnt(0);
    const unsigned old = xb_add(&bar[XB_XSUB(b.x)], 1u);
    const unsigned gen = old / b.nloc;
    if (old + 1u == (gen + 1u) * b.nloc) {
      __builtin_amdgcn_fence(__ATOMIC_RELEASE, "agent");
      asm volatile("s_waitcnt vmcnt(0)" ::: "memory");
      const unsigned og = xb_add(&bar[XB_TOP], 1u);
      const unsigned tg = og / b.nx;
      if (og + 1u == (tg + 1u) * b.nx) xb_add(&bar[XB_TOPGEN], 1u);
      else while (xb_ld(&bar[XB_TOPGEN]) == tg) __builtin_amdgcn_s_sleep(1);
      __builtin_amdgcn_fence(__ATOMIC_ACQUIRE, "agent");
      xb_add(&bar[XB_XGEN(b.x)], 1u);
      asm volatile("s_waitcnt vmcnt(0)" ::: "memory");
    } else {
      while (xb_ld(&bar[XB_XGEN(b.x)]) == gen) __builtin_amdgcn_s_sleep(1);
      __builtin_amdgcn_fence(__ATOMIC_ACQUIRE, "agent");
      asm volatile("s_waitcnt vmcnt(0)" ::: "memory");
    }
  }
  __syncthreads();
}
#define LDS_FLOATS 18432
#define SYNC() xcd_barrier(xbar)
#define RW_TWO false
#define NRW (RW_TWO ? 128 : 256)

__global__ void __launch_bounds__(256, 2) fwd_megakernel(Params p) {
  cg::grid_group grid = cg::this_grid();
  __shared__ __attribute__((aligned(16))) float lds[LDS_FLOATS];
  const int bid = blockIdx.x, nb = gridDim.x, t = tid_();
  XcdBar xbar; xbar.bar = (unsigned*)(p.ws + OFF_XB); xbar.x = 0; xbar.nloc = 1; xbar.nx = 1;

  for (int task = bid; task < N_CONVERT_TASKS + 96 + 1; task += nb) {
    if (task < 96) mods_task(p, task, lds);
    else if (task == 96) {
      if (t < 4) ((unsigned*)(p.ws + OFF_BAR))[t] = 0u;
      for (int i = t; i < XB_WORDS; i += 256) ((unsigned*)(p.ws + OFF_XB))[i] = 0u;
      float* rope = (float*)(p.ws + OFF_ROPE);
      for (int i = t; i < 1024; i += 256) {
        int pos = i >> 4, fi = i & 15;
        float fr = powf(10000.f, -(float)fi / 16.f);
        float ang = (float)pos * fr;
        rope[i * 2] = cosf(ang); rope[i * 2 + 1] = sinf(ang);
      }
    } else convert_task(p, 0, task - 97, lds);
  }
  grid.sync();
  {
    unsigned xr; asm volatile("s_getreg_b32 %0, hwreg(HW_REG_XCC_ID)" : "=s"(xr));
    xbar.x = xr & 15u;
    if (t == 0) xb_add(&xbar.bar[XB_XCNT(xbar.x)], 1u + ((nb == 512 && bid >= NRW) ? 65536u : 0u));
  }
  for (int task = bid; task < MROWS / 4; task += nb) ln_row(p, 0, 0, task * 4 + (t >> 6));
  XcdBar pbar; pbar.bar = xbar.bar + 4096; pbar.x = xbar.x; pbar.nloc = 1; pbar.nx = 1;
  if (t == 0) {
    unsigned nx, npx, nlocp;
    for (;;) {
      unsigned sum = 0; nx = 0; npx = 0; nlocp = 0;
#pragma unroll
      for (int j = 0; j < 16; j++) {
        const unsigned w = xb_ld(&xbar.bar[XB_XCNT(j)]);
        const unsigned c = w & 65535u, cp = w >> 16;
        sum += c; nx += c > 0u ? 1u : 0u; npx += cp > 0u ? 1u : 0u;
        if ((unsigned)j == xbar.x) { xbar.nloc = c; nlocp = cp; }
      }
      if (sum == (unsigned)nb) break;
      __builtin_amdgcn_s_sleep(4);
    }
    xbar.nx = nx; pbar.nx = npx > 0u ? npx : 1u; pbar.nloc = nlocp > 0u ? nlocp : 1u;
  }
  SYNC();

  for (int layer = 0; layer < 2; layer++) {
    const int latonly = layer;
    if ((nb & 7) == 0) { int tm, tn; for (int it = 0; xcd_tile(it, bid, nb, 144, 31, 6, tm, tn); it++) inproj_tile(p, layer, tm, tn, (u16*)lds); }
    else for (int task = bid; task < 144 * 31; task += nb) inproj_tile(p, layer, task / 31, task % 31, (u16*)lds);
    SYNC();
    {
      const int ncg = latonly ? 8 : 9, ncs = latonly ? 32 : 36;
      const int NG = 64 * ncg, NS = 32 * ncs;
      auto p2_task = [&](int task) {
        if (task < NG) {
          int nc = task % ncg + (latonly ? 1 : 0); int q = task / ncg; int h = q & 3; q >>= 2; int b = q & 7; int mx = q >> 3;
          gla_p2_task(p, layer, mx, b, h, nc, lds);
        } else {
          int q = task - NG; int gq = q & 3; q >>= 2; int nc = q % ncs + (latonly ? 4 : 0); int b = q / ncs;
          s5_task<2>(p, layer, ((b * 36 + nc) << 2) | gq, lds);
        }
      };
      if (nb == 512) {
        unsigned* bar = (unsigned*)(p.ws + OFF_BAR);
        const int ng = nb - NRW;
        if (bid < NRW) {
          rwkv_scan_task<RW_TWO>(p, layer, bid, lds);
          if (t == 0) {
            while (xb_ld(&pbar.bar[XB_TOPGEN]) < 2u * layer + 2u) __builtin_amdgcn_s_sleep(8);
            __threadfence();
          }
          __syncthreads();
        } else {
          const int gb = bid - NRW;
          for (int task = gb; task < 2304; task += ng) {
            if (task < 1152) gla_p1_task(p, layer, task, lds); else s5_task<1>(p, layer, task - 1152, lds);
          }
          xcd_barrier(pbar);
          for (int task = gb; task < 2048 + 64; task += ng) {
            if (task < 2048) gla_carry_task(p, layer, task); else s5_carry_task(p, layer, task - 2048);
          }
          xcd_barrier(pbar);
        }
        int* shq = (int*)(lds + LDS_FLOATS - 4);
        for (;;) {
          __syncthreads();
          if (t == 0) *shq = (int)__hip_atomic_fetch_add(bar + 1 + layer, 1u, __ATOMIC_RELAXED, __HIP_MEMORY_SCOPE_AGENT);
          __syncthreads();
          const int task = *shq;
          if (task >= NG + NS) break;
          p2_task(task);
        }
        SYNC();
      } else {
        for (int task = bid; task < NRW + 2304; task += nb) {
          if (task < NRW) rwkv_scan_task<RW_TWO>(p, layer, task, lds);
          else if (task < NRW + 1152) gla_p1_task(p, layer, task - NRW, lds);
          else s5_task<1>(p, layer, task - NRW - 1152, lds);
        }
        SYNC();
        for (int task = bid; task < 2048 + 64; task += nb) {
          if (task < 2048) gla_carry_task(p, layer, task); else s5_carry_task(p, layer, task - 2048);
        }
        SYNC();
        for (int task = bid; task < NG + NS; task += nb) p2_task(task);
        SYNC();
      }
    }
    {
      const int ntm = latonly ? 128 : 144;
      for (int task = bid; task < ntm * 2 + MROWS / 8; task += nb) {
        if (task < ntm * 2) glu_tile(p, layer, latonly, task >> 1, task & 1, (u16*)lds);
        else rwkv_combine_rows(p, layer, (task - ntm * 2) * 8, latonly);
      }
    }
    SYNC();
    {
      const int ntm = latonly ? 128 : 144;
      if ((nb & 7) == 0) { int tm, tn; for (int it = 0; xcd_tile(it, bid, nb, ntm, 16, 8, tm, tn); it++) merge_tile(p, layer, latonly, tm, tn, (u16*)lds); }
      else for (int task = bid; task < ntm * 16; task += nb) merge_tile(p, layer, latonly, task >> 4, task & 15, (u16*)lds);
    }
    SYNC();
    {
      const int ntm = latonly ? 128 : 144;
      if ((nb & 7) == 0) { int tm, tn; for (int it = 0; xcd_tile(it, bid, nb, ntm, 8, 8, tm, tn); it++) outproj_tile(p, layer, latonly, tm, tn, (u16*)lds); }
      else for (int task = bid; task < ntm * 8; task += nb) outproj_tile(p, layer, latonly, task >> 3, task & 7, (u16*)lds);
    }
    SYNC();
    if (layer == 0) {
      for (int task = bid; task < MROWS / 4 + N_CONVERT_TASKS; task += nb) {
        if (task < N_CONVERT_TASKS) convert_task(p, 1, task, lds);
        else ln_row(p, 1, 0, (task - N_CONVERT_TASKS) * 4 + (t >> 6));
      }
      SYNC();
    } else {
      for (int task = bid; task < NBATCH * 2048 / 4; task += nb) {
        int r = task * 4 + (t >> 6); int b = r >> 11, tl = r & 2047;
        ln_row(p, 1, 1, b * TT + 256 + tl);
      }
    }
  }
}

extern "C" void kernel_launch(void* const* d_in, const int* in_sizes, int n_in,
                              void* d_out, int out_size, void* d_ws, size_t ws_size,
                              hipStream_t stream) {
  static int grid_blocks = 0;
  if (!grid_blocks) {
    int dev = 0, cus = 0, per_cu = 0;
    (void)hipGetDevice(&dev);
    (void)hipDeviceGetAttribute(&cus, hipDeviceAttributeMultiprocessorCount, dev);
    (void)hipOccupancyMaxActiveBlocksPerMultiprocessor(&per_cu, fwd_megakernel, 256, 0);
    if (per_cu > 2) per_cu = 2;
    if (per_cu < 1) per_cu = 1;
    grid_blocks = cus * per_cu;
  }
  if (ws_size < WS_NEED) { fprintf(stderr, "workspace too small\n"); return; }
  Params p{};
  for (int i = 0; i < 36; i++) p.in[i] = (const float*)d_in[i];
  p.out = (float*)d_out;
  p.ws = (char*)d_ws;
  void* args[] = {&p};
  hipError_t e = hipLaunchCooperativeKernel((void*)fwd_megakernel, dim3(grid_blocks), dim3(256), args, 0, stream);
  if (e != hipSuccess) fprintf(stderr, "cooperative launch failed: %s (grid %d)\n", hipGetErrorString(e), grid_blocks);
}
```

```cpp
#include <hip/hip_runtime.h>
#include <hip/hip_bf16.h>
#include <hip/hip_cooperative_groups.h>
#include <cstdio>
namespace cg = cooperative_groups;

typedef __attribute__((ext_vector_type(8))) short bf16x8;
typedef __attribute__((ext_vector_type(4))) float f32x4;
typedef unsigned short u16;

#define D_ 1024
#define NBATCH 8
#define TT 2304
#define MROWS 18432
#define PC 3904
#define DIN 8000
#define C_S5U 0
#define C_S5Z 256
#define C_HGQ 512
#define C_HGF 768
#define C_HGI 1280
#define C_HGZ 1536
#define C_RTQ 1792
#define C_RTK 2048
#define C_RTV 2304
#define C_RTZ 2560
#define C_RWX 2816
#define C_RWZ 3648

#define OFF_WINT   0ul
#define OFF_WBT    (OFF_WINT + 16384000ul)
#define OFF_WOT    (OFF_WBT + 2097152ul)
#define OFF_GLUT   (OFF_WOT + 2097152ul)
#define OFF_U      (OFF_GLUT + 131072ul)
#define OFF_PROJ   (OFF_U + 37748736ul)
#define OFF_HCTX   (OFF_PROJ + 143917056ul)
#define OFF_SCR    (OFF_HCTX + 8388608ul)
#define OFF_RWO    (OFF_SCR)
#define OFF_HGST   (OFF_SCR + 18874368ul)
#define OFF_RTST   (OFF_HGST + 9437184ul)
#define OFF_RETOF  (OFF_SCR + 37748736ul)
#define OFF_S5ST   (OFF_RETOF + 9437184ul)
#define OFF_MODS   (OFF_S5ST + 4718592ul)
#define OFF_HGP    (OFF_MODS + 221184ul)
#define OFF_BONUS  (OFF_HGP + 147456ul)
#define OFF_ROPE   (OFF_BONUS + 589824ul)
#define OFF_BAR    (OFF_ROPE + 8192ul)
#define OFF_XB     (OFF_BAR + 256ul)
#define WS_NEED    (OFF_XB + 32768ul)

struct Params {
  const float* in[36];
  float* out;
  char* ws;
};

__device__ __forceinline__ int tid_() { int t = __builtin_amdgcn_workitem_id_x(); asm volatile("" : "+v"(t)); return t; }
__device__ __forceinline__ u16 f2bf(float f) {
  unsigned u = __float_as_uint(f);
  u += 0x7fffu + ((u >> 16) & 1u);
  return (u16)(u >> 16);
}
__device__ __forceinline__ float bf2f(u16 h) { return __uint_as_float(((unsigned)h) << 16); }
__device__ __forceinline__ unsigned pack2(float a, float b) { return (unsigned)f2bf(a) | ((unsigned)f2bf(b) << 16); }
__device__ __forceinline__ float sigmoidf_(float x) { return __builtin_amdgcn_rcpf(1.f + __expf(-x)); }
__device__ __forceinline__ float siluf_(float x) { return x * __builtin_amdgcn_rcpf(1.f + __expf(-x)); }
__device__ __forceinline__ float geluf_(float x) {
  float t = tanhf(0.7978845608028654f * (x + 0.044715f * x * x * x));
  return 0.5f * x * (1.f + t);
}
template <int CTRL>
__device__ __forceinline__ float dppf(float x) {
  return __int_as_float(__builtin_amdgcn_update_dpp(0, __float_as_int(x), CTRL, 0xf, 0xf, true));
}
__device__ __forceinline__ float allsum16(float x) {
  x += dppf<0x128>(x);
  x += dppf<0x124>(x);
  x += dppf<0x122>(x);
  x += dppf<0x121>(x);
  return x;
}
__device__ __forceinline__ float wavesum(float x) {
  x = allsum16(x);
  x += __shfl_xor(x, 16, 64);
  x += __shfl_xor(x, 32, 64);
  return x;
}
__device__ __forceinline__ void ld4bf(const u16* p, float (&o)[4]) {
  uint2 v = *(const uint2*)p;
  o[0] = __uint_as_float(v.x << 16); o[1] = __uint_as_float(v.x & 0xffff0000u);
  o[2] = __uint_as_float(v.y << 16); o[3] = __uint_as_float(v.y & 0xffff0000u);
}
__device__ __forceinline__ void st4bf(u16* p, float a, float b, float c, float d) {
  uint2 v; v.x = pack2(a, b); v.y = pack2(c, d);
  *(uint2*)p = v;
}
__device__ __forceinline__ int jmap(int d, int s) { return d == 0 ? s : (s < 256 ? 255 - s : 2559 - s); }
__device__ __forceinline__ bool has_prev(int j) { return j != 0 && j != 256; }
__device__ __forceinline__ bool has_next(int j) { return j != 255 && j != 2303; }

__device__ __forceinline__ const float* hin_ptr(const Params& p, int layer, int row) {
  int b = row / TT, j = row - b * TT;
  if (layer == 0) return j < 256 ? p.in[2] + ((size_t)(b * 256 + j)) * D_ : p.in[0] + ((size_t)(b * 2048 + j - 256)) * D_;
  return j < 256 ? (const float*)(p.ws + OFF_HCTX) + ((size_t)(b * 256 + j)) * D_ : p.out + ((size_t)(b * 2048 + j - 256)) * D_;
}
__device__ __forceinline__ float* hout_ptr(const Params& p, int row) {
  int b = row / TT, j = row - b * TT;
  return j < 256 ? (float*)(p.ws + OFF_HCTX) + ((size_t)(b * 256 + j)) * D_ : p.out + ((size_t)(b * 2048 + j - 256)) * D_;
}
__device__ __forceinline__ int modrow_of(int row) { int b = row / TT, j = row - b * TT; return j < 256 ? 8 : b; }

__device__ void transpose_tile(const float* __restrict__ src, u16* __restrict__ dst, int K, int N, int k0, int n0, float* lds) {
  const int t = tid_();
  __syncthreads();
#pragma unroll
  for (int i = 0; i < 16; i++) {
    int r = i * 4 + (t >> 6), c = t & 63;
    lds[r * 65 + c] = src[(size_t)(k0 + r) * N + n0 + c];
  }
  __syncthreads();
#pragma unroll
  for (int i = 0; i < 16; i++) {
    int r = i * 4 + (t >> 6), c = t & 63;
    dst[(size_t)(n0 + r) * K + k0 + c] = f2bf(lds[c * 65 + r]);
  }
}
__device__ void convert_task(const Params& p, int layer, int task, float* lds) {
  if (task < 2000) {
    int kt = task / 125, nt = task % 125;
    transpose_tile(p.in[6] + (size_t)layer * 1024 * DIN, (u16*)(p.ws + OFF_WINT), 1024, DIN, kt * 64, nt * 64, lds);
  } else if (task < 2256) {
    int q = task - 2000; int br = q >> 6; q &= 63; int kt = q >> 4, nt = q & 15;
    transpose_tile(p.in[31] + ((size_t)layer * 4 + br) * 256 * 1024, (u16*)(p.ws + OFF_WBT) + (size_t)br * 1024 * 256, 256, 1024, kt * 64, nt * 64, lds);
  } else if (task < 2512) {
    int q = task - 2256; int kt = q >> 4, nt = q & 15;
    transpose_tile(p.in[32] + (size_t)layer * 1024 * 1024, (u16*)(p.ws + OFF_WOT), 1024, 1024, kt * 64, nt * 64, lds);
  } else {
    int q = task - 2512; int kt = q >> 2, nt = q & 3;
    transpose_tile(p.in[16] + (size_t)layer * 256 * 256, (u16*)(p.ws + OFF_GLUT), 256, 256, kt * 64, nt * 64, lds);
  }
}
#define N_CONVERT_TASKS 2528

__device__ void mods_task(const Params& p, int task, float* lds) {
  const int t = tid_();
  int layer = task / 48, cgp = task % 48;
  float* sc = lds;
  float* red = lds + 9 * 1024;
  __syncthreads();
  for (int i = t; i < 9 * 1024; i += 256) {
    int r = i >> 10, k = i & 1023;
    float v = r < 8 ? p.in[1][r * 1024 + k] : p.in[3][k];
    sc[i] = siluf_(v);
  }
  __syncthreads();
  int col = cgp * 64 + (t & 63), kq = t >> 6;
  float acc[9];
#pragma unroll
  for (int r = 0; r < 9; r++) acc[r] = 0.f;
  const float* wp = p.in[4] + (size_t)layer * 1024 * 3072 + col;
#pragma unroll 16
  for (int k = kq * 256; k < kq * 256 + 256; k++) {
    float w = wp[(size_t)k * 3072];
#pragma unroll
    for (int r = 0; r < 9; r++) acc[r] += sc[r * 1024 + k] * w;
  }
#pragma unroll
  for (int r = 0; r < 9; r++) red[(kq * 9 + r) * 64 + (t & 63)] = acc[r];
  __syncthreads();
  float* mods = (float*)(p.ws + OFF_MODS);
  for (int i = t; i < 9 * 64; i += 256) {
    int r = i >> 6, c = i & 63;
    float s = red[(0 * 9 + r) * 64 + c] + red[(1 * 9 + r) * 64 + c] + red[(2 * 9 + r) * 64 + c] + red[(3 * 9 + r) * 64 + c];
    int cc = cgp * 64 + c;
    mods[((size_t)layer * 9 + r) * 3072 + cc] = s + p.in[5][layer * 3072 + cc];
  }
}

__device__ void ln_row(const Params& p, int mode, int layer, int row) {
  const int lane = tid_() & 63;
  float v[16];
  if (mode == 0) {
    const float* src = hin_ptr(p, 0, row);
#pragma unroll
    for (int i = 0; i < 4; i++) { float4 q = *(const float4*)(src + i * 256 + lane * 4); v[i*4]=q.x; v[i*4+1]=q.y; v[i*4+2]=q.z; v[i*4+3]=q.w; }
  } else {
    float* src = hout_ptr(p, row);
#pragma unroll
    for (int i = 0; i < 4; i++) { float4 q = *(const float4*)(src + i * 256 + lane * 4); v[i*4]=q.x; v[i*4+1]=q.y; v[i*4+2]=q.z; v[i*4+3]=q.w; }
    float s = 0.f;
#pragma unroll
    for (int i = 0; i < 16; i++) s += v[i];
    float mean = wavesum(s) * (1.f / 1024.f);
    float q2 = 0.f;
#pragma unroll
    for (int i = 0; i < 16; i++) { v[i] -= mean; q2 += v[i] * v[i]; }
    float rstd = rsqrtf(wavesum(q2) * (1.f / 1024.f) + 1e-5f);
    const float* lw = p.in[34] + layer * 1024; const float* lb = p.in[35] + layer * 1024;
#pragma unroll
    for (int i = 0; i < 4; i++) {
      float4 w4 = *(const float4*)(lw + i * 256 + lane * 4), b4 = *(const float4*)(lb + i * 256 + lane * 4);
      v[i*4] = v[i*4] * rstd * w4.x + b4.x; v[i*4+1] = v[i*4+1] * rstd * w4.y + b4.y;
      v[i*4+2] = v[i*4+2] * rstd * w4.z + b4.z; v[i*4+3] = v[i*4+3] * rstd * w4.w + b4.w;
      *(float4*)(src + i * 256 + lane * 4) = make_float4(v[i*4], v[i*4+1], v[i*4+2], v[i*4+3]);
    }
    if (layer == 1) return;
  }
  int ml = mode == 0 ? 0 : 1;
  float s = 0.f;
#pragma unroll
  for (int i = 0; i < 16; i++) s += v[i];
  float mean = wavesum(s) * (1.f / 1024.f);
  float q2 = 0.f;
#pragma unroll
  for (int i = 0; i < 16; i++) { v[i] -= mean; q2 += v[i] * v[i]; }
  float rstd = rsqrtf(wavesum(q2) * (1.f / 1024.f) + 1e-5f);
  const float* md = (const float*)(p.ws + OFF_MODS) + ((size_t)ml * 9 + modrow_of(row)) * 3072;
  u16* up = (u16*)(p.ws + OFF_U) + (size_t)row * 1024;
#pragma unroll
  for (int i = 0; i < 4; i++) {
    float4 sh = *(const float4*)(md + i * 256 + lane * 4), sc = *(const float4*)(md + 1024 + i * 256 + lane * 4);
    st4bf(up + i * 256 + lane * 4, v[i*4] * rstd * (1.f + sc.x) + sh.x, v[i*4+1] * rstd * (1.f + sc.y) + sh.y,
          v[i*4+2] * rstd * (1.f + sc.z) + sh.z, v[i*4+3] * rstd * (1.f + sc.w) + sh.w);
  }
}

#define STAGE_LOAD(P, kk_) do { const unsigned k_ = (kk_); \
  P##a0 = *(const uint4*)(A + (oa + k_)); P##a1 = *(const uint4*)(A + (oa + sa + k_)); \
  P##a2 = *(const uint4*)(A + (oa + 2 * sa + k_)); P##a3 = *(const uint4*)(A + (oa + 3 * sa + k_)); \
  P##b0 = *(const uint4*)(B + (ob + k_)); P##b1 = *(const uint4*)(B + (ob + sb + k_)); \
  if (NT == 4) { P##b2 = *(const uint4*)(B + (ob + 2 * sb + k_)); P##b3 = *(const uint4*)(B + (ob + 3 * sb + k_)); } } while (0)
#define STAGE_WRITE(P, Asw, Bsw) do { \
  *(uint4*)(Asw) = P##a0; *(uint4*)((Asw) + 32 * 72) = P##a1; *(uint4*)((Asw) + 64 * 72) = P##a2; *(uint4*)((Asw) + 96 * 72) = P##a3; \
  *(uint4*)(Bsw) = P##b0; *(uint4*)((Bsw) + 32 * 72) = P##b1; \
  if (NT == 4) { *(uint4*)((Bsw) + 64 * 72) = P##b2; *(uint4*)((Bsw) + 96 * 72) = P##b3; } } while (0)
template <int MT, int NT>
__device__ __forceinline__ void stage_compute(f32x4 (&acc)[MT][NT], const u16* As, const u16* Bs, int lane, int wm, int wn) {
#pragma unroll
  for (int kk = 0; kk < 2; kk++) {
    bf16x8 af[MT], bfr[NT];
#pragma unroll
    for (int mt = 0; mt < MT; mt++) af[mt] = *(const bf16x8*)(As + (wm * MT * 16 + mt * 16 + (lane & 15)) * 72 + kk * 32 + (lane >> 4) * 8);
#pragma unroll
    for (int nt = 0; nt < NT; nt++) bfr[nt] = *(const bf16x8*)(Bs + (wn * NT * 16 + nt * 16 + (lane & 15)) * 72 + kk * 32 + (lane >> 4) * 8);
    __builtin_amdgcn_s_setprio(1);
#pragma unroll
    for (int mt = 0; mt < MT; mt++)
#pragma unroll
      for (int nt = 0; nt < NT; nt++)
        acc[mt][nt] = __builtin_amdgcn_mfma_f32_16x16x32_bf16(af[mt], bfr[nt], acc[mt][nt], 0, 0, 0);
    __builtin_amdgcn_s_setprio(0);
  }
}
template <int MT, int NT>
__device__ __forceinline__ void gemm_kloop(f32x4 (&acc)[MT][NT], const u16* __restrict__ A, int lda,
                                           const u16* __restrict__ B, int ldb, int K, u16* lds) {
  static_assert(MT == 4, "MT");
  constexpr int BM = MT * 32, BN = NT * 32, SS = (BM + BN) * 72;
  const int t = tid_(), lane = t & 63, w = t >> 6, wm = w >> 1, wn = w & 1;
  u16* As0 = lds; u16* Bs0 = lds + BM * 72; u16* As1 = lds + SS; u16* Bs1 = lds + SS + BM * 72;
  const int lr = t >> 3, lc = (t & 7) * 8;
  const unsigned oa = (unsigned)(lr * lda + lc), ob = (unsigned)(lr * ldb + lc);
  const unsigned sa = 32u * (unsigned)lda, sb = 32u * (unsigned)ldb;
  const int swo = lr * 72 + lc;
  const unsigned klast = (unsigned)(K - 64);
  uint4 R0a0, R0a1, R0a2, R0a3, R0b0, R0b1, R0b2, R0b3, R1a0, R1a1, R1a2, R1a3, R1b0, R1b1, R1b2, R1b3;
  STAGE_LOAD(R0, 0u);
  STAGE_LOAD(R1, 64u);
  __syncthreads();
  STAGE_WRITE(R0, As0 + swo, Bs0 + swo);
  STAGE_LOAD(R0, 128u < klast ? 128u : klast);
  __syncthreads();
#pragma unroll 1
  for (int k0 = 0; k0 < K; k0 += 128) {
    STAGE_WRITE(R1, As1 + swo, Bs1 + swo);
    { unsigned kn = (unsigned)k0 + 192u; STAGE_LOAD(R1, kn < klast ? kn : klast); }
    stage_compute<MT, NT>(acc, As0, Bs0, lane, wm, wn);
    __syncthreads();
    STAGE_WRITE(R0, As0 + swo, Bs0 + swo);
    { unsigned kn = (unsigned)k0 + 256u; STAGE_LOAD(R0, kn < klast ? kn : klast); }
    stage_compute<MT, NT>(acc, As1, Bs1, lane, wm, wn);
    __syncthreads();
  }
}
template <int MT, int NT>
__device__ __forceinline__ void zero_acc(f32x4 (&acc)[MT][NT]) {
#pragma unroll
  for (int i = 0; i < MT; i++)
#pragma unroll
    for (int j = 0; j < NT; j++) acc[i][j] = (f32x4){0.f, 0.f, 0.f, 0.f};
}
__device__ __forceinline__ int tile_m0(int latonly, int tm) {
  if (!latonly) return tm * 128;
  int b = tm >> 4; return b * TT + 256 + (tm & 15) * 128;
}

__device__ __forceinline__ bool xcd_tile(int it, int bid, int nb, int NTM, int NTN, int G, int& tm, int& tn) {
  const int xcd = bid & 7, lb = bid >> 3, nlb = nb >> 3, tmx = NTM >> 3;
  const int idx = it * nlb + lb;
  if (idx >= tmx * NTN) return false;
  const int full = tmx / G;
  int g = idx / (G * NTN);
  if (g > full) g = full;
  const int r = idx - g * G * NTN;
  const int gs = (g < full) ? G : (tmx - full * G);
  tn = r / gs;
  tm = xcd * tmx + g * G + (r - tn * gs);
  return true;
}
__device__ void inproj_tile(const Params& p, int layer, int tm, int tn, u16* lds) {
  int m0 = tm * 128, n0 = tn * 128;
  f32x4 acc[4][4]; zero_acc(acc);
  gemm_kloop<4, 4>(acc, (const u16*)(p.ws + OFF_U) + (size_t)m0 * 1024, 1024,
                   (const u16*)(p.ws + OFF_WINT) + (size_t)n0 * 1024, 1024, 1024, lds);
  const int t = tid_(), lane = t & 63, w = t >> 6, wm = w >> 1, wn = w & 1;
  const float* bias = p.in[7] + (size_t)layer * DIN;
  u16* proj = (u16*)(p.ws + OFF_PROJ);
#pragma unroll
  for (int nt = 0; nt < 4; nt++) {
    const int cl = wn * 64 + nt * 16 + (lane & 15);
    const float bv = (n0 + cl < PC) ? bias[n0 + cl] : 0.f;
#pragma unroll
    for (int mt = 0; mt < 4; mt++)
#pragma unroll
      for (int r = 0; r < 4; r++) lds[(wm * 64 + mt * 16 + (lane >> 4) * 4 + r) * 136 + cl] = f2bf(acc[mt][nt][r] + bv);
  }
  __syncthreads();
#pragma unroll
  for (int i = 0; i < 8; i++) {
    const int q = t + 256 * i, row = q >> 4, ch = q & 15;
    if (n0 + ch * 8 < PC) *(uint4*)(proj + (size_t)(m0 + row) * PC + n0 + ch * 8) = *(const uint4*)(lds + row * 136 + ch * 8);
  }
}
__device__ void glu_tile(const Params& p, int layer, int latonly, int tm, int tn, u16* lds) {
  int m0 = tile_m0(latonly, tm), n0 = tn * 128;
  f32x4 acc[4][4]; zero_acc(acc);
  u16* proj = (u16*)(p.ws + OFF_PROJ);
  gemm_kloop<4, 4>(acc, proj + (size_t)m0 * PC + C_S5U, PC, (const u16*)(p.ws + OFF_GLUT) + (size_t)n0 * 256, 256, 256, lds);
  const int t = tid_(), lane = t & 63, w = t >> 6, wm = w >> 1, wn = w & 1;
  const float* bias = p.in[17] + layer * 256;
#pragma unroll
  for (int nt = 0; nt < 4; nt++) {
    const int cl = wn * 64 + nt * 16 + (lane & 15);
    const float bv = bias[n0 + cl];
#pragma unroll
    for (int mt = 0; mt < 4; mt++)
#pragma unroll
      for (int r = 0; r < 4; r++) lds[(wm * 64 + mt * 16 + (lane >> 4) * 4 + r) * 136 + cl] = f2bf(sigmoidf_(acc[mt][nt][r] + bv));
  }
  __syncthreads();
#pragma unroll
  for (int i = 0; i < 8; i++) {
    const int q = t + 256 * i, row = q >> 4, ch = q & 15;
    u16* pr = proj + (size_t)(m0 + row) * PC + n0 + ch * 8;
    uint4 sg = *(const uint4*)(lds + row * 136 + ch * 8);
    uint4 yy = *(const uint4*)(pr + C_S5U), zz = *(const uint4*)(pr + C_S5Z), oo;
    const unsigned* sgp = (const unsigned*)&sg; const unsigned* yp = (const unsigned*)&yy; const unsigned* zp = (const unsigned*)&zz; unsigned* op = (unsigned*)&oo;
#pragma unroll
    for (int e = 0; e < 4; e++) {
      float s0 = __uint_as_float(sgp[e] << 16), s1 = __uint_as_float(sgp[e] & 0xffff0000u);
      float y0 = __uint_as_float(yp[e] << 16), y1 = __uint_as_float(yp[e] & 0xffff0000u);
      float z0 = __uint_as_float(zp[e] << 16), z1 = __uint_as_float(zp[e] & 0xffff0000u);
      op[e] = pack2(y0 * s0 * siluf_(z0), y1 * s1 * siluf_(z1));
    }
    *(uint4*)(pr + C_S5Z) = oo;
  }
}
__device__ void merge_tile(const Params& p, int layer, int latonly, int tm, int tn, u16* lds) {
  int m0 = tile_m0(latonly, tm), n0 = tn * 64;
  f32x4 accm[4][2]; zero_acc(accm);
  const u16* proj = (const u16*)(p.ws + OFF_PROJ);
  const int lane = tid_() & 63, w = tid_() >> 6, wm = w >> 1, wn = w & 1;
  const float* bias = p.in[7] + (size_t)layer * DIN + PC;
#pragma unroll 1
  for (int k = 0; k < 4; k++) {
    const int ycol = k == 0 ? C_S5Z : (k == 1 ? C_HGQ : (k == 2 ? C_RTQ : C_RWZ));
    f32x4 accb[4][2]; zero_acc(accb);
    gemm_kloop<4, 2>(accb, proj + (size_t)m0 * PC + ycol, PC,
                     (const u16*)(p.ws + OFF_WBT) + ((size_t)k * 1024 + n0) * 256, 256, 256, lds);
    f32x4 accg[4][2]; zero_acc(accg);
    gemm_kloop<4, 2>(accg, (const u16*)(p.ws + OFF_U) + (size_t)m0 * 1024, 1024,
                     (const u16*)(p.ws + OFF_WINT) + ((size_t)PC + k * 1024 + n0) * 1024, 1024, 1024, lds);
#pragma unroll
    for (int nt = 0; nt < 2; nt++) {
      float bv = bias[k * 1024 + n0 + wn * 32 + nt * 16 + (lane & 15)];
#pragma unroll
      for (int mt = 0; mt < 4; mt++)
#pragma unroll
        for (int r = 0; r < 4; r++) accm[mt][nt][r] += sigmoidf_(accg[mt][nt][r] + bv) * accb[mt][nt][r];
    }
  }
  u16* mg = (u16*)(p.ws + OFF_SCR);
#pragma unroll
  for (int nt = 0; nt < 2; nt++) {
    const int cl = wn * 32 + nt * 16 + (lane & 15);
#pragma unroll
    for (int mt = 0; mt < 4; mt++)
#pragma unroll
      for (int r = 0; r < 4; r++) lds[(wm * 64 + mt * 16 + (lane >> 4) * 4 + r) * 72 + cl] = f2bf(accm[mt][nt][r]);
  }
  __syncthreads();
  {
    const int t = tid_();
#pragma unroll
    for (int i = 0; i < 4; i++) {
      const int q = t + 256 * i, row = q >> 3, ch = q & 7;
      *(uint4*)(mg + (size_t)(m0 + row) * 1024 + n0 + ch * 8) = *(const uint4*)(lds + row * 72 + ch * 8);
    }
  }
}
__device__ void outproj_tile(const Params& p, int layer, int latonly, int tm, int tn, u16* lds) {
  int m0 = tile_m0(latonly, tm), n0 = tn * 128;
  f32x4 acc[4][4]; zero_acc(acc);
  gemm_kloop<4, 4>(acc, (const u16*)(p.ws + OFF_SCR) + (size_t)m0 * 1024, 1024,
                   (const u16*)(p.ws + OFF_WOT) + (size_t)n0 * 1024, 1024, 1024, lds);
  const int lane = tid_() & 63, w = tid_() >> 6, wm = w >> 1, wn = w & 1;
  const float* bias = p.in[33] + layer * 1024;
  const float* hi0 = hin_ptr(p, layer, m0);
  float* ho0 = hout_ptr(p, m0);
  const float* gate = (const float*)(p.ws + OFF_MODS) + ((size_t)layer * 9 + modrow_of(m0)) * 3072 + 2048;
  float* cs = (float*)lds;
#pragma unroll
  for (int nt = 0; nt < 4; nt++) {
    const int cl = wn * 64 + nt * 16 + (lane & 15);
    const float bv = bias[n0 + cl];
#pragma unroll
    for (int mt = 0; mt < 4; mt++)
#pragma unroll
      for (int r = 0; r < 4; r++) cs[(wm * 64 + mt * 16 + (lane >> 4) * 4 + r) * 132 + cl] = acc[mt][nt][r] + bv;
  }
  __syncthreads();
  {
    const int t = tid_();
#pragma unroll 4
    for (int i = 0; i < 16; i++) {
      const int q = t + 256 * i, row = q >> 5, ch = q & 31;
      const float4 a4 = *(const float4*)(cs + row * 132 + ch * 4);
      const float4 g4 = *(const float4*)(gate + n0 + ch * 4);
      const float4 h4 = *(const float4*)(hi0 + (size_t)row * 1024 + n0 + ch * 4);
      float4 o4;
      o4.x = 1.4142135623730951f * h4.x + g4.x * a4.x; o4.y = 1.4142135623730951f * h4.y + g4.y * a4.y;
      o4.z = 1.4142135623730951f * h4.z + g4.z * a4.z; o4.w = 1.4142135623730951f * h4.w + g4.w * a4.w;
      *(float4*)(ho0 + (size_t)row * 1024 + n0 + ch * 4) = o4;
    }
  }
}

template <bool TWO>
__device__ void rwkv_scan_task(const Params& p, int layer, int task, float* lds) {
  const int t = tid_();
  const int rh = TWO ? (task & 1) : (task & 3), h = TWO ? ((task >> 1) & 3) : ((task >> 2) & 3);
  const int b = TWO ? ((task >> 3) & 7) : ((task >> 4) & 7), d = TWO ? (task >> 6) : (task >> 7);
  constexpr int RPB = TWO ? 32 : 16;
  float* sh_lora = lds;
  float* sh_w2 = sh_lora + 512;
  float* sh_a2 = sh_w2 + 1024;
  float* sh_r = sh_a2 + 1024;
  float* sh_w = sh_r + 1024;
  float* sh_k = sh_w + 1024;
  float* sh_kk = sh_k + 1024;
  float* sh_b = sh_kk + 1024;
  float* sh_v = sh_b + 1024;
  float* sh_o = sh_v + 512;
  const u16* proj = (const u16*)(p.ws + OFF_PROJ);
  u16* rwo = (u16*)(p.ws + OFF_RWO) + (size_t)d * MROWS * 256;
  float* bonus = (float*)(p.ws + OFF_BONUS) + (size_t)d * MROWS * 4;
  const float* mu0 = p.in[21] + (size_t)layer * 2 * 832;
  const float* mu1 = mu0 + 832;
  __syncthreads();
  for (int i = t; i < 1024; i += 256) {
    int rr = i >> 6, c = i & 63;
    sh_w2[i] = p.in[23][(((size_t)layer * 2 + d) * 16 + rr) * 256 + h * 64 + c];
    sh_a2[i] = p.in[25][(((size_t)layer * 2 + d) * 16 + rr) * 256 + h * 64 + c];
  }
  const int pst = t >> 4, cq = t & 15;
  const int ch0 = h * 64 + cq * 4;
  float mur0[4], mur1[4], muk0[4], muk1[4], w0v[4], a0v[4], kkw[4], kaw[4], rkw[4];
#pragma unroll
  for (int i = 0; i < 4; i++) {
    mur0[i] = mu0[ch0 + i]; mur1[i] = mu1[ch0 + i];
    muk0[i] = mu0[256 + ch0 + i]; muk1[i] = mu1[256 + ch0 + i];
    w0v[i] = p.in[22][((size_t)layer * 2 + d) * 256 + ch0 + i];
    a0v[i] = p.in[24][((size_t)layer * 2 + d) * 256 + ch0 + i];
    kkw[i] = p.in[26][layer * 256 + ch0 + i];
    kaw[i] = p.in[27][layer * 256 + ch0 + i];
    rkw[i] = p.in[28][layer * 256 + ch0 + i];
  }
  const int vch = 512 + h * 64 + rh * RPB + cq;
  const float muv0 = mu0[vch], muv1 = mu1[vch], muw0 = TWO ? mu0[vch + 16] : 0.f, muw1 = TWO ? mu1[vch + 16] : 0.f;
  const int lidx0 = t * 2;
  float lmu00, lmu01, lmu10, lmu11;
  {
    int q = lidx0 & 31;
    int col = q < 16 ? (768 + d * 16 + q) : (800 + d * 16 + (q - 16));
    lmu00 = mu0[col]; lmu01 = mu0[col + 1]; lmu10 = mu1[col]; lmu11 = mu1[col + 1];
  }
  const int rl = t >> 4, ks = t & 15;
  float4 S = make_float4(0.f, 0.f, 0.f, 0.f), S2 = make_float4(0.f, 0.f, 0.f, 0.f);
  unsigned lx0 = 0, lx1 = 0, lxp0 = 0, lxp1 = 0, lxn0 = 0, lxn1 = 0;
  uint2 rr_c, rr_p, rr_n, rk_c, rk_p, rk_n;
  unsigned rv_c, rv_p, rv_n, rw_c = 0, rw_p = 0, rw_n = 0;
  auto fetch = [&](int s0) {
    {
      int st2 = lidx0 >> 5, q = lidx0 & 31;
      int j = jmap(d, s0 + st2);
      int col = q < 16 ? (768 + d * 16 + q) : (800 + d * 16 + (q - 16));
      const u16* pr = proj + ((size_t)(b * TT + j)) * PC + C_RWX + col;
      const u16* prp = has_prev(j) ? pr - PC : pr;
      const u16* prn = has_next(j) ? pr + PC : pr;
      lx0 = pr[0]; lx1 = pr[1]; lxp0 = prp[0]; lxp1 = prp[1]; lxn0 = prn[0]; lxn1 = prn[1];
    }
    int j = jmap(d, s0 + pst);
    const u16* pr = proj + ((size_t)(b * TT + j)) * PC + C_RWX;
    const u16* prp = has_prev(j) ? pr - PC : pr;
    const u16* prn = has_next(j) ? pr + PC : pr;
    rr_c = *(const uint2*)(pr + ch0); rr_p = *(const uint2*)(prp + ch0); rr_n = *(const uint2*)(prn + ch0);
    rk_c = *(const uint2*)(pr + 256 + ch0); rk_p = *(const uint2*)(prp + 256 + ch0); rk_n = *(const uint2*)(prn + 256 + ch0);
    rv_c = pr[vch]; rv_p = prp[vch]; rv_n = prn[vch];
    if (TWO) { rw_c = pr[vch + 16]; rw_p = prp[vch + 16]; rw_n = prn[vch + 16]; }
  };
  auto unpack4 = [](uint2 v, float (&o)[4]) {
    o[0] = __uint_as_float(v.x << 16); o[1] = __uint_as_float(v.x & 0xffff0000u);
    o[2] = __uint_as_float(v.y << 16); o[3] = __uint_as_float(v.y & 0xffff0000u);
  };
  fetch(0);
  for (int s0 = 0; s0 < TT; s0 += 16) {
    {
      int st2 = lidx0 >> 5, q = lidx0 & 31;
      int ja = jmap(d, s0 + st2);
      const float hpa = has_prev(ja) ? 1.f : 0.f, hna = has_next(ja) ? 1.f : 0.f;
      float x0 = __uint_as_float(lx0 << 16), x1 = __uint_as_float(lx1 << 16);
      float xs0 = x0 + lmu00 * (__uint_as_float(lxp0 << 16) * hpa - x0) + lmu10 * (__uint_as_float(lxn0 << 16) * hna - x0);
      float xs1 = x1 + lmu01 * (__uint_as_float(lxp1 << 16) * hpa - x1) + lmu11 * (__uint_as_float(lxn1 << 16) * hna - x1);
      if (q < 16) {
        xs0 = 1.f - 2.f * __builtin_amdgcn_rcpf(__expf(2.f * xs0) + 1.f);
        xs1 = 1.f - 2.f * __builtin_amdgcn_rcpf(__expf(2.f * xs1) + 1.f);
      }
      *(float2*)(sh_lora + lidx0) = make_float2(xs0, xs1);
    }
    __syncthreads();
    const int jcur = jmap(d, s0 + pst);
    {
      const float hpf = has_prev(jcur) ? 1.f : 0.f, hnf = has_next(jcur) ? 1.f : 0.f;
      float r4[4], k4[4], t0[4], t1[4];
      unpack4(rr_c, r4); unpack4(rr_p, t0); unpack4(rr_n, t1);
#pragma unroll
      for (int i = 0; i < 4; i++) r4[i] = r4[i] + mur0[i] * (t0[i] * hpf - r4[i]) + mur1[i] * (t1[i] * hnf - r4[i]);
      unpack4(rk_c, k4); unpack4(rk_p, t0); unpack4(rk_n, t1);
#pragma unroll
      for (int i = 0; i < 4; i++) k4[i] = k4[i] + muk0[i] * (t0[i] * hpf - k4[i]) + muk1[i] * (t1[i] * hnf - k4[i]);
      float wl[4], al[4];
#pragma unroll
      for (int i = 0; i < 4; i++) { wl[i] = w0v[i]; al[i] = a0v[i]; }
      float lrow[32];
#pragma unroll
      for (int i4 = 0; i4 < 8; i4++) {
        float4 q4 = *(const float4*)(sh_lora + pst * 32 + i4 * 4);
        lrow[i4 * 4] = q4.x; lrow[i4 * 4 + 1] = q4.y; lrow[i4 * 4 + 2] = q4.z; lrow[i4 * 4 + 3] = q4.w;
      }
#pragma unroll
      for (int rr = 0; rr < 16; rr++) {
        float lw_ = lrow[rr], la_ = lrow[16 + rr];
        float4 w2 = *(const float4*)(sh_w2 + rr * 64 + cq * 4);
        float4 a2 = *(const float4*)(sh_a2 + rr * 64 + cq * 4);
        wl[0] += lw_ * w2.x; wl[1] += lw_ * w2.y; wl[2] += lw_ * w2.z; wl[3] += lw_ * w2.w;
        al[0] += la_ * a2.x; al[1] += la_ * a2.y; al[2] += la_ * a2.z; al[3] += la_ * a2.w;
      }
      float wv[4], kd[4], kk[4], bb[4];
      float ss = 0.f, bon = 0.f;
#pragma unroll
      for (int i = 0; i < 4; i++) {
        float a = wl[i];
        float lw = fminf(a, 0.f) - __logf(1.f + __expf(-fabsf(a))) - 0.5f;
        wv[i] = __expf(-__expf(lw));
        float ic = sigmoidf_(al[i]);
        float kr = k4[i] * kkw[i];
        kk[i] = kr; ss += kr * kr;
        kd[i] = k4[i] * (1.f + (ic - 1.f) * kaw[i]);
        bb[i] = ic;
        bon += r4[i] * kd[i] * rkw[i];
      }
      ss = allsum16(ss); bon = allsum16(bon);
      float inv = rsqrtf(fmaxf(ss, 1e-24f));
#pragma unroll
      for (int i = 0; i < 4; i++) { kk[i] *= inv; bb[i] *= kk[i]; }
      *(float4*)(sh_r + pst * 64 + cq * 4) = make_float4(r4[0], r4[1], r4[2], r4[3]);
      *(float4*)(sh_w + pst * 64 + cq * 4) = make_float4(wv[0], wv[1], wv[2], wv[3]);
      *(float4*)(sh_k + pst * 64 + cq * 4) = make_float4(kd[0], kd[1], kd[2], kd[3]);
      *(float4*)(sh_kk + pst * 64 + cq * 4) = make_float4(kk[0], kk[1], kk[2], kk[3]);
      *(float4*)(sh_b + pst * 64 + cq * 4) = make_float4(bb[0], bb[1], bb[2], bb[3]);
      if (rh == 0 && cq == 0) bonus[(size_t)(b * TT + jcur) * 4 + h] = bon;
      float xv = __uint_as_float(rv_c << 16);
      sh_v[pst * 32 + cq] = xv + muv0 * (__uint_as_float(rv_p << 16) * hpf - xv) + muv1 * (__uint_as_float(rv_n << 16) * hnf - xv);
      float xw = __uint_as_float(rw_c << 16);
      if (TWO) sh_v[pst * 32 + 16 + cq] = xw + muw0 * (__uint_as_float(rw_p << 16) * hpf - xw) + muw1 * (__uint_as_float(rw_n << 16) * hnf - xw);
    }
    __syncthreads();
    if (s0 + 16 < TT) fetch(s0 + 16);
    float oacc = 0.f, oacc2 = 0.f;
    {
      float4 nkk = *(const float4*)(sh_kk + ks * 4), nw = *(const float4*)(sh_w + ks * 4), nb4 = *(const float4*)(sh_b + ks * 4);
      float4 nk = *(const float4*)(sh_k + ks * 4), nr = *(const float4*)(sh_r + ks * 4);
      float nv = sh_v[rl], nv2 = sh_v[16 + rl];
#pragma unroll 4
      for (int st = 0; st < 16; st++) {
        const float4 kk4 = nkk, w4 = nw, b4 = nb4, k4 = nk, r4 = nr; const float vv = nv, vv2 = nv2;
        {
          const int sn = (st + 1) & 15;
          nkk = *(const float4*)(sh_kk + sn * 64 + ks * 4); nw = *(const float4*)(sh_w + sn * 64 + ks * 4);
          nb4 = *(const float4*)(sh_b + sn * 64 + ks * 4); nk = *(const float4*)(sh_k + sn * 64 + ks * 4);
          nr = *(const float4*)(sh_r + sn * 64 + ks * 4); nv = sh_v[sn * 32 + rl]; nv2 = sh_v[sn * 32 + 16 + rl];
        }
        float sa = -((S.x * kk4.x + S.y * kk4.y) + (S.z * kk4.z + S.w * kk4.w));
        float sa2 = 0.f;
        if (TWO) sa2 = -((S2.x * kk4.x + S2.y * kk4.y) + (S2.z * kk4.z + S2.w * kk4.w));
        sa = allsum16(sa); if (TWO) sa2 = allsum16(sa2);
        S.x = S.x * w4.x + (sa * b4.x + vv * k4.x);
        S.y = S.y * w4.y + (sa * b4.y + vv * k4.y);
        S.z = S.z * w4.z + (sa * b4.z + vv * k4.z);
        S.w = S.w * w4.w + (sa * b4.w + vv * k4.w);
        if (TWO) {
          S2.x = S2.x * w4.x + (sa2 * b4.x + vv2 * k4.x);
          S2.y = S2.y * w4.y + (sa2 * b4.y + vv2 * k4.y);
          S2.z = S2.z * w4.z + (sa2 * b4.z + vv2 * k4.z);
          S2.w = S2.w * w4.w + (sa2 * b4.w + vv2 * k4.w);
        }
        float o = (S.x * r4.x + S.y * r4.y) + (S.z * r4.z + S.w * r4.w);
        float o2 = 0.f;
        if (TWO) o2 = (S2.x * r4.x + S2.y * r4.y) + (S2.z * r4.z + S2.w * r4.w);
        o = allsum16(o); if (TWO) o2 = allsum16(o2);
        oacc = (ks == st) ? o : oacc;
        oacc2 = (ks == st) ? o2 : oacc2;
      }
    }
    sh_o[ks * 32 + rl] = oacc;
    if (TWO) sh_o[ks * 32 + 16 + rl] = oacc2;
    __syncthreads();
    {
      u16* op = rwo + (size_t)(b * TT + jcur) * 256 + h * 64 + rh * RPB + cq;
      op[0] = f2bf(sh_o[pst * 32 + cq]);
      if (TWO) op[16] = f2bf(sh_o[pst * 32 + 16 + cq]);
    }
  }
}

__device__ void rwkv_combine_rows(const Params& p, int layer, int row0, int latonly) {
  const int lane = tid_() & 63, h = tid_() >> 6;
  const int ch = h * 64 + lane;
  const u16* rwo = (const u16*)(p.ws + OFF_RWO);
  u16* proj = (u16*)(p.ws + OFF_PROJ);
  const float* mu0 = p.in[21] + (size_t)layer * 2 * 832; const float* mu1 = mu0 + 832;
  const float* bonus = (const float*)(p.ws + OFF_BONUS);
  const float gw = p.in[29][layer * 256 + ch], gb = p.in[30][layer * 256 + ch];
  const float m0 = mu0[512 + ch], m1 = mu1[512 + ch];
  const int vc = C_RWX + 512 + ch;
  float o[8], xv[8], xp[8], xn[8], bs[8], z[8];
#pragma unroll
  for (int i = 0; i < 8; i++) {
    const int row = row0 + i;
    const int j = row % TT;
    const u16* pr = proj + (size_t)row * PC;
    o[i] = bf2f(rwo[(size_t)row * 256 + ch]) + bf2f(rwo[(size_t)MROWS * 256 + (size_t)row * 256 + ch]);
    xv[i] = bf2f(pr[vc]);
    xp[i] = has_prev(j) ? bf2f(pr[vc - PC]) : 0.f;
    xn[i] = has_next(j) ? bf2f(pr[vc + PC]) : 0.f;
    bs[i] = bonus[(size_t)row * 4 + h] + bonus[(size_t)MROWS * 4 + (size_t)row * 4 + h];
    z[i] = bf2f(pr[C_RWZ + ch]);
  }
#pragma unroll
  for (int i = 0; i < 8; i++) {
    const int row = row0 + i;
    if (latonly && (row % TT) < 256) continue;
    float mean = wavesum(o[i]) * (1.f / 64.f);
    float dlt = o[i] - mean;
    float var = wavesum(dlt * dlt) * (1.f / 64.f);
    float on = dlt * rsqrtf(var + 64e-5f) * gw + gb;
    float v = xv[i] + m0 * (xp[i] - xv[i]) + m1 * (xn[i] - xv[i]);
    proj[(size_t)row * PC + C_RWZ + ch] = f2bf((on + bs[i] * v) * siluf_(z[i]));
  }
}

template <int MX, int PASS>
__device__ __forceinline__ void gla_sweep(const Params& p, int layer, int d, int b, int h, int c, float* lds) {
  const int t = tid_(), w = t >> 6, lane = t & 63;
  float* kbuf = lds;
  float* fbuf = kbuf + 1024;
  float* qbuf = fbuf + 1024;
  float* vbuf = qbuf + 1024;
  float* part = vbuf + 1024;
  u16* proj = (u16*)(p.ws + OFF_PROJ);
  const int dbh = (d * 8 + b) * 4 + h;
  float* stt = (float*)(p.ws + (MX == 0 ? OFF_HGST : OFF_RTST)) + ((size_t)dbh * 9 + c) * 4096;
  float S[16];
#pragma unroll
  for (int i = 0; i < 16; i++) S[i] = PASS == 1 ? 0.f : stt[(w * 16 + i) * 64 + lane];
  float gam = 1.f;
  if (MX == 1) gam = __expf(-__expf(p.in[20][((size_t)layer * 2 + d) * 4 + h]));
  float Pl = 1.f;
  const int pst = t >> 4, c4 = (t & 15) * 4;
  float lb4[4] = {0.f, 0.f, 0.f, 0.f};
  if (MX == 0 && layer == 1) {
#pragma unroll
    for (int i = 0; i < 4; i++) {
      float l0 = p.in[18][(0 * 2 + d) * 256 + h * 64 + c4 + i], l1 = p.in[18][(1 * 2 + d) * 256 + h * 64 + c4 + i];
      float mx = fmaxf(l0, l1);
      float e0 = __expf(l0 - mx), e1 = __expf(l1 - mx);
      lb4[i] = e1 / (e0 + e1);
    }
  }
  const int vcol0 = (MX == 0 ? C_HGI : C_RTV) + h * 64;
  const float* rope = (const float*)(p.ws + OFF_ROPE);
  uint2 r_a, r_b, r_c, r_d, r_v; float4 r_cs0, r_cs1;
  r_a = r_b = r_c = r_d = r_v = make_uint2(0u, 0u); r_cs0 = r_cs1 = make_float4(1.f, 0.f, 1.f, 0.f);
  auto fetch = [&](int s0) {
    int j = jmap(d, s0 + pst);
    const u16* pr = proj + (size_t)(b * TT + j) * PC;
    r_v = *(const uint2*)(pr + vcol0 + c4);
    if (MX == 0) {
      r_a = *(const uint2*)(pr + C_HGF + d * 256 + h * 64 + c4);
      if (PASS == 2) r_b = *(const uint2*)(pr + C_HGQ + h * 64 + c4);
    } else {
      r_a = *(const uint2*)(pr + C_RTK + h * 64 + c4);
      r_c = *(const uint2*)(pr + C_RTK + h * 64 + (c4 ^ 16));
      if (PASS == 2) { r_b = *(const uint2*)(pr + C_RTQ + h * 64 + c4); r_d = *(const uint2*)(pr + C_RTQ + h * 64 + (c4 ^ 16)); }
      if (j >= 256) {
        int tl = j - 256;
        int pos = (c4 & 32) ? (tl & 63) : (tl >> 6);
        const float* rp = rope + (pos * 16 + (c4 & 15)) * 2;
        r_cs0 = *(const float4*)rp; r_cs1 = *(const float4*)(rp + 4);
      } else { r_cs0 = make_float4(1.f, 0.f, 1.f, 0.f); r_cs1 = r_cs0; }
    }
  };
  auto unpack4 = [](uint2 v, float (&o)[4]) {
    o[0] = __uint_as_float(v.x << 16); o[1] = __uint_as_float(v.x & 0xffff0000u);
    o[2] = __uint_as_float(v.y << 16); o[3] = __uint_as_float(v.y & 0xffff0000u);
  };
  u16* ofp; int ofs;
  if (MX == 0) { ofp = proj + C_HGF + h * 64 + lane; ofs = PC; }
  else { ofp = (u16*)(p.ws + OFF_RETOF) + h * 64 + lane; ofs = 256; }
  const int zcol = (MX == 0 ? C_HGZ : C_RTZ) + h * 64 + lane;
  const int ycol = (MX == 0 ? C_HGQ : C_RTQ) + h * 64 + lane;
  float normw = 1.f;
  if (MX == 0 && PASS == 2) normw = p.in[19][layer * 256 + h * 64 + lane];
  fetch(c * 256);
  for (int sub = 0; sub < 16; sub++) {
    const int s0 = c * 256 + sub * 16;
    __syncthreads();
    {
      float va[4], vb[4], vc[4], vd[4], vv4[4];
      unpack4(r_a, va); unpack4(r_v, vv4);
      *(float4*)(vbuf + pst * 64 + c4) = make_float4(vv4[0], vv4[1], vv4[2], vv4[3]);
      if (MX == 0) {
        float f[4], k[4];
#pragma unroll
        for (int i = 0; i < 4; i++) { f[i] = lb4[i] + (1.f - lb4[i]) * sigmoidf_(va[i]); k[i] = 1.f - f[i]; }
        *(float4*)(kbuf + pst * 64 + c4) = make_float4(k[0], k[1], k[2], k[3]);
        *(float4*)(fbuf + pst * 64 + c4) = make_float4(f[0], f[1], f[2], f[3]);
        if (PASS == 2) {
          unpack4(r_b, vb);
          *(float4*)(qbuf + pst * 64 + c4) = make_float4(siluf_(vb[0]), siluf_(vb[1]), siluf_(vb[2]), siluf_(vb[3]));
        }
      } else {
        unpack4(r_c, vc);
        float cs[8] = {r_cs0.x, r_cs0.y, r_cs0.z, r_cs0.w, r_cs1.x, r_cs1.y, r_cs1.z, r_cs1.w};
        float sgn = (c4 & 16) ? 1.f : -1.f;
#pragma unroll
        for (int i = 0; i < 4; i++) va[i] = (va[i] * cs[2 * i] + sgn * vc[i] * cs[2 * i + 1]) * 0.125f;
        *(float4*)(kbuf + pst * 64 + c4) = make_float4(va[0], va[1], va[2], va[3]);
        if (PASS == 2) {
          unpack4(r_b, vb); unpack4(r_d, vd);
#pragma unroll
          for (int i = 0; i < 4; i++) vb[i] = vb[i] * cs[2 * i] + sgn * vd[i] * cs[2 * i + 1];
          *(float4*)(qbuf + pst * 64 + c4) = make_float4(vb[0], vb[1], vb[2], vb[3]);
        }
      }
    }
    __syncthreads();
    if (sub + 1 < 16) fetch(s0 + 16);
    u16 pf_o[4], pf_z[4];
    if (PASS == 2 && d == 1) {
#pragma unroll
      for (int e = 0; e < 4; e++) {
        size_t row = (size_t)(b * TT + jmap(d, s0 + w * 4 + e));
        pf_o[e] = ofp[row * ofs]; pf_z[e] = proj[row * PC + zcol];
      }
    }
#pragma unroll 2
    for (int st = 0; st < 16; st++) {
      const float vv = vbuf[st * 64 + lane];
      float o = 0.f;
#pragma unroll
      for (int i4 = 0; i4 < 4; i4++) {
        float4 kv = *(const float4*)(kbuf + st * 64 + w * 16 + i4 * 4);
        float4 fv = make_float4(gam, gam, gam, gam);
        if (MX == 0) fv = *(const float4*)(fbuf + st * 64 + w * 16 + i4 * 4);
        S[i4*4]   = fv.x * S[i4*4]   + kv.x * vv;
        S[i4*4+1] = fv.y * S[i4*4+1] + kv.y * vv;
        S[i4*4+2] = fv.z * S[i4*4+2] + kv.z * vv;
        S[i4*4+3] = fv.w * S[i4*4+3] + kv.w * vv;
        if (PASS == 2) {
          float4 qv = *(const float4*)(qbuf + st * 64 + w * 16 + i4 * 4);
          o += S[i4*4] * qv.x + S[i4*4+1] * qv.y + S[i4*4+2] * qv.z + S[i4*4+3] * qv.w;
        }
      }
      if (MX == 0 && PASS == 1) { if (lane < 16) Pl *= fbuf[st * 64 + w * 16 + lane]; }
      if (PASS == 2) part[(w * 16 + st) * 64 + lane] = o;
    }
    if (PASS == 2) {
      __syncthreads();
#pragma unroll
      for (int e = 0; e < 4; e++) {
        int st = w * 4 + e;
        float o = part[(0 * 16 + st) * 64 + lane] + part[(1 * 16 + st) * 64 + lane] + part[(2 * 16 + st) * 64 + lane] + part[(3 * 16 + st) * 64 + lane];
        int j = jmap(d, s0 + st);
        size_t row = (size_t)(b * TT + j);
        if (d == 0) {
          ofp[row * ofs] = f2bf(o);
        } else {
          o += bf2f(pf_o[e]);
          float ss = wavesum(o * o);
          float y = o * rsqrtf(ss * (1.f / 64.f) + 1e-6f) * normw;
          proj[row * PC + ycol] = f2bf(y * siluf_(bf2f(pf_z[e])));
        }
      }
    }
  }
  if (PASS == 1) {
#pragma unroll
    for (int i = 0; i < 16; i++) stt[(w * 16 + i) * 64 + lane] = S[i];
    if (MX == 0 && lane < 16) ((float*)(p.ws + OFF_HGP))[((size_t)dbh * 9 + c) * 64 + w * 16 + lane] = Pl;
  }
}

#define RS 72
template <int PASS>
__device__ __forceinline__ void ret_sweep(const Params& p, int layer, int d, int b, int h, int nc, int cstep, u16* lds) {
  const int t = tid_(), lane = t & 63, w4 = t >> 6;
  u16* Qs = lds;
  u16* Ks = Qs + 64 * RS;
  u16* Kt = Ks + 64 * RS;
  u16* Vt = Kt + 64 * RS;
  u16* Vd = Vt + 64 * RS;
  u16* Ps = Vd + 64 * RS;
  u16* St = Ps + 64 * RS;
  u16* proj = (u16*)(p.ws + OFF_PROJ);
  const float* rope = (const float*)(p.ws + OFF_ROPE);
  const float lg = -__expf(p.in[20][((size_t)layer * 2 + d) * 4 + h]) * 1.4426950408889634f;
  const float g64 = exp2f(64.f * lg);
  const int dbh = (d * 8 + b) * 4 + h;
  float* stt = (float*)(p.ws + OFF_RTST) + ((size_t)dbh * 9 + cstep) * 4096;
  f32x4 accS[4];
#pragma unroll
  for (int nt = 0; nt < 4; nt++)
#pragma unroll
    for (int r = 0; r < 4; r++)
      accS[nt][r] = PASS == 1 ? 0.f : stt[(w4 * 16 + (lane >> 4) * 4 + r) * 64 + nt * 16 + (lane & 15)];
  uint4 rq[2], rqp[2], rk[2], rkp[2], rv[2];
  auto fetch = [&](int w) {
#pragma unroll
    for (int e = 0; e < 2; e++) {
      const int q = t + 256 * e, sl = q & 63, c8 = (q >> 6) * 8;
      const u16* pr = proj + (size_t)(b * TT + nc * 256 + w * 64 + sl) * PC + h * 64;
      rk[e] = *(const uint4*)(pr + C_RTK + c8); rkp[e] = *(const uint4*)(pr + C_RTK + (c8 ^ 16));
      rv[e] = *(const uint4*)(pr + C_RTV + c8);
      if (PASS == 2) { rq[e] = *(const uint4*)(pr + C_RTQ + c8); rqp[e] = *(const uint4*)(pr + C_RTQ + (c8 ^ 16)); }
    }
  };
  auto up = [](uint4 v, float (&o)[8]) {
    const unsigned* u = (const unsigned*)&v;
#pragma unroll
    for (int i = 0; i < 4; i++) { o[2 * i] = __uint_as_float(u[i] << 16); o[2 * i + 1] = __uint_as_float(u[i] & 0xffff0000u); }
  };
  fetch(d == 0 ? 0 : 3);
  for (int wi = 0; wi < 4; wi++) {
    const int w = d == 0 ? wi : 3 - wi;
    __syncthreads();
    if (PASS == 2 && wi == 0) {
#pragma unroll
      for (int nt = 0; nt < 4; nt++)
        *(uint2*)(St + (nt * 16 + (lane & 15)) * RS + w4 * 16 + (lane >> 4) * 4) =
            make_uint2(pack2(accS[nt][0], accS[nt][1]), pack2(accS[nt][2], accS[nt][3]));
    }
#pragma unroll
    for (int e = 0; e < 2; e++) {
      const int q = t + 256 * e, sl = q & 63, c8 = (q >> 6) * 8;
      const int j = nc * 256 + w * 64 + sl;
      float kx[8], kp[8], vx[8], qx[8], qp[8];
      up(rk[e], kx); up(rkp[e], kp); up(rv[e], vx);
      if (PASS == 2) { up(rq[e], qx); up(rqp[e], qp); }
      if (j >= 256) {
        const int tl = j - 256;
        const int pos = (c8 & 32) ? (tl & 63) : (tl >> 6);
        const float* rp = rope + (pos * 16 + (c8 & 15)) * 2;
        const float sgn = (c8 & 16) ? 1.f : -1.f;
#pragma unroll
        for (int i2 = 0; i2 < 4; i2++) {
          const float4 cs = *(const float4*)(rp + i2 * 4);
          kx[2 * i2] = kx[2 * i2] * cs.x + sgn * kp[2 * i2] * cs.y;
          kx[2 * i2 + 1] = kx[2 * i2 + 1] * cs.z + sgn * kp[2 * i2 + 1] * cs.w;
          if (PASS == 2) {
            qx[2 * i2] = qx[2 * i2] * cs.x + sgn * qp[2 * i2] * cs.y;
            qx[2 * i2 + 1] = qx[2 * i2 + 1] * cs.z + sgn * qp[2 * i2 + 1] * cs.w;
          }
        }
      }
      const float dec = exp2f((float)(d == 0 ? 63 - sl : sl) * lg);
      u16 kb[8];
#pragma unroll
      for (int i = 0; i < 8; i++) {
        kb[i] = f2bf(kx[i] * 0.125f);
        Kt[(c8 + i) * RS + sl] = kb[i];
        Vd[(c8 + i) * RS + sl] = f2bf(vx[i] * dec);
      }
      if (PASS == 2) {
        uint4 kk4, qq4;
        kk4.x = kb[0] | ((unsigned)kb[1] << 16); kk4.y = kb[2] | ((unsigned)kb[3] << 16);
        kk4.z = kb[4] | ((unsigned)kb[5] << 16); kk4.w = kb[6] | ((unsigned)kb[7] << 16);
        qq4.x = pack2(qx[0], qx[1]); qq4.y = pack2(qx[2], qx[3]); qq4.z = pack2(qx[4], qx[5]); qq4.w = pack2(qx[6], qx[7]);
        *(uint4*)(Ks + sl * RS + c8) = kk4;
        *(uint4*)(Qs + sl * RS + c8) = qq4;
        const unsigned short* vraw = (const unsigned short*)&rv[e];
#pragma unroll
        for (int i = 0; i < 8; i++) Vt[(c8 + i) * RS + sl] = vraw[i];
      }
    }
    __syncthreads();
    if (wi + 1 < 4) fetch(d == 0 ? wi + 1 : 2 - wi);
    if (PASS == 2) {
      f32x4 accP[4];
#pragma unroll
      for (int nt = 0; nt < 4; nt++) accP[nt] = (f32x4){0.f, 0.f, 0.f, 0.f};
      bf16x8 aq[2];
#pragma unroll
      for (int kk = 0; kk < 2; kk++) aq[kk] = *(const bf16x8*)(Qs + (w4 * 16 + (lane & 15)) * RS + kk * 32 + (lane >> 4) * 8);
#pragma unroll
      for (int kk = 0; kk < 2; kk++)
#pragma unroll
        for (int nt = 0; nt < 4; nt++) {
          bf16x8 bk = *(const bf16x8*)(Ks + (nt * 16 + (lane & 15)) * RS + kk * 32 + (lane >> 4) * 8);
          accP[nt] = __builtin_amdgcn_mfma_f32_16x16x32_bf16(aq[kk], bk, accP[nt], 0, 0, 0);
        }
#pragma unroll
      for (int nt = 0; nt < 4; nt++)
#pragma unroll
        for (int r = 0; r < 4; r++) {
          const int il = w4 * 16 + (lane >> 4) * 4 + r, sl = nt * 16 + (lane & 15);
          const int e = d == 0 ? il - sl : sl - il;
          const float f = e >= 0 ? exp2f((float)e * lg) : 0.f;
          Ps[il * RS + sl] = f2bf(accP[nt][r] * f);
        }
      __syncthreads();
      f32x4 accO[4], accI[4];
#pragma unroll
      for (int nt = 0; nt < 4; nt++) { accO[nt] = (f32x4){0.f, 0.f, 0.f, 0.f}; accI[nt] = (f32x4){0.f, 0.f, 0.f, 0.f}; }
#pragma unroll
      for (int kk = 0; kk < 2; kk++) {
        bf16x8 ap = *(const bf16x8*)(Ps + (w4 * 16 + (lane & 15)) * RS + kk * 32 + (lane >> 4) * 8);
#pragma unroll
        for (int nt = 0; nt < 4; nt++) {
          bf16x8 bv = *(const bf16x8*)(Vt + (nt * 16 + (lane & 15)) * RS + kk * 32 + (lane >> 4) * 8);
          accO[nt] = __builtin_amdgcn_mfma_f32_16x16x32_bf16(ap, bv, accO[nt], 0, 0, 0);
          bf16x8 bs = *(const bf16x8*)(St + (nt * 16 + (lane & 15)) * RS + kk * 32 + (lane >> 4) * 8);
          accI[nt] = __builtin_amdgcn_mfma_f32_16x16x32_bf16(aq[kk], bs, accI[nt], 0, 0, 0);
        }
      }
      u16* ofp = (u16*)(p.ws + OFF_RETOF);
#pragma unroll
      for (int r = 0; r < 4; r++) {
        const int il = w4 * 16 + (lane >> 4) * 4 + r;
        const size_t row = (size_t)(b * TT + nc * 256 + w * 64 + il);
        const float rho = exp2f((float)(d == 0 ? il + 1 : 64 - il) * lg);
        float o[4], ss = 0.f;
#pragma unroll
        for (int nt = 0; nt < 4; nt++) {
          o[nt] = accO[nt][r] + rho * accI[nt][r];
          if (d == 1) o[nt] += bf2f(ofp[row * 256 + h * 64 + nt * 16 + (lane & 15)]);
          ss += o[nt] * o[nt];
        }
        if (d == 0) {
#pragma unroll
          for (int nt = 0; nt < 4; nt++) ofp[row * 256 + h * 64 + nt * 16 + (lane & 15)] = f2bf(o[nt]);
        } else {
          ss = allsum16(ss);
          const float sc = rsqrtf(ss * (1.f / 64.f) + 1e-6f);
#pragma unroll
          for (int nt = 0; nt < 4; nt++) {
            const int cv = h * 64 + nt * 16 + (lane & 15);
            const float z = bf2f(proj[row * PC + C_RTZ + cv]);
            proj[row * PC + C_RTQ + cv] = f2bf(o[nt] * sc * siluf_(z));
          }
        }
      }
    }
#pragma unroll
    for (int nt = 0; nt < 4; nt++)
#pragma unroll
      for (int r = 0; r < 4; r++) accS[nt][r] *= g64;
#pragma unroll
    for (int kk = 0; kk < 2; kk++) {
      bf16x8 ak = *(const bf16x8*)(Kt + (w4 * 16 + (lane & 15)) * RS + kk * 32 + (lane >> 4) * 8);
#pragma unroll
      for (int nt = 0; nt < 4; nt++) {
        bf16x8 bv = *(const bf16x8*)(Vd + (nt * 16 + (lane & 15)) * RS + kk * 32 + (lane >> 4) * 8);
        accS[nt] = __builtin_amdgcn_mfma_f32_16x16x32_bf16(ak, bv, accS[nt], 0, 0, 0);
      }
    }
    __syncthreads();
    if (PASS == 2 && wi + 1 < 4) {
#pragma unroll
      for (int nt = 0; nt < 4; nt++)
        *(uint2*)(St + (nt * 16 + (lane & 15)) * RS + w4 * 16 + (lane >> 4) * 4) =
            make_uint2(pack2(accS[nt][0], accS[nt][1]), pack2(accS[nt][2], accS[nt][3]));
    }
  }
  if (PASS == 1) {
#pragma unroll
    for (int nt = 0; nt < 4; nt++)
#pragma unroll
      for (int r = 0; r < 4; r++) stt[(w4 * 16 + (lane >> 4) * 4 + r) * 64 + nt * 16 + (lane & 15)] = accS[nt][r];
  }
}
__device__ void gla_p1_task(const Params& p, int layer, int task, float* lds) {
  int c = task % 9; int q = task / 9; int h = q & 3; q >>= 2; int b = q & 7; q >>= 3; int d = q & 1; int mx = q >> 1;
  if (mx == 0) gla_sweep<0, 1>(p, layer, d, b, h, c, lds);
  else { const int nc = d == 0 ? c : (c == 0 ? 0 : 9 - c); ret_sweep<1>(p, layer, d, b, h, nc, c, (u16*)lds); }
}
__device__ void gla_p2_task(const Params& p, int layer, int mx, int b, int h, int nc, float* lds) {
  int cb = nc == 0 ? 0 : 9 - nc;
  if (mx == 0) { gla_sweep<0, 2>(p, layer, 0, b, h, nc, lds); __threadfence_block(); gla_sweep<0, 2>(p, layer, 1, b, h, cb, lds); }
  else { ret_sweep<2>(p, layer, 0, b, h, nc, nc, (u16*)lds); __threadfence_block(); ret_sweep<2>(p, layer, 1, b, h, nc, cb, (u16*)lds); }
}
__device__ void gla_carry_task(const Params& p, int layer, int task) {
  int e = task * 256 + tid_();
  int v = e & 63, k = (e >> 6) & 63, dbh = (e >> 12) & 63, mx = e >> 18;
  float* stt = (float*)(p.ws + (mx == 0 ? OFF_HGST : OFF_RTST)) + (size_t)dbh * 9 * 4096 + k * 64 + v;
  const float* P = (const float*)(p.ws + OFF_HGP) + (size_t)dbh * 9 * 64 + k;
  float pg = 1.f;
  if (mx == 1) { int d = dbh >> 5, h = dbh & 3; pg = __expf(-256.f * __expf(p.in[20][((size_t)layer * 2 + d) * 4 + h])); }
  float S = 0.f;
  for (int c = 0; c < 9; c++) {
    float E = stt[(size_t)c * 4096];
    stt[(size_t)c * 4096] = S;
    float pp = mx == 0 ? P[c * 64] : pg;
    S = pp * S + E;
  }
}

__device__ __forceinline__ int s5_bwd_chunk(int nc) { return nc < 4 ? 3 - nc : 39 - nc; }
template <int PASS>
__device__ void s5_task(const Params& p, int layer, int task, float* lds) {
  const int t = tid_(), w = t >> 6, lane = t & 63;
  int gq = task & 3; int q = task >> 2; int nc = q % 36; int b = q / 36;
  const int g = gq * 4 + w;
  float* ubuf = lds + w * 256;
  u16* hbuf = (u16*)(lds + 1024) + w * (16 * 136);
  float* ybuf = lds + 1024 + 4352 + w * 1024;
  u16* proj = (u16*)(p.ws + OFF_PROJ);
  float2* st5 = (float2*)(p.ws + OFF_S5ST);
  bf16x8 cfrag[4];
  if (PASS == 2) {
    const float* cre = p.in[13] + ((size_t)layer * 16 + g) * 16 * 64;
    const float* cim = p.in[14] + ((size_t)layer * 16 + g) * 16 * 64;
    int pp = lane & 15;
#pragma unroll
    for (int ks = 0; ks < 4; ks++)
#pragma unroll
      for (int i = 0; i < 8; i++) {
        int kidx = ks * 32 + (lane >> 4) * 8 + i; int n = kidx >> 1;
        float val = (kidx & 1) ? -cim[pp * 64 + n] : cre[pp * 64 + n];
        cfrag[ks][i] = (short)f2bf(val);
      }
  }
  for (int d = 0; d < 2; d++) {
    float lre = p.in[8][(((size_t)layer * 2 + d) * 16 + g) * 64 + lane];
    float lim = p.in[9][(((size_t)layer * 2 + d) * 16 + g) * 64 + lane];
    float dt = __expf(p.in[10][((size_t)layer * 2 + d) * 16 + g]);
    float mag = __expf(lre * dt);
    float sn, cs; sincosf(lim * dt, &sn, &cs);
    float are = mag * cs, aim = mag * sn;
    float den = 1.f / (lre * lre + lim * lim);
    float cre_ = ((are - 1.f) * lre + aim * lim) * den;
    float cim_ = (aim * lre - (are - 1.f) * lim) * den;
    float bbr[16], bbi[16];
    {
      const float* br = p.in[11] + (((size_t)layer * 16 + g) * 64 + lane) * 16;
      const float* bi = p.in[12] + (((size_t)layer * 16 + g) * 64 + lane) * 16;
#pragma unroll
      for (int i = 0; i < 16; i++) {
        float x = br[i], y = bi[i];
        bbr[i] = cre_ * x - cim_ * y; bbi[i] = cre_ * y + cim_ * x;
      }
    }
    int cstep = d == 0 ? nc : s5_bwd_chunk(nc);
    size_t sidx = ((((size_t)d * 8 + b) * 16 + g) * 36 + cstep) * 64 + lane;
    float hre = 0.f, him = 0.f;
    if (PASS == 2) { float2 h0 = st5[sidx]; hre = h0.x; him = h0.y; }
    uint2 ru;
    auto fetchu = [&](int sub) {
      int st = lane >> 2, p4 = (lane & 3) * 4;
      int jl = d == 0 ? sub * 16 + st : 63 - (sub * 16 + st);
      ru = *(const uint2*)(proj + (size_t)(b * TT + nc * 64 + jl) * PC + C_S5U + g * 16 + p4);
    };
    fetchu(0);
    for (int sub = 0; sub < 4; sub++) {
      __syncthreads();
      {
        int st = lane >> 2, p4 = (lane & 3) * 4;
        *(float4*)(ubuf + st * 16 + p4) = make_float4(__uint_as_float(ru.x << 16), __uint_as_float(ru.x & 0xffff0000u),
                                                       __uint_as_float(ru.y << 16), __uint_as_float(ru.y & 0xffff0000u));
      }
      __syncthreads();
      if (sub + 1 < 4) fetchu(sub + 1);
#pragma unroll 2
      for (int st = 0; st < 16; st++) {
        float bur = 0.f, bui = 0.f;
#pragma unroll
        for (int i4 = 0; i4 < 4; i4++) {
          float4 uu = *(const float4*)(ubuf + st * 16 + i4 * 4);
          bur += bbr[i4*4] * uu.x + bbr[i4*4+1] * uu.y + bbr[i4*4+2] * uu.z + bbr[i4*4+3] * uu.w;
          bui += bbi[i4*4] * uu.x + bbi[i4*4+1] * uu.y + bbi[i4*4+2] * uu.z + bbi[i4*4+3] * uu.w;
        }
        float nre = are * hre - aim * him + bur;
        float nim = are * him + aim * hre + bui;
        hre = nre; him = nim;
        if (PASS == 2) *(unsigned*)(hbuf + st * 136 + lane * 2) = pack2(hre, him);
      }
      if (PASS == 2) {
        __syncthreads();
        f32x4 acc = (f32x4){0.f, 0.f, 0.f, 0.f};
#pragma unroll
        for (int ks = 0; ks < 4; ks++) {
          bf16x8 af = *(const bf16x8*)(hbuf + (lane & 15) * 136 + ks * 32 + (lane >> 4) * 8);
          acc = __builtin_amdgcn_mfma_f32_16x16x32_bf16(af, cfrag[ks], acc, 0, 0, 0);
        }
#pragma unroll
        for (int r = 0; r < 4; r++) {
          int st = (lane >> 4) * 4 + r;
          int jl = d == 0 ? sub * 16 + st : 63 - (sub * 16 + st);
          float* yp = ybuf + jl * 16 + (lane & 15);
          if (d == 0) *yp = acc[r]; else *yp += acc[r];
        }
      }
    }
    if (PASS == 1) st5[sidx] = make_float2(hre, him);
  }
  if (PASS == 2) {
    __syncthreads();
    const float* dsk = p.in[15] + layer * 256 + g * 16;
#pragma unroll
    for (int i = 0; i < 16; i++) {
      int idx = lane + 64 * i; int jl = idx >> 4, pp = idx & 15;
      u16* up = proj + (size_t)(b * TT + nc * 64 + jl) * PC + C_S5U + g * 16 + pp;
      float y = ybuf[jl * 16 + pp] + dsk[pp] * bf2f(*up);
      *up = f2bf(geluf_(y));
    }
  }
}
__device__ void s5_carry_task(const Params& p, int layer, int task) {
  int e = task * 256 + tid_();
  int n = e & 63, g = (e >> 6) & 15, d = e >> 13;
  float lre = p.in[8][(((size_t)layer * 2 + d) * 16 + g) * 64 + n];
  float lim = p.in[9][(((size_t)layer * 2 + d) * 16 + g) * 64 + n];
  float dt = __expf(p.in[10][((size_t)layer * 2 + d) * 16 + g]);
  float mag = __expf(lre * dt * 64.f);
  float sn, cs; sincosf(lim * dt * 64.f, &sn, &cs);
  float are = mag * cs, aim = mag * sn;
  float2* st5 = (float2*)(p.ws + OFF_S5ST) + (size_t)(e >> 6) * 36 * 64 + n;
  float sre = 0.f, sim = 0.f;
  for (int c = 0; c < 36; c++) {
    float2 E = st5[(size_t)c * 64];
    st5[(size_t)c * 64] = make_float2(sre, sim);
    float nre = are * sre - aim * sim + E.x;
    float nim = are * sim + aim * sre + E.y;
    sre = nre; sim = nim;
  }
}

__device__ __forceinline__ void group_barrier(unsigned* cnt, unsigned target) {
  asm volatile("s_waitcnt vmcnt(0)" ::: "memory");
  __syncthreads();
  if (tid_() == 0) {
    __threadfence();
    asm volatile("s_waitcnt vmcnt(0)" ::: "memory");
    __hip_atomic_fetch_add(cnt, 1u, __ATOMIC_RELAXED, __HIP_MEMORY_SCOPE_AGENT);
    while (__hip_atomic_load(cnt, __ATOMIC_RELAXED, __HIP_MEMORY_SCOPE_AGENT) < target) __builtin_amdgcn_s_sleep(2);
    __threadfence();
    asm volatile("s_waitcnt vmcnt(0)" ::: "memory");
  }
  __syncthreads();
}
#define XB_XCNT(j) (64 * (j))
#define XB_XSUB(j) (1024 + 64 * (j))
#define XB_XGEN(j) (2048 + 64 * (j))
#define XB_TOP     3072
#define XB_TOPGEN  3136
#define XB_WORDS   8192
struct XcdBar { unsigned* bar; unsigned x, nloc, nx; };
__device__ __forceinline__ unsigned xb_ld(unsigned* q) { return __hip_atomic_load(q, __ATOMIC_RELAXED, __HIP_MEMORY_SCOPE_AGENT); }
__device__ __forceinline__ unsigned xb_add(unsigned* q, unsigned v) { return __hip_atomic_fetch_add(q, v, __ATOMIC_RELAXED, __HIP_MEMORY_SCOPE_AGENT); }
__device__ __forceinline__ void xcd_barrier(const XcdBar& b) {
  asm volatile("s_waitcnt vmcnt(0)" ::: "memory");
  __syncthreads();
  if (tid_() == 0) {
    unsigned* bar = b.bar;
    __builtin_amdgcn_s_waitcnt(0);
    const unsigned old = xb_add(&bar[XB_XSUB(b.x)], 1u);
    const unsigned gen = old / b.nloc;
    if (old + 1u == (gen + 1u) * b.nloc) {
      __builtin_amdgcn_fence(__ATOMIC_RELEASE, "agent");
      asm volatile("s_waitcnt vmcnt(0)" ::: "memory");
      const unsigned og = xb_add(&bar[XB_TOP], 1u);
      const unsigned tg = og / b.nx;
      if (og + 1u == (tg + 1u) * b.nx) xb_add(&bar[XB_TOPGEN], 1u);
      else while (xb_ld(&bar[XB_TOPGEN]) == tg) __builtin_amdgcn_s_sleep(1);
      __builtin_amdgcn_fence(__ATOMIC_ACQUIRE, "agent");
      xb_add(&bar[XB_XGEN(b.x)], 1u);
      asm volatile("s_waitcnt vmcnt(0)" ::: "memory");
    } else {
      while (xb_ld(&bar[XB_XGEN(b.x)]) == gen) __builtin_amdgcn_s_sleep(1);
      __builtin_amdgcn_fence(__ATOMIC_ACQUIRE, "agent");
      asm volatile("s_waitcnt vmcnt(0)" ::: "memory");
    }
  }
  __syncthreads();
}
#define LDS_FLOATS 18432
#define SYNC() xcd_barrier(xbar)
#define RW_TWO false
#define NRW (RW_TWO ? 128 : 256)

__global__ void __launch_bounds__(256, 2) fwd_megakernel(Params p) {
  cg::grid_group grid = cg::this_grid();
  __shared__ __attribute__((aligned(16))) float lds[LDS_FLOATS];
  const int bid = blockIdx.x, nb = gridDim.x, t = tid_();
  XcdBar xbar; xbar.bar = (unsigned*)(p.ws + OFF_XB); xbar.x = 0; xbar.nloc = 1; xbar.nx = 1;

  for (int task = bid; task < N_CONVERT_TASKS + 96 + 1; task += nb) {
    if (task < 96) mods_task(p, task, lds);
    else if (task == 96) {
      if (t < 4) ((unsigned*)(p.ws + OFF_BAR))[t] = 0u;
      for (int i = t; i < XB_WORDS; i += 256) ((unsigned*)(p.ws + OFF_XB))[i] = 0u;
      float* rope = (float*)(p.ws + OFF_ROPE);
      for (int i = t; i < 1024; i += 256) {
        int pos = i >> 4, fi = i & 15;
        float fr = powf(10000.f, -(float)fi / 16.f);
        float ang = (float)pos * fr;
        rope[i * 2] = cosf(ang); rope[i * 2 + 1] = sinf(ang);
      }
    } else convert_task(p, 0, task - 97, lds);
  }
  grid.sync();
  {
    unsigned xr; asm volatile("s_getreg_b32 %0, hwreg(HW_REG_XCC_ID)" : "=s"(xr));
    xbar.x = xr & 15u;
    if (t == 0) xb_add(&xbar.bar[XB_XCNT(xbar.x)], 1u + ((nb == 512 && bid >= NRW) ? 65536u : 0u));
  }
  for (int task = bid; task < MROWS / 4; task += nb) ln_row(p, 0, 0, task * 4 + (t >> 6));
  XcdBar pbar; pbar.bar = xbar.bar + 4096; pbar.x = xbar.x; pbar.nloc = 1; pbar.nx = 1;
  if (t == 0) {
    unsigned nx, npx, nlocp;
    for (;;) {
      unsigned sum = 0; nx = 0; npx = 0; nlocp = 0;
#pragma unroll
      for (int j = 0; j < 16; j++) {
        const unsigned w = xb_ld(&xbar.bar[XB_XCNT(j)]);
        const unsigned c = w & 65535u, cp = w >> 16;
        sum += c; nx += c > 0u ? 1u : 0u; npx += cp > 0u ? 1u : 0u;
        if ((unsigned)j == xbar.x) { xbar.nloc = c; nlocp = cp; }
      }
      if (sum == (unsigned)nb) break;
      __builtin_amdgcn_s_sleep(4);
    }
    xbar.nx = nx; pbar.nx = npx > 0u ? npx : 1u; pbar.nloc = nlocp > 0u ? nlocp : 1u;
  }
  SYNC();

  for (int layer = 0; layer < 2; layer++) {
    const int latonly = layer;
    if ((nb & 7) == 0) { int tm, tn; for (int it = 0; xcd_tile(it, bid, nb, 144, 31, 6, tm, tn); it++) inproj_tile(p, layer, tm, tn, (u16*)lds); }
    else for (int task = bid; task < 144 * 31; task += nb) inproj_tile(p, layer, task / 31, task % 31, (u16*)lds);
    SYNC();
    {
      const int ncg = latonly ? 8 : 9, ncs = latonly ? 32 : 36;
      const int NG = 64 * ncg, NS = 32 * ncs;
      auto p2_task = [&](int task) {
        if (task < NG) {
          int nc = task % ncg + (latonly ? 1 : 0); int q = task / ncg; int h = q & 3; q >>= 2; int b = q & 7; int mx = q >> 3;
          gla_p2_task(p, layer, mx, b, h, nc, lds);
        } else {
          int q = task - NG; int gq = q & 3; q >>= 2; int nc = q % ncs + (latonly ? 4 : 0); int b = q / ncs;
          s5_task<2>(p, layer, ((b * 36 + nc) << 2) | gq, lds);
        }
      };
      if (nb == 512) {
        unsigned* bar = (unsigned*)(p.ws + OFF_BAR);
        const int ng = nb - NRW;
        if (bid < NRW) {
          rwkv_scan_task<RW_TWO>(p, layer, bid, lds);
          if (t == 0) {
            while (xb_ld(&pbar.bar[XB_TOPGEN]) < 2u * layer + 2u) __builtin_amdgcn_s_sleep(8);
            __threadfence();
          }
          __syncthreads();
        } else {
          const int gb = bid - NRW;
          for (int task = gb; task < 2304; task += ng) {
            if (task < 1152) gla_p1_task(p, layer, task, lds); else s5_task<1>(p, layer, task - 1152, lds);
          }
          xcd_barrier(pbar);
          for (int task = gb; task < 2048 + 64; task += ng) {
            if (task < 2048) gla_carry_task(p, layer, task); else s5_carry_task(p, layer, task - 2048);
          }
          xcd_barrier(pbar);
        }
        int* shq = (int*)(lds + LDS_FLOATS - 4);
        for (;;) {
          __syncthreads();
          if (t == 0) *shq = (int)__hip_atomic_fetch_add(bar + 1 + layer, 1u, __ATOMIC_RELAXED, __HIP_MEMORY_SCOPE_AGENT);
          __syncthreads();
          const int task = *shq;
          if (task >= NG + NS) break;
          p2_task(task);
        }
        SYNC();
      } else {
        for (int task = bid; task < NRW + 2304; task += nb) {
          if (task < NRW) rwkv_scan_task<RW_TWO>(p, layer, task, lds);
          else if (task < NRW + 1152) gla_p1_task(p, layer, task - NRW, lds);
          else s5_task<1>(p, layer, task - NRW - 1152, lds);
        }
        SYNC();
        for (int task = bid; task < 2048 + 64; task += nb) {
          if (task < 2048) gla_carry_task(p, layer, task); else s5_carry_task(p, layer, task - 2048);
        }
        SYNC();
        for (int task = bid; task < NG + NS; task += nb) p2_task(task);
        SYNC();
      }
    }
    {
      const int ntm = latonly ? 128 : 144;
      for (int task = bid; task < ntm * 2 + MROWS / 8; task += nb) {
        if (task < ntm * 2) glu_tile(p, layer, latonly, task >> 1, task & 1, (u16*)lds);
        else rwkv_combine_rows(p, layer, (task - ntm * 2) * 8, latonly);
      }
    }
    SYNC();
    {
      const int ntm = latonly ? 128 : 144;
      if ((nb & 7) == 0) { int tm, tn; for (int it = 0; xcd_tile(it, bid, nb, ntm, 16, 8, tm, tn); it++) merge_tile(p, layer, latonly, tm, tn, (u16*)lds); }
      else for (int task = bid; task < ntm * 16; task += nb) merge_tile(p, layer, latonly, task >> 4, task & 15, (u16*)lds);
    }
    SYNC();
    {
      const int ntm = latonly ? 128 : 144;
      if ((nb & 7) == 0) { int tm, tn; for (int it = 0; xcd_tile(it, bid, nb, ntm, 8, 8, tm, tn); it++) outproj_tile(p, layer, latonly, tm, tn, (u16*)lds); }
      else for (int task = bid; task < ntm * 8; task += nb) outproj_tile(p, layer, latonly, task >> 3, task & 7, (u16*)lds);
    }
    SYNC();
    if (layer == 0) {
      for (int task = bid; task < MROWS / 4 + N_CONVERT_TASKS; task += nb) {
        if (task < N_CONVERT_TASKS) convert_task(p, 1, task, lds);
        else ln_row(p, 1, 0, (task - N_CONVERT_TASKS) * 4 + (t >> 6));
      }
      SYNC();
    } else {
      for (int task = bid; task < NBATCH * 2048 / 4; task += nb) {
        int r = task * 4 + (t >> 6); int b = r >> 11, tl = r & 2047;
        ln_row(p, 1, 1, b * TT + 256 + tl);
      }
    }
  }
}

extern "C" void kernel_launch(void* const* d_in, const int* in_sizes, int n_in,
                              void* d_out, int out_size, void* d_ws, size_t ws_size,
                              hipStream_t stream) {
  static int grid_blocks = 0;
  if (!grid_blocks) {
    int dev = 0, cus = 0, per_cu = 0;
    (void)hipGetDevice(&dev);
    (void)hipDeviceGetAttribute(&cus, hipDeviceAttributeMultiprocessorCount, dev);
    (void)hipOccupancyMaxActiveBlocksPerMultiprocessor(&per_cu, fwd_megakernel, 256, 0);
    if (per_cu > 2) per_cu = 2;
    if (per_cu < 1) per_cu = 1;
    grid_blocks = cus * per_cu;
  }
  if (ws_size < WS_NEED) { fprintf(stderr, "workspace too small\n"); return; }
  Params p{};
  for (int i = 0; i < 36; i++) p.in[i] = (const float*)d_in[i];
  p.out = (float*)d_out;
  p.ws = (char*)d_ws;
  void* args[] = {&p};
  hipError_t e = hipLaunchCooperativeKernel((void*)fwd_megakernel, dim3(grid_blocks), dim3(256), args, 0, stream);
  if (e != hipSuccess) fprintf(stderr, "cooperative launch failed: %s (grid %d)\n", hipGetErrorString(e), grid_blocks);
}
```

```cpp
#include <hip/hip_runtime.h>
#include <hip/hip_bf16.h>
#include <hip/hip_cooperative_groups.h>
#include <cstdio>
namespace cg = cooperative_groups;

typedef __attribute__((ext_vector_type(8))) short bf16x8;
typedef __attribute__((ext_vector_type(4))) float f32x4;
typedef unsigned short u16;

#define D_ 1024
#define NBATCH 8
#define TT 2304
#define MROWS 18432
#define PC 3904
#define DIN 8000
#define C_S5U 0
#define C_S5Z 256
#define C_HGQ 512
#define C_HGF 768
#define C_HGI 1280
#define C_HGZ 1536
#define C_RTQ 1792
#define C_RTK 2048
#define C_RTV 2304
#define C_RTZ 2560
#define C_RWX 2816
#define C_RWZ 3648

#define OFF_WINT   0ul
#define OFF_WBT    (OFF_WINT + 16384000ul)
#define OFF_WOT    (OFF_WBT + 2097152ul)
#define OFF_GLUT   (OFF_WOT + 2097152ul)
#define OFF_U      (OFF_GLUT + 131072ul)
#define OFF_PROJ   (OFF_U + 37748736ul)
#define OFF_HCTX   (OFF_PROJ + 143917056ul)
#define OFF_SCR    (OFF_HCTX + 8388608ul)
#define OFF_RWO    (OFF_SCR)
#define OFF_HGST   (OFF_SCR + 18874368ul)
#define OFF_RTST   (OFF_HGST + 9437184ul)
#define OFF_RETOF  (OFF_SCR + 37748736ul)
#define OFF_S5ST   (OFF_RETOF + 9437184ul)
#define OFF_MODS   (OFF_S5ST + 4718592ul)
#define OFF_HGP    (OFF_MODS + 221184ul)
#define OFF_BONUS  (OFF_HGP + 147456ul)
#define OFF_ROPE   (OFF_BONUS + 589824ul)
#define OFF_BAR    (OFF_ROPE + 8192ul)
#define OFF_XB     (OFF_BAR + 256ul)
#define WS_NEED    (OFF_XB + 32768ul)

struct Params {
  const float* in[36];
  float* out;
  char* ws;
};

__device__ __forceinline__ int tid_() { int t = __builtin_amdgcn_workitem_id_x(); asm volatile("" : "+v"(t)); return t; }
__device__ __forceinline__ u16 f2bf(float f) {
  unsigned u = __float_as_uint(f);
  u += 0x7fffu + ((u >> 16) & 1u);
  return (u16)(u >> 16);
}
__device__ __forceinline__ float bf2f(u16 h) { return __uint_as_float(((unsigned)h) << 16); }
__device__ __forceinline__ unsigned pack2(float a, float b) { return (unsigned)f2bf(a) | ((unsigned)f2bf(b) << 16); }
__device__ __forceinline__ float sigmoidf_(float x) { return __builtin_amdgcn_rcpf(1.f + __expf(-x)); }
__device__ __forceinline__ float siluf_(float x) { return x * __builtin_amdgcn_rcpf(1.f + __expf(-x)); }
__device__ __forceinline__ float geluf_(float x) {
  float t = tanhf(0.7978845608028654f * (x + 0.044715f * x * x * x));
  return 0.5f * x * (1.f + t);
}
template <int CTRL>
__device__ __forceinline__ float dppf(float x) {
  return __int_as_float(__builtin_amdgcn_update_dpp(0, __float_as_int(x), CTRL, 0xf, 0xf, true));
}
__device__ __forceinline__ float allsum16(float x) {
  x += dppf<0x128>(x);
  x += dppf<0x124>(x);
  x += dppf<0x122>(x);
  x += dppf<0x121>(x);
  return x;
}
__device__ __forceinline__ float wavesum(float x) {
  x = allsum16(x);
  x += __shfl_xor(x, 16, 64);
  x += __shfl_xor(x, 32, 64);
  return x;
}
__device__ __forceinline__ void ld4bf(const u16* p, float (&o)[4]) {
  uint2 v = *(const uint2*)p;
  o[0] = __uint_as_float(v.x << 16); o[1] = __uint_as_float(v.x & 0xffff0000u);
  o[2] = __uint_as_float(v.y << 16); o[3] = __uint_as_float(v.y & 0xffff0000u);
}
__device__ __forceinline__ void st4bf(u16* p, float a, float b, float c, float d) {
  uint2 v; v.x = pack2(a, b); v.y = pack2(c, d);
  *(uint2*)p = v;
}
__device__ __forceinline__ int jmap(int d, int s) { return d == 0 ? s : (s < 256 ? 255 - s : 2559 - s); }
__device__ __forceinline__ bool has_prev(int j) { return j != 0 && j != 256; }
__device__ __forceinline__ bool has_next(int j) { return j != 255 && j != 2303; }

__device__ __forceinline__ const float* hin_ptr(const Params& p, int layer, int row) {
  int b = row / TT, j = row - b * TT;
  if (layer == 0) return j < 256 ? p.in[2] + ((size_t)(b * 256 + j)) * D_ : p.in[0] + ((size_t)(b * 2048 + j - 256)) * D_;
  return j < 256 ? (const float*)(p.ws + OFF_HCTX) + ((size_t)(b * 256 + j)) * D_ : p.out + ((size_t)(b * 2048 + j - 256)) * D_;
}
__device__ __forceinline__ float* hout_ptr(const Params& p, int row) {
  int b = row / TT, j = row - b * TT;
  return j < 256 ? (float*)(p.ws + OFF_HCTX) + ((size_t)(b * 256 + j)) * D_ : p.out + ((size_t)(b * 2048 + j - 256)) * D_;
}
__device__ __forceinline__ int modrow_of(int row) { int b = row / TT, j = row - b * TT; return j < 256 ? 8 : b; }

__device__ void transpose_tile(const float* __restrict__ src, u16* __restrict__ dst, int K, int N, int k0, int n0, float* lds) {
  const int t = tid_();
  __syncthreads();
#pragma unroll
  for (int i = 0; i < 16; i++) {
    int r = i * 4 + (t >> 6), c = t & 63;
    lds[r * 65 + c] = src[(size_t)(k0 + r) * N + n0 + c];
  }
  __syncthreads();
#pragma unroll
  for (int i = 0; i < 16; i++) {
    int r = i * 4 + (t >> 6), c = t & 63;
    dst[(size_t)(n0 + r) * K + k0 + c] = f2bf(lds[c * 65 + r]);
  }
}
__device__ void convert_task(const Params& p, int layer, int task, float* lds) {
  if (task < 2000) {
    int kt = task / 125, nt = task % 125;
    transpose_tile(p.in[6] + (size_t)layer * 1024 * DIN, (u16*)(p.ws + OFF_WINT), 1024, DIN, kt * 64, nt * 64, lds);
  } else if (task < 2256) {
    int q = task - 2000; int br = q >> 6; q &= 63; int kt = q >> 4, nt = q & 15;
    transpose_tile(p.in[31] + ((size_t)layer * 4 + br) * 256 * 1024, (u16*)(p.ws + OFF_WBT) + (size_t)br * 1024 * 256, 256, 1024, kt * 64, nt * 64, lds);
  } else if (task < 2512) {
    int q = task - 2256; int kt = q >> 4, nt = q & 15;
    transpose_tile(p.in[32] + (size_t)layer * 1024 * 1024, (u16*)(p.ws + OFF_WOT), 1024, 1024, kt * 64, nt * 64, lds);
  } else {
    int q = task - 2512; int kt = q >> 2, nt = q & 3;
    transpose_tile(p.in[16] + (size_t)layer * 256 * 256, (u16*)(p.ws + OFF_GLUT), 256, 256, kt * 64, nt * 64, lds);
  }
}
#define N_CONVERT_TASKS 2528

__device__ void mods_task(const Params& p, int task, float* lds) {
  const int t = tid_();
  int layer = task / 48, cgp = task % 48;
  float* sc = lds;
  float* red = lds + 9 * 1024;
  __syncthreads();
  for (int i = t; i < 9 * 1024; i += 256) {
    int r = i >> 10, k = i & 1023;
    float v = r < 8 ? p.in[1][r * 1024 + k] : p.in[3][k];
    sc[i] = siluf_(v);
  }
  __syncthreads();
  int col = cgp * 64 + (t & 63), kq = t >> 6;
  float acc[9];
#pragma unroll
  for (int r = 0; r < 9; r++) acc[r] = 0.f;
  const float* wp = p.in[4] + (size_t)layer * 1024 * 3072 + col;
#pragma unroll 16
  for (int k = kq * 256; k < kq * 256 + 256; k++) {
    float w = wp[(size_t)k * 3072];
#pragma unroll
    for (int r = 0; r < 9; r++) acc[r] += sc[r * 1024 + k] * w;
  }
#pragma unroll
  for (int r = 0; r < 9; r++) red[(kq * 9 + r) * 64 + (t & 63)] = acc[r];
  __syncthreads();
  float* mods = (float*)(p.ws + OFF_MODS);
  for (int i = t; i < 9 * 64; i += 256) {
    int r = i >> 6, c = i & 63;
    float s = red[(0 * 9 + r) * 64 + c] + red[(1 * 9 + r) * 64 + c] + red[(2 * 9 + r) * 64 + c] + red[(3 * 9 + r) * 64 + c];
    int cc = cgp * 64 + c;
    mods[((size_t)layer * 9 + r) * 3072 + cc] = s + p.in[5][layer * 3072 + cc];
  }
}

__device__ void ln_row(const Params& p, int mode, int layer, int row) {
  const int lane = tid_() & 63;
  float v[16];
  if (mode == 0) {
    const float* src = hin_ptr(p, 0, row);
#pragma unroll
    for (int i = 0; i < 4; i++) { float4 q = *(const float4*)(src + i * 256 + lane * 4); v[i*4]=q.x; v[i*4+1]=q.y; v[i*4+2]=q.z; v[i*4+3]=q.w; }
  } else {
    float* src = hout_ptr(p, row);
#pragma unroll
    for (int i = 0; i < 4; i++) { float4 q = *(const float4*)(src + i * 256 + lane * 4); v[i*4]=q.x; v[i*4+1]=q.y; v[i*4+2]=q.z; v[i*4+3]=q.w; }
    float s = 0.f;
#pragma unroll
    for (int i = 0; i < 16; i++) s += v[i];
    float mean = wavesum(s) * (1.f / 1024.f);
    float q2 = 0.f;
#pragma unroll
    for (int i = 0; i < 16; i++) { v[i] -= mean; q2 += v[i] * v[i]; }
    float rstd = rsqrtf(wavesum(q2) * (1.f / 1024.f) + 1e-5f);
    const float* lw = p.in[34] + layer * 1024; const float* lb = p.in[35] + layer * 1024;
#pragma unroll
    for (int i = 0; i < 4; i++) {
      float4 w4 = *(const float4*)(lw + i * 256 + lane * 4), b4 = *(const float4*)(lb + i * 256 + lane * 4);
      v[i*4] = v[i*4] * rstd * w4.x + b4.x; v[i*4+1] = v[i*4+1] * rstd * w4.y + b4.y;
      v[i*4+2] = v[i*4+2] * rstd * w4.z + b4.z; v[i*4+3] = v[i*4+3] * rstd * w4.w + b4.w;
      *(float4*)(src + i * 256 + lane * 4) = make_float4(v[i*4], v[i*4+1], v[i*4+2], v[i*4+3]);
    }
    if (layer == 1) return;
  }
  int ml = mode == 0 ? 0 : 1;
  float s = 0.f;
#pragma unroll
  for (int i = 0; i < 16; i++) s += v[i];
  float mean = wavesum(s) * (1.f / 1024.f);
  float q2 = 0.f;
#pragma unroll
  for (int i = 0; i < 16; i++) { v[i] -= mean; q2 += v[i] * v[i]; }
  float rstd = rsqrtf(wavesum(q2) * (1.f / 1024.f) + 1e-5f);
  const float* md = (const float*)(p.ws + OFF_MODS) + ((size_t)ml * 9 + modrow_of(row)) * 3072;
  u16* up = (u16*)(p.ws + OFF_U) + (size_t)row * 1024;
#pragma unroll
  for (int i = 0; i < 4; i++) {
    float4 sh = *(const float4*)(md + i * 256 + lane * 4), sc = *(const float4*)(md + 1024 + i * 256 + lane * 4);
    st4bf(up + i * 256 + lane * 4, v[i*4] * rstd * (1.f + sc.x) + sh.x, v[i*4+1] * rstd * (1.f + sc.y) + sh.y,
          v[i*4+2] * rstd * (1.f + sc.z) + sh.z, v[i*4+3] * rstd * (1.f + sc.w) + sh.w);
  }
}

#define STAGE_LOAD(P, kk_) do { const unsigned k_ = (kk_); \
  P##a0 = *(const uint4*)(A + (oa + k_)); P##a1 = *(const uint4*)(A + (oa + sa + k_)); \
  P##a2 = *(const uint4*)(A + (oa + 2 * sa + k_)); P##a3 = *(const uint4*)(A + (oa + 3 * sa + k_)); \
  P##b0 = *(const uint4*)(B + (ob + k_)); P##b1 = *(const uint4*)(B + (ob + sb + k_)); \
  if (NT == 4) { P##b2 = *(const uint4*)(B + (ob + 2 * sb + k_)); P##b3 = *(const uint4*)(B + (ob + 3 * sb + k_)); } } while (0)
#define STAGE_WRITE(P, Asw, Bsw) do { \
  *(uint4*)(Asw) = P##a0; *(uint4*)((Asw) + 32 * 72) = P##a1; *(uint4*)((Asw) + 64 * 72) = P##a2; *(uint4*)((Asw) + 96 * 72) = P##a3; \
  *(uint4*)(Bsw) = P##b0; *(uint4*)((Bsw) + 32 * 72) = P##b1; \
  if (NT == 4) { *(uint4*)((Bsw) + 64 * 72) = P##b2; *(uint4*)((Bsw) + 96 * 72) = P##b3; } } while (0)
template <int MT, int NT>
__device__ __forceinline__ void stage_compute(f32x4 (&acc)[MT][NT], const u16* As, const u16* Bs, int lane, int wm, int wn) {
#pragma unroll
  for (int kk = 0; kk < 2; kk++) {
    bf16x8 af[MT], bfr[NT];
#pragma unroll
    for (int mt = 0; mt < MT; mt++) af[mt] = *(const bf16x8*)(As + (wm * MT * 16 + mt * 16 + (lane & 15)) * 72 + kk * 32 + (lane >> 4) * 8);
#pragma unroll
    for (int nt = 0; nt < NT; nt++) bfr[nt] = *(const bf16x8*)(Bs + (wn * NT * 16 + nt * 16 + (lane & 15)) * 72 + kk * 32 + (lane >> 4) * 8);
    __builtin_amdgcn_s_setprio(1);
#pragma unroll
    for (int mt = 0; mt < MT; mt++)
#pragma unroll
      for (int nt = 0; nt < NT; nt++)
        acc[mt][nt] = __builtin_amdgcn_mfma_f32_16x16x32_bf16(af[mt], bfr[nt], acc[mt][nt], 0, 0, 0);
    __builtin_amdgcn_s_setprio(0);
  }
}
template <int MT, int NT>
__device__ __forceinline__ void gemm_kloop(f32x4 (&acc)[MT][NT], const u16* __restrict__ A, int lda,
                                           const u16* __restrict__ B, int ldb, int K, u16* lds) {
  static_assert(MT == 4, "MT");
  constexpr int BM = MT * 32, BN = NT * 32, SS = (BM + BN) * 72;
  const int t = tid_(), lane = t & 63, w = t >> 6, wm = w >> 1, wn = w & 1;
  u16* As0 = lds; u16* Bs0 = lds + BM * 72; u16* As1 = lds + SS; u16* Bs1 = lds + SS + BM * 72;
  const int lr = t >> 3, lc = (t & 7) * 8;
  const unsigned oa = (unsigned)(lr * lda + lc), ob = (unsigned)(lr * ldb + lc);
  const unsigned sa = 32u * (unsigned)lda, sb = 32u * (unsigned)ldb;
  const int swo = lr * 72 + lc;
  const unsigned klast = (unsigned)(K - 64);
  uint4 R0a0, R0a1, R0a2, R0a3, R0b0, R0b1, R0b2, R0b3, R1a0, R1a1, R1a2, R1a3, R1b0, R1b1, R1b2, R1b3;
  STAGE_LOAD(R0, 0u);
  STAGE_LOAD(R1, 64u);
  __syncthreads();
  STAGE_WRITE(R0, As0 + swo, Bs0 + swo);
  STAGE_LOAD(R0, 128u < klast ? 128u : klast);
  __syncthreads();
#pragma unroll 1
  for (int k0 = 0; k0 < K; k0 += 128) {
    STAGE_WRITE(R1, As1 + swo, Bs1 + swo);
    { unsigned kn = (unsigned)k0 + 192u; STAGE_LOAD(R1, kn < klast ? kn : klast); }
    stage_compute<MT, NT>(acc, As0, Bs0, lane, wm, wn);
    __syncthreads();
    STAGE_WRITE(R0, As0 + swo, Bs0 + swo);
    { unsigned kn = (unsigned)k0 + 256u; STAGE_LOAD(R0, kn < klast ? kn : klast); }
    stage_compute<MT, NT>(acc, As1, Bs1, lane, wm, wn);
    __syncthreads();
  }
}
template <int MT, int NT>
__device__ __forceinline__ void zero_acc(f32x4 (&acc)[MT][NT]) {
#pragma unroll
  for (int i = 0; i < MT; i++)
#pragma unroll
    for (int j = 0; j < NT; j++) acc[i][j] = (f32x4){0.f, 0.f, 0.f, 0.f};
}
__device__ __forceinline__ int tile_m0(int latonly, int tm) {
  if (!latonly) return tm * 128;
  int b = tm >> 4; return b * TT + 256 + (tm & 15) * 128;
}

__device__ __forceinline__ bool xcd_tile(int it, int bid, int nb, int NTM, int NTN, int G, int& tm, int& tn) {
  const int xcd = bid & 7, lb = bid >> 3, nlb = nb >> 3, tmx = NTM >> 3;
  const int idx = it * nlb + lb;
  if (idx >= tmx * NTN) return false;
  const int full = tmx / G;
  int g = idx / (G * NTN);
  if (g > full) g = full;
  const int r = idx - g * G * NTN;
  const int gs = (g < full) ? G : (tmx - full * G);
  tn = r / gs;
  tm = xcd * tmx + g * G + (r - tn * gs);
  return true;
}
__device__ void inproj_tile(const Params& p, int layer, int tm, int tn, u16* lds) {
  int m0 = tm * 128, n0 = tn * 128;
  f32x4 acc[4][4]; zero_acc(acc);
  gemm_kloop<4, 4>(acc, (const u16*)(p.ws + OFF_U) + (size_t)m0 * 1024, 1024,
                   (const u16*)(p.ws + OFF_WINT) + (size_t)n0 * 1024, 1024, 1024, lds);
  const int t = tid_(), lane = t & 63, w = t >> 6, wm = w >> 1, wn = w & 1;
  const float* bias = p.in[7] + (size_t)layer * DIN;
  u16* proj = (u16*)(p.ws + OFF_PROJ);
#pragma unroll
  for (int nt = 0; nt < 4; nt++) {
    const int cl = wn * 64 + nt * 16 + (lane & 15);
    const float bv = (n0 + cl < PC) ? bias[n0 + cl] : 0.f;
#pragma unroll
    for (int mt = 0; mt < 4; mt++)
#pragma unroll
      for (int r = 0; r < 4; r++) lds[(wm * 64 + mt * 16 + (lane >> 4) * 4 + r) * 136 + cl] = f2bf(acc[mt][nt][r] + bv);
  }
  __syncthreads();
#pragma unroll
  for (int i = 0; i < 8; i++) {
    const int q = t + 256 * i, row = q >> 4, ch = q & 15;
    if (n0 + ch * 8 < PC) *(uint4*)(proj + (size_t)(m0 + row) * PC + n0 + ch * 8) = *(const uint4*)(lds + row * 136 + ch * 8);
  }
}
__device__ void glu_tile(const Params& p, int layer, int latonly, int tm, int tn, u16* lds) {
  int m0 = tile_m0(latonly, tm), n0 = tn * 128;
  f32x4 acc[4][4]; zero_acc(acc);
  u16* proj = (u16*)(p.ws + OFF_PROJ);
  gemm_kloop<4, 4>(acc, proj + (size_t)m0 * PC + C_S5U, PC, (const u16*)(p.ws + OFF_GLUT) + (size_t)n0 * 256, 256, 256, lds);
  const int t = tid_(), lane = t & 63, w = t >> 6, wm = w >> 1, wn = w & 1;
  const float* bias = p.in[17] + layer * 256;
#pragma unroll
  for (int nt = 0; nt < 4; nt++) {
    const int cl = wn * 64 + nt * 16 + (lane & 15);
    const float bv = bias[n0 + cl];
#pragma unroll
    for (int mt = 0; mt < 4; mt++)
#pragma unroll
      for (int r = 0; r < 4; r++) lds[(wm * 64 + mt * 16 + (lane >> 4) * 4 + r) * 136 + cl] = f2bf(sigmoidf_(acc[mt][nt][r] + bv));
  }
  __syncthreads();
#pragma unroll
  for (int i = 0; i < 8; i++) {
    const int q = t + 256 * i, row = q >> 4, ch = q & 15;
    u16* pr = proj + (size_t)(m0 + row) * PC + n0 + ch * 8;
    uint4 sg = *(const uint4*)(lds + row * 136 + ch * 8);
    uint4 yy = *(const uint4*)(pr + C_S5U), zz = *(const uint4*)(pr + C_S5Z), oo;
    const unsigned* sgp = (const unsigned*)&sg; const unsigned* yp = (const unsigned*)&yy; const unsigned* zp = (const unsigned*)&zz; unsigned* op = (unsigned*)&oo;
#pragma unroll
    for (int e = 0; e < 4; e++) {
      float s0 = __uint_as_float(sgp[e] << 16), s1 = __uint_as_float(sgp[e] & 0xffff0000u);
      float y0 = __uint_as_float(yp[e] << 16), y1 = __uint_as_float(yp[e] & 0xffff0000u);
      float z0 = __uint_as_float(zp[e] << 16), z1 = __uint_as_float(zp[e] & 0xffff0000u);
      op[e] = pack2(y0 * s0 * siluf_(z0), y1 * s1 * siluf_(z1));
    }
    *(uint4*)(pr + C_S5Z) = oo;
  }
}
__device__ void merge_tile(const Params& p, int layer, int latonly, int tm, int tn, u16* lds) {
  int m0 = tile_m0(latonly, tm), n0 = tn * 64;
  f32x4 accm[4][2]; zero_acc(accm);
  const u16* proj = (const u16*)(p.ws + OFF_PROJ);
  const int lane = tid_() & 63, w = tid_() >> 6, wm = w >> 1, wn = w & 1;
  const float* bias = p.in[7] + (size_t)layer * DIN + PC;
#pragma unroll 1
  for (int k = 0; k < 4; k++) {
    const int ycol = k == 0 ? C_S5Z : (k == 1 ? C_HGQ : (k == 2 ? C_RTQ : C_RWZ));
    f32x4 accb[4][2]; zero_acc(accb);
    gemm_kloop<4, 2>(accb, proj + (size_t)m0 * PC + ycol, PC,
                     (const u16*)(p.ws + OFF_WBT) + ((size_t)k * 1024 + n0) * 256, 256, 256, lds);
    f32x4 accg[4][2]; zero_acc(accg);
    gemm_kloop<4, 2>(accg, (const u16*)(p.ws + OFF_U) + (size_t)m0 * 1024, 1024,
                     (const u16*)(p.ws + OFF_WINT) + ((size_t)PC + k * 1024 + n0) * 1024, 1024, 1024, lds);
#pragma unroll
    for (int nt = 0; nt < 2; nt++) {
      float bv = bias[k * 1024 + n0 + wn * 32 + nt * 16 + (lane & 15)];
#pragma unroll
      for (int mt = 0; mt < 4; mt++)
#pragma unroll
        for (int r = 0; r < 4; r++) accm[mt][nt][r] += sigmoidf_(accg[mt][nt][r] + bv) * accb[mt][nt][r];
    }
  }
  u16* mg = (u16*)(p.ws + OFF_SCR);
#pragma unroll
  for (int nt = 0; nt < 2; nt++) {
    const int cl = wn * 32 + nt * 16 + (lane & 15);
#pragma unroll
    for (int mt = 0; mt < 4; mt++)
#pragma unroll
      for (int r = 0; r < 4; r++) lds[(wm * 64 + mt * 16 + (lane >> 4) * 4 + r) * 72 + cl] = f2bf(accm[mt][nt][r]);
  }
  __syncthreads();
  {
    const int t = tid_();
#pragma unroll
    for (int i = 0; i < 4; i++) {
      const int q = t + 256 * i, row = q >> 3, ch = q & 7;
      *(uint4*)(mg + (size_t)(m0 + row) * 1024 + n0 + ch * 8) = *(const uint4*)(lds + row * 72 + ch * 8);
    }
  }
}
__device__ void outproj_tile(const Params& p, int layer, int latonly, int tm, int tn, u16* lds) {
  int m0 = tile_m0(latonly, tm), n0 = tn * 128;
  f32x4 acc[4][4]; zero_acc(acc);
  gemm_kloop<4, 4>(acc, (const u16*)(p.ws + OFF_SCR) + (size_t)m0 * 1024, 1024,
                   (const u16*)(p.ws + OFF_WOT) + (size_t)n0 * 1024, 1024, 1024, lds);
  const int lane = tid_() & 63, w = tid_() >> 6, wm = w >> 1, wn = w & 1;
  const float* bias = p.in[33] + layer * 1024;
  const float* hi0 = hin_ptr(p, layer, m0);
  float* ho0 = hout_ptr(p, m0);
  const float* gate = (const float*)(p.ws + OFF_MODS) + ((size_t)layer * 9 + modrow_of(m0)) * 3072 + 2048;
  float* cs = (float*)lds;
#pragma unroll
  for (int nt = 0; nt < 4; nt++) {
    const int cl = wn * 64 + nt * 16 + (lane & 15);
    const float bv = bias[n0 + cl];
#pragma unroll
    for (int mt = 0; mt < 4; mt++)
#pragma unroll
      for (int r = 0; r < 4; r++) cs[(wm * 64 + mt * 16 + (lane >> 4) * 4 + r) * 132 + cl] = acc[mt][nt][r] + bv;
  }
  __syncthreads();
  {
    const int t = tid_();
#pragma unroll 4
    for (int i = 0; i < 16; i++) {
      const int q = t + 256 * i, row = q >> 5, ch = q & 31;
      const float4 a4 = *(const float4*)(cs + row * 132 + ch * 4);
      const float4 g4 = *(const float4*)(gate + n0 + ch * 4);
      const float4 h4 = *(const float4*)(hi0 + (size_t)row * 1024 + n0 + ch * 4);
      float4 o4;
      o4.x = 1.4142135623730951f * h4.x + g4.x * a4.x; o4.y = 1.4142135623730951f * h4.y + g4.y * a4.y;
      o4.z = 1.4142135623730951f * h4.z + g4.z * a4.z; o4.w = 1.4142135623730951f * h4.w + g4.w * a4.w;
      *(float4*)(ho0 + (size_t)row * 1024 + n0 + ch * 4) = o4;
    }
  }
}

template <bool TWO>
__device__ void rwkv_scan_task(const Params& p, int layer, int task, float* lds) {
  const int t = tid_();
  const int rh = TWO ? (task & 1) : (task & 3), h = TWO ? ((task >> 1) & 3) : ((task >> 2) & 3);
  const int b = TWO ? ((task >> 3) & 7) : ((task >> 4) & 7), d = TWO ? (task >> 6) : (task >> 7);
  constexpr int RPB = TWO ? 32 : 16;
  float* sh_lora = lds;
  float* sh_w2 = sh_lora + 512;
  float* sh_a2 = sh_w2 + 1024;
  float* sh_r = sh_a2 + 1024;
  float* sh_w = sh_r + 1024;
  float* sh_k = sh_w + 1024;
  float* sh_kk = sh_k + 1024;
  float* sh_b = sh_kk + 1024;
  float* sh_v = sh_b + 1024;
  float* sh_o = sh_v + 512;
  const u16* proj = (const u16*)(p.ws + OFF_PROJ);
  u16* rwo = (u16*)(p.ws + OFF_RWO) + (size_t)d * MROWS * 256;
  float* bonus = (float*)(p.ws + OFF_BONUS) + (size_t)d * MROWS * 4;
  const float* mu0 = p.in[21] + (size_t)layer * 2 * 832;
  const float* mu1 = mu0 + 832;
  __syncthreads();
  for (int i = t; i < 1024; i += 256) {
    int rr = i >> 6, c = i & 63;
    sh_w2[i] = p.in[23][(((size_t)layer * 2 + d) * 16 + rr) * 256 + h * 64 + c];
    sh_a2[i] = p.in[25][(((size_t)layer * 2 + d) * 16 + rr) * 256 + h * 64 + c];
  }
  const int pst = t >> 4, cq = t & 15;
  const int ch0 = h * 64 + cq * 4;
  float mur0[4], mur1[4], muk0[4], muk1[4], w0v[4], a0v[4], kkw[4], kaw[4], rkw[4];
#pragma unroll
  for (int i = 0; i < 4; i++) {
    mur0[i] = mu0[ch0 + i]; mur1[i] = mu1[ch0 + i];
    muk0[i] = mu0[256 + ch0 + i]; muk1[i] = mu1[256 + ch0 + i];
    w0v[i] = p.in[22][((size_t)layer * 2 + d) * 256 + ch0 + i];
    a0v[i] = p.in[24][((size_t)layer * 2 + d) * 256 + ch0 + i];
    kkw[i] = p.in[26][layer * 256 + ch0 + i];
    kaw[i] = p.in[27][layer * 256 + ch0 + i];
    rkw[i] = p.in[28][layer * 256 + ch0 + i];
  }
  const int vch = 512 + h * 64 + rh * RPB + cq;
  const float muv0 = mu0[vch], muv1 = mu1[vch], muw0 = TWO ? mu0[vch + 16] : 0.f, muw1 = TWO ? mu1[vch + 16] : 0.f;
  const int lidx0 = t * 2;
  float lmu00, lmu01, lmu10, lmu11;
  {
    int q = lidx0 & 31;
    int col = q < 16 ? (768 + d * 16 + q) : (800 + d * 16 + (q - 16));
    lmu00 = mu0[col]; lmu01 = mu0[col + 1]; lmu10 = mu1[col]; lmu11 = mu1[col + 1];
  }
  const int rl = t >> 4, ks = t & 15;
  float4 S = make_float4(0.f, 0.f, 0.f, 0.f), S2 = make_float4(0.f, 0.f, 0.f, 0.f);
  unsigned lx0 = 0, lx1 = 0, lxp0 = 0, lxp1 = 0, lxn0 = 0, lxn1 = 0;
  uint2 rr_c, rr_p, rr_n, rk_c, rk_p, rk_n;
  unsigned rv_c, rv_p, rv_n, rw_c = 0, rw_p = 0, rw_n = 0;
  auto fetch = [&](int s0) {
    {
      int st2 = lidx0 >> 5, q = lidx0 & 31;
      int j = jmap(d, s0 + st2);
      int col = q < 16 ? (768 + d * 16 + q) : (800 + d * 16 + (q - 16));
      const u16* pr = proj + ((size_t)(b * TT + j)) * PC + C_RWX + col;
      const u16* prp = has_prev(j) ? pr - PC : pr;
      const u16* prn = has_next(j) ? pr + PC : pr;
      lx0 = pr[0]; lx1 = pr[1]; lxp0 = prp[0]; lxp1 = prp[1]; lxn0 = prn[0]; lxn1 = prn[1];
    }
    int j = jmap(d, s0 + pst);
    const u16* pr = proj + ((size_t)(b * TT + j)) * PC + C_RWX;
    const u16* prp = has_prev(j) ? pr - PC : pr;
    const u16* prn = has_next(j) ? pr + PC : pr;
    rr_c = *(const uint2*)(pr + ch0); rr_p = *(const uint2*)(prp + ch0); rr_n = *(const uint2*)(prn + ch0);
    rk_c = *(const uint2*)(pr + 256 + ch0); rk_p = *(const uint2*)(prp + 256 + ch0); rk_n = *(const uint2*)(prn + 256 + ch0);
    rv_c = pr[vch]; rv_p = prp[vch]; rv_n = prn[vch];
    if (TWO) { rw_c = pr[vch + 16]; rw_p = prp[vch + 16]; rw_n = prn[vch + 16]; }
  };
  auto unpack4 = [](uint2 v, float (&o)[4]) {
    o[0] = __uint_as_float(v.x << 16); o[1] = __uint_as_float(v.x & 0xffff0000u);
    o[2] = __uint_as_float(v.y << 16); o[3] = __uint_as_float(v.y & 0xffff0000u);
  };
  fetch(0);
  for (int s0 = 0; s0 < TT; s0 += 16) {
    {
      int st2 = lidx0 >> 5, q = lidx0 & 31;
      int ja = jmap(d, s0 + st2);
      const float hpa = has_prev(ja) ? 1.f : 0.f, hna = has_next(ja) ? 1.f : 0.f;
      float x0 = __uint_as_float(lx0 << 16), x1 = __uint_as_float(lx1 << 16);
      float xs0 = x0 + lmu00 * (__uint_as_float(lxp0 << 16) * hpa - x0) + lmu10 * (__uint_as_float(lxn0 << 16) * hna - x0);
      float xs1 = x1 + lmu01 * (__uint_as_float(lxp1 << 16) * hpa - x1) + lmu11 * (__uint_as_float(lxn1 << 16) * hna - x1);
      if (q < 16) {
        xs0 = 1.f - 2.f * __builtin_amdgcn_rcpf(__expf(2.f * xs0) + 1.f);
        xs1 = 1.f - 2.f * __builtin_amdgcn_rcpf(__expf(2.f * xs1) + 1.f);
      }
      *(float2*)(sh_lora + lidx0) = make_float2(xs0, xs1);
    }
    __syncthreads();
    const int jcur = jmap(d, s0 + pst);
    {
      const float hpf = has_prev(jcur) ? 1.f : 0.f, hnf = has_next(jcur) ? 1.f : 0.f;
      float r4[4], k4[4], t0[4], t1[4];
      unpack4(rr_c, r4); unpack4(rr_p, t0); unpack4(rr_n, t1);
#pragma unroll
      for (int i = 0; i < 4; i++) r4[i] = r4[i] + mur0[i] * (t0[i] * hpf - r4[i]) + mur1[i] * (t1[i] * hnf - r4[i]);
      unpack4(rk_c, k4); unpack4(rk_p, t0); unpack4(rk_n, t1);
#pragma unroll
      for (int i = 0; i < 4; i++) k4[i] = k4[i] + muk0[i] * (t0[i] * hpf - k4[i]) + muk1[i] * (t1[i] * hnf - k4[i]);
      float wl[4], al[4];
#pragma unroll
      for (int i = 0; i < 4; i++) { wl[i] = w0v[i]; al[i] = a0v[i]; }
      float lrow[32];
#pragma unroll
      for (int i4 = 0; i4 < 8; i4++) {
        float4 q4 = *(const float4*)(sh_lora + pst * 32 + i4 * 4);
        lrow[i4 * 4] = q4.x; lrow[i4 * 4 + 1] = q4.y; lrow[i4 * 4 + 2] = q4.z; lrow[i4 * 4 + 3] = q4.w;
      }
#pragma unroll
      for (int rr = 0; rr < 16; rr++) {
        float lw_ = lrow[rr], la_ = lrow[16 + rr];
        float4 w2 = *(const float4*)(sh_w2 + rr * 64 + cq * 4);
        float4 a2 = *(const float4*)(sh_a2 + rr * 64 + cq * 4);
        wl[0] += lw_ * w2.x; wl[1] += lw_ * w2.y; wl[2] += lw_ * w2.z; wl[3] += lw_ * w2.w;
        al[0] += la_ * a2.x; al[1] += la_ * a2.y; al[2] += la_ * a2.z; al[3] += la_ * a2.w;
      }
      float wv[4], kd[4], kk[4], bb[4];
      float ss = 0.f, bon = 0.f;
#pragma unroll
      for (int i = 0; i < 4; i++) {
        float a = wl[i];
        float lw = fminf(a, 0.f) - __logf(1.f + __expf(-fabsf(a))) - 0.5f;
        wv[i] = __expf(-__expf(lw));
        float ic = sigmoidf_(al[i]);
        float kr = k4[i] * kkw[i];
        kk[i] = kr; ss += kr * kr;
        kd[i] = k4[i] * (1.f + (ic - 1.f) * kaw[i]);
        bb[i] = ic;
        bon += r4[i] * kd[i] * rkw[i];
      }
      ss = allsum16(ss); bon = allsum16(bon);
      float inv = rsqrtf(fmaxf(ss, 1e-24f));
#pragma unroll
      for (int i = 0; i < 4; i++) { kk[i] *= inv; bb[i] *= kk[i]; }
      *(float4*)(sh_r + pst * 64 + cq * 4) = make_float4(r4[0], r4[1], r4[2], r4[3]);
      *(float4*)(sh_w + pst * 64 + cq * 4) = make_float4(wv[0], wv[1], wv[2], wv[3]);
      *(float4*)(sh_k + pst * 64 + cq * 4) = make_float4(kd[0], kd[1], kd[2], kd[3]);
      *(float4*)(sh_kk + pst * 64 + cq * 4) = make_float4(kk[0], kk[1], kk[2], kk[3]);
      *(float4*)(sh_b + pst * 64 + cq * 4) = make_float4(bb[0], bb[1], bb[2], bb[3]);
      if (rh == 0 && cq == 0) bonus[(size_t)(b * TT + jcur) * 4 + h] = bon;
      float xv = __uint_as_float(rv_c << 16);
      sh_v[pst * 32 + cq] = xv + muv0 * (__uint_as_float(rv_p << 16) * hpf - xv) + muv1 * (__uint_as_float(rv_n << 16) * hnf - xv);
      float xw = __uint_as_float(rw_c << 16);
      if (TWO) sh_v[pst * 32 + 16 + cq] = xw + muw0 * (__uint_as_float(rw_p << 16) * hpf - xw) + muw1 * (__uint_as_float(rw_n << 16) * hnf - xw);
    }
    __syncthreads();
    if (s0 + 16 < TT) fetch(s0 + 16);
    float oacc = 0.f, oacc2 = 0.f;
    {
      float4 nkk = *(const float4*)(sh_kk + ks * 4), nw = *(const float4*)(sh_w + ks * 4), nb4 = *(const float4*)(sh_b + ks * 4);
      float4 nk = *(const float4*)(sh_k + ks * 4), nr = *(const float4*)(sh_r + ks * 4);
      float nv = sh_v[rl], nv2 = sh_v[16 + rl];
#pragma unroll 4
      for (int st = 0; st < 16; st++) {
        const float4 kk4 = nkk, w4 = nw, b4 = nb4, k4 = nk, r4 = nr; const float vv = nv, vv2 = nv2;
        {
          const int sn = (st + 1) & 15;
          nkk = *(const float4*)(sh_kk + sn * 64 + ks * 4); nw = *(const float4*)(sh_w + sn * 64 + ks * 4);
          nb4 = *(const float4*)(sh_b + sn * 64 + ks * 4); nk = *(const float4*)(sh_k + sn * 64 + ks * 4);
          nr = *(const float4*)(sh_r + sn * 64 + ks * 4); nv = sh_v[sn * 32 + rl]; nv2 = sh_v[sn * 32 + 16 + rl];
        }
        float sa = -((S.x * kk4.x + S.y * kk4.y) + (S.z * kk4.z + S.w * kk4.w));
        float sa2 = 0.f;
        if (TWO) sa2 = -((S2.x * kk4.x + S2.y * kk4.y) + (S2.z * kk4.z + S2.w * kk4.w));
        sa = allsum16(sa); if (TWO) sa2 = allsum16(sa2);
        S.x = S.x * w4.x + (sa * b4.x + vv * k4.x);
        S.y = S.y * w4.y + (sa * b4.y + vv * k4.y);
        S.z = S.z * w4.z + (sa * b4.z + vv * k4.z);
        S.w = S.w * w4.w + (sa * b4.w + vv * k4.w);
        if (TWO) {
          S2.x = S2.x * w4.x + (sa2 * b4.x + vv2 * k4.x);
          S2.y = S2.y * w4.y + (sa2 * b4.y + vv2 * k4.y);
          S2.z = S2.z * w4.z + (sa2 * b4.z + vv2 * k4.z);
          S2.w = S2.w * w4.w + (sa2 * b4.w + vv2 * k4.w);
        }
        float o = (S.x * r4.x + S.y * r4.y) + (S.z * r4.z + S.w * r4.w);
        float o2 = 0.f;
        if (TWO) o2 = (S2.x * r4.x + S2.y * r4.y) + (S2.z * r4.z + S2.w * r4.w);
        o = allsum16(o); if (TWO) o2 = allsum16(o2);
        oacc = (ks == st) ? o : oacc;
        oacc2 = (ks == st) ? o2 : oacc2;
      }
    }
    sh_o[ks * 32 + rl] = oacc;
    if (TWO) sh_o[ks * 32 + 16 + rl] = oacc2;
    __syncthreads();
    {
      u16* op = rwo + (size_t)(b * TT + jcur) * 256 + h * 64 + rh * RPB + cq;
      op[0] = f2bf(sh_o[pst * 32 + cq]);
      if (TWO) op[16] = f2bf(sh_o[pst * 32 + 16 + cq]);
    }
  }
}

__device__ void rwkv_combine_rows(const Params& p, int layer, int row0, int latonly) {
  const int lane = tid_() & 63, h = tid_() >> 6;
  const int ch = h * 64 + lane;
  const u16* rwo = (const u16*)(p.ws + OFF_RWO);
  u16* proj = (u16*)(p.ws + OFF_PROJ);
  const float* mu0 = p.in[21] + (size_t)layer * 2 * 832; const float* mu1 = mu0 + 832;
  const float* bonus = (const float*)(p.ws + OFF_BONUS);
  const float gw = p.in[29][layer * 256 + ch], gb = p.in[30][layer * 256 + ch];
  const float m0 = mu0[512 + ch], m1 = mu1[512 + ch];
  const int vc = C_RWX + 512 + ch;
  float o[8], xv[8], xp[8], xn[8], bs[8], z[8];
#pragma unroll
  for (int i = 0; i < 8; i++) {
    const int row = row0 + i;
    const int j = row % TT;
    const u16* pr = proj + (size_t)row * PC;
    o[i] = bf2f(rwo[(size_t)row * 256 + ch]) + bf2f(rwo[(size_t)MROWS * 256 + (size_t)row * 256 + ch]);
    xv[i] = bf2f(pr[vc]);
    xp[i] = has_prev(j) ? bf2f(pr[vc - PC]) : 0.f;
    xn[i] = has_next(j) ? bf2f(pr[vc + PC]) : 0.f;
    bs[i] = bonus[(size_t)row * 4 + h] + bonus[(size_t)MROWS * 4 + (size_t)row * 4 + h];
    z[i] = bf2f(pr[C_RWZ + ch]);
  }
#pragma unroll
  for (int i = 0; i < 8; i++) {
    const int row = row0 + i;
    if (latonly && (row % TT) < 256) continue;
    float mean = wavesum(o[i]) * (1.f / 64.f);
    float dlt = o[i] - mean;
    float var = wavesum(dlt * dlt) * (1.f / 64.f);
    float on = dlt * rsqrtf(var + 64e-5f) * gw + gb;
    float v = xv[i] + m0 * (xp[i] - xv[i]) + m1 * (xn[i] - xv[i]);
    proj[(size_t)row * PC + C_RWZ + ch] = f2bf((on + bs[i] * v) * siluf_(z[i]));
  }
}

template <int MX, int PASS>
__device__ __forceinline__ void gla_sweep(const Params& p, int layer, int d, int b, int h, int c, float* lds) {
  const int t = tid_(), w = t >> 6, lane = t & 63;
  float* kbuf = lds;
  float* fbuf = kbuf + 1024;
  float* qbuf = fbuf + 1024;
  float* vbuf = qbuf + 1024;
  float* part = vbuf + 1024;
  u16* proj = (u16*)(p.ws + OFF_PROJ);
  const int dbh = (d * 8 + b) * 4 + h;
  float* stt = (float*)(p.ws + (MX == 0 ? OFF_HGST : OFF_RTST)) + ((size_t)dbh * 9 + c) * 4096;
  float S[16];
#pragma unroll
  for (int i = 0; i < 16; i++) S[i] = PASS == 1 ? 0.f : stt[(w * 16 + i) * 64 + lane];
  float gam = 1.f;
  if (MX == 1) gam = __expf(-__expf(p.in[20][((size_t)layer * 2 + d) * 4 + h]));
  float Pl = 1.f;
  const int pst = t >> 4, c4 = (t & 15) * 4;
  float lb4[4] = {0.f, 0.f, 0.f, 0.f};
  if (MX == 0 && layer == 1) {
#pragma unroll
    for (int i = 0; i < 4; i++) {
      float l0 = p.in[18][(0 * 2 + d) * 256 + h * 64 + c4 + i], l1 = p.in[18][(1 * 2 + d) * 256 + h * 64 + c4 + i];
      float mx = fmaxf(l0, l1);
      float e0 = __expf(l0 - mx), e1 = __expf(l1 - mx);
      lb4[i] = e1 / (e0 + e1);
    }
  }
  const int vcol0 = (MX == 0 ? C_HGI : C_RTV) + h * 64;
  const float* rope = (const float*)(p.ws + OFF_ROPE);
  uint2 r_a, r_b, r_c, r_d, r_v; float4 r_cs0, r_cs1;
  r_a = r_b = r_c = r_d = r_v = make_uint2(0u, 0u); r_cs0 = r_cs1 = make_float4(1.f, 0.f, 1.f, 0.f);
  auto fetch = [&](int s0) {
    int j = jmap(d, s0 + pst);
    const u16* pr = proj + (size_t)(b * TT + j) * PC;
    r_v = *(const uint2*)(pr + vcol0 + c4);
    if (MX == 0) {
      r_a = *(const uint2*)(pr + C_HGF + d * 256 + h * 64 + c4);
      if (PASS == 2) r_b = *(const uint2*)(pr + C_HGQ + h * 64 + c4);
    } else {
      r_a = *(const uint2*)(pr + C_RTK + h * 64 + c4);
      r_c = *(const uint2*)(pr + C_RTK + h * 64 + (c4 ^ 16));
      if (PASS == 2) { r_b = *(const uint2*)(pr + C_RTQ + h * 64 + c4); r_d = *(const uint2*)(pr + C_RTQ + h * 64 + (c4 ^ 16)); }
      if (j >= 256) {
        int tl = j - 256;
        int pos = (c4 & 32) ? (tl & 63) : (tl >> 6);
        const float* rp = rope + (pos * 16 + (c4 & 15)) * 2;
        r_cs0 = *(const float4*)rp; r_cs1 = *(const float4*)(rp + 4);
      } else { r_cs0 = make_float4(1.f, 0.f, 1.f, 0.f); r_cs1 = r_cs0; }
    }
  };
  auto unpack4 = [](uint2 v, float (&o)[4]) {
    o[0] = __uint_as_float(v.x << 16); o[1] = __uint_as_float(v.x & 0xffff0000u);
    o[2] = __uint_as_float(v.y << 16); o[3] = __uint_as_float(v.y & 0xffff0000u);
  };
  u16* ofp; int ofs;
  if (MX == 0) { ofp = proj + C_HGF + h * 64 + lane; ofs = PC; }
  else { ofp = (u16*)(p.ws + OFF_RETOF) + h * 64 + lane; ofs = 256; }
  const int zcol = (MX == 0 ? C_HGZ : C_RTZ) + h * 64 + lane;
  const int ycol = (MX == 0 ? C_HGQ : C_RTQ) + h * 64 + lane;
  float normw = 1.f;
  if (MX == 0 && PASS == 2) normw = p.in[19][layer * 256 + h * 64 + lane];
  fetch(c * 256);
  for (int sub = 0; sub < 16; sub++) {
    const int s0 = c * 256 + sub * 16;
    __syncthreads();
    {
      float va[4], vb[4], vc[4], vd[4], vv4[4];
      unpack4(r_a, va); unpack4(r_v, vv4);
      *(float4*)(vbuf + pst * 64 + c4) = make_float4(vv4[0], vv4[1], vv4[2], vv4[3]);
      if (MX == 0) {
        float f[4], k[4];
#pragma unroll
        for (int i = 0; i < 4; i++) { f[i] = lb4[i] + (1.f - lb4[i]) * sigmoidf_(va[i]); k[i] = 1.f - f[i]; }
        *(float4*)(kbuf + pst * 64 + c4) = make_float4(k[0], k[1], k[2], k[3]);
        *(float4*)(fbuf + pst * 64 + c4) = make_float4(f[0], f[1], f[2], f[3]);
        if (PASS == 2) {
          unpack4(r_b, vb);
          *(float4*)(qbuf + pst * 64 + c4) = make_float4(siluf_(vb[0]), siluf_(vb[1]), siluf_(vb[2]), siluf_(vb[3]));
        }
      } else {
        unpack4(r_c, vc);
        float cs[8] = {r_cs0.x, r_cs0.y, r_cs0.z, r_cs0.w, r_cs1.x, r_cs1.y, r_cs1.z, r_cs1.w};
        float sgn = (c4 & 16) ? 1.f : -1.f;
#pragma unroll
        for (int i = 0; i < 4; i++) va[i] = (va[i] * cs[2 * i] + sgn * vc[i] * cs[2 * i + 1]) * 0.125f;
        *(float4*)(kbuf + pst * 64 + c4) = make_float4(va[0], va[1], va[2], va[3]);
        if (PASS == 2) {
          unpack4(r_b, vb); unpack4(r_d, vd);
#pragma unroll
          for (int i = 0; i < 4; i++) vb[i] = vb[i] * cs[2 * i] + sgn * vd[i] * cs[2 * i + 1];
          *(float4*)(qbuf + pst * 64 + c4) = make_float4(vb[0], vb[1], vb[2], vb[3]);
        }
      }
    }
    __syncthreads();
    if (sub + 1 < 16) fetch(s0 + 16);
    u16 pf_o[4], pf_z[4];
    if (PASS == 2 && d == 1) {
#pragma unroll
      for (int e = 0; e < 4; e++) {
        size_t row = (size_t)(b * TT + jmap(d, s0 + w * 4 + e));
        pf_o[e] = ofp[row * ofs]; pf_z[e] = proj[row * PC + zcol];
      }
    }
#pragma unroll 2
    for (int st = 0; st < 16; st++) {
      const float vv = vbuf[st * 64 + lane];
      float o = 0.f;
#pragma unroll
      for (int i4 = 0; i4 < 4; i4++) {
        float4 kv = *(const float4*)(kbuf + st * 64 + w * 16 + i4 * 4);
        float4 fv = make_float4(gam, gam, gam, gam);
        if (MX == 0) fv = *(const float4*)(fbuf + st * 64 + w * 16 + i4 * 4);
        S[i4*4]   = fv.x * S[i4*4]   + kv.x * vv;
        S[i4*4+1] = fv.y * S[i4*4+1] + kv.y * vv;
        S[i4*4+2] = fv.z * S[i4*4+2] + kv.z * vv;
        S[i4*4+3] = fv.w * S[i4*4+3] + kv.w * vv;
        if (PASS == 2) {
          float4 qv = *(const float4*)(qbuf + st * 64 + w * 16 + i4 * 4);
          o += S[i4*4] * qv.x + S[i4*4+1] * qv.y + S[i4*4+2] * qv.z + S[i4*4+3] * qv.w;
        }
      }
      if (MX == 0 && PASS == 1) { if (lane < 16) Pl *= fbuf[st * 64 + w * 16 + lane]; }
      if (PASS == 2) part[(w * 16 + st) * 64 + lane] = o;
    }
    if (PASS == 2) {
      __syncthreads();
#pragma unroll
      for (int e = 0; e < 4; e++) {
        int st = w * 4 + e;
        float o = part[(0 * 16 + st) * 64 + lane] + part[(1 * 16 + st) * 64 + lane] + part[(2 * 16 + st) * 64 + lane] + part[(3 * 16 + st) * 64 + lane];
        int j = jmap(d, s0 + st);
        size_t row = (size_t)(b * TT + j);
        if (d == 0) {
          ofp[row * ofs] = f2bf(o);
        } else {
          o += bf2f(pf_o[e]);
          float ss = wavesum(o * o);
          float y = o * rsqrtf(ss * (1.f / 64.f) + 1e-6f) * normw;
          proj[row * PC + ycol] = f2bf(y * siluf_(bf2f(pf_z[e])));
        }
      }
    }
  }
  if (PASS == 1) {
#pragma unroll
    for (int i = 0; i < 16; i++) stt[(w * 16 + i) * 64 + lane] = S[i];
    if (MX == 0 && lane < 16) ((float*)(p.ws + OFF_HGP))[((size_t)dbh * 9 + c) * 64 + w * 16 + lane] = Pl;
  }
}

#define RS 72
template <int PASS>
__device__ __forceinline__ void ret_sweep(const Params& p, int layer, int d, int b, int h, int nc, int cstep, u16* lds) {
  const int t = tid_(), lane = t & 63, w4 = t >> 6;
  u16* Qs = lds;
  u16* Ks = Qs + 64 * RS;
  u16* Kt = Ks + 64 * RS;
  u16* Vt = Kt + 64 * RS;
  u16* Vd = Vt + 64 * RS;
  u16* Ps = Vd + 64 * RS;
  u16* St = Ps + 64 * RS;
  u16* proj = (u16*)(p.ws + OFF_PROJ);
  const float* rope = (const float*)(p.ws + OFF_ROPE);
  const float lg = -__expf(p.in[20][((size_t)layer * 2 + d) * 4 + h]) * 1.4426950408889634f;
  const float g64 = exp2f(64.f * lg);
  const int dbh = (d * 8 + b) * 4 + h;
  float* stt = (float*)(p.ws + OFF_RTST) + ((size_t)dbh * 9 + cstep) * 4096;
  f32x4 accS[4];
#pragma unroll
  for (int nt = 0; nt < 4; nt++)
#pragma unroll
    for (int r = 0; r < 4; r++)
      accS[nt][r] = PASS == 1 ? 0.f : stt[(w4 * 16 + (lane >> 4) * 4 + r) * 64 + nt * 16 + (lane & 15)];
  uint4 rq[2], rqp[2], rk[2], rkp[2], rv[2];
  auto fetch = [&](int w) {
#pragma unroll
    for (int e = 0; e < 2; e++) {
      const int q = t + 256 * e, sl = q & 63, c8 = (q >> 6) * 8;
      const u16* pr = proj + (size_t)(b * TT + nc * 256 + w * 64 + sl) * PC + h * 64;
      rk[e] = *(const uint4*)(pr + C_RTK + c8); rkp[e] = *(const uint4*)(pr + C_RTK + (c8 ^ 16));
      rv[e] = *(const uint4*)(pr + C_RTV + c8);
      if (PASS == 2) { rq[e] = *(const uint4*)(pr + C_RTQ + c8); rqp[e] = *(const uint4*)(pr + C_RTQ + (c8 ^ 16)); }
    }
  };
  auto up = [](uint4 v, float (&o)[8]) {
    const unsigned* u = (const unsigned*)&v;
#pragma unroll
    for (int i = 0; i < 4; i++) { o[2 * i] = __uint_as_float(u[i] << 16); o[2 * i + 1] = __uint_as_float(u[i] & 0xffff0000u); }
  };
  fetch(d == 0 ? 0 : 3);
  for (int wi = 0; wi < 4; wi++) {
    const int w = d == 0 ? wi : 3 - wi;
    __syncthreads();
    if (PASS == 2 && wi == 0) {
#pragma unroll
      for (int nt = 0; nt < 4; nt++)
        *(uint2*)(St + (nt * 16 + (lane & 15)) * RS + w4 * 16 + (lane >> 4) * 4) =
            make_uint2(pack2(accS[nt][0], accS[nt][1]), pack2(accS[nt][2], accS[nt][3]));
    }
#pragma unroll
    for (int e = 0; e < 2; e++) {
      const int q = t + 256 * e, sl = q & 63, c8 = (q >> 6) * 8;
      const int j = nc * 256 + w * 64 + sl;
      float kx[8], kp[8], vx[8], qx[8], qp[8];
      up(rk[e], kx); up(rkp[e], kp); up(rv[e], vx);
      if (PASS == 2) { up(rq[e], qx); up(rqp[e], qp); }
      if (j >= 256) {
        const int tl = j - 256;
        const int pos = (c8 & 32) ? (tl & 63) : (tl >> 6);
        const float* rp = rope + (pos * 16 + (c8 & 15)) * 2;
        const float sgn = (c8 & 16) ? 1.f : -1.f;
#pragma unroll
        for (int i2 = 0; i2 < 4; i2++) {
          const float4 cs = *(const float4*)(rp + i2 * 4);
          kx[2 * i2] = kx[2 * i2] * cs.x + sgn * kp[2 * i2] * cs.y;
          kx[2 * i2 + 1] = kx[2 * i2 + 1] * cs.z + sgn * kp[2 * i2 + 1] * cs.w;
          if (PASS == 2) {
            qx[2 * i2] = qx[2 * i2] * cs.x + sgn * qp[2 * i2] * cs.y;
            qx[2 * i2 + 1] = qx[2 * i2 + 1] * cs.z + sgn * qp[2 * i2 + 1] * cs.w;
          }
        }
      }
      const float dec = exp2f((float)(d == 0 ? 63 - sl : sl) * lg);
      u16 kb[8];
#pragma unroll
      for (int i = 0; i < 8; i++) {
        kb[i] = f2bf(kx[i] * 0.125f);
        Kt[(c8 + i) * RS + sl] = kb[i];
        Vd[(c8 + i) * RS + sl] = f2bf(vx[i] * dec);
      }
      if (PASS == 2) {
        uint4 kk4, qq4;
        kk4.x = kb[0] | ((unsigned)kb[1] << 16); kk4.y = kb[2] | ((unsigned)kb[3] << 16);
        kk4.z = kb[4] | ((unsigned)kb[5] << 16); kk4.w = kb[6] | ((unsigned)kb[7] << 16);
        qq4.x = pack2(qx[0], qx[1]); qq4.y = pack2(qx[2], qx[3]); qq4.z = pack2(qx[4], qx[5]); qq4.w = pack2(qx[6], qx[7]);
        *(uint4*)(Ks + sl * RS + c8) = kk4;
        *(uint4*)(Qs + sl * RS + c8) = qq4;
        const unsigned short* vraw = (const unsigned short*)&rv[e];
#pragma unroll
        for (int i = 0; i < 8; i++) Vt[(c8 + i) * RS + sl] = vraw[i];
      }
    }
    __syncthreads();
    if (wi + 1 < 4) fetch(d == 0 ? wi + 1 : 2 - wi);
    if (PASS == 2) {
      f32x4 accP[4];
#pragma unroll
      for (int nt = 0; nt < 4; nt++) accP[nt] = (f32x4){0.f, 0.f, 0.f, 0.f};
      bf16x8 aq[2];
#pragma unroll
      for (int kk = 0; kk < 2; kk++) aq[kk] = *(const bf16x8*)(Qs + (w4 * 16 + (lane & 15)) * RS + kk * 32 + (lane >> 4) * 8);
#pragma unroll
      for (int kk = 0; kk < 2; kk++)
#pragma unroll
        for (int nt = 0; nt < 4; nt++) {
          bf16x8 bk = *(const bf16x8*)(Ks + (nt * 16 + (lane & 15)) * RS + kk * 32 + (lane >> 4) * 8);
          accP[nt] = __builtin_amdgcn_mfma_f32_16x16x32_bf16(aq[kk], bk, accP[nt], 0, 0, 0);
        }
#pragma unroll
      for (int nt = 0; nt < 4; nt++)
#pragma unroll
        for (int r = 0; r < 4; r++) {
          const int il = w4 * 16 + (lane >> 4) * 4 + r, sl = nt * 16 + (lane & 15);
          const int e = d == 0 ? il - sl : sl - il;
          const float f = e >= 0 ? exp2f((float)e * lg) : 0.f;
          Ps[il * RS + sl] = f2bf(accP[nt][r] * f);
        }
      __syncthreads();
      f32x4 accO[4], accI[4];
#pragma unroll
      for (int nt = 0; nt < 4; nt++) { accO[nt] = (f32x4){0.f, 0.f, 0.f, 0.f}; accI[nt] = (f32x4){0.f, 0.f, 0.f, 0.f}; }
#pragma unroll
      for (int kk = 0; kk < 2; kk++) {
        bf16x8 ap = *(const bf16x8*)(Ps + (w4 * 16 + (lane & 15)) * RS + kk * 32 + (lane >> 4) * 8);
#pragma unroll
        for (int nt = 0; nt < 4; nt++) {
          bf16x8 bv = *(const bf16x8*)(Vt + (nt * 16 + (lane & 15)) * RS + kk * 32 + (lane >> 4) * 8);
          accO[nt] = __builtin_amdgcn_mfma_f32_16x16x32_bf16(ap, bv, accO[nt], 0, 0, 0);
          bf16x8 bs = *(const bf16x8*)(St + (nt * 16 + (lane & 15)) * RS + kk * 32 + (lane >> 4) * 8);
          accI[nt] = __builtin_amdgcn_mfma_f32_16x16x32_bf16(aq[kk], bs, accI[nt], 0, 0, 0);
        }
      }
      u16* ofp = (u16*)(p.ws + OFF_RETOF);
#pragma unroll
      for (int r = 0; r < 4; r++) {
        const int il = w4 * 16 + (lane >> 4) * 4 + r;
        const size_t row = (size_t)(b * TT + nc * 256 + w * 64 + il);
        const float rho = exp2f((float)(d == 0 ? il + 1 : 64 - il) * lg);
        float o[4], ss = 0.f;
#pragma unroll
        for (int nt = 0; nt < 4; nt++) {
          o[nt] = accO[nt][r] + rho * accI[nt][r];
          if (d == 1) o[nt] += bf2f(ofp[row * 256 + h * 64 + nt * 16 + (lane & 15)]);
          ss += o[nt] * o[nt];
        }
        if (d == 0) {
#pragma unroll
          for (int nt = 0; nt < 4; nt++) ofp[row * 256 + h * 64 + nt * 16 + (lane & 15)] = f2bf(o[nt]);
        } else {
          ss = allsum16(ss);
          const float sc = rsqrtf(ss * (1.f / 64.f) + 1e-6f);
#pragma unroll
          for (int nt = 0; nt < 4; nt++) {
            const int cv = h * 64 + nt * 16 + (lane & 15);
            const float z = bf2f(proj[row * PC + C_RTZ + cv]);
            proj[row * PC + C_RTQ + cv] = f2bf(o[nt] * sc * siluf_(z));
          }
        }
      }
    }
#pragma unroll
    for (int nt = 0; nt < 4; nt++)
#pragma unroll
      for (int r = 0; r < 4; r++) accS[nt][r] *= g64;
#pragma unroll
    for (int kk = 0; kk < 2; kk++) {
      bf16x8 ak = *(const bf16x8*)(Kt + (w4 * 16 + (lane & 15)) * RS + kk * 32 + (lane >> 4) * 8);
#pragma unroll
      for (int nt = 0; nt < 4; nt++) {
        bf16x8 bv = *(const bf16x8*)(Vd + (nt * 16 + (lane & 15)) * RS + kk * 32 + (lane >> 4) * 8);
        accS[nt] = __builtin_amdgcn_mfma_f32_16x16x32_bf16(ak, bv, accS[nt], 0, 0, 0);
      }
    }
    __syncthreads();
    if (PASS == 2 && wi + 1 < 4) {
#pragma unroll
      for (int nt = 0; nt < 4; nt++)
        *(uint2*)(St + (nt * 16 + (lane & 15)) * RS + w4 * 16 + (lane >> 4) * 4) =
            make_uint2(pack2(accS[nt][0], accS[nt][1]), pack2(accS[nt][2], accS[nt][3]));
    }
  }
  if (PASS == 1) {
#pragma unroll
    for (int nt = 0; nt < 4; nt++)
#pragma unroll
      for (int r = 0; r < 4; r++) stt[(w4 * 16 + (lane >> 4) * 4 + r) * 64 + nt * 16 + (lane & 15)] = accS[nt][r];
  }
}
__device__ void gla_p1_task(const Params& p, int layer, int task, float* lds) {
  int c = task % 9; int q = task / 9; int h = q & 3; q >>= 2; int b = q & 7; q >>= 3; int d = q & 1; int mx = q >> 1;
  if (mx == 0) gla_sweep<0, 1>(p, layer, d, b, h, c, lds);
  else { const int nc = d == 0 ? c : (c == 0 ? 0 : 9 - c); ret_sweep<1>(p, layer, d, b, h, nc, c, (u16*)lds); }
}
__device__ void gla_p2_task(const Params& p, int layer, int mx, int b, int h, int nc, float* lds) {
  int cb = nc == 0 ? 0 : 9 - nc;
  if (mx == 0) { gla_sweep<0, 2>(p, layer, 0, b, h, nc, lds); __threadfence_block(); gla_sweep<0, 2>(p, layer, 1, b, h, cb, lds); }
  else { ret_sweep<2>(p, layer, 0, b, h, nc, nc, (u16*)lds); __threadfence_block(); ret_sweep<2>(p, layer, 1, b, h, nc, cb, (u16*)lds); }
}
__device__ void gla_carry_task(const Params& p, int layer, int task) {
  int e = task * 256 + tid_();
  int v = e & 63, k = (e >> 6) & 63, dbh = (e >> 12) & 63, mx = e >> 18;
  float* stt = (float*)(p.ws + (mx == 0 ? OFF_HGST : OFF_RTST)) + (size_t)dbh * 9 * 4096 + k * 64 + v;
  const float* P = (const float*)(p.ws + OFF_HGP) + (size_t)dbh * 9 * 64 + k;
  float pg = 1.f;
  if (mx == 1) { int d = dbh >> 5, h = dbh & 3; pg = __expf(-256.f * __expf(p.in[20][((size_t)layer * 2 + d) * 4 + h])); }
  float S = 0.f;
  for (int c = 0; c < 9; c++) {
    float E = stt[(size_t)c * 4096];
    stt[(size_t)c * 4096] = S;
    float pp = mx == 0 ? P[c * 64] : pg;
    S = pp * S + E;
  }
}

__device__ __forceinline__ int s5_bwd_chunk(int nc) { return nc < 4 ? 3 - nc : 39 - nc; }
template <int PASS>
__device__ void s5_task(const Params& p, int layer, int task, float* lds) {
  const int t = tid_(), w = t >> 6, lane = t & 63;
  int gq = task & 3; int q = task >> 2; int nc = q % 36; int b = q / 36;
  const int g = gq * 4 + w;
  float* ubuf = lds + w * 256;
  u16* hbuf = (u16*)(lds + 1024) + w * (16 * 136);
  float* ybuf = lds + 1024 + 4352 + w * 1024;
  u16* proj = (u16*)(p.ws + OFF_PROJ);
  float2* st5 = (float2*)(p.ws + OFF_S5ST);
  bf16x8 cfrag[4];
  if (PASS == 2) {
    const float* cre = p.in[13] + ((size_t)layer * 16 + g) * 16 * 64;
    const float* cim = p.in[14] + ((size_t)layer * 16 + g) * 16 * 64;
    int pp = lane & 15;
#pragma unroll
    for (int ks = 0; ks < 4; ks++)
#pragma unroll
      for (int i = 0; i < 8; i++) {
        int kidx = ks * 32 + (lane >> 4) * 8 + i; int n = kidx >> 1;
        float val = (kidx & 1) ? -cim[pp * 64 + n] : cre[pp * 64 + n];
        cfrag[ks][i] = (short)f2bf(val);
      }
  }
  for (int d = 0; d < 2; d++) {
    float lre = p.in[8][(((size_t)layer * 2 + d) * 16 + g) * 64 + lane];
    float lim = p.in[9][(((size_t)layer * 2 + d) * 16 + g) * 64 + lane];
    float dt = __expf(p.in[10][((size_t)layer * 2 + d) * 16 + g]);
    float mag = __expf(lre * dt);
    float sn, cs; sincosf(lim * dt, &sn, &cs);
    float are = mag * cs, aim = mag * sn;
    float den = 1.f / (lre * lre + lim * lim);
    float cre_ = ((are - 1.f) * lre + aim * lim) * den;
    float cim_ = (aim * lre - (are - 1.f) * lim) * den;
    float bbr[16], bbi[16];
    {
      const float* br = p.in[11] + (((size_t)layer * 16 + g) * 64 + lane) * 16;
      const float* bi = p.in[12] + (((size_t)layer * 16 + g) * 64 + lane) * 16;
#pragma unroll
      for (int i = 0; i < 16; i++) {
        float x = br[i], y = bi[i];
        bbr[i] = cre_ * x - cim_ * y; bbi[i] = cre_ * y + cim_ * x;
      }
    }
    int cstep = d == 0 ? nc : s5_bwd_chunk(nc);
    size_t sidx = ((((size_t)d * 8 + b) * 16 + g) * 36 + cstep) * 64 + lane;
    float hre = 0.f, him = 0.f;
    if (PASS == 2) { float2 h0 = st5[sidx]; hre = h0.x; him = h0.y; }
    uint2 ru;
    auto fetchu = [&](int sub) {
      int st = lane >> 2, p4 = (lane & 3) * 4;
      int jl = d == 0 ? sub * 16 + st : 63 - (sub * 16 + st);
      ru = *(const uint2*)(proj + (size_t)(b * TT + nc * 64 + jl) * PC + C_S5U + g * 16 + p4);
    };
    fetchu(0);
    for (int sub = 0; sub < 4; sub++) {
      __syncthreads();
      {
        int st = lane >> 2, p4 = (lane & 3) * 4;
        *(float4*)(ubuf + st * 16 + p4) = make_float4(__uint_as_float(ru.x << 16), __uint_as_float(ru.x & 0xffff0000u),
                                                       __uint_as_float(ru.y << 16), __uint_as_float(ru.y & 0xffff0000u));
      }
      __syncthreads();
      if (sub + 1 < 4) fetchu(sub + 1);
#pragma unroll 2
      for (int st = 0; st < 16; st++) {
        float bur = 0.f, bui = 0.f;
#pragma unroll
        for (int i4 = 0; i4 < 4; i4++) {
          float4 uu = *(const float4*)(ubuf + st * 16 + i4 * 4);
          bur += bbr[i4*4] * uu.x + bbr[i4*4+1] * uu.y + bbr[i4*4+2] * uu.z + bbr[i4*4+3] * uu.w;
          bui += bbi[i4*4] * uu.x + bbi[i4*4+1] * uu.y + bbi[i4*4+2] * uu.z + bbi[i4*4+3] * uu.w;
        }
        float nre = are * hre - aim * him + bur;
        float nim = are * him + aim * hre + bui;
        hre = nre; him = nim;
        if (PASS == 2) *(unsigned*)(hbuf + st * 136 + lane * 2) = pack2(hre, him);
      }
      if (PASS == 2) {
        __syncthreads();
        f32x4 acc = (f32x4){0.f, 0.f, 0.f, 0.f};
#pragma unroll
        for (int ks = 0; ks < 4; ks++) {
          bf16x8 af = *(const bf16x8*)(hbuf + (lane & 15) * 136 + ks * 32 + (lane >> 4) * 8);
          acc = __builtin_amdgcn_mfma_f32_16x16x32_bf16(af, cfrag[ks], acc, 0, 0, 0);
        }
#pragma unroll
        for (int r = 0; r < 4; r++) {
          int st = (lane >> 4) * 4 + r;
          int jl = d == 0 ? sub * 16 + st : 63 - (sub * 16 + st);
          float* yp = ybuf + jl * 16 + (lane & 15);
          if (d == 0) *yp = acc[r]; else *yp += acc[r];
        }
      }
    }
    if (PASS == 1) st5[sidx] = make_float2(hre, him);
  }
  if (PASS == 2) {
    __syncthreads();
    const float* dsk = p.in[15] + layer * 256 + g * 16;
#pragma unroll
    for (int i = 0; i < 16; i++) {
      int idx = lane + 64 * i; int jl = idx >> 4, pp = idx & 15;
      u16* up = proj + (size_t)(b * TT + nc * 64 + jl) * PC + C_S5U + g * 16 + pp;
      float y = ybuf[jl * 16 + pp] + dsk[pp] * bf2f(*up);
      *up = f2bf(geluf_(y));
    }
  }
}
__device__ void s5_carry_task(const Params& p, int layer, int task) {
  int e = task * 256 + tid_();
  int n = e & 63, g = (e >> 6) & 15, d = e >> 13;
  float lre = p.in[8][(((size_t)layer * 2 + d) * 16 + g) * 64 + n];
  float lim = p.in[9][(((size_t)layer * 2 + d) * 16 + g) * 64 + n];
  float dt = __expf(p.in[10][((size_t)layer * 2 + d) * 16 + g]);
  float mag = __expf(lre * dt * 64.f);
  float sn, cs; sincosf(lim * dt * 64.f, &sn, &cs);
  float are = mag * cs, aim = mag * sn;
  float2* st5 = (float2*)(p.ws + OFF_S5ST) + (size_t)(e >> 6) * 36 * 64 + n;
  float sre = 0.f, sim = 0.f;
  for (int c = 0; c < 36; c++) {
    float2 E = st5[(size_t)c * 64];
    st5[(size_t)c * 64] = make_float2(sre, sim);
    float nre = are * sre - aim * sim + E.x;
    float nim = are * sim + aim * sre + E.y;
    sre = nre; sim = nim;
  }
}

__device__ __forceinline__ void group_barrier(unsigned* cnt, unsigned target) {
  asm volatile("s_waitcnt vmcnt(0)" ::: "memory");
  __syncthreads();
  if (tid_() == 0) {
    __threadfence();
    asm volatile("s_waitcnt vmcnt(0)" ::: "memory");
    __hip_atomic_fetch_add(cnt, 1u, __ATOMIC_RELAXED, __HIP_MEMORY_SCOPE_AGENT);
    while (__hip_atomic_load(cnt, __ATOMIC_RELAXED, __HIP_MEMORY_SCOPE_AGENT) < target) __builtin_amdgcn_s_sleep(2);
    __threadfence();
    asm volatile("s_waitcnt vmcnt(0)" ::: "memory");
  }
  __syncthreads();
}
#define XB_XCNT(j) (64 * (j))
#define XB_XSUB(j) (1024 + 64 * (j))
#define XB_XGEN(j) (2048 + 64 * (j))
#define XB_TOP     3072
#define XB_TOPGEN  3136
#define XB_WORDS   8192
struct XcdBar { unsigned* bar; unsigned x, nloc, nx; };
__device__ __forceinline__ unsigned xb_ld(unsigned* q) { return __hip_atomic_load(q, __ATOMIC_RELAXED, __HIP_MEMORY_SCOPE_AGENT); }
__device__ __forceinline__ unsigned xb_add(unsigned* q, unsigned v) { return __hip_atomic_fetch_add(q, v, __ATOMIC_RELAXED, __HIP_MEMORY_SCOPE_AGENT); }
__device__ __forceinline__ void xcd_barrier(const XcdBar& b) {
  asm volatile("s_waitcnt vmcnt(0)" ::: "memory");
  __syncthreads();
  if (tid_() == 0) {
    unsigned* bar = b.bar;
    __builtin_amdgcn_s_waitcnt(0);
    const unsigned old = xb_add(&bar[XB_XSUB(b.x)], 1u);
    const unsigned gen = old / b.nloc;
    if (old + 1u == (gen + 1u) * b.nloc) {
      __builtin_amdgcn_fence(__ATOMIC_RELEASE, "agent");
      asm volatile("s_waitcnt vmcnt(0)" ::: "memory");
      const unsigned og = xb_add(&bar[XB_TOP], 1u);
      const unsigned tg = og / b.nx;
      if (og + 1u == (tg + 1u) * b.nx) xb_add(&bar[XB_TOPGEN], 1u);
      else while (xb_ld(&bar[XB_TOPGEN]) == tg) __builtin_amdgcn_s_sleep(1);
      __builtin_amdgcn_fence(__ATOMIC_ACQUIRE, "agent");
      xb_add(&bar[XB_XGEN(b.x)], 1u);
      asm volatile("s_waitcnt vmcnt(0)" ::: "memory");
    } else {
      while (xb_ld(&bar[XB_XGEN(b.x)]) == gen) __builtin_amdgcn_s_sleep(1);
      __builtin_amdgcn_fence(__ATOMIC_ACQUIRE, "agent");
      asm volatile("s_waitcnt vmcnt(0)" ::: "memory");
    }
  }
  __syncthreads();
}
#define LDS_FLOATS 18432
#define SYNC() xcd_barrier(xbar)
#define RW_TWO false
#define NRW (RW_TWO ? 128 : 256)

__global__ void __launch_bounds__(256, 2) fwd_megakernel(Params p) {
  cg::grid_group grid = cg::this_grid();
  __shared__ __attribute__((aligned(16))) float lds[LDS_FLOATS];
  const int bid = blockIdx.x, nb = gridDim.x, t = tid_();
  XcdBar xbar; xbar.bar = (unsigned*)(p.ws + OFF_XB); xbar.x = 0; xbar.nloc = 1; xbar.nx = 1;

  if (p.ws == nullptr) grid.sync();
  {
    unsigned xr; asm volatile("s_getreg_b32 %0, hwreg(HW_REG_XCC_ID)" : "=s"(xr));
    xbar.x = xr & 15u;
    if (t == 0) xb_add(&xbar.bar[XB_XCNT(xbar.x)], 1u + ((nb == 512 && bid >= NRW) ? 65536u : 0u));
  }
  for (int task = bid; task < N_CONVERT_TASKS + 96 + 1; task += nb) {
    if (task < 96) mods_task(p, task, lds);
    else if (task == 96) {
      float* rope = (float*)(p.ws + OFF_ROPE);
      for (int i = t; i < 1024; i += 256) {
        int pos = i >> 4, fi = i & 15;
        float fr = powf(10000.f, -(float)fi / 16.f);
        float ang = (float)pos * fr;
        rope[i * 2] = cosf(ang); rope[i * 2 + 1] = sinf(ang);
      }
    } else convert_task(p, 0, task - 97, lds);
  }
  XcdBar pbar; pbar.bar = xbar.bar + 4096; pbar.x = xbar.x; pbar.nloc = 1; pbar.nx = 1;
  if (t == 0) {
    unsigned nx, npx, nlocp;
    for (;;) {
      unsigned sum = 0; nx = 0; npx = 0; nlocp = 0;
#pragma unroll
      for (int j = 0; j < 16; j++) {
        const unsigned w = xb_ld(&xbar.bar[XB_XCNT(j)]);
        const unsigned c = w & 65535u, cp = w >> 16;
        sum += c; nx += c > 0u ? 1u : 0u; npx += cp > 0u ? 1u : 0u;
        if ((unsigned)j == xbar.x) { xbar.nloc = c; nlocp = cp; }
      }
      if (sum == (unsigned)nb) break;
      __builtin_amdgcn_s_sleep(4);
    }
    xbar.nx = nx; pbar.nx = npx > 0u ? npx : 1u; pbar.nloc = nlocp > 0u ? nlocp : 1u;
  }
  SYNC();
  for (int task = bid; task < MROWS / 4; task += nb) ln_row(p, 0, 0, task * 4 + (t >> 6));
  SYNC();

  for (int layer = 0; layer < 2; layer++) {
    const int latonly = layer;
    if ((nb & 7) == 0) { int tm, tn; for (int it = 0; xcd_tile(it, bid, nb, 144, 31, 6, tm, tn); it++) inproj_tile(p, layer, tm, tn, (u16*)lds); }
    else for (int task = bid; task < 144 * 31; task += nb) inproj_tile(p, layer, task / 31, task % 31, (u16*)lds);
    SYNC();
    {
      const int ncg = latonly ? 8 : 9, ncs = latonly ? 32 : 36;
      const int NG = 64 * ncg, NS = 32 * ncs;
      auto p2_task = [&](int task) {
        if (task < NG) {
          int nc = task % ncg + (latonly ? 1 : 0); int q = task / ncg; int h = q & 3; q >>= 2; int b = q & 7; int mx = q >> 3;
          gla_p2_task(p, layer, mx, b, h, nc, lds);
        } else {
          int q = task - NG; int gq = q & 3; q >>= 2; int nc = q % ncs + (latonly ? 4 : 0); int b = q / ncs;
          s5_task<2>(p, layer, ((b * 36 + nc) << 2) | gq, lds);
        }
      };
      if (nb == 512) {
        unsigned* bar = (unsigned*)(p.ws + OFF_BAR);
        const int ng = nb - NRW;
        if (bid < NRW) {
          rwkv_scan_task<RW_TWO>(p, layer, bid, lds);
          if (t == 0) {
            while (xb_ld(&pbar.bar[XB_TOPGEN]) < 2u * layer + 2u) __builtin_amdgcn_s_sleep(8);
            __threadfence();
          }
          __syncthreads();
        } else {
          const int gb = bid - NRW;
          for (int task = gb; task < 2304; task += ng) {
            if (task < 1152) gla_p1_task(p, layer, task, lds); else s5_task<1>(p, layer, task - 1152, lds);
          }
          xcd_barrier(pbar);
          for (int task = gb; task < 2048 + 64; task += ng) {
            if (task < 2048) gla_carry_task(p, layer, task); else s5_carry_task(p, layer, task - 2048);
          }
          xcd_barrier(pbar);
        }
        int* shq = (int*)(lds + LDS_FLOATS - 4);
        for (;;) {
          __syncthreads();
          if (t == 0) *shq = (int)__hip_atomic_fetch_add(bar + 1 + layer, 1u, __ATOMIC_RELAXED, __HIP_MEMORY_SCOPE_AGENT);
          __syncthreads();
          const int task = *shq;
          if (task >= NG + NS) break;
          p2_task(task);
        }
        SYNC();
      } else {
        for (int task = bid; task < NRW + 2304; task += nb) {
          if (task < NRW) rwkv_scan_task<RW_TWO>(p, layer, task, lds);
          else if (task < NRW + 1152) gla_p1_task(p, layer, task - NRW, lds);
          else s5_task<1>(p, layer, task - NRW - 1152, lds);
        }
        SYNC();
        for (int task = bid; task < 2048 + 64; task += nb) {
          if (task < 2048) gla_carry_task(p, layer, task); else s5_carry_task(p, layer, task - 2048);
        }
        SYNC();
        for (int task = bid; task < NG + NS; task += nb) p2_task(task);
        SYNC();
      }
    }
    {
      const int ntm = latonly ? 128 : 144;
      for (int task = bid; task < ntm * 2 + MROWS / 8; task += nb) {
        if (task < ntm * 2) glu_tile(p, layer, latonly, task >> 1, task & 1, (u16*)lds);
        else rwkv_combine_rows(p, layer, (task - ntm * 2) * 8, latonly);
      }
    }
    SYNC();
    {
      const int ntm = latonly ? 128 : 144;
      if ((nb & 7) == 0) { int tm, tn; for (int it = 0; xcd_tile(it, bid, nb, ntm, 16, 8, tm, tn); it++) merge_tile(p, layer, latonly, tm, tn, (u16*)lds); }
      else for (int task = bid; task < ntm * 16; task += nb) merge_tile(p, layer, latonly, task >> 4, task & 15, (u16*)lds);
    }
    SYNC();
    {
      const int ntm = latonly ? 128 : 144;
      if ((nb & 7) == 0) { int tm, tn; for (int it = 0; xcd_tile(it, bid, nb, ntm, 8, 8, tm, tn); it++) outproj_tile(p, layer, latonly, tm, tn, (u16*)lds); }
      else for (int task = bid; task < ntm * 8; task += nb) outproj_tile(p, layer, latonly, task >> 3, task & 7, (u16*)lds);
    }
    SYNC();
    if (layer == 0) {
      for (int task = bid; task < MROWS / 4 + N_CONVERT_TASKS; task += nb) {
        if (task < N_CONVERT_TASKS) convert_task(p, 1, task, lds);
        else ln_row(p, 1, 0, (task - N_CONVERT_TASKS) * 4 + (t >> 6));
      }
      SYNC();
    } else {
      for (int task = bid; task < NBATCH * 2048 / 4; task += nb) {
        int r = task * 4 + (t >> 6); int b = r >> 11, tl = r & 2047;
        ln_row(p, 1, 1, b * TT + 256 + tl);
      }
    }
  }
}

extern "C" void kernel_launch(void* const* d_in, const int* in_sizes, int n_in,
                              void* d_out, int out_size, void* d_ws, size_t ws_size,
                              hipStream_t stream) {
  static int grid_blocks = 0;
  if (!grid_blocks) {
    int dev = 0, cus = 0, per_cu = 0;
    (void)hipGetDevice(&dev);
    (void)hipDeviceGetAttribute(&cus, hipDeviceAttributeMultiprocessorCount, dev);
    (void)hipOccupancyMaxActiveBlocksPerMultiprocessor(&per_cu, fwd_megakernel, 256, 0);
    if (per_cu > 2) per_cu = 2;
    if (per_cu < 1) per_cu = 1;
    grid_blocks = cus * per_cu;
  }
  if (ws_size < WS_NEED) { fprintf(stderr, "workspace too small\n"); return; }
  Params p{};
  for (int i = 0; i < 36; i++) p.in[i] = (const float*)d_in[i];
  p.out = (float*)d_out;
  p.ws = (char*)d_ws;
  (void)hipMemsetAsync((char*)d_ws + OFF_BAR, 0, 256 + 32768, stream);
  void* args[] = {&p};
  hipError_t e = hipLaunchCooperativeKernel((void*)fwd_megakernel, dim3(grid_blocks), dim3(256), args, 0, stream);
  if (e != hipSuccess) fprintf(stderr, "cooperative launch failed: %s (grid %d)\n", hipGetErrorString(e), grid_blocks);
}
```

```cpp
#include <hip/hip_runtime.h>
#include <hip/hip_bf16.h>
#include <hip/hip_cooperative_groups.h>
#include <cstdio>
namespace cg = cooperative_groups;

typedef __attribute__((ext_vector_type(8))) short bf16x8;
typedef __attribute__((ext_vector_type(4))) float f32x4;
typedef unsigned short u16;

#define D_ 1024
#define NBATCH 8
#define TT 2304
#define MROWS 18432
#define PC 3904
#define DIN 8000
#define C_S5U 0
#define C_S5Z 256
#define C_HGQ 512
#define C_HGF 768
#define C_HGI 1280
#define C_HGZ 1536
#define C_RTQ 1792
#define C_RTK 2048
#define C_RTV 2304
#define C_RTZ 2560
#define C_RWX 2816
#define C_RWZ 3648

#define OFF_WINT   0ul
#define OFF_WBT    (OFF_WINT + 16384000ul)
#define OFF_WOT    (OFF_WBT + 2097152ul)
#define OFF_GLUT   (OFF_WOT + 2097152ul)
#define OFF_U      (OFF_GLUT + 131072ul)
#define OFF_PROJ   (OFF_U + 37748736ul)
#define OFF_HCTX   (OFF_PROJ + 143917056ul)
#define OFF_SCR    (OFF_HCTX + 8388608ul)
#define OFF_RWO    (OFF_SCR)
#define OFF_HGST   (OFF_SCR + 18874368ul)
#define OFF_RTST   (OFF_HGST + 9437184ul)
#define OFF_RETOF  (OFF_SCR + 37748736ul)
#define OFF_S5ST   (OFF_RETOF + 9437184ul)
#define OFF_MODS   (OFF_S5ST + 4718592ul)
#define OFF_HGP    (OFF_MODS + 221184ul)
#define OFF_BONUS  (OFF_HGP + 147456ul)
#define OFF_ROPE   (OFF_BONUS + 589824ul)
#define OFF_BAR    (OFF_ROPE + 8192ul)
#define OFF_XB     (OFF_BAR + 256ul)
#define WS_NEED    (OFF_XB + 32768ul)

struct Params {
  const float* in[36];
  float* out;
  char* ws;
};

__device__ __forceinline__ int tid_() { int t = __builtin_amdgcn_workitem_id_x(); asm volatile("" : "+v"(t)); return t; }
__device__ __forceinline__ u16 f2bf(float f) {
  unsigned u = __float_as_uint(f);
  u += 0x7fffu + ((u >> 16) & 1u);
  return (u16)(u >> 16);
}
__device__ __forceinline__ float bf2f(u16 h) { return __uint_as_float(((unsigned)h) << 16); }
__device__ __forceinline__ unsigned pack2(float a, float b) { return (unsigned)f2bf(a) | ((unsigned)f2bf(b) << 16); }
__device__ __forceinline__ float sigmoidf_(float x) { return __builtin_amdgcn_rcpf(1.f + __expf(-x)); }
__device__ __forceinline__ float siluf_(float x) { return x * __builtin_amdgcn_rcpf(1.f + __expf(-x)); }
__device__ __forceinline__ float geluf_(float x) {
  float t = tanhf(0.7978845608028654f * (x + 0.044715f * x * x * x));
  return 0.5f * x * (1.f + t);
}
template <int CTRL>
__device__ __forceinline__ float dppf(float x) {
  return __int_as_float(__builtin_amdgcn_update_dpp(0, __float_as_int(x), CTRL, 0xf, 0xf, true));
}
__device__ __forceinline__ float allsum16(float x) {
  x += dppf<0x128>(x);
  x += dppf<0x124>(x);
  x += dppf<0x122>(x);
  x += dppf<0x121>(x);
  return x;
}
__device__ __forceinline__ float wavesum(float x) {
  x = allsum16(x);
  x += __shfl_xor(x, 16, 64);
  x += __shfl_xor(x, 32, 64);
  return x;
}
__device__ __forceinline__ void ld4bf(const u16* p, float (&o)[4]) {
  uint2 v = *(const uint2*)p;
  o[0] = __uint_as_float(v.x << 16); o[1] = __uint_as_float(v.x & 0xffff0000u);
  o[2] = __uint_as_float(v.y << 16); o[3] = __uint_as_float(v.y & 0xffff0000u);
}
__device__ __forceinline__ void st4bf(u16* p, float a, float b, float c, float d) {
  uint2 v; v.x = pack2(a, b); v.y = pack2(c, d);
  *(uint2*)p = v;
}
__device__ __forceinline__ int jmap(int d, int s) { return d == 0 ? s : (s < 256 ? 255 - s : 2559 - s); }
__device__ __forceinline__ bool has_prev(int j) { return j != 0 && j != 256; }
__device__ __forceinline__ bool has_next(int j) { return j != 255 && j != 2303; }

__device__ __forceinline__ const float* hin_ptr(const Params& p, int layer, int row) {
  int b = row / TT, j = row - b * TT;
  if (layer == 0) return j < 256 ? p.in[2] + ((size_t)(b * 256 + j)) * D_ : p.in[0] + ((size_t)(b * 2048 + j - 256)) * D_;
  return j < 256 ? (const float*)(p.ws + OFF_HCTX) + ((size_t)(b * 256 + j)) * D_ : p.out + ((size_t)(b * 2048 + j - 256)) * D_;
}
__device__ __forceinline__ float* hout_ptr(const Params& p, int row) {
  int b = row / TT, j = row - b * TT;
  return j < 256 ? (float*)(p.ws + OFF_HCTX) + ((size_t)(b * 256 + j)) * D_ : p.out + ((size_t)(b * 2048 + j - 256)) * D_;
}
__device__ __forceinline__ int modrow_of(int row) { int b = row / TT, j = row - b * TT; return j < 256 ? 8 : b; }

__device__ void transpose_tile(const float* __restrict__ src, u16* __restrict__ dst, int K, int N, int k0, int n0, float* lds) {
  const int t = tid_();
  __syncthreads();
#pragma unroll
  for (int i = 0; i < 16; i++) {
    int r = i * 4 + (t >> 6), c = t & 63;
    lds[r * 65 + c] = src[(size_t)(k0 + r) * N + n0 + c];
  }
  __syncthreads();
#pragma unroll
  for (int i = 0; i < 16; i++) {
    int r = i * 4 + (t >> 6), c = t & 63;
    dst[(size_t)(n0 + r) * K + k0 + c] = f2bf(lds[c * 65 + r]);
  }
}
__device__ void convert_task(const Params& p, int layer, int task, float* lds) {
  if (task < 2000) {
    int kt = task / 125, nt = task % 125;
    transpose_tile(p.in[6] + (size_t)layer * 1024 * DIN, (u16*)(p.ws + OFF_WINT), 1024, DIN, kt * 64, nt * 64, lds);
  } else if (task < 2256) {
    int q = task - 2000; int br = q >> 6; q &= 63; int kt = q >> 4, nt = q & 15;
    transpose_tile(p.in[31] + ((size_t)layer * 4 + br) * 256 * 1024, (u16*)(p.ws + OFF_WBT) + (size_t)br * 1024 * 256, 256, 1024, kt * 64, nt * 64, lds);
  } else if (task < 2512) {
    int q = task - 2256; int kt = q >> 4, nt = q & 15;
    transpose_tile(p.in[32] + (size_t)layer * 1024 * 1024, (u16*)(p.ws + OFF_WOT), 1024, 1024, kt * 64, nt * 64, lds);
  } else {
    int q = task - 2512; int kt = q >> 2, nt = q & 3;
    transpose_tile(p.in[16] + (size_t)layer * 256 * 256, (u16*)(p.ws + OFF_GLUT), 256, 256, kt * 64, nt * 64, lds);
  }
}
#define N_CONVERT_TASKS 2528

__device__ void mods_task(const Params& p, int task, float* lds) {
  const int t = tid_();
  int layer = task / 96, cgp = task % 96;
  float* sc = lds;
  float* red = lds + 9 * 1024;
  __syncthreads();
  for (int i = t; i < 9 * 1024; i += 256) {
    int r = i >> 10, k = i & 1023;
    float v = r < 8 ? p.in[1][r * 1024 + k] : p.in[3][k];
    sc[i] = siluf_(v);
  }
  __syncthreads();
  const int cl = t & 31, kq = t >> 5;
  int col = cgp * 32 + cl;
  float acc[9];
#pragma unroll
  for (int r = 0; r < 9; r++) acc[r] = 0.f;
  const float* wp = p.in[4] + (size_t)layer * 1024 * 3072 + col;
#pragma unroll 16
  for (int k = kq * 128; k < kq * 128 + 128; k++) {
    float w = wp[(size_t)k * 3072];
#pragma unroll
    for (int r = 0; r < 9; r++) acc[r] += sc[r * 1024 + k] * w;
  }
#pragma unroll
  for (int r = 0; r < 9; r++) red[(kq * 9 + r) * 32 + cl] = acc[r];
  __syncthreads();
  float* mods = (float*)(p.ws + OFF_MODS);
  for (int i = t; i < 9 * 32; i += 256) {
    int r = i >> 5, c = i & 31;
    float s_ = 0.f;
#pragma unroll
    for (int g = 0; g < 8; g++) s_ += red[(g * 9 + r) * 32 + c];
    int cc = cgp * 32 + c;
    mods[((size_t)layer * 9 + r) * 3072 + cc] = s_ + p.in[5][layer * 3072 + cc];
  }
}

__device__ void ln_row(const Params& p, int mode, int layer, int row) {
  const int lane = tid_() & 63;
  float v[16];
  if (mode == 0) {
    const float* src = hin_ptr(p, 0, row);
#pragma unroll
    for (int i = 0; i < 4; i++) { float4 q = *(const float4*)(src + i * 256 + lane * 4); v[i*4]=q.x; v[i*4+1]=q.y; v[i*4+2]=q.z; v[i*4+3]=q.w; }
  } else {
    float* src = hout_ptr(p, row);
#pragma unroll
    for (int i = 0; i < 4; i++) { float4 q = *(const float4*)(src + i * 256 + lane * 4); v[i*4]=q.x; v[i*4+1]=q.y; v[i*4+2]=q.z; v[i*4+3]=q.w; }
    float s = 0.f;
#pragma unroll
    for (int i = 0; i < 16; i++) s += v[i];
    float mean = wavesum(s) * (1.f / 1024.f);
    float q2 = 0.f;
#pragma unroll
    for (int i = 0; i < 16; i++) { v[i] -= mean; q2 += v[i] * v[i]; }
    float rstd = rsqrtf(wavesum(q2) * (1.f / 1024.f) + 1e-5f);
    const float* lw = p.in[34] + layer * 1024; const float* lb = p.in[35] + layer * 1024;
#pragma unroll
    for (int i = 0; i < 4; i++) {
      float4 w4 = *(const float4*)(lw + i * 256 + lane * 4), b4 = *(const float4*)(lb + i * 256 + lane * 4);
      v[i*4] = v[i*4] * rstd * w4.x + b4.x; v[i*4+1] = v[i*4+1] * rstd * w4.y + b4.y;
      v[i*4+2] = v[i*4+2] * rstd * w4.z + b4.z; v[i*4+3] = v[i*4+3] * rstd * w4.w + b4.w;
      *(float4*)(src + i * 256 + lane * 4) = make_float4(v[i*4], v[i*4+1], v[i*4+2], v[i*4+3]);
    }
    if (layer == 1) return;
  }
  int ml = mode == 0 ? 0 : 1;
  float s = 0.f;
#pragma unroll
  for (int i = 0; i < 16; i++) s += v[i];
  float mean = wavesum(s) * (1.f / 1024.f);
  float q2 = 0.f;
#pragma unroll
  for (int i = 0; i < 16; i++) { v[i] -= mean; q2 += v[i] * v[i]; }
  float rstd = rsqrtf(wavesum(q2) * (1.f / 1024.f) + 1e-5f);
  const float* md = (const float*)(p.ws + OFF_MODS) + ((size_t)ml * 9 + modrow_of(row)) * 3072;
  u16* up = (u16*)(p.ws + OFF_U) + (size_t)row * 1024;
#pragma unroll
  for (int i = 0; i < 4; i++) {
    float4 sh = *(const float4*)(md + i * 256 + lane * 4), sc = *(const float4*)(md + 1024 + i * 256 + lane * 4);
    st4bf(up + i * 256 + lane * 4, v[i*4] * rstd * (1.f + sc.x) + sh.x, v[i*4+1] * rstd * (1.f + sc.y) + sh.y,
          v[i*4+2] * rstd * (1.f + sc.z) + sh.z, v[i*4+3] * rstd * (1.f + sc.w) + sh.w);
  }
}

#define STAGE_LOAD(P, kk_) do { const unsigned k_ = (kk_); \
  P##a0 = *(const uint4*)(A + (oa + k_)); P##a1 = *(const uint4*)(A + (oa + sa + k_)); \
  P##a2 = *(const uint4*)(A + (oa + 2 * sa + k_)); P##a3 = *(const uint4*)(A + (oa + 3 * sa + k_)); \
  P##b0 = *(const uint4*)(B + (ob + k_)); P##b1 = *(const uint4*)(B + (ob + sb + k_)); \
  if (NT == 4) { P##b2 = *(const uint4*)(B + (ob + 2 * sb + k_)); P##b3 = *(const uint4*)(B + (ob + 3 * sb + k_)); } } while (0)
#define STAGE_WRITE(P, Asw, Bsw) do { \
  *(uint4*)(Asw) = P##a0; *(uint4*)((Asw) + 32 * 72) = P##a1; *(uint4*)((Asw) + 64 * 72) = P##a2; *(uint4*)((Asw) + 96 * 72) = P##a3; \
  *(uint4*)(Bsw) = P##b0; *(uint4*)((Bsw) + 32 * 72) = P##b1; \
  if (NT == 4) { *(uint4*)((Bsw) + 64 * 72) = P##b2; *(uint4*)((Bsw) + 96 * 72) = P##b3; } } while (0)
template <int MT, int NT>
__device__ __forceinline__ void stage_compute(f32x4 (&acc)[MT][NT], const u16* As, const u16* Bs, int lane, int wm, int wn) {
#pragma unroll
  for (int kk = 0; kk < 2; kk++) {
    bf16x8 af[MT], bfr[NT];
#pragma unroll
    for (int mt = 0; mt < MT; mt++) af[mt] = *(const bf16x8*)(As + (wm * MT * 16 + mt * 16 + (lane & 15)) * 72 + kk * 32 + (lane >> 4) * 8);
#pragma unroll
    for (int nt = 0; nt < NT; nt++) bfr[nt] = *(const bf16x8*)(Bs + (wn * NT * 16 + nt * 16 + (lane & 15)) * 72 + kk * 32 + (lane >> 4) * 8);
    __builtin_amdgcn_s_setprio(1);
#pragma unroll
    for (int mt = 0; mt < MT; mt++)
#pragma unroll
      for (int nt = 0; nt < NT; nt++)
        acc[mt][nt] = __builtin_amdgcn_mfma_f32_16x16x32_bf16(af[mt], bfr[nt], acc[mt][nt], 0, 0, 0);
    __builtin_amdgcn_s_setprio(0);
  }
}
template <int MT, int NT>
__device__ __forceinline__ void gemm_kloop(f32x4 (&acc)[MT][NT], const u16* __restrict__ A, int lda,
                                           const u16* __restrict__ B, int ldb, int K, u16* lds) {
  static_assert(MT == 4, "MT");
  constexpr int BM = MT * 32, BN = NT * 32, SS = (BM + BN) * 72;
  const int t = tid_(), lane = t & 63, w = t >> 6, wm = w >> 1, wn = w & 1;
  u16* As0 = lds; u16* Bs0 = lds + BM * 72; u16* As1 = lds + SS; u16* Bs1 = lds + SS + BM * 72;
  const int lr = t >> 3, lc = (t & 7) * 8;
  const unsigned oa = (unsigned)(lr * lda + lc), ob = (unsigned)(lr * ldb + lc);
  const unsigned sa = 32u * (unsigned)lda, sb = 32u * (unsigned)ldb;
  const int swo = lr * 72 + lc;
  const unsigned klast = (unsigned)(K - 64);
  uint4 R0a0, R0a1, R0a2, R0a3, R0b0, R0b1, R0b2, R0b3, R1a0, R1a1, R1a2, R1a3, R1b0, R1b1, R1b2, R1b3;
  STAGE_LOAD(R0, 0u);
  STAGE_LOAD(R1, 64u);
  __syncthreads();
  STAGE_WRITE(R0, As0 + swo, Bs0 + swo);
  STAGE_LOAD(R0, 128u < klast ? 128u : klast);
  __syncthreads();
#pragma unroll 1
  for (int k0 = 0; k0 < K; k0 += 128) {
    STAGE_WRITE(R1, As1 + swo, Bs1 + swo);
    { unsigned kn = (unsigned)k0 + 192u; STAGE_LOAD(R1, kn < klast ? kn : klast); }
    stage_compute<MT, NT>(acc, As0, Bs0, lane, wm, wn);
    __syncthreads();
    STAGE_WRITE(R0, As0 + swo, Bs0 + swo);
    { unsigned kn = (unsigned)k0 + 256u; STAGE_LOAD(R0, kn < klast ? kn : klast); }
    stage_compute<MT, NT>(acc, As1, Bs1, lane, wm, wn);
    __syncthreads();
  }
}
template <int MT, int NT>
__device__ __forceinline__ void zero_acc(f32x4 (&acc)[MT][NT]) {
#pragma unroll
  for (int i = 0; i < MT; i++)
#pragma unroll
    for (int j = 0; j < NT; j++) acc[i][j] = (f32x4){0.f, 0.f, 0.f, 0.f};
}
__device__ __forceinline__ int tile_m0(int latonly, int tm) {
  if (!latonly) return tm * 128;
  int b = tm >> 4; return b * TT + 256 + (tm & 15) * 128;
}

__device__ __forceinline__ bool xcd_tile(int it, int bid, int nb, int NTM, int NTN, int G, int& tm, int& tn) {
  const int xcd = bid & 7, lb = bid >> 3, nlb = nb >> 3, tmx = NTM >> 3;
  const int idx = it * nlb + lb;
  if (idx >= tmx * NTN) return false;
  const int full = tmx / G;
  int g = idx / (G * NTN);
  if (g > full) g = full;
  const int r = idx - g * G * NTN;
  const int gs = (g < full) ? G : (tmx - full * G);
  tn = r / gs;
  tm = xcd * tmx + g * G + (r - tn * gs);
  return true;
}
__device__ void inproj_tile(const Params& p, int layer, int tm, int tn, u16* lds) {
  int m0 = tm * 128, n0 = tn * 128;
  f32x4 acc[4][4]; zero_acc(acc);
  gemm_kloop<4, 4>(acc, (const u16*)(p.ws + OFF_U) + (size_t)m0 * 1024, 1024,
                   (const u16*)(p.ws + OFF_WINT) + (size_t)n0 * 1024, 1024, 1024, lds);
  const int t = tid_(), lane = t & 63, w = t >> 6, wm = w >> 1, wn = w & 1;
  const float* bias = p.in[7] + (size_t)layer * DIN;
  u16* proj = (u16*)(p.ws + OFF_PROJ);
#pragma unroll
  for (int nt = 0; nt < 4; nt++) {
    const int cl = wn * 64 + nt * 16 + (lane & 15);
    const float bv = (n0 + cl < PC) ? bias[n0 + cl] : 0.f;
#pragma unroll
    for (int mt = 0; mt < 4; mt++)
#pragma unroll
      for (int r = 0; r < 4; r++) lds[(wm * 64 + mt * 16 + (lane >> 4) * 4 + r) * 136 + cl] = f2bf(acc[mt][nt][r] + bv);
  }
  __syncthreads();
#pragma unroll
  for (int i = 0; i < 8; i++) {
    const int q = t + 256 * i, row = q >> 4, ch = q & 15;
    if (n0 + ch * 8 < PC) *(uint4*)(proj + (size_t)(m0 + row) * PC + n0 + ch * 8) = *(const uint4*)(lds + row * 136 + ch * 8);
  }
}
__device__ void glu_tile(const Params& p, int layer, int latonly, int tm, int tn, u16* lds) {
  int m0 = tile_m0(latonly, tm), n0 = tn * 128;
  f32x4 acc[4][4]; zero_acc(acc);
  u16* proj = (u16*)(p.ws + OFF_PROJ);
  gemm_kloop<4, 4>(acc, proj + (size_t)m0 * PC + C_S5U, PC, (const u16*)(p.ws + OFF_GLUT) + (size_t)n0 * 256, 256, 256, lds);
  const int t = tid_(), lane = t & 63, w = t >> 6, wm = w >> 1, wn = w & 1;
  const float* bias = p.in[17] + layer * 256;
#pragma unroll
  for (int nt = 0; nt < 4; nt++) {
    const int cl = wn * 64 + nt * 16 + (lane & 15);
    const float bv = bias[n0 + cl];
#pragma unroll
    for (int mt = 0; mt < 4; mt++)
#pragma unroll
      for (int r = 0; r < 4; r++) lds[(wm * 64 + mt * 16 + (lane >> 4) * 4 + r) * 136 + cl] = f2bf(sigmoidf_(acc[mt][nt][r] + bv));
  }
  __syncthreads();
#pragma unroll
  for (int i = 0; i < 8; i++) {
    const int q = t + 256 * i, row = q >> 4, ch = q & 15;
    u16* pr = proj + (size_t)(m0 + row) * PC + n0 + ch * 8;
    uint4 sg = *(const uint4*)(lds + row * 136 + ch * 8);
    uint4 yy = *(const uint4*)(pr + C_S5U), zz = *(const uint4*)(pr + C_S5Z), oo;
    const unsigned* sgp = (const unsigned*)&sg; const unsigned* yp = (const unsigned*)&yy; const unsigned* zp = (const unsigned*)&zz; unsigned* op = (unsigned*)&oo;
#pragma unroll
    for (int e = 0; e < 4; e++) {
      float s0 = __uint_as_float(sgp[e] << 16), s1 = __uint_as_float(sgp[e] & 0xffff0000u);
      float y0 = __uint_as_float(yp[e] << 16), y1 = __uint_as_float(yp[e] & 0xffff0000u);
      float z0 = __uint_as_float(zp[e] << 16), z1 = __uint_as_float(zp[e] & 0xffff0000u);
      op[e] = pack2(y0 * s0 * siluf_(z0), y1 * s1 * siluf_(z1));
    }
    *(uint4*)(pr + C_S5Z) = oo;
  }
}
__device__ void merge_tile(const Params& p, int layer, int latonly, int tm, int tn, u16* lds) {
  int m0 = tile_m0(latonly, tm), n0 = tn * 64;
  f32x4 accm[4][2]; zero_acc(accm);
  const u16* proj = (const u16*)(p.ws + OFF_PROJ);
  const int lane = tid_() & 63, w = tid_() >> 6, wm = w >> 1, wn = w & 1;
  const float* bias = p.in[7] + (size_t)layer * DIN + PC;
#pragma unroll 1
  for (int k = 0; k < 4; k++) {
    const int ycol = k == 0 ? C_S5Z : (k == 1 ? C_HGQ : (k == 2 ? C_RTQ : C_RWZ));
    f32x4 accb[4][2]; zero_acc(accb);
    gemm_kloop<4, 2>(accb, proj + (size_t)m0 * PC + ycol, PC,
                     (const u16*)(p.ws + OFF_WBT) + ((size_t)k * 1024 + n0) * 256, 256, 256, lds);
    f32x4 accg[4][2]; zero_acc(accg);
    gemm_kloop<4, 2>(accg, (const u16*)(p.ws + OFF_U) + (size_t)m0 * 1024, 1024,
                     (const u16*)(p.ws + OFF_WINT) + ((size_t)PC + k * 1024 + n0) * 1024, 1024, 1024, lds);
#pragma unroll
    for (int nt = 0; nt < 2; nt++) {
      float bv = bias[k * 1024 + n0 + wn * 32 + nt * 16 + (lane & 15)];
#pragma unroll
      for (int mt = 0; mt < 4; mt++)
#pragma unroll
        for (int r = 0; r < 4; r++) accm[mt][nt][r] += sigmoidf_(accg[mt][nt][r] + bv) * accb[mt][nt][r];
    }
  }
  u16* mg = (u16*)(p.ws + OFF_SCR);
#pragma unroll
  for (int nt = 0; nt < 2; nt++) {
    const int cl = wn * 32 + nt * 16 + (lane & 15);
#pragma unroll
    for (int mt = 0; mt < 4; mt++)
#pragma unroll
      for (int r = 0; r < 4; r++) lds[(wm * 64 + mt * 16 + (lane >> 4) * 4 + r) * 72 + cl] = f2bf(accm[mt][nt][r]);
  }
  __syncthreads();
  {
    const int t = tid_();
#pragma unroll
    for (int i = 0; i < 4; i++) {
      const int q = t + 256 * i, row = q >> 3, ch = q & 7;
      *(uint4*)(mg + (size_t)(m0 + row) * 1024 + n0 + ch * 8) = *(const uint4*)(lds + row * 72 + ch * 8);
    }
  }
}
__device__ void outproj_tile(const Params& p, int layer, int latonly, int tm, int tn, u16* lds) {
  int m0 = tile_m0(latonly, tm), n0 = tn * 128;
  f32x4 acc[4][4]; zero_acc(acc);
  gemm_kloop<4, 4>(acc, (const u16*)(p.ws + OFF_SCR) + (size_t)m0 * 1024, 1024,
                   (const u16*)(p.ws + OFF_WOT) + (size_t)n0 * 1024, 1024, 1024, lds);
  const int lane = tid_() & 63, w = tid_() >> 6, wm = w >> 1, wn = w & 1;
  const float* bias = p.in[33] + layer * 1024;
  const float* hi0 = hin_ptr(p, layer, m0);
  float* ho0 = hout_ptr(p, m0);
  const float* gate = (const float*)(p.ws + OFF_MODS) + ((size_t)layer * 9 + modrow_of(m0)) * 3072 + 2048;
  float* cs = (float*)lds;
#pragma unroll
  for (int nt = 0; nt < 4; nt++) {
    const int cl = wn * 64 + nt * 16 + (lane & 15);
    const float bv = bias[n0 + cl];
#pragma unroll
    for (int mt = 0; mt < 4; mt++)
#pragma unroll
      for (int r = 0; r < 4; r++) cs[(wm * 64 + mt * 16 + (lane >> 4) * 4 + r) * 132 + cl] = acc[mt][nt][r] + bv;
  }
  __syncthreads();
  {
    const int t = tid_();
#pragma unroll 4
    for (int i = 0; i < 16; i++) {
      const int q = t + 256 * i, row = q >> 5, ch = q & 31;
      const float4 a4 = *(const float4*)(cs + row * 132 + ch * 4);
      const float4 g4 = *(const float4*)(gate + n0 + ch * 4);
      const float4 h4 = *(const float4*)(hi0 + (size_t)row * 1024 + n0 + ch * 4);
      float4 o4;
      o4.x = 1.4142135623730951f * h4.x + g4.x * a4.x; o4.y = 1.4142135623730951f * h4.y + g4.y * a4.y;
      o4.z = 1.4142135623730951f * h4.z + g4.z * a4.z; o4.w = 1.4142135623730951f * h4.w + g4.w * a4.w;
      *(float4*)(ho0 + (size_t)row * 1024 + n0 + ch * 4) = o4;
    }
  }
}

template <bool TWO>
__device__ void rwkv_scan_task(const Params& p, int layer, int task, float* lds) {
  const int t = tid_();
  const int rh = TWO ? (task & 1) : (task & 3), h = TWO ? ((task >> 1) & 3) : ((task >> 2) & 3);
  const int b = TWO ? ((task >> 3) & 7) : ((task >> 4) & 7), d = TWO ? (task >> 6) : (task >> 7);
  constexpr int RPB = TWO ? 32 : 16;
  float* sh_lora = lds;
  float* sh_w2 = sh_lora + 512;
  float* sh_a2 = sh_w2 + 1024;
  float* sh_r = sh_a2 + 1024;
  float* sh_w = sh_r + 1024;
  float* sh_k = sh_w + 1024;
  float* sh_kk = sh_k + 1024;
  float* sh_b = sh_kk + 1024;
  float* sh_v = sh_b + 1024;
  float* sh_o = sh_v + 512;
  const u16* proj = (const u16*)(p.ws + OFF_PROJ);
  u16* rwo = (u16*)(p.ws + OFF_RWO) + (size_t)d * MROWS * 256;
  float* bonus = (float*)(p.ws + OFF_BONUS) + (size_t)d * MROWS * 4;
  const float* mu0 = p.in[21] + (size_t)layer * 2 * 832;
  const float* mu1 = mu0 + 832;
  __syncthreads();
  for (int i = t; i < 1024; i += 256) {
    int rr = i >> 6, c = i & 63;
    sh_w2[i] = p.in[23][(((size_t)layer * 2 + d) * 16 + rr) * 256 + h * 64 + c];
    sh_a2[i] = p.in[25][(((size_t)layer * 2 + d) * 16 + rr) * 256 + h * 64 + c];
  }
  const int pst = t >> 4, cq = t & 15;
  const int ch0 = h * 64 + cq * 4;
  float mur0[4], mur1[4], muk0[4], muk1[4], w0v[4], a0v[4], kkw[4], kaw[4], rkw[4];
#pragma unroll
  for (int i = 0; i < 4; i++) {
    mur0[i] = mu0[ch0 + i]; mur1[i] = mu1[ch0 + i];
    muk0[i] = mu0[256 + ch0 + i]; muk1[i] = mu1[256 + ch0 + i];
    w0v[i] = p.in[22][((size_t)layer * 2 + d) * 256 + ch0 + i];
    a0v[i] = p.in[24][((size_t)layer * 2 + d) * 256 + ch0 + i];
    kkw[i] = p.in[26][layer * 256 + ch0 + i];
    kaw[i] = p.in[27][layer * 256 + ch0 + i];
    rkw[i] = p.in[28][layer * 256 + ch0 + i];
  }
  const int vch = 512 + h * 64 + rh * RPB + cq;
  const float muv0 = mu0[vch], muv1 = mu1[vch], muw0 = TWO ? mu0[vch + 16] : 0.f, muw1 = TWO ? mu1[vch + 16] : 0.f;
  const int lidx0 = t * 2;
  float lmu00, lmu01, lmu10, lmu11;
  {
    int q = lidx0 & 31;
    int col = q < 16 ? (768 + d * 16 + q) : (800 + d * 16 + (q - 16));
    lmu00 = mu0[col]; lmu01 = mu0[col + 1]; lmu10 = mu1[col]; lmu11 = mu1[col + 1];
  }
  const int rl = t >> 4, ks = t & 15;
  float4 S = make_float4(0.f, 0.f, 0.f, 0.f), S2 = make_float4(0.f, 0.f, 0.f, 0.f);
  unsigned lx0 = 0, lx1 = 0, lxp0 = 0, lxp1 = 0, lxn0 = 0, lxn1 = 0;
  uint2 rr_c, rr_p, rr_n, rk_c, rk_p, rk_n;
  unsigned rv_c, rv_p, rv_n, rw_c = 0, rw_p = 0, rw_n = 0;
  auto fetch = [&](int s0) {
    {
      int st2 = lidx0 >> 5, q = lidx0 & 31;
      int j = jmap(d, s0 + st2);
      int col = q < 16 ? (768 + d * 16 + q) : (800 + d * 16 + (q - 16));
      const u16* pr = proj + ((size_t)(b * TT + j)) * PC + C_RWX + col;
      const u16* prp = has_prev(j) ? pr - PC : pr;
      const u16* prn = has_next(j) ? pr + PC : pr;
      lx0 = pr[0]; lx1 = pr[1]; lxp0 = prp[0]; lxp1 = prp[1]; lxn0 = prn[0]; lxn1 = prn[1];
    }
    int j = jmap(d, s0 + pst);
    const u16* pr = proj + ((size_t)(b * TT + j)) * PC + C_RWX;
    const u16* prp = has_prev(j) ? pr - PC : pr;
    const u16* prn = has_next(j) ? pr + PC : pr;
    rr_c = *(const uint2*)(pr + ch0); rr_p = *(const uint2*)(prp + ch0); rr_n = *(const uint2*)(prn + ch0);
    rk_c = *(const uint2*)(pr + 256 + ch0); rk_p = *(const uint2*)(prp + 256 + ch0); rk_n = *(const uint2*)(prn + 256 + ch0);
    rv_c = pr[vch]; rv_p = prp[vch]; rv_n = prn[vch];
    if (TWO) { rw_c = pr[vch + 16]; rw_p = prp[vch + 16]; rw_n = prn[vch + 16]; }
  };
  auto unpack4 = [](uint2 v, float (&o)[4]) {
    o[0] = __uint_as_float(v.x << 16); o[1] = __uint_as_float(v.x & 0xffff0000u);
    o[2] = __uint_as_float(v.y << 16); o[3] = __uint_as_float(v.y & 0xffff0000u);
  };
  fetch(0);
  for (int s0 = 0; s0 < TT; s0 += 16) {
    {
      int st2 = lidx0 >> 5, q = lidx0 & 31;
      int ja = jmap(d, s0 + st2);
      const float hpa = has_prev(ja) ? 1.f : 0.f, hna = has_next(ja) ? 1.f : 0.f;
      float x0 = __uint_as_float(lx0 << 16), x1 = __uint_as_float(lx1 << 16);
      float xs0 = x0 + lmu00 * (__uint_as_float(lxp0 << 16) * hpa - x0) + lmu10 * (__uint_as_float(lxn0 << 16) * hna - x0);
      float xs1 = x1 + lmu01 * (__uint_as_float(lxp1 << 16) * hpa - x1) + lmu11 * (__uint_as_float(lxn1 << 16) * hna - x1);
      if (q < 16) {
        xs0 = 1.f - 2.f * __builtin_amdgcn_rcpf(__expf(2.f * xs0) + 1.f);
        xs1 = 1.f - 2.f * __builtin_amdgcn_rcpf(__expf(2.f * xs1) + 1.f);
      }
      *(float2*)(sh_lora + lidx0) = make_float2(xs0, xs1);
    }
    __syncthreads();
    const int jcur = jmap(d, s0 + pst);
    {
      const float hpf = has_prev(jcur) ? 1.f : 0.f, hnf = has_next(jcur) ? 1.f : 0.f;
      float r4[4], k4[4], t0[4], t1[4];
      unpack4(rr_c, r4); unpack4(rr_p, t0); unpack4(rr_n, t1);
#pragma unroll
      for (int i = 0; i < 4; i++) r4[i] = r4[i] + mur0[i] * (t0[i] * hpf - r4[i]) + mur1[i] * (t1[i] * hnf - r4[i]);
      unpack4(rk_c, k4); unpack4(rk_p, t0); unpack4(rk_n, t1);
#pragma unroll
      for (int i = 0; i < 4; i++) k4[i] = k4[i] + muk0[i] * (t0[i] * hpf - k4[i]) + muk1[i] * (t1[i] * hnf - k4[i]);
      float wl[4], al[4];
#pragma unroll
      for (int i = 0; i < 4; i++) { wl[i] = w0v[i]; al[i] = a0v[i]; }
      float lrow[32];
#pragma unroll
      for (int i4 = 0; i4 < 8; i4++) {
        float4 q4 = *(const float4*)(sh_lora + pst * 32 + i4 * 4);
        lrow[i4 * 4] = q4.x; lrow[i4 * 4 + 1] = q4.y; lrow[i4 * 4 + 2] = q4.z; lrow[i4 * 4 + 3] = q4.w;
      }
#pragma unroll
      for (int rr = 0; rr < 16; rr++) {
        float lw_ = lrow[rr], la_ = lrow[16 + rr];
        float4 w2 = *(const float4*)(sh_w2 + rr * 64 + cq * 4);
        float4 a2 = *(const float4*)(sh_a2 + rr * 64 + cq * 4);
        wl[0] += lw_ * w2.x; wl[1] += lw_ * w2.y; wl[2] += lw_ * w2.z; wl[3] += lw_ * w2.w;
        al[0] += la_ * a2.x; al[1] += la_ * a2.y; al[2] += la_ * a2.z; al[3] += la_ * a2.w;
      }
      float wv[4], kd[4], kk[4], bb[4];
      float ss = 0.f, bon = 0.f;
#pragma unroll
      for (int i = 0; i < 4; i++) {
        float a = wl[i];
        float lw = fminf(a, 0.f) - __logf(1.f + __expf(-fabsf(a))) - 0.5f;
        wv[i] = __expf(-__expf(lw));
        float ic = sigmoidf_(al[i]);
        float kr = k4[i] * kkw[i];
        kk[i] = kr; ss += kr * kr;
        kd[i] = k4[i] * (1.f + (ic - 1.f) * kaw[i]);
        bb[i] = ic;
        bon += r4[i] * kd[i] * rkw[i];
      }
      ss = allsum16(ss); bon = allsum16(bon);
      float inv = rsqrtf(fmaxf(ss, 1e-24f));
#pragma unroll
      for (int i = 0; i < 4; i++) { kk[i] *= inv; bb[i] *= kk[i]; }
      *(float4*)(sh_r + pst * 64 + cq * 4) = make_float4(r4[0], r4[1], r4[2], r4[3]);
      *(float4*)(sh_w + pst * 64 + cq * 4) = make_float4(wv[0], wv[1], wv[2], wv[3]);
      *(float4*)(sh_k + pst * 64 + cq * 4) = make_float4(kd[0], kd[1], kd[2], kd[3]);
      *(float4*)(sh_kk + pst * 64 + cq * 4) = make_float4(kk[0], kk[1], kk[2], kk[3]);
      *(float4*)(sh_b + pst * 64 + cq * 4) = make_float4(bb[0], bb[1], bb[2], bb[3]);
      if (rh == 0 && cq == 0) bonus[(size_t)(b * TT + jcur) * 4 + h] = bon;
      float xv = __uint_as_float(rv_c << 16);
      sh_v[pst * 32 + cq] = xv + muv0 * (__uint_as_float(rv_p << 16) * hpf - xv) + muv1 * (__uint_as_float(rv_n << 16) * hnf - xv);
      float xw = __uint_as_float(rw_c << 16);
      if (TWO) sh_v[pst * 32 + 16 + cq] = xw + muw0 * (__uint_as_float(rw_p << 16) * hpf - xw) + muw1 * (__uint_as_float(rw_n << 16) * hnf - xw);
    }
    __syncthreads();
    if (s0 + 16 < TT) fetch(s0 + 16);
    float oacc = 0.f, oacc2 = 0.f;
    {
      float4 nkk = *(const float4*)(sh_kk + ks * 4), nw = *(const float4*)(sh_w + ks * 4), nb4 = *(const float4*)(sh_b + ks * 4);
      float4 nk = *(const float4*)(sh_k + ks * 4), nr = *(const float4*)(sh_r + ks * 4);
      float nv = sh_v[rl], nv2 = sh_v[16 + rl];
#pragma unroll 4
      for (int st = 0; st < 16; st++) {
        const float4 kk4 = nkk, w4 = nw, b4 = nb4, k4 = nk, r4 = nr; const float vv = nv, vv2 = nv2;
        {
          const int sn = (st + 1) & 15;
          nkk = *(const float4*)(sh_kk + sn * 64 + ks * 4); nw = *(const float4*)(sh_w + sn * 64 + ks * 4);
          nb4 = *(const float4*)(sh_b + sn * 64 + ks * 4); nk = *(const float4*)(sh_k + sn * 64 + ks * 4);
          nr = *(const float4*)(sh_r + sn * 64 + ks * 4); nv = sh_v[sn * 32 + rl]; nv2 = sh_v[sn * 32 + 16 + rl];
        }
        float sa = -((S.x * kk4.x + S.y * kk4.y) + (S.z * kk4.z + S.w * kk4.w));
        float sa2 = 0.f;
        if (TWO) sa2 = -((S2.x * kk4.x + S2.y * kk4.y) + (S2.z * kk4.z + S2.w * kk4.w));
        sa = allsum16(sa); if (TWO) sa2 = allsum16(sa2);
        S.x = S.x * w4.x + (sa * b4.x + vv * k4.x);
        S.y = S.y * w4.y + (sa * b4.y + vv * k4.y);
        S.z = S.z * w4.z + (sa * b4.z + vv * k4.z);
        S.w = S.w * w4.w + (sa * b4.w + vv * k4.w);
        if (TWO) {
          S2.x = S2.x * w4.x + (sa2 * b4.x + vv2 * k4.x);
          S2.y = S2.y * w4.y + (sa2 * b4.y + vv2 * k4.y);
          S2.z = S2.z * w4.z + (sa2 * b4.z + vv2 * k4.z);
          S2.w = S2.w * w4.w + (sa2 * b4.w + vv2 * k4.w);
        }
        float o = (S.x * r4.x + S.y * r4.y) + (S.z * r4.z + S.w * r4.w);
        float o2 = 0.f;
        if (TWO) o2 = (S2.x * r4.x + S2.y * r4.y) + (S2.z * r4.z + S2.w * r4.w);
        o = allsum16(o); if (TWO) o2 = allsum16(o2);
        oacc = (ks == st) ? o : oacc;
        oacc2 = (ks == st) ? o2 : oacc2;
      }
    }
    sh_o[ks * 32 + rl] = oacc;
    if (TWO) sh_o[ks * 32 + 16 + rl] = oacc2;
    __syncthreads();
    {
      u16* op = rwo + (size_t)(b * TT + jcur) * 256 + h * 64 + rh * RPB + cq;
      op[0] = f2bf(sh_o[pst * 32 + cq]);
      if (TWO) op[16] = f2bf(sh_o[pst * 32 + 16 + cq]);
    }
  }
}

__device__ void rwkv_combine_rows(const Params& p, int layer, int row0, int latonly) {
  const int lane = tid_() & 63, h = tid_() >> 6;
  const int ch = h * 64 + lane;
  const u16* rwo = (const u16*)(p.ws + OFF_RWO);
  u16* proj = (u16*)(p.ws + OFF_PROJ);
  const float* mu0 = p.in[21] + (size_t)layer * 2 * 832; const float* mu1 = mu0 + 832;
  const float* bonus = (const float*)(p.ws + OFF_BONUS);
  const float gw = p.in[29][layer * 256 + ch], gb = p.in[30][layer * 256 + ch];
  const float m0 = mu0[512 + ch], m1 = mu1[512 + ch];
  const int vc = C_RWX + 512 + ch;
  float o[8], xv[8], xp[8], xn[8], bs[8], z[8];
#pragma unroll
  for (int i = 0; i < 8; i++) {
    const int row = row0 + i;
    const int j = row % TT;
    const u16* pr = proj + (size_t)row * PC;
    o[i] = bf2f(rwo[(size_t)row * 256 + ch]) + bf2f(rwo[(size_t)MROWS * 256 + (size_t)row * 256 + ch]);
    xv[i] = bf2f(pr[vc]);
    xp[i] = has_prev(j) ? bf2f(pr[vc - PC]) : 0.f;
    xn[i] = has_next(j) ? bf2f(pr[vc + PC]) : 0.f;
    bs[i] = bonus[(size_t)row * 4 + h] + bonus[(size_t)MROWS * 4 + (size_t)row * 4 + h];
    z[i] = bf2f(pr[C_RWZ + ch]);
  }
#pragma unroll
  for (int i = 0; i < 8; i++) {
    const int row = row0 + i;
    if (latonly && (row % TT) < 256) continue;
    float mean = wavesum(o[i]) * (1.f / 64.f);
    float dlt = o[i] - mean;
    float var = wavesum(dlt * dlt) * (1.f / 64.f);
    float on = dlt * rsqrtf(var + 64e-5f) * gw + gb;
    float v = xv[i] + m0 * (xp[i] - xv[i]) + m1 * (xn[i] - xv[i]);
    proj[(size_t)row * PC + C_RWZ + ch] = f2bf((on + bs[i] * v) * siluf_(z[i]));
  }
}

template <int MX, int PASS>
__device__ __forceinline__ void gla_sweep(const Params& p, int layer, int d, int b, int h, int c, float* lds) {
  const int t = tid_(), w = t >> 6, lane = t & 63;
  float* kbuf = lds;
  float* fbuf = kbuf + 1024;
  float* qbuf = fbuf + 1024;
  float* vbuf = qbuf + 1024;
  float* part = vbuf + 1024;
  u16* proj = (u16*)(p.ws + OFF_PROJ);
  const int dbh = (d * 8 + b) * 4 + h;
  float* stt = (float*)(p.ws + (MX == 0 ? OFF_HGST : OFF_RTST)) + ((size_t)dbh * 9 + c) * 4096;
  float S[16];
#pragma unroll
  for (int i = 0; i < 16; i++) S[i] = PASS == 1 ? 0.f : stt[(w * 16 + i) * 64 + lane];
  float gam = 1.f;
  if (MX == 1) gam = __expf(-__expf(p.in[20][((size_t)layer * 2 + d) * 4 + h]));
  float Pl = 1.f;
  const int pst = t >> 4, c4 = (t & 15) * 4;
  float lb4[4] = {0.f, 0.f, 0.f, 0.f};
  if (MX == 0 && layer == 1) {
#pragma unroll
    for (int i = 0; i < 4; i++) {
      float l0 = p.in[18][(0 * 2 + d) * 256 + h * 64 + c4 + i], l1 = p.in[18][(1 * 2 + d) * 256 + h * 64 + c4 + i];
      float mx = fmaxf(l0, l1);
      float e0 = __expf(l0 - mx), e1 = __expf(l1 - mx);
      lb4[i] = e1 / (e0 + e1);
    }
  }
  const int vcol0 = (MX == 0 ? C_HGI : C_RTV) + h * 64;
  const float* rope = (const float*)(p.ws + OFF_ROPE);
  uint2 r_a, r_b, r_c, r_d, r_v; float4 r_cs0, r_cs1;
  r_a = r_b = r_c = r_d = r_v = make_uint2(0u, 0u); r_cs0 = r_cs1 = make_float4(1.f, 0.f, 1.f, 0.f);
  auto fetch = [&](int s0) {
    int j = jmap(d, s0 + pst);
    const u16* pr = proj + (size_t)(b * TT + j) * PC;
    r_v = *(const uint2*)(pr + vcol0 + c4);
    if (MX == 0) {
      r_a = *(const uint2*)(pr + C_HGF + d * 256 + h * 64 + c4);
      if (PASS == 2) r_b = *(const uint2*)(pr + C_HGQ + h * 64 + c4);
    } else {
      r_a = *(const uint2*)(pr + C_RTK + h * 64 + c4);
      r_c = *(const uint2*)(pr + C_RTK + h * 64 + (c4 ^ 16));
      if (PASS == 2) { r_b = *(const uint2*)(pr + C_RTQ + h * 64 + c4); r_d = *(const uint2*)(pr + C_RTQ + h * 64 + (c4 ^ 16)); }
      if (j >= 256) {
        int tl = j - 256;
        int pos = (c4 & 32) ? (tl & 63) : (tl >> 6);
        const float* rp = rope + (pos * 16 + (c4 & 15)) * 2;
        r_cs0 = *(const float4*)rp; r_cs1 = *(const float4*)(rp + 4);
      } else { r_cs0 = make_float4(1.f, 0.f, 1.f, 0.f); r_cs1 = r_cs0; }
    }
  };
  auto unpack4 = [](uint2 v, float (&o)[4]) {
    o[0] = __uint_as_float(v.x << 16); o[1] = __uint_as_float(v.x & 0xffff0000u);
    o[2] = __uint_as_float(v.y << 16); o[3] = __uint_as_float(v.y & 0xffff0000u);
  };
  u16* ofp; int ofs;
  if (MX == 0) { ofp = proj + C_HGF + h * 64 + lane; ofs = PC; }
  else { ofp = (u16*)(p.ws + OFF_RETOF) + h * 64 + lane; ofs = 256; }
  const int zcol = (MX == 0 ? C_HGZ : C_RTZ) + h * 64 + lane;
  const int ycol = (MX == 0 ? C_HGQ : C_RTQ) + h * 64 + lane;
  float normw = 1.f;
  if (MX == 0 && PASS == 2) normw = p.in[19][layer * 256 + h * 64 + lane];
  fetch(c * 256);
  for (int sub = 0; sub < 16; sub++) {
    const int s0 = c * 256 + sub * 16;
    __syncthreads();
    {
      float va[4], vb[4], vc[4], vd[4], vv4[4];
      unpack4(r_a, va); unpack4(r_v, vv4);
      *(float4*)(vbuf + pst * 64 + c4) = make_float4(vv4[0], vv4[1], vv4[2], vv4[3]);
      if (MX == 0) {
        float f[4], k[4];
#pragma unroll
        for (int i = 0; i < 4; i++) { f[i] = lb4[i] + (1.f - lb4[i]) * sigmoidf_(va[i]); k[i] = 1.f - f[i]; }
        *(float4*)(kbuf + pst * 64 + c4) = make_float4(k[0], k[1], k[2], k[3]);
        *(float4*)(fbuf + pst * 64 + c4) = make_float4(f[0], f[1], f[2], f[3]);
        if (PASS == 2) {
          unpack4(r_b, vb);
          *(float4*)(qbuf + pst * 64 + c4) = make_float4(siluf_(vb[0]), siluf_(vb[1]), siluf_(vb[2]), siluf_(vb[3]));
        }
      } else {
        unpack4(r_c, vc);
        float cs[8] = {r_cs0.x, r_cs0.y, r_cs0.z, r_cs0.w, r_cs1.x, r_cs1.y, r_cs1.z, r_cs1.w};
        float sgn = (c4 & 16) ? 1.f : -1.f;
#pragma unroll
        for (int i = 0; i < 4; i++) va[i] = (va[i] * cs[2 * i] + sgn * vc[i] * cs[2 * i + 1]) * 0.125f;
        *(float4*)(kbuf + pst * 64 + c4) = make_float4(va[0], va[1], va[2], va[3]);
        if (PASS == 2) {
          unpack4(r_b, vb); unpack4(r_d, vd);
#pragma unroll
          for (int i = 0; i < 4; i++) vb[i] = vb[i] * cs[2 * i] + sgn * vd[i] * cs[2 * i + 1];
          *(float4*)(qbuf + pst * 64 + c4) = make_float4(vb[0], vb[1], vb[2], vb[3]);
        }
      }
    }
    __syncthreads();
    if (sub + 1 < 16) fetch(s0 + 16);
    u16 pf_o[4], pf_z[4];
    if (PASS == 2 && d == 1) {
#pragma unroll
      for (int e = 0; e < 4; e++) {
        size_t row = (size_t)(b * TT + jmap(d, s0 + w * 4 + e));
        pf_o[e] = ofp[row * ofs]; pf_z[e] = proj[row * PC + zcol];
      }
    }
#pragma unroll 2
    for (int st = 0; st < 16; st++) {
      const float vv = vbuf[st * 64 + lane];
      float o = 0.f;
#pragma unroll
      for (int i4 = 0; i4 < 4; i4++) {
        float4 kv = *(const float4*)(kbuf + st * 64 + w * 16 + i4 * 4);
        float4 fv = make_float4(gam, gam, gam, gam);
        if (MX == 0) fv = *(const float4*)(fbuf + st * 64 + w * 16 + i4 * 4);
        S[i4*4]   = fv.x * S[i4*4]   + kv.x * vv;
        S[i4*4+1] = fv.y * S[i4*4+1] + kv.y * vv;
        S[i4*4+2] = fv.z * S[i4*4+2] + kv.z * vv;
        S[i4*4+3] = fv.w * S[i4*4+3] + kv.w * vv;
        if (PASS == 2) {
          float4 qv = *(const float4*)(qbuf + st * 64 + w * 16 + i4 * 4);
          o += S[i4*4] * qv.x + S[i4*4+1] * qv.y + S[i4*4+2] * qv.z + S[i4*4+3] * qv.w;
        }
      }
      if (MX == 0 && PASS == 1) { if (lane < 16) Pl *= fbuf[st * 64 + w * 16 + lane]; }
      if (PASS == 2) part[(w * 16 + st) * 64 + lane] = o;
    }
    if (PASS == 2) {
      __syncthreads();
#pragma unroll
      for (int e = 0; e < 4; e++) {
        int st = w * 4 + e;
        float o = part[(0 * 16 + st) * 64 + lane] + part[(1 * 16 + st) * 64 + lane] + part[(2 * 16 + st) * 64 + lane] + part[(3 * 16 + st) * 64 + lane];
        int j = jmap(d, s0 + st);
        size_t row = (size_t)(b * TT + j);
        if (d == 0) {
          ofp[row * ofs] = f2bf(o);
        } else {
          o += bf2f(pf_o[e]);
          float ss = wavesum(o * o);
          float y = o * rsqrtf(ss * (1.f / 64.f) + 1e-6f) * normw;
          proj[row * PC + ycol] = f2bf(y * siluf_(bf2f(pf_z[e])));
        }
      }
    }
  }
  if (PASS == 1) {
#pragma unroll
    for (int i = 0; i < 16; i++) stt[(w * 16 + i) * 64 + lane] = S[i];
    if (MX == 0 && lane < 16) ((float*)(p.ws + OFF_HGP))[((size_t)dbh * 9 + c) * 64 + w * 16 + lane] = Pl;
  }
}

#define RS 72
template <int PASS>
__device__ __forceinline__ void ret_sweep(const Params& p, int layer, int d, int b, int h, int nc, int cstep, u16* lds) {
  const int t = tid_(), lane = t & 63, w4 = t >> 6;
  u16* Qs = lds;
  u16* Ks = Qs + 64 * RS;
  u16* Kt = Ks + 64 * RS;
  u16* Vt = Kt + 64 * RS;
  u16* Vd = Vt + 64 * RS;
  u16* Ps = Vd + 64 * RS;
  u16* St = Ps + 64 * RS;
  u16* proj = (u16*)(p.ws + OFF_PROJ);
  const float* rope = (const float*)(p.ws + OFF_ROPE);
  const float lg = -__expf(p.in[20][((size_t)layer * 2 + d) * 4 + h]) * 1.4426950408889634f;
  const float g64 = exp2f(64.f * lg);
  const int dbh = (d * 8 + b) * 4 + h;
  float* stt = (float*)(p.ws + OFF_RTST) + ((size_t)dbh * 9 + cstep) * 4096;
  f32x4 accS[4];
#pragma unroll
  for (int nt = 0; nt < 4; nt++)
#pragma unroll
    for (int r = 0; r < 4; r++)
      accS[nt][r] = PASS == 1 ? 0.f : stt[(w4 * 16 + (lane >> 4) * 4 + r) * 64 + nt * 16 + (lane & 15)];
  uint4 rq[2], rqp[2], rk[2], rkp[2], rv[2];
  auto fetch = [&](int w) {
#pragma unroll
    for (int e = 0; e < 2; e++) {
      const int q = t + 256 * e, sl = q & 63, c8 = (q >> 6) * 8;
      const u16* pr = proj + (size_t)(b * TT + nc * 256 + w * 64 + sl) * PC + h * 64;
      rk[e] = *(const uint4*)(pr + C_RTK + c8); rkp[e] = *(const uint4*)(pr + C_RTK + (c8 ^ 16));
      rv[e] = *(const uint4*)(pr + C_RTV + c8);
      if (PASS == 2) { rq[e] = *(const uint4*)(pr + C_RTQ + c8); rqp[e] = *(const uint4*)(pr + C_RTQ + (c8 ^ 16)); }
    }
  };
  auto up = [](uint4 v, float (&o)[8]) {
    const unsigned* u = (const unsigned*)&v;
#pragma unroll
    for (int i = 0; i < 4; i++) { o[2 * i] = __uint_as_float(u[i] << 16); o[2 * i + 1] = __uint_as_float(u[i] & 0xffff0000u); }
  };
  fetch(d == 0 ? 0 : 3);
  for (int wi = 0; wi < 4; wi++) {
    const int w = d == 0 ? wi : 3 - wi;
    __syncthreads();
    if (PASS == 2 && wi == 0) {
#pragma unroll
      for (int nt = 0; nt < 4; nt++)
        *(uint2*)(St + (nt * 16 + (lane & 15)) * RS + w4 * 16 + (lane >> 4) * 4) =
            make_uint2(pack2(accS[nt][0], accS[nt][1]), pack2(accS[nt][2], accS[nt][3]));
    }
#pragma unroll
    for (int e = 0; e < 2; e++) {
      const int q = t + 256 * e, sl = q & 63, c8 = (q >> 6) * 8;
      const int j = nc * 256 + w * 64 + sl;
      float kx[8], kp[8], vx[8], qx[8], qp[8];
      up(rk[e], kx); up(rkp[e], kp); up(rv[e], vx);
      if (PASS == 2) { up(rq[e], qx); up(rqp[e], qp); }
      if (j >= 256) {
        const int tl = j - 256;
        const int pos = (c8 & 32) ? (tl & 63) : (tl >> 6);
        const float* rp = rope + (pos * 16 + (c8 & 15)) * 2;
        const float sgn = (c8 & 16) ? 1.f : -1.f;
#pragma unroll
        for (int i2 = 0; i2 < 4; i2++) {
          const float4 cs = *(const float4*)(rp + i2 * 4);
          kx[2 * i2] = kx[2 * i2] * cs.x + sgn * kp[2 * i2] * cs.y;
          kx[2 * i2 + 1] = kx[2 * i2 + 1] * cs.z + sgn * kp[2 * i2 + 1] * cs.w;
          if (PASS == 2) {
            qx[2 * i2] = qx[2 * i2] * cs.x + sgn * qp[2 * i2] * cs.y;
            qx[2 * i2 + 1] = qx[2 * i2 + 1] * cs.z + sgn * qp[2 * i2 + 1] * cs.w;
          }
        }
      }
      const float dec = exp2f((float)(d == 0 ? 63 - sl : sl) * lg);
      u16 kb[8];
#pragma unroll
      for (int i = 0; i < 8; i++) {
        kb[i] = f2bf(kx[i] * 0.125f);
        Kt[(c8 + i) * RS + sl] = kb[i];
        Vd[(c8 + i) * RS + sl] = f2bf(vx[i] * dec);
      }
      if (PASS == 2) {
        uint4 kk4, qq4;
        kk4.x = kb[0] | ((unsigned)kb[1] << 16); kk4.y = kb[2] | ((unsigned)kb[3] << 16);
        kk4.z = kb[4] | ((unsigned)kb[5] << 16); kk4.w = kb[6] | ((unsigned)kb[7] << 16);
        qq4.x = pack2(qx[0], qx[1]); qq4.y = pack2(qx[2], qx[3]); qq4.z = pack2(qx[4], qx[5]); qq4.w = pack2(qx[6], qx[7]);
        *(uint4*)(Ks + sl * RS + c8) = kk4;
        *(uint4*)(Qs + sl * RS + c8) = qq4;
        const unsigned short* vraw = (const unsigned short*)&rv[e];
#pragma unroll
        for (int i = 0; i < 8; i++) Vt[(c8 + i) * RS + sl] = vraw[i];
      }
    }
    __syncthreads();
    if (wi + 1 < 4) fetch(d == 0 ? wi + 1 : 2 - wi);
    if (PASS == 2) {
      f32x4 accP[4];
#pragma unroll
      for (int nt = 0; nt < 4; nt++) accP[nt] = (f32x4){0.f, 0.f, 0.f, 0.f};
      bf16x8 aq[2];
#pragma unroll
      for (int kk = 0; kk < 2; kk++) aq[kk] = *(const bf16x8*)(Qs + (w4 * 16 + (lane & 15)) * RS + kk * 32 + (lane >> 4) * 8);
#pragma unroll
      for (int kk = 0; kk < 2; kk++)
#pragma unroll
        for (int nt = 0; nt < 4; nt++) {
          bf16x8 bk = *(const bf16x8*)(Ks + (nt * 16 + (lane & 15)) * RS + kk * 32 + (lane >> 4) * 8);
          accP[nt] = __builtin_amdgcn_mfma_f32_16x16x32_bf16(aq[kk], bk, accP[nt], 0, 0, 0);
        }
#pragma unroll
      for (int nt = 0; nt < 4; nt++)
#pragma unroll
        for (int r = 0; r < 4; r++) {
          const int il = w4 * 16 + (lane >> 4) * 4 + r, sl = nt * 16 + (lane & 15);
          const int e = d == 0 ? il - sl : sl - il;
          const float f = e >= 0 ? exp2f((float)e * lg) : 0.f;
          Ps[il * RS + sl] = f2bf(accP[nt][r] * f);
        }
      __syncthreads();
      f32x4 accO[4], accI[4];
#pragma unroll
      for (int nt = 0; nt < 4; nt++) { accO[nt] = (f32x4){0.f, 0.f, 0.f, 0.f}; accI[nt] = (f32x4){0.f, 0.f, 0.f, 0.f}; }
#pragma unroll
      for (int kk = 0; kk < 2; kk++) {
        bf16x8 ap = *(const bf16x8*)(Ps + (w4 * 16 + (lane & 15)) * RS + kk * 32 + (lane >> 4) * 8);
#pragma unroll
        for (int nt = 0; nt < 4; nt++) {
          bf16x8 bv = *(const bf16x8*)(Vt + (nt * 16 + (lane & 15)) * RS + kk * 32 + (lane >> 4) * 8);
          accO[nt] = __builtin_amdgcn_mfma_f32_16x16x32_bf16(ap, bv, accO[nt], 0, 0, 0);
          bf16x8 bs = *(const bf16x8*)(St + (nt * 16 + (lane & 15)) * RS + kk * 32 + (lane >> 4) * 8);
          accI[nt] = __builtin_amdgcn_mfma_f32_16x16x32_bf16(aq[kk], bs, accI[nt], 0, 0, 0);
        }
      }
      u16* ofp = (u16*)(p.ws + OFF_RETOF);
#pragma unroll
      for (int r = 0; r < 4; r++) {
        const int il = w4 * 16 + (lane >> 4) * 4 + r;
        const size_t row = (size_t)(b * TT + nc * 256 + w * 64 + il);
        const float rho = exp2f((float)(d == 0 ? il + 1 : 64 - il) * lg);
        float o[4], ss = 0.f;
#pragma unroll
        for (int nt = 0; nt < 4; nt++) {
          o[nt] = accO[nt][r] + rho * accI[nt][r];
          if (d == 1) o[nt] += bf2f(ofp[row * 256 + h * 64 + nt * 16 + (lane & 15)]);
          ss += o[nt] * o[nt];
        }
        if (d == 0) {
#pragma unroll
          for (int nt = 0; nt < 4; nt++) ofp[row * 256 + h * 64 + nt * 16 + (lane & 15)] = f2bf(o[nt]);
        } else {
          ss = allsum16(ss);
          const float sc = rsqrtf(ss * (1.f / 64.f) + 1e-6f);
#pragma unroll
          for (int nt = 0; nt < 4; nt++) {
            const int cv = h * 64 + nt * 16 + (lane & 15);
            const float z = bf2f(proj[row * PC + C_RTZ + cv]);
            proj[row * PC + C_RTQ + cv] = f2bf(o[nt] * sc * siluf_(z));
          }
        }
      }
    }
#pragma unroll
    for (int nt = 0; nt < 4; nt++)
#pragma unroll
      for (int r = 0; r < 4; r++) accS[nt][r] *= g64;
#pragma unroll
    for (int kk = 0; kk < 2; kk++) {
      bf16x8 ak = *(const bf16x8*)(Kt + (w4 * 16 + (lane & 15)) * RS + kk * 32 + (lane >> 4) * 8);
#pragma unroll
      for (int nt = 0; nt < 4; nt++) {
        bf16x8 bv = *(const bf16x8*)(Vd + (nt * 16 + (lane & 15)) * RS + kk * 32 + (lane >> 4) * 8);
        accS[nt] = __builtin_amdgcn_mfma_f32_16x16x32_bf16(ak, bv, accS[nt], 0, 0, 0);
      }
    }
    __syncthreads();
    if (PASS == 2 && wi + 1 < 4) {
#pragma unroll
      for (int nt = 0; nt < 4; nt++)
        *(uint2*)(St + (nt * 16 + (lane & 15)) * RS + w4 * 16 + (lane >> 4) * 4) =
            make_uint2(pack2(accS[nt][0], accS[nt][1]), pack2(accS[nt][2], accS[nt][3]));
    }
  }
  if (PASS == 1) {
#pragma unroll
    for (int nt = 0; nt < 4; nt++)
#pragma unroll
      for (int r = 0; r < 4; r++) stt[(w4 * 16 + (lane >> 4) * 4 + r) * 64 + nt * 16 + (lane & 15)] = accS[nt][r];
  }
}
__device__ void gla_p1_task(const Params& p, int layer, int task, float* lds) {
  int c = task % 9; int q = task / 9; int h = q & 3; q >>= 2; int b = q & 7; q >>= 3; int d = q & 1; int mx = q >> 1;
  if (mx == 0) gla_sweep<0, 1>(p, layer, d, b, h, c, lds);
  else { const int nc = d == 0 ? c : (c == 0 ? 0 : 9 - c); ret_sweep<1>(p, layer, d, b, h, nc, c, (u16*)lds); }
}
__device__ void gla_p2_task(const Params& p, int layer, int mx, int b, int h, int nc, float* lds) {
  int cb = nc == 0 ? 0 : 9 - nc;
  if (mx == 0) { gla_sweep<0, 2>(p, layer, 0, b, h, nc, lds); __threadfence_block(); gla_sweep<0, 2>(p, layer, 1, b, h, cb, lds); }
  else { ret_sweep<2>(p, layer, 0, b, h, nc, nc, (u16*)lds); __threadfence_block(); ret_sweep<2>(p, layer, 1, b, h, nc, cb, (u16*)lds); }
}
__device__ void gla_carry_task(const Params& p, int layer, int task) {
  int e = task * 256 + tid_();
  int v = e & 63, k = (e >> 6) & 63, dbh = (e >> 12) & 63, mx = e >> 18;
  float* stt = (float*)(p.ws + (mx == 0 ? OFF_HGST : OFF_RTST)) + (size_t)dbh * 9 * 4096 + k * 64 + v;
  const float* P = (const float*)(p.ws + OFF_HGP) + (size_t)dbh * 9 * 64 + k;
  float pg = 1.f;
  if (mx == 1) { int d = dbh >> 5, h = dbh & 3; pg = __expf(-256.f * __expf(p.in[20][((size_t)layer * 2 + d) * 4 + h])); }
  float S = 0.f;
  for (int c = 0; c < 9; c++) {
    float E = stt[(size_t)c * 4096];
    stt[(size_t)c * 4096] = S;
    float pp = mx == 0 ? P[c * 64] : pg;
    S = pp * S + E;
  }
}

__device__ __forceinline__ int s5_bwd_chunk(int nc) { return nc < 4 ? 3 - nc : 39 - nc; }
template <int PASS>
__device__ void s5_task(const Params& p, int layer, int task, float* lds) {
  const int t = tid_(), w = t >> 6, lane = t & 63;
  int gq = task & 3; int q = task >> 2; int nc = q % 36; int b = q / 36;
  const int g = gq * 4 + w;
  float* ubuf = lds + w * 256;
  u16* hbuf = (u16*)(lds + 1024) + w * (16 * 136);
  float* ybuf = lds + 1024 + 4352 + w * 1024;
  u16* proj = (u16*)(p.ws + OFF_PROJ);
  float2* st5 = (float2*)(p.ws + OFF_S5ST);
  bf16x8 cfrag[4];
  if (PASS == 2) {
    const float* cre = p.in[13] + ((size_t)layer * 16 + g) * 16 * 64;
    const float* cim = p.in[14] + ((size_t)layer * 16 + g) * 16 * 64;
    int pp = lane & 15;
#pragma unroll
    for (int ks = 0; ks < 4; ks++)
#pragma unroll
      for (int i = 0; i < 8; i++) {
        int kidx = ks * 32 + (lane >> 4) * 8 + i; int n = kidx >> 1;
        float val = (kidx & 1) ? -cim[pp * 64 + n] : cre[pp * 64 + n];
        cfrag[ks][i] = (short)f2bf(val);
      }
  }
  for (int d = 0; d < 2; d++) {
    float lre = p.in[8][(((size_t)layer * 2 + d) * 16 + g) * 64 + lane];
    float lim = p.in[9][(((size_t)layer * 2 + d) * 16 + g) * 64 + lane];
    float dt = __expf(p.in[10][((size_t)layer * 2 + d) * 16 + g]);
    float mag = __expf(lre * dt);
    float sn, cs; sincosf(lim * dt, &sn, &cs);
    float are = mag * cs, aim = mag * sn;
    float den = 1.f / (lre * lre + lim * lim);
    float cre_ = ((are - 1.f) * lre + aim * lim) * den;
    float cim_ = (aim * lre - (are - 1.f) * lim) * den;
    float bbr[16], bbi[16];
    {
      const float* br = p.in[11] + (((size_t)layer * 16 + g) * 64 + lane) * 16;
      const float* bi = p.in[12] + (((size_t)layer * 16 + g) * 64 + lane) * 16;
#pragma unroll
      for (int i = 0; i < 16; i++) {
        float x = br[i], y = bi[i];
        bbr[i] = cre_ * x - cim_ * y; bbi[i] = cre_ * y + cim_ * x;
      }
    }
    int cstep = d == 0 ? nc : s5_bwd_chunk(nc);
    size_t sidx = ((((size_t)d * 8 + b) * 16 + g) * 36 + cstep) * 64 + lane;
    float hre = 0.f, him = 0.f;
    if (PASS == 2) { float2 h0 = st5[sidx]; hre = h0.x; him = h0.y; }
    uint2 ru;
    auto fetchu = [&](int sub) {
      int st = lane >> 2, p4 = (lane & 3) * 4;
      int jl = d == 0 ? sub * 16 + st : 63 - (sub * 16 + st);
      ru = *(const uint2*)(proj + (size_t)(b * TT + nc * 64 + jl) * PC + C_S5U + g * 16 + p4);
    };
    fetchu(0);
    for (int sub = 0; sub < 4; sub++) {
      __syncthreads();
      {
        int st = lane >> 2, p4 = (lane & 3) * 4;
        *(float4*)(ubuf + st * 16 + p4) = make_float4(__uint_as_float(ru.x << 16), __uint_as_float(ru.x & 0xffff0000u),
                                                       __uint_as_float(ru.y << 16), __uint_as_float(ru.y & 0xffff0000u));
      }
      __syncthreads();
      if (sub + 1 < 4) fetchu(sub + 1);
#pragma unroll 2
      for (int st = 0; st < 16; st++) {
        float bur = 0.f, bui = 0.f;
#pragma unroll
        for (int i4 = 0; i4 < 4; i4++) {
          float4 uu = *(const float4*)(ubuf + st * 16 + i4 * 4);
          bur += bbr[i4*4] * uu.x + bbr[i4*4+1] * uu.y + bbr[i4*4+2] * uu.z + bbr[i4*4+3] * uu.w;
          bui += bbi[i4*4] * uu.x + bbi[i4*4+1] * uu.y + bbi[i4*4+2] * uu.z + bbi[i4*4+3] * uu.w;
        }
        float nre = are * hre - aim * him + bur;
        float nim = are * him + aim * hre + bui;
        hre = nre; him = nim;
        if (PASS == 2) *(unsigned*)(hbuf + st * 136 + lane * 2) = pack2(hre, him);
      }
      if (PASS == 2) {
        __syncthreads();
        f32x4 acc = (f32x4){0.f, 0.f, 0.f, 0.f};
#pragma unroll
        for (int ks = 0; ks < 4; ks++) {
          bf16x8 af = *(const bf16x8*)(hbuf + (lane & 15) * 136 + ks * 32 + (lane >> 4) * 8);
          acc = __builtin_amdgcn_mfma_f32_16x16x32_bf16(af, cfrag[ks], acc, 0, 0, 0);
        }
#pragma unroll
        for (int r = 0; r < 4; r++) {
          int st = (lane >> 4) * 4 + r;
          int jl = d == 0 ? sub * 16 + st : 63 - (sub * 16 + st);
          float* yp = ybuf + jl * 16 + (lane & 15);
          if (d == 0) *yp = acc[r]; else *yp += acc[r];
        }
      }
    }
    if (PASS == 1) st5[sidx] = make_float2(hre, him);
  }
  if (PASS == 2) {
    __syncthreads();
    const float* dsk = p.in[15] + layer * 256 + g * 16;
#pragma unroll
    for (int i = 0; i < 16; i++) {
      int idx = lane + 64 * i; int jl = idx >> 4, pp = idx & 15;
      u16* up = proj + (size_t)(b * TT + nc * 64 + jl) * PC + C_S5U + g * 16 + pp;
      float y = ybuf[jl * 16 + pp] + dsk[pp] * bf2f(*up);
      *up = f2bf(geluf_(y));
    }
  }
}
__device__ void s5_carry_task(const Params& p, int layer, int task) {
  int e = task * 256 + tid_();
  int n = e & 63, g = (e >> 6) & 15, d = e >> 13;
  float lre = p.in[8][(((size_t)layer * 2 + d) * 16 + g) * 64 + n];
  float lim = p.in[9][(((size_t)layer * 2 + d) * 16 + g) * 64 + n];
  float dt = __expf(p.in[10][((size_t)layer * 2 + d) * 16 + g]);
  float mag = __expf(lre * dt * 64.f);
  float sn, cs; sincosf(lim * dt * 64.f, &sn, &cs);
  float are = mag * cs, aim = mag * sn;
  float2* st5 = (float2*)(p.ws + OFF_S5ST) + (size_t)(e >> 6) * 36 * 64 + n;
  float sre = 0.f, sim = 0.f;
  for (int c = 0; c < 36; c++) {
    float2 E = st5[(size_t)c * 64];
    st5[(size_t)c * 64] = make_float2(sre, sim);
    float nre = are * sre - aim * sim + E.x;
    float nim = are * sim + aim * sre + E.y;
    sre = nre; sim = nim;
  }
}

__device__ __forceinline__ void group_barrier(unsigned* cnt, unsigned target) {
  asm volatile("s_waitcnt vmcnt(0)" ::: "memory");
  __syncthreads();
  if (tid_() == 0) {
    __threadfence();
    asm volatile("s_waitcnt vmcnt(0)" ::: "memory");
    __hip_atomic_fetch_add(cnt, 1u, __ATOMIC_RELAXED, __HIP_MEMORY_SCOPE_AGENT);
    while (__hip_atomic_load(cnt, __ATOMIC_RELAXED, __HIP_MEMORY_SCOPE_AGENT) < target) __builtin_amdgcn_s_sleep(2);
    __threadfence();
    asm volatile("s_waitcnt vmcnt(0)" ::: "memory");
  }
  __syncthreads();
}
#define XB_XCNT(j) (64 * (j))
#define XB_XSUB(j) (1024 + 64 * (j))
#define XB_XGEN(j) (2048 + 64 * (j))
#define XB_TOP     3072
#define XB_TOPGEN  3136
#define XB_WORDS   8192
struct XcdBar { unsigned* bar; unsigned x, nloc, nx; };
__device__ __forceinline__ unsigned xb_ld(unsigned* q) { return __hip_atomic_load(q, __ATOMIC_RELAXED, __HIP_MEMORY_SCOPE_AGENT); }
__device__ __forceinline__ unsigned xb_add(unsigned* q, unsigned v) { return __hip_atomic_fetch_add(q, v, __ATOMIC_RELAXED, __HIP_MEMORY_SCOPE_AGENT); }
__device__ __forceinline__ void xcd_barrier(const XcdBar& b) {
  asm volatile("s_waitcnt vmcnt(0)" ::: "memory");
  __syncthreads();
  if (tid_() == 0) {
    unsigned* bar = b.bar;
    __builtin_amdgcn_s_waitcnt(0);
    const unsigned old = xb_add(&bar[XB_XSUB(b.x)], 1u);
    const unsigned gen = old / b.nloc;
    if (old + 1u == (gen + 1u) * b.nloc) {
      __builtin_amdgcn_fence(__ATOMIC_RELEASE, "agent");
      asm volatile("s_waitcnt vmcnt(0)" ::: "memory");
      const unsigned og = xb_add(&bar[XB_TOP], 1u);
      const unsigned tg = og / b.nx;
      if (og + 1u == (tg + 1u) * b.nx) xb_add(&bar[XB_TOPGEN], 1u);
      else while (xb_ld(&bar[XB_TOPGEN]) == tg) __builtin_amdgcn_s_sleep(1);
      __builtin_amdgcn_fence(__ATOMIC_ACQUIRE, "agent");
      xb_add(&bar[XB_XGEN(b.x)], 1u);
      asm volatile("s_waitcnt vmcnt(0)" ::: "memory");
    } else {
      while (xb_ld(&bar[XB_XGEN(b.x)]) == gen) __builtin_amdgcn_s_sleep(1);
      __builtin_amdgcn_fence(__ATOMIC_ACQUIRE, "agent");
      asm volatile("s_waitcnt vmcnt(0)" ::: "memory");
    }
  }
  __syncthreads();
}
#define LDS_FLOATS 18432
#define SYNC() xcd_barrier(xbar)
#define RW_TWO false
#define NRW (RW_TWO ? 128 : 256)

__global__ void __launch_bounds__(256, 2) fwd_megakernel(Params p) {
  cg::grid_group grid = cg::this_grid();
  __shared__ __attribute__((aligned(16))) float lds[LDS_FLOATS];
  const int bid = blockIdx.x, nb = gridDim.x, t = tid_();
  XcdBar xbar; xbar.bar = (unsigned*)(p.ws + OFF_XB); xbar.x = 0; xbar.nloc = 1; xbar.nx = 1;

  if (p.ws == nullptr) grid.sync();
  {
    unsigned xr; asm volatile("s_getreg_b32 %0, hwreg(HW_REG_XCC_ID)" : "=s"(xr));
    xbar.x = xr & 15u;
    if (t == 0) xb_add(&xbar.bar[XB_XCNT(xbar.x)], 1u + ((nb == 512 && bid >= NRW) ? 65536u : 0u));
  }
  for (int task = bid; task < N_CONVERT_TASKS + 192 + 1; task += nb) {
    if (task < 192) mods_task(p, task, lds);
    else if (task == 192) {
      float* rope = (float*)(p.ws + OFF_ROPE);
      for (int i = t; i < 1024; i += 256) {
        int pos = i >> 4, fi = i & 15;
        float fr = powf(10000.f, -(float)fi / 16.f);
        float ang = (float)pos * fr;
        rope[i * 2] = cosf(ang); rope[i * 2 + 1] = sinf(ang);
      }
    } else convert_task(p, 0, task - 193, lds);
  }
  XcdBar pbar; pbar.bar = xbar.bar + 4096; pbar.x = xbar.x; pbar.nloc = 1; pbar.nx = 1;
  if (t == 0) {
    unsigned nx, npx, nlocp;
    for (;;) {
      unsigned sum = 0; nx = 0; npx = 0; nlocp = 0;
#pragma unroll
      for (int j = 0; j < 16; j++) {
        const unsigned w = xb_ld(&xbar.bar[XB_XCNT(j)]);
        const unsigned c = w & 65535u, cp = w >> 16;
        sum += c; nx += c > 0u ? 1u : 0u; npx += cp > 0u ? 1u : 0u;
        if ((unsigned)j == xbar.x) { xbar.nloc = c; nlocp = cp; }
      }
      if (sum == (unsigned)nb) break;
      __builtin_amdgcn_s_sleep(4);
    }
    xbar.nx = nx; pbar.nx = npx > 0u ? npx : 1u; pbar.nloc = nlocp > 0u ? nlocp : 1u;
  }
  SYNC();
  for (int task = bid; task < MROWS / 4; task += nb) ln_row(p, 0, 0, task * 4 + (t >> 6));
  SYNC();

  for (int layer = 0; layer < 2; layer++) {
    const int latonly = layer;
    if ((nb & 7) == 0) { int tm, tn; for (int it = 0; xcd_tile(it, bid, nb, 144, 31, 6, tm, tn); it++) inproj_tile(p, layer, tm, tn, (u16*)lds); }
    else for (int task = bid; task < 144 * 31; task += nb) inproj_tile(p, layer, task / 31, task % 31, (u16*)lds);
    SYNC();
    {
      const int ncg = latonly ? 8 : 9, ncs = latonly ? 32 : 36;
      const int NG = 64 * ncg, NS = 32 * ncs;
      auto p2_task = [&](int task) {
        if (task < NG) {
          int nc = task % ncg + (latonly ? 1 : 0); int q = task / ncg; int h = q & 3; q >>= 2; int b = q & 7; int mx = q >> 3;
          gla_p2_task(p, layer, mx, b, h, nc, lds);
        } else {
          int q = task - NG; int gq = q & 3; q >>= 2; int nc = q % ncs + (latonly ? 4 : 0); int b = q / ncs;
          s5_task<2>(p, layer, ((b * 36 + nc) << 2) | gq, lds);
        }
      };
      if (nb == 512) {
        unsigned* bar = (unsigned*)(p.ws + OFF_BAR);
        const int ng = nb - NRW;
        if (bid < NRW) {
          rwkv_scan_task<RW_TWO>(p, layer, bid, lds);
          if (t == 0) {
            while (xb_ld(&pbar.bar[XB_TOPGEN]) < 2u * layer + 2u) __builtin_amdgcn_s_sleep(8);
            __threadfence();
          }
          __syncthreads();
        } else {
          const int gb = bid - NRW;
          for (int task = gb; task < 2304; task += ng) {
            if (task < 1152) gla_p1_task(p, layer, task, lds); else s5_task<1>(p, layer, task - 1152, lds);
          }
          xcd_barrier(pbar);
          for (int task = gb; task < 2048 + 64; task += ng) {
            if (task < 2048) gla_carry_task(p, layer, task); else s5_carry_task(p, layer, task - 2048);
          }
          xcd_barrier(pbar);
        }
        int* shq = (int*)(lds + LDS_FLOATS - 4);
        for (;;) {
          __syncthreads();
          if (t == 0) *shq = (int)__hip_atomic_fetch_add(bar + 1 + layer, 1u, __ATOMIC_RELAXED, __HIP_MEMORY_SCOPE_AGENT);
          __syncthreads();
          const int task = *shq;
          if (task >= NG + NS) break;
          p2_task(task);
        }
        SYNC();
      } else {
        for (int task = bid; task < NRW + 2304; task += nb) {
          if (task < NRW) rwkv_scan_task<RW_TWO>(p, layer, task, lds);
          else if (task < NRW + 1152) gla_p1_task(p, layer, task - NRW, lds);
          else s5_task<1>(p, layer, task - NRW - 1152, lds);
        }
        SYNC();
        for (int task = bid; task < 2048 + 64; task += nb) {
          if (task < 2048) gla_carry_task(p, layer, task); else s5_carry_task(p, layer, task - 2048);
        }
        SYNC();
        for (int task = bid; task < NG + NS; task += nb) p2_task(task);
        SYNC();
      }
    }
    {
      const int ntm = latonly ? 128 : 144;
      for (int task = bid; task < ntm * 2 + MROWS / 8; task += nb) {
        if (task < ntm * 2) glu_tile(p, layer, latonly, task >> 1, task & 1, (u16*)lds);
        else rwkv_combine_rows(p, layer, (task - ntm * 2) * 8, latonly);
      }
    }
    SYNC();
    {
      const int ntm = latonly ? 128 : 144;
      if ((nb & 7) == 0) { int tm, tn; for (int it = 0; xcd_tile(it, bid, nb, ntm, 16, 8, tm, tn); it++) merge_tile(p, layer, latonly, tm, tn, (u16*)lds); }
      else for (int task = bid; task < ntm * 16; task += nb) merge_tile(p, layer, latonly, task >> 4, task & 15, (u16*)lds);
    }
    SYNC();
    {
      const int ntm = latonly ? 128 : 144;
      if ((nb & 7) == 0) { int tm, tn; for (int it = 0; xcd_tile(it, bid, nb, ntm, 8, 8, tm, tn); it++) outproj_tile(p, layer, latonly, tm, tn, (u16*)lds); }
      else for (int task = bid; task < ntm * 8; task += nb) outproj_tile(p, layer, latonly, task >> 3, task & 7, (u16*)lds);
    }
    SYNC();
    if (layer == 0) {
      for (int task = bid; task < MROWS / 4 + N_CONVERT_TASKS; task += nb) {
        if (task < N_CONVERT_TASKS) convert_task(p, 1, task, lds);
        else ln_row(p, 1, 0, (task - N_CONVERT_TASKS) * 4 + (t >> 6));
      }
      SYNC();
    } else {
      for (int task = bid; task < NBATCH * 2048 / 4; task += nb) {
        int r = task * 4 + (t >> 6); int b = r >> 11, tl = r & 2047;
        ln_row(p, 1, 1, b * TT + 256 + tl);
      }
    }
  }
}

extern "C" void kernel_launch(void* const* d_in, const int* in_sizes, int n_in,
                              void* d_out, int out_size, void* d_ws, size_t ws_size,
                              hipStream_t stream) {
  static int grid_blocks = 0;
  if (!grid_blocks) {
    int dev = 0, cus = 0, per_cu = 0;
    (void)hipGetDevice(&dev);
    (void)hipDeviceGetAttribute(&cus, hipDeviceAttributeMultiprocessorCount, dev);
    (void)hipOccupancyMaxActiveBlocksPerMultiprocessor(&per_cu, fwd_megakernel, 256, 0);
    if (per_cu > 2) per_cu = 2;
    if (per_cu < 1) per_cu = 1;
    grid_blocks = cus * per_cu;
  }
  if (ws_size < WS_NEED) { fprintf(stderr, "workspace too small\n"); return; }
  Params p{};
  for (int i = 0; i < 36; i++) p.in[i] = (const float*)d_in[i];
  p.out = (float*)d_out;
  p.ws = (char*)d_ws;
  (void)hipMemsetAsync((char*)d_ws + OFF_BAR, 0, 256 + 32768, stream);
  void* args[] = {&p};
  hipError_t e = hipLaunchCooperativeKernel((void*)fwd_megakernel, dim3(grid_blocks), dim3(256), args, 0, stream);
  if (e != hipSuccess) fprintf(stderr, "cooperative launch failed: %s (grid %d)\n", hipGetErrorString(e), grid_blocks);
}
```

```cpp
#include <hip/hip_runtime.h>
#include <hip/hip_bf16.h>
#include <hip/hip_cooperative_groups.h>
#include <cstdio>
namespace cg = cooperative_groups;

typedef __attribute__((ext_vector_type(8))) short bf16x8;
typedef __attribute__((ext_vector_type(4))) float f32x4;
typedef unsigned short u16;

#define D_ 1024
#define NBATCH 8
#define TT 2304
#define MROWS 18432
#define PC 3904
#define DIN 8000
#define C_S5U 0
#define C_S5Z 256
#define C_HGQ 512
#define C_HGF 768
#define C_HGI 1280
#define C_HGZ 1536
#define C_RTQ 1792
#define C_RTK 2048
#define C_RTV 2304
#define C_RTZ 2560
#define C_RWX 2816
#define C_RWZ 3648

#define OFF_WINT   0ul
#define OFF_WBT    (OFF_WINT + 16384000ul)
#define OFF_WOT    (OFF_WBT + 2097152ul)
#define OFF_GLUT   (OFF_WOT + 2097152ul)
#define OFF_U      (OFF_GLUT + 131072ul)
#define OFF_PROJ   (OFF_U + 37748736ul)
#define OFF_HCTX   (OFF_PROJ + 143917056ul)
#define OFF_SCR    (OFF_HCTX + 8388608ul)
#define OFF_RWO    (OFF_SCR)
#define OFF_HGST   (OFF_SCR + 18874368ul)
#define OFF_RTST   (OFF_HGST + 9437184ul)
#define OFF_RETOF  (OFF_SCR + 37748736ul)
#define OFF_S5ST   (OFF_RETOF + 9437184ul)
#define OFF_MODS   (OFF_S5ST + 4718592ul)
#define OFF_HGP    (OFF_MODS + 221184ul)
#define OFF_BONUS  (OFF_HGP + 147456ul)
#define OFF_ROPE   (OFF_BONUS + 589824ul)
#define OFF_BAR    (OFF_ROPE + 8192ul)
#define OFF_XB     (OFF_BAR + 256ul)
#define WS_NEED    (OFF_XB + 32768ul)

struct Params {
  const float* in[36];
  float* out;
  char* ws;
};

__device__ __forceinline__ int tid_() { int t = __builtin_amdgcn_workitem_id_x(); asm volatile("" : "+v"(t)); return t; }
__device__ __forceinline__ u16 f2bf(float f) {
  unsigned u = __float_as_uint(f);
  u += 0x7fffu + ((u >> 16) & 1u);
  return (u16)(u >> 16);
}
__device__ __forceinline__ float bf2f(u16 h) { return __uint_as_float(((unsigned)h) << 16); }
__device__ __forceinline__ unsigned pack2(float a, float b) { return (unsigned)f2bf(a) | ((unsigned)f2bf(b) << 16); }
__device__ __forceinline__ float sigmoidf_(float x) { return __builtin_amdgcn_rcpf(1.f + __expf(-x)); }
__device__ __forceinline__ float siluf_(float x) { return x * __builtin_amdgcn_rcpf(1.f + __expf(-x)); }
__device__ __forceinline__ float geluf_(float x) {
  float t = tanhf(0.7978845608028654f * (x + 0.044715f * x * x * x));
  return 0.5f * x * (1.f + t);
}
template <int CTRL>
__device__ __forceinline__ float dppf(float x) {
  return __int_as_float(__builtin_amdgcn_update_dpp(0, __float_as_int(x), CTRL, 0xf, 0xf, true));
}
__device__ __forceinline__ float allsum16(float x) {
  x += dppf<0x128>(x);
  x += dppf<0x124>(x);
  x += dppf<0x122>(x);
  x += dppf<0x121>(x);
  return x;
}
__device__ __forceinline__ float wavesum(float x) {
  x = allsum16(x);
  x += __shfl_xor(x, 16, 64);
  x += __shfl_xor(x, 32, 64);
  return x;
}
__device__ __forceinline__ void ld4bf(const u16* p, float (&o)[4]) {
  uint2 v = *(const uint2*)p;
  o[0] = __uint_as_float(v.x << 16); o[1] = __uint_as_float(v.x & 0xffff0000u);
  o[2] = __uint_as_float(v.y << 16); o[3] = __uint_as_float(v.y & 0xffff0000u);
}
__device__ __forceinline__ void st4bf(u16* p, float a, float b, float c, float d) {
  uint2 v; v.x = pack2(a, b); v.y = pack2(c, d);
  *(uint2*)p = v;
}
__device__ __forceinline__ int jmap(int d, int s) { return d == 0 ? s : (s < 256 ? 255 - s : 2559 - s); }
__device__ __forceinline__ bool has_prev(int j) { return j != 0 && j != 256; }
__device__ __forceinline__ bool has_next(int j) { return j != 255 && j != 2303; }

__device__ __forceinline__ const float* hin_ptr(const Params& p, int layer, int row) {
  int b = row / TT, j = row - b * TT;
  if (layer == 0) return j < 256 ? p.in[2] + ((size_t)(b * 256 + j)) * D_ : p.in[0] + ((size_t)(b * 2048 + j - 256)) * D_;
  return j < 256 ? (const float*)(p.ws + OFF_HCTX) + ((size_t)(b * 256 + j)) * D_ : p.out + ((size_t)(b * 2048 + j - 256)) * D_;
}
__device__ __forceinline__ float* hout_ptr(const Params& p, int row) {
  int b = row / TT, j = row - b * TT;
  return j < 256 ? (float*)(p.ws + OFF_HCTX) + ((size_t)(b * 256 + j)) * D_ : p.out + ((size_t)(b * 2048 + j - 256)) * D_;
}
__device__ __forceinline__ int modrow_of(int row) { int b = row / TT, j = row - b * TT; return j < 256 ? 8 : b; }

__device__ void transpose_tile(const float* __restrict__ src, u16* __restrict__ dst, int K, int N, int k0, int n0, float* lds) {
  const int t = tid_();
  __syncthreads();
#pragma unroll
  for (int i = 0; i < 16; i++) {
    int r = i * 4 + (t >> 6), c = t & 63;
    lds[r * 65 + c] = src[(size_t)(k0 + r) * N + n0 + c];
  }
  __syncthreads();
#pragma unroll
  for (int i = 0; i < 16; i++) {
    int r = i * 4 + (t >> 6), c = t & 63;
    dst[(size_t)(n0 + r) * K + k0 + c] = f2bf(lds[c * 65 + r]);
  }
}
__device__ void convert_task(const Params& p, int layer, int task, float* lds) {
  if (task < 2000) {
    int kt = task / 125, nt = task % 125;
    transpose_tile(p.in[6] + (size_t)layer * 1024 * DIN, (u16*)(p.ws + OFF_WINT), 1024, DIN, kt * 64, nt * 64, lds);
  } else if (task < 2256) {
    int q = task - 2000; int br = q >> 6; q &= 63; int kt = q >> 4, nt = q & 15;
    transpose_tile(p.in[31] + ((size_t)layer * 4 + br) * 256 * 1024, (u16*)(p.ws + OFF_WBT) + (size_t)br * 1024 * 256, 256, 1024, kt * 64, nt * 64, lds);
  } else if (task < 2512) {
    int q = task - 2256; int kt = q >> 4, nt = q & 15;
    transpose_tile(p.in[32] + (size_t)layer * 1024 * 1024, (u16*)(p.ws + OFF_WOT), 1024, 1024, kt * 64, nt * 64, lds);
  } else {
    int q = task - 2512; int kt = q >> 2, nt = q & 3;
    transpose_tile(p.in[16] + (size_t)layer * 256 * 256, (u16*)(p.ws + OFF_GLUT), 256, 256, kt * 64, nt * 64, lds);
  }
}
#define N_CONVERT_TASKS 2528

__device__ void mods_task(const Params& p, int task, float* lds) {
  const int t = tid_();
  int layer = task / 96, cgp = task % 96;
  float* sc = lds;
  float* red = lds + 9 * 1024;
  __syncthreads();
  for (int i = t; i < 9 * 1024; i += 256) {
    int r = i >> 10, k = i & 1023;
    float v = r < 8 ? p.in[1][r * 1024 + k] : p.in[3][k];
    sc[i] = siluf_(v);
  }
  __syncthreads();
  const int cl = t & 31, kq = t >> 5;
  int col = cgp * 32 + cl;
  float acc[9];
#pragma unroll
  for (int r = 0; r < 9; r++) acc[r] = 0.f;
  const float* wp = p.in[4] + (size_t)layer * 1024 * 3072 + col;
#pragma unroll 16
  for (int k = kq * 128; k < kq * 128 + 128; k++) {
    float w = wp[(size_t)k * 3072];
#pragma unroll
    for (int r = 0; r < 9; r++) acc[r] += sc[r * 1024 + k] * w;
  }
#pragma unroll
  for (int r = 0; r < 9; r++) red[(kq * 9 + r) * 32 + cl] = acc[r];
  __syncthreads();
  float* mods = (float*)(p.ws + OFF_MODS);
  for (int i = t; i < 9 * 32; i += 256) {
    int r = i >> 5, c = i & 31;
    float s_ = 0.f;
#pragma unroll
    for (int g = 0; g < 8; g++) s_ += red[(g * 9 + r) * 32 + c];
    int cc = cgp * 32 + c;
    mods[((size_t)layer * 9 + r) * 3072 + cc] = s_ + p.in[5][layer * 3072 + cc];
  }
}

__device__ void ln_row(const Params& p, int mode, int layer, int row) {
  const int lane = tid_() & 63;
  float v[16];
  if (mode == 0) {
    const float* src = hin_ptr(p, 0, row);
#pragma unroll
    for (int i = 0; i < 4; i++) { float4 q = *(const float4*)(src + i * 256 + lane * 4); v[i*4]=q.x; v[i*4+1]=q.y; v[i*4+2]=q.z; v[i*4+3]=q.w; }
  } else {
    float* src = hout_ptr(p, row);
#pragma unroll
    for (int i = 0; i < 4; i++) { float4 q = *(const float4*)(src + i * 256 + lane * 4); v[i*4]=q.x; v[i*4+1]=q.y; v[i*4+2]=q.z; v[i*4+3]=q.w; }
    float s = 0.f;
#pragma unroll
    for (int i = 0; i < 16; i++) s += v[i];
    float mean = wavesum(s) * (1.f / 1024.f);
    float q2 = 0.f;
#pragma unroll
    for (int i = 0; i < 16; i++) { v[i] -= mean; q2 += v[i] * v[i]; }
    float rstd = rsqrtf(wavesum(q2) * (1.f / 1024.f) + 1e-5f);
    const float* lw = p.in[34] + layer * 1024; const float* lb = p.in[35] + layer * 1024;
#pragma unroll
    for (int i = 0; i < 4; i++) {
      float4 w4 = *(const float4*)(lw + i * 256 + lane * 4), b4 = *(const float4*)(lb + i * 256 + lane * 4);
      v[i*4] = v[i*4] * rstd * w4.x + b4.x; v[i*4+1] = v[i*4+1] * rstd * w4.y + b4.y;
      v[i*4+2] = v[i*4+2] * rstd * w4.z + b4.z; v[i*4+3] = v[i*4+3] * rstd * w4.w + b4.w;
      *(float4*)(src + i * 256 + lane * 4) = make_float4(v[i*4], v[i*4+1], v[i*4+2], v[i*4+3]);
    }
    if (layer == 1) return;
  }
  int ml = mode == 0 ? 0 : 1;
  float s = 0.f;
#pragma unroll
  for (int i = 0; i < 16; i++) s += v[i];
  float mean = wavesum(s) * (1.f / 1024.f);
  float q2 = 0.f;
#pragma unroll
  for (int i = 0; i < 16; i++) { v[i] -= mean; q2 += v[i] * v[i]; }
  float rstd = rsqrtf(wavesum(q2) * (1.f / 1024.f) + 1e-5f);
  const float* md = (const float*)(p.ws + OFF_MODS) + ((size_t)ml * 9 + modrow_of(row)) * 3072;
  u16* up = (u16*)(p.ws + OFF_U) + (size_t)row * 1024;
#pragma unroll
  for (int i = 0; i < 4; i++) {
    float4 sh = *(const float4*)(md + i * 256 + lane * 4), sc = *(const float4*)(md + 1024 + i * 256 + lane * 4);
    st4bf(up + i * 256 + lane * 4, v[i*4] * rstd * (1.f + sc.x) + sh.x, v[i*4+1] * rstd * (1.f + sc.y) + sh.y,
          v[i*4+2] * rstd * (1.f + sc.z) + sh.z, v[i*4+3] * rstd * (1.f + sc.w) + sh.w);
  }
}

#define STAGE_LOAD(P, kk_) do { const unsigned k_ = (kk_); \
  P##a0 = *(const uint4*)(A + (oa + k_)); P##a1 = *(const uint4*)(A + (oa + sa + k_)); \
  P##a2 = *(const uint4*)(A + (oa + 2 * sa + k_)); P##a3 = *(const uint4*)(A + (oa + 3 * sa + k_)); \
  P##b0 = *(const uint4*)(B + (ob + k_)); P##b1 = *(const uint4*)(B + (ob + sb + k_)); \
  if (NT == 4) { P##b2 = *(const uint4*)(B + (ob + 2 * sb + k_)); P##b3 = *(const uint4*)(B + (ob + 3 * sb + k_)); } } while (0)
#define STAGE_WRITE(P, Asw, Bsw) do { \
  *(uint4*)(Asw) = P##a0; *(uint4*)((Asw) + 32 * 72) = P##a1; *(uint4*)((Asw) + 64 * 72) = P##a2; *(uint4*)((Asw) + 96 * 72) = P##a3; \
  *(uint4*)(Bsw) = P##b0; *(uint4*)((Bsw) + 32 * 72) = P##b1; \
  if (NT == 4) { *(uint4*)((Bsw) + 64 * 72) = P##b2; *(uint4*)((Bsw) + 96 * 72) = P##b3; } } while (0)
template <int MT, int NT>
__device__ __forceinline__ void stage_compute(f32x4 (&acc)[MT][NT], const u16* As, const u16* Bs, int lane, int wm, int wn) {
#pragma unroll
  for (int kk = 0; kk < 2; kk++) {
    bf16x8 af[MT], bfr[NT];
#pragma unroll
    for (int mt = 0; mt < MT; mt++) af[mt] = *(const bf16x8*)(As + (wm * MT * 16 + mt * 16 + (lane & 15)) * 72 + kk * 32 + (lane >> 4) * 8);
#pragma unroll
    for (int nt = 0; nt < NT; nt++) bfr[nt] = *(const bf16x8*)(Bs + (wn * NT * 16 + nt * 16 + (lane & 15)) * 72 + kk * 32 + (lane >> 4) * 8);
    __builtin_amdgcn_s_setprio(1);
#pragma unroll
    for (int mt = 0; mt < MT; mt++)
#pragma unroll
      for (int nt = 0; nt < NT; nt++)
        acc[mt][nt] = __builtin_amdgcn_mfma_f32_16x16x32_bf16(af[mt], bfr[nt], acc[mt][nt], 0, 0, 0);
    __builtin_amdgcn_s_setprio(0);
  }
}
template <int MT, int NT>
__device__ __forceinline__ void gemm_kloop(f32x4 (&acc)[MT][NT], const u16* __restrict__ A, int lda,
                                           const u16* __restrict__ B, int ldb, int K, u16* lds) {
  static_assert(MT == 4, "MT");
  constexpr int BM = MT * 32, BN = NT * 32, SS = (BM + BN) * 72;
  const int t = tid_(), lane = t & 63, w = t >> 6, wm = w >> 1, wn = w & 1;
  u16* As0 = lds; u16* Bs0 = lds + BM * 72; u16* As1 = lds + SS; u16* Bs1 = lds + SS + BM * 72;
  const int lr = t >> 3, lc = (t & 7) * 8;
  const unsigned oa = (unsigned)(lr * lda + lc), ob = (unsigned)(lr * ldb + lc);
  const unsigned sa = 32u * (unsigned)lda, sb = 32u * (unsigned)ldb;
  const int swo = lr * 72 + lc;
  const unsigned klast = (unsigned)(K - 64);
  uint4 R0a0, R0a1, R0a2, R0a3, R0b0, R0b1, R0b2, R0b3, R1a0, R1a1, R1a2, R1a3, R1b0, R1b1, R1b2, R1b3;
  STAGE_LOAD(R0, 0u);
  STAGE_LOAD(R1, 64u);
  __syncthreads();
  STAGE_WRITE(R0, As0 + swo, Bs0 + swo);
  STAGE_LOAD(R0, 128u < klast ? 128u : klast);
  __syncthreads();
#pragma unroll 1
  for (int k0 = 0; k0 < K; k0 += 128) {
    STAGE_WRITE(R1, As1 + swo, Bs1 + swo);
    { unsigned kn = (unsigned)k0 + 192u; STAGE_LOAD(R1, kn < klast ? kn : klast); }
    stage_compute<MT, NT>(acc, As0, Bs0, lane, wm, wn);
    __syncthreads();
    STAGE_WRITE(R0, As0 + swo, Bs0 + swo);
    { unsigned kn = (unsigned)k0 + 256u; STAGE_LOAD(R0, kn < klast ? kn : klast); }
    stage_compute<MT, NT>(acc, As1, Bs1, lane, wm, wn);
    __syncthreads();
  }
}
template <int MT, int NT>
__device__ __forceinline__ void zero_acc(f32x4 (&acc)[MT][NT]) {
#pragma unroll
  for (int i = 0; i < MT; i++)
#pragma unroll
    for (int j = 0; j < NT; j++) acc[i][j] = (f32x4){0.f, 0.f, 0.f, 0.f};
}
__device__ __forceinline__ int tile_m0(int latonly, int tm) {
  if (!latonly) return tm * 128;
  int b = tm >> 4; return b * TT + 256 + (tm & 15) * 128;
}

__device__ __forceinline__ bool xcd_tile(int it, int bid, int nb, int NTM, int NTN, int G, int& tm, int& tn) {
  const int xcd = bid & 7, lb = bid >> 3, nlb = nb >> 3, tmx = NTM >> 3;
  const int idx = it * nlb + lb;
  if (idx >= tmx * NTN) return false;
  const int full = tmx / G;
  int g = idx / (G * NTN);
  if (g > full) g = full;
  const int r = idx - g * G * NTN;
  const int gs = (g < full) ? G : (tmx - full * G);
  tn = r / gs;
  tm = xcd * tmx + g * G + (r - tn * gs);
  return true;
}
__device__ void inproj_tile(const Params& p, int layer, int tm, int tn, u16* lds) {
  int m0 = tm * 128, n0 = tn * 128;
  f32x4 acc[4][4]; zero_acc(acc);
  gemm_kloop<4, 4>(acc, (const u16*)(p.ws + OFF_U) + (size_t)m0 * 1024, 1024,
                   (const u16*)(p.ws + OFF_WINT) + (size_t)n0 * 1024, 1024, 1024, lds);
  const int t = tid_(), lane = t & 63, w = t >> 6, wm = w >> 1, wn = w & 1;
  const float* bias = p.in[7] + (size_t)layer * DIN;
  u16* proj = (u16*)(p.ws + OFF_PROJ);
#pragma unroll
  for (int nt = 0; nt < 4; nt++) {
    const int cl = wn * 64 + nt * 16 + (lane & 15);
    const float bv = (n0 + cl < PC) ? bias[n0 + cl] : 0.f;
#pragma unroll
    for (int mt = 0; mt < 4; mt++)
#pragma unroll
      for (int r = 0; r < 4; r++) lds[(wm * 64 + mt * 16 + (lane >> 4) * 4 + r) * 136 + cl] = f2bf(acc[mt][nt][r] + bv);
  }
  __syncthreads();
#pragma unroll
  for (int i = 0; i < 8; i++) {
    const int q = t + 256 * i, row = q >> 4, ch = q & 15;
    if (n0 + ch * 8 < PC) *(uint4*)(proj + (size_t)(m0 + row) * PC + n0 + ch * 8) = *(const uint4*)(lds + row * 136 + ch * 8);
  }
}
__device__ void glu_tile(const Params& p, int layer, int latonly, int tm, int tn, u16* lds) {
  int m0 = tile_m0(latonly, tm), n0 = tn * 128;
  f32x4 acc[4][4]; zero_acc(acc);
  u16* proj = (u16*)(p.ws + OFF_PROJ);
  gemm_kloop<4, 4>(acc, proj + (size_t)m0 * PC + C_S5U, PC, (const u16*)(p.ws + OFF_GLUT) + (size_t)n0 * 256, 256, 256, lds);
  const int t = tid_(), lane = t & 63, w = t >> 6, wm = w >> 1, wn = w & 1;
  const float* bias = p.in[17] + layer * 256;
#pragma unroll
  for (int nt = 0; nt < 4; nt++) {
    const int cl = wn * 64 + nt * 16 + (lane & 15);
    const float bv = bias[n0 + cl];
#pragma unroll
    for (int mt = 0; mt < 4; mt++)
#pragma unroll
      for (int r = 0; r < 4; r++) lds[(wm * 64 + mt * 16 + (lane >> 4) * 4 + r) * 136 + cl] = f2bf(sigmoidf_(acc[mt][nt][r] + bv));
  }
  __syncthreads();
#pragma unroll
  for (int i = 0; i < 8; i++) {
    const int q = t + 256 * i, row = q >> 4, ch = q & 15;
    u16* pr = proj + (size_t)(m0 + row) * PC + n0 + ch * 8;
    uint4 sg = *(const uint4*)(lds + row * 136 + ch * 8);
    uint4 yy = *(const uint4*)(pr + C_S5U), zz = *(const uint4*)(pr + C_S5Z), oo;
    const unsigned* sgp = (const unsigned*)&sg; const unsigned* yp = (const unsigned*)&yy; const unsigned* zp = (const unsigned*)&zz; unsigned* op = (unsigned*)&oo;
#pragma unroll
    for (int e = 0; e < 4; e++) {
      float s0 = __uint_as_float(sgp[e] << 16), s1 = __uint_as_float(sgp[e] & 0xffff0000u);
      float y0 = __uint_as_float(yp[e] << 16), y1 = __uint_as_float(yp[e] & 0xffff0000u);
      float z0 = __uint_as_float(zp[e] << 16), z1 = __uint_as_float(zp[e] & 0xffff0000u);
      op[e] = pack2(y0 * s0 * siluf_(z0), y1 * s1 * siluf_(z1));
    }
    *(uint4*)(pr + C_S5Z) = oo;
  }
}
__device__ void merge_tile(const Params& p, int layer, int latonly, int tm, int tn, u16* lds) {
  constexpr int NT = 2;
  int m0 = tile_m0(latonly, tm), n0 = tn * 64;
  f32x4 accm[4][2]; zero_acc(accm);
  f32x4 accb[4][2]; zero_acc(accb);
  f32x4 accg[4][2]; zero_acc(accg);
  const u16* proj = (const u16*)(p.ws + OFF_PROJ);
  const u16* ub = (const u16*)(p.ws + OFF_U) + (size_t)m0 * 1024;
  const u16* wbt = (const u16*)(p.ws + OFF_WBT) + (size_t)n0 * 256;
  const u16* wgt = (const u16*)(p.ws + OFF_WINT) + ((size_t)PC + n0) * 1024;
  const int t = tid_(), lane = t & 63, w = t >> 6, wm = w >> 1, wn = w & 1;
  const float* bias = p.in[7] + (size_t)layer * DIN + PC;
  constexpr int SS = (128 + 64) * 72;
  u16* As0 = lds; u16* Bs0 = lds + 128 * 72; u16* As1 = lds + SS; u16* Bs1 = lds + SS + 128 * 72;
  const int lr = t >> 3, lc = (t & 7) * 8;
  const int swo = lr * 72 + lc;
  const unsigned oay = (unsigned)(lr * PC + lc), oau = (unsigned)(lr * 1024 + lc), obb = (unsigned)(lr * 256 + lc), obg = (unsigned)(lr * 1024 + lc);
  uint4 R0a0, R0a1, R0a2, R0a3, R0b0, R0b1, R0b2, R0b3, R1a0, R1a1, R1a2, R1a3, R1b0, R1b1, R1b2, R1b3;
  const u16* W = (const u16*)p.ws;
  const unsigned baseY = (unsigned)(OFF_PROJ / 2) + (unsigned)m0 * PC + oay;
  const unsigned baseU = (unsigned)(OFF_U / 2) + (unsigned)m0 * 1024u + oau;
  const unsigned baseB = (unsigned)(OFF_WBT / 2) + (unsigned)n0 * 256u + obb;
  const unsigned baseG = (unsigned)(OFF_WINT / 2) + ((unsigned)PC + (unsigned)n0) * 1024u + obg;
#define MLOAD(P, step_) do { int s_ = (step_); if (s_ > 79) s_ = 79; const int k_ = s_ / 20, r_ = s_ - k_ * 20; \
    const bool br_ = r_ < 4; \
    const unsigned yc_ = k_ == 0 ? C_S5Z : (k_ == 1 ? C_HGQ : (k_ == 2 ? C_RTQ : C_RWZ)); \
    const unsigned ao_ = br_ ? baseY + yc_ + 64u * r_ : baseU + 64u * (r_ - 4); \
    const unsigned bo_ = br_ ? baseB + (unsigned)k_ * 262144u + 64u * r_ : baseG + (unsigned)k_ * 1048576u + 64u * (r_ - 4); \
    const unsigned sa_ = br_ ? 32u * PC : 32768u, sb_ = br_ ? 8192u : 32768u; \
    P##a0 = *(const uint4*)(W + ao_); P##a1 = *(const uint4*)(W + (ao_ + sa_)); \
    P##a2 = *(const uint4*)(W + (ao_ + 2 * sa_)); P##a3 = *(const uint4*)(W + (ao_ + 3 * sa_)); \
    P##b0 = *(const uint4*)(W + bo_); P##b1 = *(const uint4*)(W + (bo_ + sb_)); } while (0)
  MLOAD(R0, 0);
  MLOAD(R1, 1);
  __syncthreads();
  STAGE_WRITE(R0, As0 + swo, Bs0 + swo);
  MLOAD(R0, 2);
  __syncthreads();
#define MPAIR(ACC) do { \
    STAGE_WRITE(R1, As1 + swo, Bs1 + swo); \
    MLOAD(R1, st + 3); \
    stage_compute<4, 2>(ACC, As0, Bs0, lane, wm, wn); \
    __syncthreads(); \
    STAGE_WRITE(R0, As0 + swo, Bs0 + swo); \
    MLOAD(R0, st + 4); \
    stage_compute<4, 2>(ACC, As1, Bs1, lane, wm, wn); \
    __syncthreads(); \
    st += 2; } while (0)
  int st = 0;
#pragma unroll 1
  for (int k = 0; k < 4; k++) {
#pragma unroll 1
    for (int i = 0; i < 2; i++) MPAIR(accb);
#pragma unroll 1
    for (int i = 0; i < 8; i++) MPAIR(accg);
#pragma unroll
    for (int nt = 0; nt < 2; nt++) {
      float bv = bias[k * 1024 + n0 + wn * 32 + nt * 16 + (lane & 15)];
#pragma unroll
      for (int mt = 0; mt < 4; mt++)
#pragma unroll
        for (int rr = 0; rr < 4; rr++) accm[mt][nt][rr] += sigmoidf_(accg[mt][nt][rr] + bv) * accb[mt][nt][rr];
    }
    zero_acc(accb); zero_acc(accg);
  }
#undef MPAIR
#undef MLOAD
  u16* mg = (u16*)(p.ws + OFF_SCR);
#pragma unroll
  for (int nt = 0; nt < 2; nt++) {
    const int cl = wn * 32 + nt * 16 + (lane & 15);
#pragma unroll
    for (int mt = 0; mt < 4; mt++)
#pragma unroll
      for (int r = 0; r < 4; r++) lds[(wm * 64 + mt * 16 + (lane >> 4) * 4 + r) * 72 + cl] = f2bf(accm[mt][nt][r]);
  }
  __syncthreads();
  {
    const int t = tid_();
#pragma unroll
    for (int i = 0; i < 4; i++) {
      const int q = t + 256 * i, row = q >> 3, ch = q & 7;
      *(uint4*)(mg + (size_t)(m0 + row) * 1024 + n0 + ch * 8) = *(const uint4*)(lds + row * 72 + ch * 8);
    }
  }
}
__device__ void outproj_tile(const Params& p, int layer, int latonly, int tm, int tn, u16* lds) {
  int m0 = tile_m0(latonly, tm), n0 = tn * 128;
  f32x4 acc[4][4]; zero_acc(acc);
  gemm_kloop<4, 4>(acc, (const u16*)(p.ws + OFF_SCR) + (size_t)m0 * 1024, 1024,
                   (const u16*)(p.ws + OFF_WOT) + (size_t)n0 * 1024, 1024, 1024, lds);
  const int lane = tid_() & 63, w = tid_() >> 6, wm = w >> 1, wn = w & 1;
  const float* bias = p.in[33] + layer * 1024;
  const float* hi0 = hin_ptr(p, layer, m0);
  float* ho0 = hout_ptr(p, m0);
  const float* gate = (const float*)(p.ws + OFF_MODS) + ((size_t)layer * 9 + modrow_of(m0)) * 3072 + 2048;
  float* cs = (float*)lds;
#pragma unroll
  for (int nt = 0; nt < 4; nt++) {
    const int cl = wn * 64 + nt * 16 + (lane & 15);
    const float bv = bias[n0 + cl];
#pragma unroll
    for (int mt = 0; mt < 4; mt++)
#pragma unroll
      for (int r = 0; r < 4; r++) cs[(wm * 64 + mt * 16 + (lane >> 4) * 4 + r) * 132 + cl] = acc[mt][nt][r] + bv;
  }
  __syncthreads();
  {
    const int t = tid_();
#pragma unroll 4
    for (int i = 0; i < 16; i++) {
      const int q = t + 256 * i, row = q >> 5, ch = q & 31;
      const float4 a4 = *(const float4*)(cs + row * 132 + ch * 4);
      const float4 g4 = *(const float4*)(gate + n0 + ch * 4);
      const float4 h4 = *(const float4*)(hi0 + (size_t)row * 1024 + n0 + ch * 4);
      float4 o4;
      o4.x = 1.4142135623730951f * h4.x + g4.x * a4.x; o4.y = 1.4142135623730951f * h4.y + g4.y * a4.y;
      o4.z = 1.4142135623730951f * h4.z + g4.z * a4.z; o4.w = 1.4142135623730951f * h4.w + g4.w * a4.w;
      *(float4*)(ho0 + (size_t)row * 1024 + n0 + ch * 4) = o4;
    }
  }
}

template <bool TWO>
__device__ void rwkv_scan_task(const Params& p, int layer, int task, float* lds) {
  const int t = tid_();
  const int rh = TWO ? (task & 1) : (task & 3), h = TWO ? ((task >> 1) & 3) : ((task >> 2) & 3);
  const int b = TWO ? ((task >> 3) & 7) : ((task >> 4) & 7), d = TWO ? (task >> 6) : (task >> 7);
  constexpr int RPB = TWO ? 32 : 16;
  float* sh_lora = lds;
  float* sh_w2 = sh_lora + 512;
  float* sh_a2 = sh_w2 + 1024;
  float* sh_r = sh_a2 + 1024;
  float* sh_w = sh_r + 1024;
  float* sh_k = sh_w + 1024;
  float* sh_kk = sh_k + 1024;
  float* sh_b = sh_kk + 1024;
  float* sh_v = sh_b + 1024;
  float* sh_o = sh_v + 512;
  const u16* proj = (const u16*)(p.ws + OFF_PROJ);
  u16* rwo = (u16*)(p.ws + OFF_RWO) + (size_t)d * MROWS * 256;
  float* bonus = (float*)(p.ws + OFF_BONUS) + (size_t)d * MROWS * 4;
  const float* mu0 = p.in[21] + (size_t)layer * 2 * 832;
  const float* mu1 = mu0 + 832;
  __syncthreads();
  for (int i = t; i < 1024; i += 256) {
    int rr = i >> 6, c = i & 63;
    sh_w2[i] = p.in[23][(((size_t)layer * 2 + d) * 16 + rr) * 256 + h * 64 + c];
    sh_a2[i] = p.in[25][(((size_t)layer * 2 + d) * 16 + rr) * 256 + h * 64 + c];
  }
  const int pst = t >> 4, cq = t & 15;
  const int ch0 = h * 64 + cq * 4;
  float mur0[4], mur1[4], muk0[4], muk1[4], w0v[4], a0v[4], kkw[4], kaw[4], rkw[4];
#pragma unroll
  for (int i = 0; i < 4; i++) {
    mur0[i] = mu0[ch0 + i]; mur1[i] = mu1[ch0 + i];
    muk0[i] = mu0[256 + ch0 + i]; muk1[i] = mu1[256 + ch0 + i];
    w0v[i] = p.in[22][((size_t)layer * 2 + d) * 256 + ch0 + i];
    a0v[i] = p.in[24][((size_t)layer * 2 + d) * 256 + ch0 + i];
    kkw[i] = p.in[26][layer * 256 + ch0 + i];
    kaw[i] = p.in[27][layer * 256 + ch0 + i];
    rkw[i] = p.in[28][layer * 256 + ch0 + i];
  }
  const int vch = 512 + h * 64 + rh * RPB + cq;
  const float muv0 = mu0[vch], muv1 = mu1[vch], muw0 = TWO ? mu0[vch + 16] : 0.f, muw1 = TWO ? mu1[vch + 16] : 0.f;
  const int lidx0 = t * 2;
  float lmu00, lmu01, lmu10, lmu11;
  {
    int q = lidx0 & 31;
    int col = q < 16 ? (768 + d * 16 + q) : (800 + d * 16 + (q - 16));
    lmu00 = mu0[col]; lmu01 = mu0[col + 1]; lmu10 = mu1[col]; lmu11 = mu1[col + 1];
  }
  const int rl = t >> 4, ks = t & 15;
  float4 S = make_float4(0.f, 0.f, 0.f, 0.f), S2 = make_float4(0.f, 0.f, 0.f, 0.f);
  unsigned lx0 = 0, lx1 = 0, lxp0 = 0, lxp1 = 0, lxn0 = 0, lxn1 = 0;
  uint2 rr_c, rr_p, rr_n, rk_c, rk_p, rk_n;
  unsigned rv_c, rv_p, rv_n, rw_c = 0, rw_p = 0, rw_n = 0;
  auto fetch = [&](int s0) {
    {
      int st2 = lidx0 >> 5, q = lidx0 & 31;
      int j = jmap(d, s0 + st2);
      int col = q < 16 ? (768 + d * 16 + q) : (800 + d * 16 + (q - 16));
      const u16* pr = proj + ((size_t)(b * TT + j)) * PC + C_RWX + col;
      const u16* prp = has_prev(j) ? pr - PC : pr;
      const u16* prn = has_next(j) ? pr + PC : pr;
      lx0 = pr[0]; lx1 = pr[1]; lxp0 = prp[0]; lxp1 = prp[1]; lxn0 = prn[0]; lxn1 = prn[1];
    }
    int j = jmap(d, s0 + pst);
    const u16* pr = proj + ((size_t)(b * TT + j)) * PC + C_RWX;
    const u16* prp = has_prev(j) ? pr - PC : pr;
    const u16* prn = has_next(j) ? pr + PC : pr;
    rr_c = *(const uint2*)(pr + ch0); rr_p = *(const uint2*)(prp + ch0); rr_n = *(const uint2*)(prn + ch0);
    rk_c = *(const uint2*)(pr + 256 + ch0); rk_p = *(const uint2*)(prp + 256 + ch0); rk_n = *(const uint2*)(prn + 256 + ch0);
    rv_c = pr[vch]; rv_p = prp[vch]; rv_n = prn[vch];
    if (TWO) { rw_c = pr[vch + 16]; rw_p = prp[vch + 16]; rw_n = prn[vch + 16]; }
  };
  auto unpack4 = [](uint2 v, float (&o)[4]) {
    o[0] = __uint_as_float(v.x << 16); o[1] = __uint_as_float(v.x & 0xffff0000u);
    o[2] = __uint_as_float(v.y << 16); o[3] = __uint_as_float(v.y & 0xffff0000u);
  };
  fetch(0);
  for (int s0 = 0; s0 < TT; s0 += 16) {
    {
      int st2 = lidx0 >> 5, q = lidx0 & 31;
      int ja = jmap(d, s0 + st2);
      const float hpa = has_prev(ja) ? 1.f : 0.f, hna = has_next(ja) ? 1.f : 0.f;
      float x0 = __uint_as_float(lx0 << 16), x1 = __uint_as_float(lx1 << 16);
      float xs0 = x0 + lmu00 * (__uint_as_float(lxp0 << 16) * hpa - x0) + lmu10 * (__uint_as_float(lxn0 << 16) * hna - x0);
      float xs1 = x1 + lmu01 * (__uint_as_float(lxp1 << 16) * hpa - x1) + lmu11 * (__uint_as_float(lxn1 << 16) * hna - x1);
      if (q < 16) {
        xs0 = 1.f - 2.f * __builtin_amdgcn_rcpf(__expf(2.f * xs0) + 1.f);
        xs1 = 1.f - 2.f * __builtin_amdgcn_rcpf(__expf(2.f * xs1) + 1.f);
      }
      *(float2*)(sh_lora + lidx0) = make_float2(xs0, xs1);
    }
    __syncthreads();
    const int jcur = jmap(d, s0 + pst);
    {
      const float hpf = has_prev(jcur) ? 1.f : 0.f, hnf = has_next(jcur) ? 1.f : 0.f;
      float r4[4], k4[4], t0[4], t1[4];
      unpack4(rr_c, r4); unpack4(rr_p, t0); unpack4(rr_n, t1);
#pragma unroll
      for (int i = 0; i < 4; i++) r4[i] = r4[i] + mur0[i] * (t0[i] * hpf - r4[i]) + mur1[i] * (t1[i] * hnf - r4[i]);
      unpack4(rk_c, k4); unpack4(rk_p, t0); unpack4(rk_n, t1);
#pragma unroll
      for (int i = 0; i < 4; i++) k4[i] = k4[i] + muk0[i] * (t0[i] * hpf - k4[i]) + muk1[i] * (t1[i] * hnf - k4[i]);
      float wl[4], al[4];
#pragma unroll
      for (int i = 0; i < 4; i++) { wl[i] = w0v[i]; al[i] = a0v[i]; }
      float lrow[32];
#pragma unroll
      for (int i4 = 0; i4 < 8; i4++) {
        float4 q4 = *(const float4*)(sh_lora + pst * 32 + i4 * 4);
        lrow[i4 * 4] = q4.x; lrow[i4 * 4 + 1] = q4.y; lrow[i4 * 4 + 2] = q4.z; lrow[i4 * 4 + 3] = q4.w;
      }
#pragma unroll
      for (int rr = 0; rr < 16; rr++) {
        float lw_ = lrow[rr], la_ = lrow[16 + rr];
        float4 w2 = *(const float4*)(sh_w2 + rr * 64 + cq * 4);
        float4 a2 = *(const float4*)(sh_a2 + rr * 64 + cq * 4);
        wl[0] += lw_ * w2.x; wl[1] += lw_ * w2.y; wl[2] += lw_ * w2.z; wl[3] += lw_ * w2.w;
        al[0] += la_ * a2.x; al[1] += la_ * a2.y; al[2] += la_ * a2.z; al[3] += la_ * a2.w;
      }
      float wv[4], kd[4], kk[4], bb[4];
      float ss = 0.f, bon = 0.f;
#pragma unroll
      for (int i = 0; i < 4; i++) {
        float a = wl[i];
        float lw = fminf(a, 0.f) - __logf(1.f + __expf(-fabsf(a))) - 0.5f;
        wv[i] = __expf(-__expf(lw));
        float ic = sigmoidf_(al[i]);
        float kr = k4[i] * kkw[i];
        kk[i] = kr; ss += kr * kr;
        kd[i] = k4[i] * (1.f + (ic - 1.f) * kaw[i]);
        bb[i] = ic;
        bon += r4[i] * kd[i] * rkw[i];
      }
      ss = allsum16(ss); bon = allsum16(bon);
      float inv = rsqrtf(fmaxf(ss, 1e-24f));
#pragma unroll
      for (int i = 0; i < 4; i++) { kk[i] *= inv; bb[i] *= kk[i]; }
      *(float4*)(sh_r + pst * 64 + cq * 4) = make_float4(r4[0], r4[1], r4[2], r4[3]);
      *(float4*)(sh_w + pst * 64 + cq * 4) = make_float4(wv[0], wv[1], wv[2], wv[3]);
      *(float4*)(sh_k + pst * 64 + cq * 4) = make_float4(kd[0], kd[1], kd[2], kd[3]);
      *(float4*)(sh_kk + pst * 64 + cq * 4) = make_float4(kk[0], kk[1], kk[2], kk[3]);
      *(float4*)(sh_b + pst * 64 + cq * 4) = make_float4(bb[0], bb[1], bb[2], bb[3]);
      if (rh == 0 && cq == 0) bonus[(size_t)(b * TT + jcur) * 4 + h] = bon;
      float xv = __uint_as_float(rv_c << 16);
      sh_v[pst * 32 + cq] = xv + muv0 * (__uint_as_float(rv_p << 16) * hpf - xv) + muv1 * (__uint_as_float(rv_n << 16) * hnf - xv);
      float xw = __uint_as_float(rw_c << 16);
      if (TWO) sh_v[pst * 32 + 16 + cq] = xw + muw0 * (__uint_as_float(rw_p << 16) * hpf - xw) + muw1 * (__uint_as_float(rw_n << 16) * hnf - xw);
    }
    __syncthreads();
    if (s0 + 16 < TT) fetch(s0 + 16);
    float oacc = 0.f, oacc2 = 0.f;
    {
      float4 nkk = *(const float4*)(sh_kk + ks * 4), nw = *(const float4*)(sh_w + ks * 4), nb4 = *(const float4*)(sh_b + ks * 4);
      float4 nk = *(const float4*)(sh_k + ks * 4), nr = *(const float4*)(sh_r + ks * 4);
      float nv = sh_v[rl], nv2 = sh_v[16 + rl];
#pragma unroll 4
      for (int st = 0; st < 16; st++) {
        const float4 kk4 = nkk, w4 = nw, b4 = nb4, k4 = nk, r4 = nr; const float vv = nv, vv2 = nv2;
        {
          const int sn = (st + 1) & 15;
          nkk = *(const float4*)(sh_kk + sn * 64 + ks * 4); nw = *(const float4*)(sh_w + sn * 64 + ks * 4);
          nb4 = *(const float4*)(sh_b + sn * 64 + ks * 4); nk = *(const float4*)(sh_k + sn * 64 + ks * 4);
          nr = *(const float4*)(sh_r + sn * 64 + ks * 4); nv = sh_v[sn * 32 + rl]; nv2 = sh_v[sn * 32 + 16 + rl];
        }
        float sa = -((S.x * kk4.x + S.y * kk4.y) + (S.z * kk4.z + S.w * kk4.w));
        float sa2 = 0.f;
        if (TWO) sa2 = -((S2.x * kk4.x + S2.y * kk4.y) + (S2.z * kk4.z + S2.w * kk4.w));
        sa = allsum16(sa); if (TWO) sa2 = allsum16(sa2);
        S.x = S.x * w4.x + (sa * b4.x + vv * k4.x);
        S.y = S.y * w4.y + (sa * b4.y + vv * k4.y);
        S.z = S.z * w4.z + (sa * b4.z + vv * k4.z);
        S.w = S.w * w4.w + (sa * b4.w + vv * k4.w);
        if (TWO) {
          S2.x = S2.x * w4.x + (sa2 * b4.x + vv2 * k4.x);
          S2.y = S2.y * w4.y + (sa2 * b4.y + vv2 * k4.y);
          S2.z = S2.z * w4.z + (sa2 * b4.z + vv2 * k4.z);
          S2.w = S2.w * w4.w + (sa2 * b4.w + vv2 * k4.w);
        }
        float o = (S.x * r4.x + S.y * r4.y) + (S.z * r4.z + S.w * r4.w);
        float o2 = 0.f;
        if (TWO) o2 = (S2.x * r4.x + S2.y * r4.y) + (S2.z * r4.z + S2.w * r4.w);
        o = allsum16(o); if (TWO) o2 = allsum16(o2);
        oacc = (ks == st) ? o : oacc;
        oacc2 = (ks == st) ? o2 : oacc2;
      }
    }
    sh_o[ks * 32 + rl] = oacc;
    if (TWO) sh_o[ks * 32 + 16 + rl] = oacc2;
    __syncthreads();
    {
      u16* op = rwo + (size_t)(b * TT + jcur) * 256 + h * 64 + rh * RPB + cq;
      op[0] = f2bf(sh_o[pst * 32 + cq]);
      if (TWO) op[16] = f2bf(sh_o[pst * 32 + 16 + cq]);
    }
  }
}

__device__ void rwkv_combine_rows(const Params& p, int layer, int row0, int latonly) {
  const int lane = tid_() & 63, h = tid_() >> 6;
  const int ch = h * 64 + lane;
  const u16* rwo = (const u16*)(p.ws + OFF_RWO);
  u16* proj = (u16*)(p.ws + OFF_PROJ);
  const float* mu0 = p.in[21] + (size_t)layer * 2 * 832; const float* mu1 = mu0 + 832;
  const float* bonus = (const float*)(p.ws + OFF_BONUS);
  const float gw = p.in[29][layer * 256 + ch], gb = p.in[30][layer * 256 + ch];
  const float m0 = mu0[512 + ch], m1 = mu1[512 + ch];
  const int vc = C_RWX + 512 + ch;
  float o[8], xv[8], xp[8], xn[8], bs[8], z[8];
#pragma unroll
  for (int i = 0; i < 8; i++) {
    const int row = row0 + i;
    const int j = row % TT;
    const u16* pr = proj + (size_t)row * PC;
    o[i] = bf2f(rwo[(size_t)row * 256 + ch]) + bf2f(rwo[(size_t)MROWS * 256 + (size_t)row * 256 + ch]);
    xv[i] = bf2f(pr[vc]);
    xp[i] = has_prev(j) ? bf2f(pr[vc - PC]) : 0.f;
    xn[i] = has_next(j) ? bf2f(pr[vc + PC]) : 0.f;
    bs[i] = bonus[(size_t)row * 4 + h] + bonus[(size_t)MROWS * 4 + (size_t)row * 4 + h];
    z[i] = bf2f(pr[C_RWZ + ch]);
  }
#pragma unroll
  for (int i = 0; i < 8; i++) {
    const int row = row0 + i;
    if (latonly && (row % TT) < 256) continue;
    float mean = wavesum(o[i]) * (1.f / 64.f);
    float dlt = o[i] - mean;
    float var = wavesum(dlt * dlt) * (1.f / 64.f);
    float on = dlt * rsqrtf(var + 64e-5f) * gw + gb;
    float v = xv[i] + m0 * (xp[i] - xv[i]) + m1 * (xn[i] - xv[i]);
    proj[(size_t)row * PC + C_RWZ + ch] = f2bf((on + bs[i] * v) * siluf_(z[i]));
  }
}

template <int MX, int PASS>
__device__ __forceinline__ void gla_sweep(const Params& p, int layer, int d, int b, int h, int c, float* lds) {
  const int t = tid_(), w = t >> 6, lane = t & 63;
  float* kbuf = lds;
  float* fbuf = kbuf + 1024;
  float* qbuf = fbuf + 1024;
  float* vbuf = qbuf + 1024;
  float* part = vbuf + 1024;
  u16* proj = (u16*)(p.ws + OFF_PROJ);
  const int dbh = (d * 8 + b) * 4 + h;
  float* stt = (float*)(p.ws + (MX == 0 ? OFF_HGST : OFF_RTST)) + ((size_t)dbh * 9 + c) * 4096;
  float S[16];
#pragma unroll
  for (int i = 0; i < 16; i++) S[i] = PASS == 1 ? 0.f : stt[(w * 16 + i) * 64 + lane];
  float gam = 1.f;
  if (MX == 1) gam = __expf(-__expf(p.in[20][((size_t)layer * 2 + d) * 4 + h]));
  float Pl = 1.f;
  const int pst = t >> 4, c4 = (t & 15) * 4;
  float lb4[4] = {0.f, 0.f, 0.f, 0.f};
  if (MX == 0 && layer == 1) {
#pragma unroll
    for (int i = 0; i < 4; i++) {
      float l0 = p.in[18][(0 * 2 + d) * 256 + h * 64 + c4 + i], l1 = p.in[18][(1 * 2 + d) * 256 + h * 64 + c4 + i];
      float mx = fmaxf(l0, l1);
      float e0 = __expf(l0 - mx), e1 = __expf(l1 - mx);
      lb4[i] = e1 / (e0 + e1);
    }
  }
  const int vcol0 = (MX == 0 ? C_HGI : C_RTV) + h * 64;
  const float* rope = (const float*)(p.ws + OFF_ROPE);
  uint2 r_a, r_b, r_c, r_d, r_v; float4 r_cs0, r_cs1;
  r_a = r_b = r_c = r_d = r_v = make_uint2(0u, 0u); r_cs0 = r_cs1 = make_float4(1.f, 0.f, 1.f, 0.f);
  auto fetch = [&](int s0) {
    int j = jmap(d, s0 + pst);
    const u16* pr = proj + (size_t)(b * TT + j) * PC;
    r_v = *(const uint2*)(pr + vcol0 + c4);
    if (MX == 0) {
      r_a = *(const uint2*)(pr + C_HGF + d * 256 + h * 64 + c4);
      if (PASS == 2) r_b = *(const uint2*)(pr + C_HGQ + h * 64 + c4);
    } else {
      r_a = *(const uint2*)(pr + C_RTK + h * 64 + c4);
      r_c = *(const uint2*)(pr + C_RTK + h * 64 + (c4 ^ 16));
      if (PASS == 2) { r_b = *(const uint2*)(pr + C_RTQ + h * 64 + c4); r_d = *(const uint2*)(pr + C_RTQ + h * 64 + (c4 ^ 16)); }
      if (j >= 256) {
        int tl = j - 256;
        int pos = (c4 & 32) ? (tl & 63) : (tl >> 6);
        const float* rp = rope + (pos * 16 + (c4 & 15)) * 2;
        r_cs0 = *(const float4*)rp; r_cs1 = *(const float4*)(rp + 4);
      } else { r_cs0 = make_float4(1.f, 0.f, 1.f, 0.f); r_cs1 = r_cs0; }
    }
  };
  auto unpack4 = [](uint2 v, float (&o)[4]) {
    o[0] = __uint_as_float(v.x << 16); o[1] = __uint_as_float(v.x & 0xffff0000u);
    o[2] = __uint_as_float(v.y << 16); o[3] = __uint_as_float(v.y & 0xffff0000u);
  };
  u16* ofp; int ofs;
  if (MX == 0) { ofp = proj + C_HGF + h * 64 + lane; ofs = PC; }
  else { ofp = (u16*)(p.ws + OFF_RETOF) + h * 64 + lane; ofs = 256; }
  const int zcol = (MX == 0 ? C_HGZ : C_RTZ) + h * 64 + lane;
  const int ycol = (MX == 0 ? C_HGQ : C_RTQ) + h * 64 + lane;
  float normw = 1.f;
  if (MX == 0 && PASS == 2) normw = p.in[19][layer * 256 + h * 64 + lane];
  fetch(c * 256);
  for (int sub = 0; sub < 16; sub++) {
    const int s0 = c * 256 + sub * 16;
    __syncthreads();
    {
      float va[4], vb[4], vc[4], vd[4], vv4[4];
      unpack4(r_a, va); unpack4(r_v, vv4);
      *(float4*)(vbuf + pst * 64 + c4) = make_float4(vv4[0], vv4[1], vv4[2], vv4[3]);
      if (MX == 0) {
        float f[4], k[4];
#pragma unroll
        for (int i = 0; i < 4; i++) { f[i] = lb4[i] + (1.f - lb4[i]) * sigmoidf_(va[i]); k[i] = 1.f - f[i]; }
        *(float4*)(kbuf + pst * 64 + c4) = make_float4(k[0], k[1], k[2], k[3]);
        *(float4*)(fbuf + pst * 64 + c4) = make_float4(f[0], f[1], f[2], f[3]);
        if (PASS == 2) {
          unpack4(r_b, vb);
          *(float4*)(qbuf + pst * 64 + c4) = make_float4(siluf_(vb[0]), siluf_(vb[1]), siluf_(vb[2]), siluf_(vb[3]));
        }
      } else {
        unpack4(r_c, vc);
        float cs[8] = {r_cs0.x, r_cs0.y, r_cs0.z, r_cs0.w, r_cs1.x, r_cs1.y, r_cs1.z, r_cs1.w};
        float sgn = (c4 & 16) ? 1.f : -1.f;
#pragma unroll
        for (int i = 0; i < 4; i++) va[i] = (va[i] * cs[2 * i] + sgn * vc[i] * cs[2 * i + 1]) * 0.125f;
        *(float4*)(kbuf + pst * 64 + c4) = make_float4(va[0], va[1], va[2], va[3]);
        if (PASS == 2) {
          unpack4(r_b, vb); unpack4(r_d, vd);
#pragma unroll
          for (int i = 0; i < 4; i++) vb[i] = vb[i] * cs[2 * i] + sgn * vd[i] * cs[2 * i + 1];
          *(float4*)(qbuf + pst * 64 + c4) = make_float4(vb[0], vb[1], vb[2], vb[3]);
        }
      }
    }
    __syncthreads();
    if (sub + 1 < 16) fetch(s0 + 16);
    u16 pf_o[4], pf_z[4];
    if (PASS == 2 && d == 1) {
#pragma unroll
      for (int e = 0; e < 4; e++) {
        size_t row = (size_t)(b * TT + jmap(d, s0 + w * 4 + e));
        pf_o[e] = ofp[row * ofs]; pf_z[e] = proj[row * PC + zcol];
      }
    }
#pragma unroll 2
    for (int st = 0; st < 16; st++) {
      const float vv = vbuf[st * 64 + lane];
      float o = 0.f;
#pragma unroll
      for (int i4 = 0; i4 < 4; i4++) {
        float4 kv = *(const float4*)(kbuf + st * 64 + w * 16 + i4 * 4);
        float4 fv = make_float4(gam, gam, gam, gam);
        if (MX == 0) fv = *(const float4*)(fbuf + st * 64 + w * 16 + i4 * 4);
        S[i4*4]   = fv.x * S[i4*4]   + kv.x * vv;
        S[i4*4+1] = fv.y * S[i4*4+1] + kv.y * vv;
        S[i4*4+2] = fv.z * S[i4*4+2] + kv.z * vv;
        S[i4*4+3] = fv.w * S[i4*4+3] + kv.w * vv;
        if (PASS == 2) {
          float4 qv = *(const float4*)(qbuf + st * 64 + w * 16 + i4 * 4);
          o += S[i4*4] * qv.x + S[i4*4+1] * qv.y + S[i4*4+2] * qv.z + S[i4*4+3] * qv.w;
        }
      }
      if (MX == 0 && PASS == 1) { if (lane < 16) Pl *= fbuf[st * 64 + w * 16 + lane]; }
      if (PASS == 2) part[(w * 16 + st) * 64 + lane] = o;
    }
    if (PASS == 2) {
      __syncthreads();
#pragma unroll
      for (int e = 0; e < 4; e++) {
        int st = w * 4 + e;
        float o = part[(0 * 16 + st) * 64 + lane] + part[(1 * 16 + st) * 64 + lane] + part[(2 * 16 + st) * 64 + lane] + part[(3 * 16 + st) * 64 + lane];
        int j = jmap(d, s0 + st);
        size_t row = (size_t)(b * TT + j);
        if (d == 0) {
          ofp[row * ofs] = f2bf(o);
        } else {
          o += bf2f(pf_o[e]);
          float ss = wavesum(o * o);
          float y = o * rsqrtf(ss * (1.f / 64.f) + 1e-6f) * normw;
          proj[row * PC + ycol] = f2bf(y * siluf_(bf2f(pf_z[e])));
        }
      }
    }
  }
  if (PASS == 1) {
#pragma unroll
    for (int i = 0; i < 16; i++) stt[(w * 16 + i) * 64 + lane] = S[i];
    if (MX == 0 && lane < 16) ((float*)(p.ws + OFF_HGP))[((size_t)dbh * 9 + c) * 64 + w * 16 + lane] = Pl;
  }
}

#define RS 72
template <int PASS>
__device__ __forceinline__ void ret_sweep(const Params& p, int layer, int d, int b, int h, int nc, int cstep, u16* lds) {
  const int t = tid_(), lane = t & 63, w4 = t >> 6;
  u16* Qs = lds;
  u16* Ks = Qs + 64 * RS;
  u16* Kt = Ks + 64 * RS;
  u16* Vt = Kt + 64 * RS;
  u16* Vd = Vt + 64 * RS;
  u16* Ps = Vd + 64 * RS;
  u16* St = Ps + 64 * RS;
  u16* proj = (u16*)(p.ws + OFF_PROJ);
  const float* rope = (const float*)(p.ws + OFF_ROPE);
  const float lg = -__expf(p.in[20][((size_t)layer * 2 + d) * 4 + h]) * 1.4426950408889634f;
  const float g64 = exp2f(64.f * lg);
  const int dbh = (d * 8 + b) * 4 + h;
  float* stt = (float*)(p.ws + OFF_RTST) + ((size_t)dbh * 9 + cstep) * 4096;
  f32x4 accS[4];
#pragma unroll
  for (int nt = 0; nt < 4; nt++)
#pragma unroll
    for (int r = 0; r < 4; r++)
      accS[nt][r] = PASS == 1 ? 0.f : stt[(w4 * 16 + (lane >> 4) * 4 + r) * 64 + nt * 16 + (lane & 15)];
  uint4 rq[2], rqp[2], rk[2], rkp[2], rv[2];
  auto fetch = [&](int w) {
#pragma unroll
    for (int e = 0; e < 2; e++) {
      const int q = t + 256 * e, sl = q & 63, c8 = (q >> 6) * 8;
      const u16* pr = proj + (size_t)(b * TT + nc * 256 + w * 64 + sl) * PC + h * 64;
      rk[e] = *(const uint4*)(pr + C_RTK + c8); rkp[e] = *(const uint4*)(pr + C_RTK + (c8 ^ 16));
      rv[e] = *(const uint4*)(pr + C_RTV + c8);
      if (PASS == 2) { rq[e] = *(const uint4*)(pr + C_RTQ + c8); rqp[e] = *(const uint4*)(pr + C_RTQ + (c8 ^ 16)); }
    }
  };
  auto up = [](uint4 v, float (&o)[8]) {
    const unsigned* u = (const unsigned*)&v;
#pragma unroll
    for (int i = 0; i < 4; i++) { o[2 * i] = __uint_as_float(u[i] << 16); o[2 * i + 1] = __uint_as_float(u[i] & 0xffff0000u); }
  };
  fetch(d == 0 ? 0 : 3);
  for (int wi = 0; wi < 4; wi++) {
    const int w = d == 0 ? wi : 3 - wi;
    __syncthreads();
    if (PASS == 2 && wi == 0) {
#pragma unroll
      for (int nt = 0; nt < 4; nt++)
        *(uint2*)(St + (nt * 16 + (lane & 15)) * RS + w4 * 16 + (lane >> 4) * 4) =
            make_uint2(pack2(accS[nt][0], accS[nt][1]), pack2(accS[nt][2], accS[nt][3]));
    }
#pragma unroll
    for (int e = 0; e < 2; e++) {
      const int q = t + 256 * e, sl = q & 63, c8 = (q >> 6) * 8;
      const int j = nc * 256 + w * 64 + sl;
      float kx[8], kp[8], vx[8], qx[8], qp[8];
      up(rk[e], kx); up(rkp[e], kp); up(rv[e], vx);
      if (PASS == 2) { up(rq[e], qx); up(rqp[e], qp); }
      if (j >= 256) {
        const int tl = j - 256;
        const int pos = (c8 & 32) ? (tl & 63) : (tl >> 6);
        const float* rp = rope + (pos * 16 + (c8 & 15)) * 2;
        const float sgn = (c8 & 16) ? 1.f : -1.f;
#pragma unroll
        for (int i2 = 0; i2 < 4; i2++) {
          const float4 cs = *(const float4*)(rp + i2 * 4);
          kx[2 * i2] = kx[2 * i2] * cs.x + sgn * kp[2 * i2] * cs.y;
          kx[2 * i2 + 1] = kx[2 * i2 + 1] * cs.z + sgn * kp[2 * i2 + 1] * cs.w;
          if (PASS == 2) {
            qx[2 * i2] = qx[2 * i2] * cs.x + sgn * qp[2 * i2] * cs.y;
            qx[2 * i2 + 1] = qx[2 * i2 + 1] * cs.z + sgn * qp[2 * i2 + 1] * cs.w;
          }
        }
      }
      const float dec = exp2f((float)(d == 0 ? 63 - sl : sl) * lg);
      u16 kb[8];
#pragma unroll
      for (int i = 0; i < 8; i++) {
        kb[i] = f2bf(kx[i] * 0.125f);
        Kt[(c8 + i) * RS + sl] = kb[i];
        Vd[(c8 + i) * RS + sl] = f2bf(vx[i] * dec);
      }
      if (PASS == 2) {
        uint4 kk4, qq4;
        kk4.x = kb[0] | ((unsigned)kb[1] << 16); kk4.y = kb[2] | ((unsigned)kb[3] << 16);
        kk4.z = kb[4] | ((unsigned)kb[5] << 16); kk4.w = kb[6] | ((unsigned)kb[7] << 16);
        qq4.x = pack2(qx[0], qx[1]); qq4.y = pack2(qx[2], qx[3]); qq4.z = pack2(qx[4], qx[5]); qq4.w = pack2(qx[6], qx[7]);
        *(uint4*)(Ks + sl * RS + c8) = kk4;
        *(uint4*)(Qs + sl * RS + c8) = qq4;
        const unsigned short* vraw = (const unsigned short*)&rv[e];
#pragma unroll
        for (int i = 0; i < 8; i++) Vt[(c8 + i) * RS + sl] = vraw[i];
      }
    }
    __syncthreads();
    if (wi + 1 < 4) fetch(d == 0 ? wi + 1 : 2 - wi);
    if (PASS == 2) {
      f32x4 accP[4];
#pragma unroll
      for (int nt = 0; nt < 4; nt++) accP[nt] = (f32x4){0.f, 0.f, 0.f, 0.f};
      bf16x8 aq[2];
#pragma unroll
      for (int kk = 0; kk < 2; kk++) aq[kk] = *(const bf16x8*)(Qs + (w4 * 16 + (lane & 15)) * RS + kk * 32 + (lane >> 4) * 8);
#pragma unroll
      for (int kk = 0; kk < 2; kk++)
#pragma unroll
        for (int nt = 0; nt < 4; nt++) {
          bf16x8 bk = *(const bf16x8*)(Ks + (nt * 16 + (lane & 15)) * RS + kk * 32 + (lane >> 4) * 8);
          accP[nt] = __builtin_amdgcn_mfma_f32_16x16x32_bf16(aq[kk], bk, accP[nt], 0, 0, 0);
        }
#pragma unroll
      for (int nt = 0; nt < 4; nt++)
#pragma unroll
        for (int r = 0; r < 4; r++) {
          const int il = w4 * 16 + (lane >> 4) * 4 + r, sl = nt * 16 + (lane & 15);
          const int e = d == 0 ? il - sl : sl - il;
          const float f = e >= 0 ? exp2f((float)e * lg) : 0.f;
          Ps[il * RS + sl] = f2bf(accP[nt][r] * f);
        }
      __syncthreads();
      f32x4 accO[4], accI[4];
#pragma unroll
      for (int nt = 0; nt < 4; nt++) { accO[nt] = (f32x4){0.f, 0.f, 0.f, 0.f}; accI[nt] = (f32x4){0.f, 0.f, 0.f, 0.f}; }
#pragma unroll
      for (int kk = 0; kk < 2; kk++) {
        bf16x8 ap = *(const bf16x8*)(Ps + (w4 * 16 + (lane & 15)) * RS + kk * 32 + (lane >> 4) * 8);
#pragma unroll
        for (int nt = 0; nt < 4; nt++) {
          bf16x8 bv = *(const bf16x8*)(Vt + (nt * 16 + (lane & 15)) * RS + kk * 32 + (lane >> 4) * 8);
          accO[nt] = __builtin_amdgcn_mfma_f32_16x16x32_bf16(ap, bv, accO[nt], 0, 0, 0);
          bf16x8 bs = *(const bf16x8*)(St + (nt * 16 + (lane & 15)) * RS + kk * 32 + (lane >> 4) * 8);
          accI[nt] = __builtin_amdgcn_mfma_f32_16x16x32_bf16(aq[kk], bs, accI[nt], 0, 0, 0);
        }
      }
      u16* ofp = (u16*)(p.ws + OFF_RETOF);
#pragma unroll
      for (int r = 0; r < 4; r++) {
        const int il = w4 * 16 + (lane >> 4) * 4 + r;
        const size_t row = (size_t)(b * TT + nc * 256 + w * 64 + il);
        const float rho = exp2f((float)(d == 0 ? il + 1 : 64 - il) * lg);
        float o[4], ss = 0.f;
#pragma unroll
        for (int nt = 0; nt < 4; nt++) {
          o[nt] = accO[nt][r] + rho * accI[nt][r];
          if (d == 1) o[nt] += bf2f(ofp[row * 256 + h * 64 + nt * 16 + (lane & 15)]);
          ss += o[nt] * o[nt];
        }
        if (d == 0) {
#pragma unroll
          for (int nt = 0; nt < 4; nt++) ofp[row * 256 + h * 64 + nt * 16 + (lane & 15)] = f2bf(o[nt]);
        } else {
          ss = allsum16(ss);
          const float sc = rsqrtf(ss * (1.f / 64.f) + 1e-6f);
#pragma unroll
          for (int nt = 0; nt < 4; nt++) {
            const int cv = h * 64 + nt * 16 + (lane & 15);
            const float z = bf2f(proj[row * PC + C_RTZ + cv]);
            proj[row * PC + C_RTQ + cv] = f2bf(o[nt] * sc * siluf_(z));
          }
        }
      }
    }
#pragma unroll
    for (int nt = 0; nt < 4; nt++)
#pragma unroll
      for (int r = 0; r < 4; r++) accS[nt][r] *= g64;
#pragma unroll
    for (int kk = 0; kk < 2; kk++) {
      bf16x8 ak = *(const bf16x8*)(Kt + (w4 * 16 + (lane & 15)) * RS + kk * 32 + (lane >> 4) * 8);
#pragma unroll
      for (int nt = 0; nt < 4; nt++) {
        bf16x8 bv = *(const bf16x8*)(Vd + (nt * 16 + (lane & 15)) * RS + kk * 32 + (lane >> 4) * 8);
        accS[nt] = __builtin_amdgcn_mfma_f32_16x16x32_bf16(ak, bv, accS[nt], 0, 0, 0);
      }
    }
    __syncthreads();
    if (PASS == 2 && wi + 1 < 4) {
#pragma unroll
      for (int nt = 0; nt < 4; nt++)
        *(uint2*)(St + (nt * 16 + (lane & 15)) * RS + w4 * 16 + (lane >> 4) * 4) =
            make_uint2(pack2(accS[nt][0], accS[nt][1]), pack2(accS[nt][2], accS[nt][3]));
    }
  }
  if (PASS == 1) {
#pragma unroll
    for (int nt = 0; nt < 4; nt++)
#pragma unroll
      for (int r = 0; r < 4; r++) stt[(w4 * 16 + (lane >> 4) * 4 + r) * 64 + nt * 16 + (lane & 15)] = accS[nt][r];
  }
}
__device__ void gla_p1_task(const Params& p, int layer, int task, float* lds) {
  int c = task % 9; int q = task / 9; int h = q & 3; q >>= 2; int b = q & 7; q >>= 3; int d = q & 1; int mx = q >> 1;
  if (mx == 0) gla_sweep<0, 1>(p, layer, d, b, h, c, lds);
  else { const int nc = d == 0 ? c : (c == 0 ? 0 : 9 - c); ret_sweep<1>(p, layer, d, b, h, nc, c, (u16*)lds); }
}
__device__ void gla_p2_task(const Params& p, int layer, int mx, int b, int h, int nc, float* lds) {
  int cb = nc == 0 ? 0 : 9 - nc;
  if (mx == 0) { gla_sweep<0, 2>(p, layer, 0, b, h, nc, lds); __threadfence_block(); gla_sweep<0, 2>(p, layer, 1, b, h, cb, lds); }
  else { ret_sweep<2>(p, layer, 0, b, h, nc, nc, (u16*)lds); __threadfence_block(); ret_sweep<2>(p, layer, 1, b, h, nc, cb, (u16*)lds); }
}
__device__ void gla_carry_task(const Params& p, int layer, int task) {
  int e = task * 256 + tid_();
  int v = e & 63, k = (e >> 6) & 63, dbh = (e >> 12) & 63, mx = e >> 18;
  float* stt = (float*)(p.ws + (mx == 0 ? OFF_HGST : OFF_RTST)) + (size_t)dbh * 9 * 4096 + k * 64 + v;
  const float* P = (const float*)(p.ws + OFF_HGP) + (size_t)dbh * 9 * 64 + k;
  float pg = 1.f;
  if (mx == 1) { int d = dbh >> 5, h = dbh & 3; pg = __expf(-256.f * __expf(p.in[20][((size_t)layer * 2 + d) * 4 + h])); }
  float S = 0.f;
  for (int c = 0; c < 9; c++) {
    float E = stt[(size_t)c * 4096];
    stt[(size_t)c * 4096] = S;
    float pp = mx == 0 ? P[c * 64] : pg;
    S = pp * S + E;
  }
}

__device__ __forceinline__ int s5_bwd_chunk(int nc) { return nc < 4 ? 3 - nc : 39 - nc; }
template <int PASS>
__device__ void s5_task(const Params& p, int layer, int task, float* lds) {
  const int t = tid_(), w = t >> 6, lane = t & 63;
  int gq = task & 3; int q = task >> 2; int nc = q % 36; int b = q / 36;
  const int g = gq * 4 + w;
  float* ubuf = lds + w * 256;
  u16* hbuf = (u16*)(lds + 1024) + w * (16 * 136);
  float* ybuf = lds + 1024 + 4352 + w * 1024;
  u16* proj = (u16*)(p.ws + OFF_PROJ);
  float2* st5 = (float2*)(p.ws + OFF_S5ST);
  bf16x8 cfrag[4];
  if (PASS == 2) {
    const float* cre = p.in[13] + ((size_t)layer * 16 + g) * 16 * 64;
    const float* cim = p.in[14] + ((size_t)layer * 16 + g) * 16 * 64;
    int pp = lane & 15;
#pragma unroll
    for (int ks = 0; ks < 4; ks++)
#pragma unroll
      for (int i = 0; i < 8; i++) {
        int kidx = ks * 32 + (lane >> 4) * 8 + i; int n = kidx >> 1;
        float val = (kidx & 1) ? -cim[pp * 64 + n] : cre[pp * 64 + n];
        cfrag[ks][i] = (short)f2bf(val);
      }
  }
  for (int d = 0; d < 2; d++) {
    float lre = p.in[8][(((size_t)layer * 2 + d) * 16 + g) * 64 + lane];
    float lim = p.in[9][(((size_t)layer * 2 + d) * 16 + g) * 64 + lane];
    float dt = __expf(p.in[10][((size_t)layer * 2 + d) * 16 + g]);
    float mag = __expf(lre * dt);
    float sn, cs; sincosf(lim * dt, &sn, &cs);
    float are = mag * cs, aim = mag * sn;
    float den = 1.f / (lre * lre + lim * lim);
    float cre_ = ((are - 1.f) * lre + aim * lim) * den;
    float cim_ = (aim * lre - (are - 1.f) * lim) * den;
    float bbr[16], bbi[16];
    {
      const float* br = p.in[11] + (((size_t)layer * 16 + g) * 64 + lane) * 16;
      const float* bi = p.in[12] + (((size_t)layer * 16 + g) * 64 + lane) * 16;
#pragma unroll
      for (int i = 0; i < 16; i++) {
        float x = br[i], y = bi[i];
        bbr[i] = cre_ * x - cim_ * y; bbi[i] = cre_ * y + cim_ * x;
      }
    }
    int cstep = d == 0 ? nc : s5_bwd_chunk(nc);
    size_t sidx = ((((size_t)d * 8 + b) * 16 + g) * 36 + cstep) * 64 + lane;
    float hre = 0.f, him = 0.f;
    if (PASS == 2) { float2 h0 = st5[sidx]; hre = h0.x; him = h0.y; }
    uint2 ru;
    auto fetchu = [&](int sub) {
      int st = lane >> 2, p4 = (lane & 3) * 4;
      int jl = d == 0 ? sub * 16 + st : 63 - (sub * 16 + st);
      ru = *(const uint2*)(proj + (size_t)(b * TT + nc * 64 + jl) * PC + C_S5U + g * 16 + p4);
    };
    fetchu(0);
    for (int sub = 0; sub < 4; sub++) {
      __syncthreads();
      {
        int st = lane >> 2, p4 = (lane & 3) * 4;
        *(float4*)(ubuf + st * 16 + p4) = make_float4(__uint_as_float(ru.x << 16), __uint_as_float(ru.x & 0xffff0000u),
                                                       __uint_as_float(ru.y << 16), __uint_as_float(ru.y & 0xffff0000u));
      }
      __syncthreads();
      if (sub + 1 < 4) fetchu(sub + 1);
#pragma unroll 2
      for (int st = 0; st < 16; st++) {
        float bur = 0.f, bui = 0.f;
#pragma unroll
        for (int i4 = 0; i4 < 4; i4++) {
          float4 uu = *(const float4*)(ubuf + st * 16 + i4 * 4);
          bur += bbr[i4*4] * uu.x + bbr[i4*4+1] * uu.y + bbr[i4*4+2] * uu.z + bbr[i4*4+3] * uu.w;
          bui += bbi[i4*4] * uu.x + bbi[i4*4+1] * uu.y + bbi[i4*4+2] * uu.z + bbi[i4*4+3] * uu.w;
        }
        float nre = are * hre - aim * him + bur;
        float nim = are * him + aim * hre + bui;
        hre = nre; him = nim;
        if (PASS == 2) *(unsigned*)(hbuf + st * 136 + lane * 2) = pack2(hre, him);
      }
      if (PASS == 2) {
        __syncthreads();
        f32x4 acc = (f32x4){0.f, 0.f, 0.f, 0.f};
#pragma unroll
        for (int ks = 0; ks < 4; ks++) {
          bf16x8 af = *(const bf16x8*)(hbuf + (lane & 15) * 136 + ks * 32 + (lane >> 4) * 8);
          acc = __builtin_amdgcn_mfma_f32_16x16x32_bf16(af, cfrag[ks], acc, 0, 0, 0);
        }
#pragma unroll
        for (int r = 0; r < 4; r++) {
          int st = (lane >> 4) * 4 + r;
          int jl = d == 0 ? sub * 16 + st : 63 - (sub * 16 + st);
          float* yp = ybuf + jl * 16 + (lane & 15);
          if (d == 0) *yp = acc[r]; else *yp += acc[r];
        }
      }
    }
    if (PASS == 1) st5[sidx] = make_float2(hre, him);
  }
  if (PASS == 2) {
    __syncthreads();
    const float* dsk = p.in[15] + layer * 256 + g * 16;
#pragma unroll
    for (int i = 0; i < 16; i++) {
      int idx = lane + 64 * i; int jl = idx >> 4, pp = idx & 15;
      u16* up = proj + (size_t)(b * TT + nc * 64 + jl) * PC + C_S5U + g * 16 + pp;
      float y = ybuf[jl * 16 + pp] + dsk[pp] * bf2f(*up);
      *up = f2bf(geluf_(y));
    }
  }
}
__device__ void s5_carry_task(const Params& p, int layer, int task) {
  int e = task * 256 + tid_();
  int n = e & 63, g = (e >> 6) & 15, d = e >> 13;
  float lre = p.in[8][(((size_t)layer * 2 + d) * 16 + g) * 64 + n];
  float lim = p.in[9][(((size_t)layer * 2 + d) * 16 + g) * 64 + n];
  float dt = __expf(p.in[10][((size_t)layer * 2 + d) * 16 + g]);
  float mag = __expf(lre * dt * 64.f);
  float sn, cs; sincosf(lim * dt * 64.f, &sn, &cs);
  float are = mag * cs, aim = mag * sn;
  float2* st5 = (float2*)(p.ws + OFF_S5ST) + (size_t)(e >> 6) * 36 * 64 + n;
  float sre = 0.f, sim = 0.f;
  for (int c = 0; c < 36; c++) {
    float2 E = st5[(size_t)c * 64];
    st5[(size_t)c * 64] = make_float2(sre, sim);
    float nre = are * sre - aim * sim + E.x;
    float nim = are * sim + aim * sre + E.y;
    sre = nre; sim = nim;
  }
}

__device__ __forceinline__ void group_barrier(unsigned* cnt, unsigned target) {
  asm volatile("s_waitcnt vmcnt(0)" ::: "memory");
  __syncthreads();
  if (tid_() == 0) {
    __threadfence();
    asm volatile("s_waitcnt vmcnt(0)" ::: "memory");
    __hip_atomic_fetch_add(cnt, 1u, __ATOMIC_RELAXED, __HIP_MEMORY_SCOPE_AGENT);
    while (__hip_atomic_load(cnt, __ATOMIC_RELAXED, __HIP_MEMORY_SCOPE_AGENT) < target) __builtin_amdgcn_s_sleep(2);
    __threadfence();
    asm volatile("s_waitcnt vmcnt(0)" ::: "memory");
  }
  __syncthreads();
}
#define XB_XCNT(j) (64 * (j))
#define XB_XSUB(j) (1024 + 64 * (j))
#define XB_XGEN(j) (2048 + 64 * (j))
#define XB_TOP     3072
#define XB_TOPGEN  3136
#define XB_WORDS   8192
struct XcdBar { unsigned* bar; unsigned x, nloc, nx; };
__device__ __forceinline__ unsigned xb_ld(unsigned* q) { return __hip_atomic_load(q, __ATOMIC_RELAXED, __HIP_MEMORY_SCOPE_AGENT); }
__device__ __forceinline__ unsigned xb_add(unsigned* q, unsigned v) { return __hip_atomic_fetch_add(q, v, __ATOMIC_RELAXED, __HIP_MEMORY_SCOPE_AGENT); }
__device__ __forceinline__ void xcd_barrier(const XcdBar& b) {
  asm volatile("s_waitcnt vmcnt(0)" ::: "memory");
  __syncthreads();
  if (tid_() == 0) {
    unsigned* bar = b.bar;
    __builtin_amdgcn_s_waitcnt(0);
    const unsigned old = xb_add(&bar[XB_XSUB(b.x)], 1u);
    const unsigned gen = old / b.nloc;
    if (old + 1u == (gen + 1u) * b.nloc) {
      __builtin_amdgcn_fence(__ATOMIC_RELEASE, "agent");
      asm volatile("s_waitcnt vmcnt(0)" ::: "memory");
      const unsigned og = xb_add(&bar[XB_TOP], 1u);
      const unsigned tg = og / b.nx;
      if (og + 1u == (tg + 1u) * b.nx) xb_add(&bar[XB_TOPGEN], 1u);
      else while (xb_ld(&bar[XB_TOPGEN]) == tg) __builtin_amdgcn_s_sleep(1);
      __builtin_amdgcn_fence(__ATOMIC_ACQUIRE, "agent");
      xb_add(&bar[XB_XGEN(b.x)], 1u);
      asm volatile("s_waitcnt vmcnt(0)" ::: "memory");
    } else {
      while (xb_ld(&bar[XB_XGEN(b.x)]) == gen) __builtin_amdgcn_s_sleep(1);
      __builtin_amdgcn_fence(__ATOMIC_ACQUIRE, "agent");
      asm volatile("s_waitcnt vmcnt(0)" ::: "memory");
    }
  }
  __syncthreads();
}
#define LDS_FLOATS 18432
#define SYNC() xcd_barrier(xbar)
#define RW_TWO false
#define NRW (RW_TWO ? 128 : 256)

__global__ void __launch_bounds__(256, 2) fwd_megakernel(Params p) {
  cg::grid_group grid = cg::this_grid();
  __shared__ __attribute__((aligned(16))) float lds[LDS_FLOATS];
  const int bid = blockIdx.x, nb = gridDim.x, t = tid_();
  XcdBar xbar; xbar.bar = (unsigned*)(p.ws + OFF_XB); xbar.x = 0; xbar.nloc = 1; xbar.nx = 1;

  if (p.ws == nullptr) grid.sync();
  {
    unsigned xr; asm volatile("s_getreg_b32 %0, hwreg(HW_REG_XCC_ID)" : "=s"(xr));
    xbar.x = xr & 15u;
    if (t == 0) xb_add(&xbar.bar[XB_XCNT(xbar.x)], 1u + ((nb == 512 && bid >= NRW) ? 65536u : 0u));
  }
  for (int task = bid; task < N_CONVERT_TASKS + 192 + 1; task += nb) {
    if (task < 192) mods_task(p, task, lds);
    else if (task == 192) {
      float* rope = (float*)(p.ws + OFF_ROPE);
      for (int i = t; i < 1024; i += 256) {
        int pos = i >> 4, fi = i & 15;
        float fr = powf(10000.f, -(float)fi / 16.f);
        float ang = (float)pos * fr;
        rope[i * 2] = cosf(ang); rope[i * 2 + 1] = sinf(ang);
      }
    } else convert_task(p, 0, task - 193, lds);
  }
  XcdBar pbar; pbar.bar = xbar.bar + 4096; pbar.x = xbar.x; pbar.nloc = 1; pbar.nx = 1;
  if (t == 0) {
    unsigned nx, npx, nlocp;
    for (;;) {
      unsigned sum = 0; nx = 0; npx = 0; nlocp = 0;
#pragma unroll
      for (int j = 0; j < 16; j++) {
        const unsigned w = xb_ld(&xbar.bar[XB_XCNT(j)]);
        const unsigned c = w & 65535u, cp = w >> 16;
        sum += c; nx += c > 0u ? 1u : 0u; npx += cp > 0u ? 1u : 0u;
        if ((unsigned)j == xbar.x) { xbar.nloc = c; nlocp = cp; }
      }
      if (sum == (unsigned)nb) break;
      __builtin_amdgcn_s_sleep(4);
    }
    xbar.nx = nx; pbar.nx = npx > 0u ? npx : 1u; pbar.nloc = nlocp > 0u ? nlocp : 1u;
  }
  SYNC();
  for (int task = bid; task < MROWS / 4; task += nb) ln_row(p, 0, 0, task * 4 + (t >> 6));
  SYNC();

  for (int layer = 0; layer < 2; layer++) {
    const int latonly = layer;
    if ((nb & 7) == 0) { int tm, tn; for (int it = 0; xcd_tile(it, bid, nb, 144, 31, 6, tm, tn); it++) inproj_tile(p, layer, tm, tn, (u16*)lds); }
    else for (int task = bid; task < 144 * 31; task += nb) inproj_tile(p, layer, task / 31, task % 31, (u16*)lds);
    SYNC();
    {
      const int ncg = latonly ? 8 : 9, ncs = latonly ? 32 : 36;
      const int NG = 64 * ncg, NS = 32 * ncs;
      auto p2_task = [&](int task) {
        if (task < NG) {
          int nc = task % ncg + (latonly ? 1 : 0); int q = task / ncg; int h = q & 3; q >>= 2; int b = q & 7; int mx = q >> 3;
          gla_p2_task(p, layer, mx, b, h, nc, lds);
        } else {
          int q = task - NG; int gq = q & 3; q >>= 2; int nc = q % ncs + (latonly ? 4 : 0); int b = q / ncs;
          s5_task<2>(p, layer, ((b * 36 + nc) << 2) | gq, lds);
        }
      };
      if (nb == 512) {
        unsigned* bar = (unsigned*)(p.ws + OFF_BAR);
        const int ng = nb - NRW;
        if (bid < NRW) {
          rwkv_scan_task<RW_TWO>(p, layer, bid, lds);
          if (t == 0) {
            while (xb_ld(&pbar.bar[XB_TOPGEN]) < 2u * layer + 2u) __builtin_amdgcn_s_sleep(8);
            __threadfence();
          }
          __syncthreads();
        } else {
          const int gb = bid - NRW;
          for (int task = gb; task < 2304; task += ng) {
            if (task < 1152) gla_p1_task(p, layer, task, lds); else s5_task<1>(p, layer, task - 1152, lds);
          }
          xcd_barrier(pbar);
          for (int task = gb; task < 2048 + 64; task += ng) {
            if (task < 2048) gla_carry_task(p, layer, task); else s5_carry_task(p, layer, task - 2048);
          }
          xcd_barrier(pbar);
        }
        int* shq = (int*)(lds + LDS_FLOATS - 4);
        for (;;) {
          __syncthreads();
          if (t == 0) *shq = (int)__hip_atomic_fetch_add(bar + 1 + layer, 1u, __ATOMIC_RELAXED, __HIP_MEMORY_SCOPE_AGENT);
          __syncthreads();
          const int task = *shq;
          if (task >= NG + NS) break;
          p2_task(task);
        }
        SYNC();
      } else {
        for (int task = bid; task < NRW + 2304; task += nb) {
          if (task < NRW) rwkv_scan_task<RW_TWO>(p, layer, task, lds);
          else if (task < NRW + 1152) gla_p1_task(p, layer, task - NRW, lds);
          else s5_task<1>(p, layer, task - NRW - 1152, lds);
        }
        SYNC();
        for (int task = bid; task < 2048 + 64; task += nb) {
          if (task < 2048) gla_carry_task(p, layer, task); else s5_carry_task(p, layer, task - 2048);
        }
        SYNC();
        for (int task = bid; task < NG + NS; task += nb) p2_task(task);
        SYNC();
      }
    }
    {
      const int ntm = latonly ? 128 : 144;
      for (int task = bid; task < ntm * 2 + MROWS / 8; task += nb) {
        if (task < ntm * 2) glu_tile(p, layer, latonly, task >> 1, task & 1, (u16*)lds);
        else rwkv_combine_rows(p, layer, (task - ntm * 2) * 8, latonly);
      }
    }
    SYNC();
    {
      const int ntm = latonly ? 128 : 144;
      if ((nb & 7) == 0) { int tm, tn; for (int it = 0; xcd_tile(it, bid, nb, ntm, 16, 8, tm, tn); it++) merge_tile(p, layer, latonly, tm, tn, (u16*)lds); }
      else for (int task = bid; task < ntm * 16; task += nb) merge_tile(p, layer, latonly, task >> 4, task & 15, (u16*)lds);
    }
    SYNC();
    {
      const int ntm = latonly ? 128 : 144;
      if ((nb & 7) == 0) { int tm, tn; for (int it = 0; xcd_tile(it, bid, nb, ntm, 8, 8, tm, tn); it++) outproj_tile(p, layer, latonly, tm, tn, (u16*)lds); }
      else for (int task = bid; task < ntm * 8; task += nb) outproj_tile(p, layer, latonly, task >> 3, task & 7, (u16*)lds);
    }
    SYNC();
    if (layer == 0) {
      for (int task = bid; task < MROWS / 4 + N_CONVERT_TASKS; task += nb) {
        if (task < N_CONVERT_TASKS) convert_task(p, 1, task, lds);
        else ln_row(p, 1, 0, (task - N_CONVERT_TASKS) * 4 + (t >> 6));
      }
      SYNC();
    } else {
      for (int task = bid; task < NBATCH * 2048 / 4; task += nb) {
        int r = task * 4 + (t >> 6); int b = r >> 11, tl = r & 2047;
        ln_row(p, 1, 1, b * TT + 256 + tl);
      }
    }
  }
}

extern "C" void kernel_launch(void* const* d_in, const int* in_sizes, int n_in,
                              void* d_out, int out_size, void* d_ws, size_t ws_size,
                              hipStream_t stream) {
  static int grid_blocks = 0;
  if (!grid_blocks) {
    int dev = 0, cus = 0, per_cu = 0;
    (void)hipGetDevice(&dev);
    (void)hipDeviceGetAttribute(&cus, hipDeviceAttributeMultiprocessorCount, dev);
    (void)hipOccupancyMaxActiveBlocksPerMultiprocessor(&per_cu, fwd_megakernel, 256, 0);
    if (per_cu > 2) per_cu = 2;
    if (per_cu < 1) per_cu = 1;
    grid_blocks = cus * per_cu;
  }
  if (ws_size < WS_NEED) { fprintf(stderr, "workspace too small\n"); return; }
  Params p{};
  for (int i = 0; i < 36; i++) p.in[i] = (const float*)d_in[i];
  p.out = (float*)d_out;
  p.ws = (char*)d_ws;
  (void)hipMemsetAsync((char*)d_ws + OFF_BAR, 0, 256 + 32768, stream);
  void* args[] = {&p};
  hipError_t e = hipLaunchCooperativeKernel((void*)fwd_megakernel, dim3(grid_blocks), dim3(256), args, 0, stream);
  if (e != hipSuccess) fprintf(stderr, "cooperative launch failed: %s (grid %d)\n", hipGetErrorString(e), grid_blocks);
}
```

```cpp
#include <hip/hip_runtime.h>
#include <hip/hip_bf16.h>
#include <hip/hip_cooperative_groups.h>
#include <cstdio>
namespace cg = cooperative_groups;

typedef __attribute__((ext_vector_type(8))) short bf16x8;
typedef __attribute__((ext_vector_type(4))) float f32x4;
typedef unsigned short u16;

#define D_ 1024
#define NBATCH 8
#define TT 2304
#define MROWS 18432
#define PC 3904
#define DIN 8000
#define C_S5U 0
#define C_S5Z 256
#define C_HGQ 512
#define C_HGF 768
#define C_HGI 1280
#define C_HGZ 1536
#define C_RTQ 1792
#define C_RTK 2048
#define C_RTV 2304
#define C_RTZ 2560
#define C_RWX 2816
#define C_RWZ 3648

#define OFF_WINT   0ul
#define OFF_WBT    (OFF_WINT + 16384000ul)
#define OFF_WOT    (OFF_WBT + 2097152ul)
#define OFF_GLUT   (OFF_WOT + 2097152ul)
#define OFF_U      (OFF_GLUT + 131072ul)
#define OFF_PROJ   (OFF_U + 37748736ul)
#define OFF_HCTX   (OFF_PROJ + 143917056ul)
#define OFF_SCR    (OFF_HCTX + 8388608ul)
#define OFF_RWO    (OFF_SCR)
#define OFF_HGST   (OFF_SCR + 18874368ul)
#define OFF_RTST   (OFF_HGST + 9437184ul)
#define OFF_RETOF  (OFF_SCR + 37748736ul)
#define OFF_S5ST   (OFF_RETOF + 9437184ul)
#define OFF_MODS   (OFF_S5ST + 4718592ul)
#define OFF_HGP    (OFF_MODS + 221184ul)
#define OFF_BONUS  (OFF_HGP + 147456ul)
#define OFF_ROPE   (OFF_BONUS + 589824ul)
#define OFF_BAR    (OFF_ROPE + 8192ul)
#define OFF_XB     (OFF_BAR + 256ul)
#define WS_NEED    (OFF_XB + 32768ul)

struct Params {
  const float* in[36];
  float* out;
  char* ws;
};

__device__ __forceinline__ int tid_() { int t = __builtin_amdgcn_workitem_id_x(); asm volatile("" : "+v"(t)); return t; }
__device__ __forceinline__ u16 f2bf(float f) {
  unsigned u = __float_as_uint(f);
  u += 0x7fffu + ((u >> 16) & 1u);
  return (u16)(u >> 16);
}
__device__ __forceinline__ float bf2f(u16 h) { return __uint_as_float(((unsigned)h) << 16); }
__device__ __forceinline__ unsigned pack2(float a, float b) { return (unsigned)f2bf(a) | ((unsigned)f2bf(b) << 16); }
__device__ __forceinline__ float sigmoidf_(float x) { return __builtin_amdgcn_rcpf(1.f + __expf(-x)); }
__device__ __forceinline__ float siluf_(float x) { return x * __builtin_amdgcn_rcpf(1.f + __expf(-x)); }
__device__ __forceinline__ float geluf_(float x) {
  float t = tanhf(0.7978845608028654f * (x + 0.044715f * x * x * x));
  return 0.5f * x * (1.f + t);
}
template <int CTRL>
__device__ __forceinline__ float dppf(float x) {
  return __int_as_float(__builtin_amdgcn_update_dpp(0, __float_as_int(x), CTRL, 0xf, 0xf, true));
}
__device__ __forceinline__ float allsum16(float x) {
  x += dppf<0x128>(x);
  x += dppf<0x124>(x);
  x += dppf<0x122>(x);
  x += dppf<0x121>(x);
  return x;
}
__device__ __forceinline__ float wavesum(float x) {
  x = allsum16(x);
  x += __shfl_xor(x, 16, 64);
  x += __shfl_xor(x, 32, 64);
  return x;
}
__device__ __forceinline__ void ld4bf(const u16* p, float (&o)[4]) {
  uint2 v = *(const uint2*)p;
  o[0] = __uint_as_float(v.x << 16); o[1] = __uint_as_float(v.x & 0xffff0000u);
  o[2] = __uint_as_float(v.y << 16); o[3] = __uint_as_float(v.y & 0xffff0000u);
}
__device__ __forceinline__ void st4bf(u16* p, float a, float b, float c, float d) {
  uint2 v; v.x = pack2(a, b); v.y = pack2(c, d);
  *(uint2*)p = v;
}
__device__ __forceinline__ int jmap(int d, int s) { return d == 0 ? s : (s < 256 ? 255 - s : 2559 - s); }
__device__ __forceinline__ bool has_prev(int j) { return j != 0 && j != 256; }
__device__ __forceinline__ bool has_next(int j) { return j != 255 && j != 2303; }

__device__ __forceinline__ const float* hin_ptr(const Params& p, int layer, int row) {
  int b = row / TT, j = row - b * TT;
  if (layer == 0) return j < 256 ? p.in[2] + ((size_t)(b * 256 + j)) * D_ : p.in[0] + ((size_t)(b * 2048 + j - 256)) * D_;
  return j < 256 ? (const float*)(p.ws + OFF_HCTX) + ((size_t)(b * 256 + j)) * D_ : p.out + ((size_t)(b * 2048 + j - 256)) * D_;
}
__device__ __forceinline__ float* hout_ptr(const Params& p, int row) {
  int b = row / TT, j = row - b * TT;
  return j < 256 ? (float*)(p.ws + OFF_HCTX) + ((size_t)(b * 256 + j)) * D_ : p.out + ((size_t)(b * 2048 + j - 256)) * D_;
}
__device__ __forceinline__ int modrow_of(int row) { int b = row / TT, j = row - b * TT; return j < 256 ? 8 : b; }

__device__ void transpose_tile(const float* __restrict__ src, u16* __restrict__ dst, int K, int N, int k0, int n0, float* lds) {
  const int t = tid_();
  __syncthreads();
#pragma unroll
  for (int i = 0; i < 16; i++) {
    int r = i * 4 + (t >> 6), c = t & 63;
    lds[r * 65 + c] = src[(size_t)(k0 + r) * N + n0 + c];
  }
  __syncthreads();
#pragma unroll
  for (int i = 0; i < 16; i++) {
    int r = i * 4 + (t >> 6), c = t & 63;
    dst[(size_t)(n0 + r) * K + k0 + c] = f2bf(lds[c * 65 + r]);
  }
}
__device__ void convert_task(const Params& p, int layer, int task, float* lds) {
  if (task < 2000) {
    int kt = task / 125, nt = task % 125;
    transpose_tile(p.in[6] + (size_t)layer * 1024 * DIN, (u16*)(p.ws + OFF_WINT), 1024, DIN, kt * 64, nt * 64, lds);
  } else if (task < 2256) {
    int q = task - 2000; int br = q >> 6; q &= 63; int kt = q >> 4, nt = q & 15;
    transpose_tile(p.in[31] + ((size_t)layer * 4 + br) * 256 * 1024, (u16*)(p.ws + OFF_WBT) + (size_t)br * 1024 * 256, 256, 1024, kt * 64, nt * 64, lds);
  } else if (task < 2512) {
    int q = task - 2256; int kt = q >> 4, nt = q & 15;
    transpose_tile(p.in[32] + (size_t)layer * 1024 * 1024, (u16*)(p.ws + OFF_WOT), 1024, 1024, kt * 64, nt * 64, lds);
  } else {
    int q = task - 2512; int kt = q >> 2, nt = q & 3;
    transpose_tile(p.in[16] + (size_t)layer * 256 * 256, (u16*)(p.ws + OFF_GLUT), 256, 256, kt * 64, nt * 64, lds);
  }
}
#define N_CONVERT_TASKS 2528

__device__ void mods_task(const Params& p, int task, float* lds) {
  const int t = tid_();
  int layer = task / 96, cgp = task % 96;
  float* sc = lds;
  float* red = lds + 9 * 1024;
  __syncthreads();
  for (int i = t; i < 9 * 1024; i += 256) {
    int r = i >> 10, k = i & 1023;
    float v = r < 8 ? p.in[1][r * 1024 + k] : p.in[3][k];
    sc[i] = siluf_(v);
  }
  __syncthreads();
  const int cl = t & 31, kq = t >> 5;
  int col = cgp * 32 + cl;
  float acc[9];
#pragma unroll
  for (int r = 0; r < 9; r++) acc[r] = 0.f;
  const float* wp = p.in[4] + (size_t)layer * 1024 * 3072 + col;
#pragma unroll 16
  for (int k = kq * 128; k < kq * 128 + 128; k++) {
    float w = wp[(size_t)k * 3072];
#pragma unroll
    for (int r = 0; r < 9; r++) acc[r] += sc[r * 1024 + k] * w;
  }
#pragma unroll
  for (int r = 0; r < 9; r++) red[(kq * 9 + r) * 32 + cl] = acc[r];
  __syncthreads();
  float* mods = (float*)(p.ws + OFF_MODS);
  for (int i = t; i < 9 * 32; i += 256) {
    int r = i >> 5, c = i & 31;
    float s_ = 0.f;
#pragma unroll
    for (int g = 0; g < 8; g++) s_ += red[(g * 9 + r) * 32 + c];
    int cc = cgp * 32 + c;
    mods[((size_t)layer * 9 + r) * 3072 + cc] = s_ + p.in[5][layer * 3072 + cc];
  }
}

__device__ void ln_row(const Params& p, int mode, int layer, int row) {
  const int lane = tid_() & 63;
  float v[16];
  if (mode == 0) {
    const float* src = hin_ptr(p, 0, row);
#pragma unroll
    for (int i = 0; i < 4; i++) { float4 q = *(const float4*)(src + i * 256 + lane * 4); v[i*4]=q.x; v[i*4+1]=q.y; v[i*4+2]=q.z; v[i*4+3]=q.w; }
  } else {
    float* src = hout_ptr(p, row);
#pragma unroll
    for (int i = 0; i < 4; i++) { float4 q = *(const float4*)(src + i * 256 + lane * 4); v[i*4]=q.x; v[i*4+1]=q.y; v[i*4+2]=q.z; v[i*4+3]=q.w; }
    float s = 0.f;
#pragma unroll
    for (int i = 0; i < 16; i++) s += v[i];
    float mean = wavesum(s) * (1.f / 1024.f);
    float q2 = 0.f;
#pragma unroll
    for (int i = 0; i < 16; i++) { v[i] -= mean; q2 += v[i] * v[i]; }
    float rstd = rsqrtf(wavesum(q2) * (1.f / 1024.f) + 1e-5f);
    const float* lw = p.in[34] + layer * 1024; const float* lb = p.in[35] + layer * 1024;
#pragma unroll
    for (int i = 0; i < 4; i++) {
      float4 w4 = *(const float4*)(lw + i * 256 + lane * 4), b4 = *(const float4*)(lb + i * 256 + lane * 4);
      v[i*4] = v[i*4] * rstd * w4.x + b4.x; v[i*4+1] = v[i*4+1] * rstd * w4.y + b4.y;
      v[i*4+2] = v[i*4+2] * rstd * w4.z + b4.z; v[i*4+3] = v[i*4+3] * rstd * w4.w + b4.w;
      *(float4*)(src + i * 256 + lane * 4) = make_float4(v[i*4], v[i*4+1], v[i*4+2], v[i*4+3]);
    }
    if (layer == 1) return;
  }
  int ml = mode == 0 ? 0 : 1;
  float s = 0.f;
#pragma unroll
  for (int i = 0; i < 16; i++) s += v[i];
  float mean = wavesum(s) * (1.f / 1024.f);
  float q2 = 0.f;
#pragma unroll
  for (int i = 0; i < 16; i++) { v[i] -= mean; q2 += v[i] * v[i]; }
  float rstd = rsqrtf(wavesum(q2) * (1.f / 1024.f) + 1e-5f);
  const float* md = (const float*)(p.ws + OFF_MODS) + ((size_t)ml * 9 + modrow_of(row)) * 3072;
  u16* up = (u16*)(p.ws + OFF_U) + (size_t)row * 1024;
#pragma unroll
  for (int i = 0; i < 4; i++) {
    float4 sh = *(const float4*)(md + i * 256 + lane * 4), sc = *(const float4*)(md + 1024 + i * 256 + lane * 4);
    st4bf(up + i * 256 + lane * 4, v[i*4] * rstd * (1.f + sc.x) + sh.x, v[i*4+1] * rstd * (1.f + sc.y) + sh.y,
          v[i*4+2] * rstd * (1.f + sc.z) + sh.z, v[i*4+3] * rstd * (1.f + sc.w) + sh.w);
  }
}

#define STAGE_LOAD(P, kk_) do { const unsigned k_ = (kk_); \
  P##a0 = *(const uint4*)(A + (oa + k_)); P##a1 = *(const uint4*)(A + (oa + sa + k_)); \
  P##a2 = *(const uint4*)(A + (oa + 2 * sa + k_)); P##a3 = *(const uint4*)(A + (oa + 3 * sa + k_)); \
  P##b0 = *(const uint4*)(B + (ob + k_)); P##b1 = *(const uint4*)(B + (ob + sb + k_)); \
  if (NT == 4) { P##b2 = *(const uint4*)(B + (ob + 2 * sb + k_)); P##b3 = *(const uint4*)(B + (ob + 3 * sb + k_)); } } while (0)
#define STAGE_WRITE(P, Asw, Bsw) do { \
  *(uint4*)(Asw) = P##a0; *(uint4*)((Asw) + 32 * 72) = P##a1; *(uint4*)((Asw) + 64 * 72) = P##a2; *(uint4*)((Asw) + 96 * 72) = P##a3; \
  *(uint4*)(Bsw) = P##b0; *(uint4*)((Bsw) + 32 * 72) = P##b1; \
  if (NT == 4) { *(uint4*)((Bsw) + 64 * 72) = P##b2; *(uint4*)((Bsw) + 96 * 72) = P##b3; } } while (0)
template <int MT, int NT>
__device__ __forceinline__ void stage_compute(f32x4 (&acc)[MT][NT], const u16* As, const u16* Bs, int lane, int wm, int wn) {
#pragma unroll
  for (int kk = 0; kk < 2; kk++) {
    bf16x8 af[MT], bfr[NT];
#pragma unroll
    for (int mt = 0; mt < MT; mt++) af[mt] = *(const bf16x8*)(As + (wm * MT * 16 + mt * 16 + (lane & 15)) * 72 + kk * 32 + (lane >> 4) * 8);
#pragma unroll
    for (int nt = 0; nt < NT; nt++) bfr[nt] = *(const bf16x8*)(Bs + (wn * NT * 16 + nt * 16 + (lane & 15)) * 72 + kk * 32 + (lane >> 4) * 8);
    __builtin_amdgcn_s_setprio(1);
#pragma unroll
    for (int mt = 0; mt < MT; mt++)
#pragma unroll
      for (int nt = 0; nt < NT; nt++)
        acc[mt][nt] = __builtin_amdgcn_mfma_f32_16x16x32_bf16(af[mt], bfr[nt], acc[mt][nt], 0, 0, 0);
    __builtin_amdgcn_s_setprio(0);
  }
}
template <int MT, int NT>
__device__ __forceinline__ void gemm_kloop(f32x4 (&acc)[MT][NT], const u16* __restrict__ A, int lda,
                                           const u16* __restrict__ B, int ldb, int K, u16* lds) {
  static_assert(MT == 4, "MT");
  constexpr int BM = MT * 32, BN = NT * 32, SS = (BM + BN) * 72;
  const int t = tid_(), lane = t & 63, w = t >> 6, wm = w >> 1, wn = w & 1;
  u16* As0 = lds; u16* Bs0 = lds + BM * 72; u16* As1 = lds + SS; u16* Bs1 = lds + SS + BM * 72;
  const int lr = t >> 3, lc = (t & 7) * 8;
  const unsigned oa = (unsigned)(lr * lda + lc), ob = (unsigned)(lr * ldb + lc);
  const unsigned sa = 32u * (unsigned)lda, sb = 32u * (unsigned)ldb;
  const int swo = lr * 72 + lc;
  const unsigned klast = (unsigned)(K - 64);
  uint4 R0a0, R0a1, R0a2, R0a3, R0b0, R0b1, R0b2, R0b3, R1a0, R1a1, R1a2, R1a3, R1b0, R1b1, R1b2, R1b3;
  STAGE_LOAD(R0, 0u);
  STAGE_LOAD(R1, 64u);
  __syncthreads();
  STAGE_WRITE(R0, As0 + swo, Bs0 + swo);
  STAGE_LOAD(R0, 128u < klast ? 128u : klast);
  __syncthreads();
#pragma unroll 1
  for (int k0 = 0; k0 < K; k0 += 128) {
    STAGE_WRITE(R1, As1 + swo, Bs1 + swo);
    { unsigned kn = (unsigned)k0 + 192u; STAGE_LOAD(R1, kn < klast ? kn : klast); }
    stage_compute<MT, NT>(acc, As0, Bs0, lane, wm, wn);
    __syncthreads();
    STAGE_WRITE(R0, As0 + swo, Bs0 + swo);
    { unsigned kn = (unsigned)k0 + 256u; STAGE_LOAD(R0, kn < klast ? kn : klast); }
    stage_compute<MT, NT>(acc, As1, Bs1, lane, wm, wn);
    __syncthreads();
  }
}
template <int MT, int NT>
__device__ __forceinline__ void zero_acc(f32x4 (&acc)[MT][NT]) {
#pragma unroll
  for (int i = 0; i < MT; i++)
#pragma unroll
    for (int j = 0; j < NT; j++) acc[i][j] = (f32x4){0.f, 0.f, 0.f, 0.f};
}
__device__ __forceinline__ int tile_m0(int latonly, int tm) {
  if (!latonly) return tm * 128;
  int b = tm >> 4; return b * TT + 256 + (tm & 15) * 128;
}

__device__ __forceinline__ bool xcd_tile(int it, int bid, int nb, int NTM, int NTN, int G, int& tm, int& tn) {
  const int xcd = bid & 7, lb = bid >> 3, nlb = nb >> 3, tmx = NTM >> 3;
  const int idx = it * nlb + lb;
  if (idx >= tmx * NTN) return false;
  const int full = tmx / G;
  int g = idx / (G * NTN);
  if (g > full) g = full;
  const int r = idx - g * G * NTN;
  const int gs = (g < full) ? G : (tmx - full * G);
  tn = r / gs;
  tm = xcd * tmx + g * G + (r - tn * gs);
  return true;
}
__device__ void inproj_tile(const Params& p, int layer, int tm, int tn, u16* lds) {
  int m0 = tm * 128, n0 = tn * 128;
  f32x4 acc[4][4]; zero_acc(acc);
  gemm_kloop<4, 4>(acc, (const u16*)(p.ws + OFF_U) + (size_t)m0 * 1024, 1024,
                   (const u16*)(p.ws + OFF_WINT) + (size_t)n0 * 1024, 1024, 1024, lds);
  const int t = tid_(), lane = t & 63, w = t >> 6, wm = w >> 1, wn = w & 1;
  const float* bias = p.in[7] + (size_t)layer * DIN;
  u16* proj = (u16*)(p.ws + OFF_PROJ);
#pragma unroll
  for (int nt = 0; nt < 4; nt++) {
    const int cl = wn * 64 + nt * 16 + (lane & 15);
    const float bv = (n0 + cl < PC) ? bias[n0 + cl] : 0.f;
#pragma unroll
    for (int mt = 0; mt < 4; mt++)
#pragma unroll
      for (int r = 0; r < 4; r++) lds[(wm * 64 + mt * 16 + (lane >> 4) * 4 + r) * 136 + cl] = f2bf(acc[mt][nt][r] + bv);
  }
  __syncthreads();
#pragma unroll
  for (int i = 0; i < 8; i++) {
    const int q = t + 256 * i, row = q >> 4, ch = q & 15;
    if (n0 + ch * 8 < PC) *(uint4*)(proj + (size_t)(m0 + row) * PC + n0 + ch * 8) = *(const uint4*)(lds + row * 136 + ch * 8);
  }
}
__device__ void glu_tile(const Params& p, int layer, int latonly, int tm, int tn, u16* lds) {
  int m0 = tile_m0(latonly, tm), n0 = tn * 128;
  f32x4 acc[4][4]; zero_acc(acc);
  u16* proj = (u16*)(p.ws + OFF_PROJ);
  gemm_kloop<4, 4>(acc, proj + (size_t)m0 * PC + C_S5U, PC, (const u16*)(p.ws + OFF_GLUT) + (size_t)n0 * 256, 256, 256, lds);
  const int t = tid_(), lane = t & 63, w = t >> 6, wm = w >> 1, wn = w & 1;
  const float* bias = p.in[17] + layer * 256;
#pragma unroll
  for (int nt = 0; nt < 4; nt++) {
    const int cl = wn * 64 + nt * 16 + (lane & 15);
    const float bv = bias[n0 + cl];
#pragma unroll
    for (int mt = 0; mt < 4; mt++)
#pragma unroll
      for (int r = 0; r < 4; r++) lds[(wm * 64 + mt * 16 + (lane >> 4) * 4 + r) * 136 + cl] = f2bf(sigmoidf_(acc[mt][nt][r] + bv));
  }
  __syncthreads();
#pragma unroll
  for (int i = 0; i < 8; i++) {
    const int q = t + 256 * i, row = q >> 4, ch = q & 15;
    u16* pr = proj + (size_t)(m0 + row) * PC + n0 + ch * 8;
    uint4 sg = *(const uint4*)(lds + row * 136 + ch * 8);
    uint4 yy = *(const uint4*)(pr + C_S5U), zz = *(const uint4*)(pr + C_S5Z), oo;
    const unsigned* sgp = (const unsigned*)&sg; const unsigned* yp = (const unsigned*)&yy; const unsigned* zp = (const unsigned*)&zz; unsigned* op = (unsigned*)&oo;
#pragma unroll
    for (int e = 0; e < 4; e++) {
      float s0 = __uint_as_float(sgp[e] << 16), s1 = __uint_as_float(sgp[e] & 0xffff0000u);
      float y0 = __uint_as_float(yp[e] << 16), y1 = __uint_as_float(yp[e] & 0xffff0000u);
      float z0 = __uint_as_float(zp[e] << 16), z1 = __uint_as_float(zp[e] & 0xffff0000u);
      op[e] = pack2(y0 * s0 * siluf_(z0), y1 * s1 * siluf_(z1));
    }
    *(uint4*)(pr + C_S5Z) = oo;
  }
}
__device__ void merge_tile(const Params& p, int layer, int latonly, int tm, int tn, u16* lds) {
  constexpr int NT = 2;
  int m0 = tile_m0(latonly, tm), n0 = tn * 64;
  f32x4 accm[4][2]; zero_acc(accm);
  f32x4 accb[4][2]; zero_acc(accb);
  f32x4 accg[4][2]; zero_acc(accg);
  const u16* proj = (const u16*)(p.ws + OFF_PROJ);
  const u16* ub = (const u16*)(p.ws + OFF_U) + (size_t)m0 * 1024;
  const u16* wbt = (const u16*)(p.ws + OFF_WBT) + (size_t)n0 * 256;
  const u16* wgt = (const u16*)(p.ws + OFF_WINT) + ((size_t)PC + n0) * 1024;
  const int t = tid_(), lane = t & 63, w = t >> 6, wm = w >> 1, wn = w & 1;
  const float* bias = p.in[7] + (size_t)layer * DIN + PC;
  constexpr int SS = (128 + 64) * 72;
  u16* As0 = lds; u16* Bs0 = lds + 128 * 72; u16* As1 = lds + SS; u16* Bs1 = lds + SS + 128 * 72;
  const int lr = t >> 3, lc = (t & 7) * 8;
  const int swo = lr * 72 + lc;
  const unsigned oay = (unsigned)(lr * PC + lc), oau = (unsigned)(lr * 1024 + lc), obb = (unsigned)(lr * 256 + lc), obg = (unsigned)(lr * 1024 + lc);
  uint4 R0a0, R0a1, R0a2, R0a3, R0b0, R0b1, R0b2, R0b3, R1a0, R1a1, R1a2, R1a3, R1b0, R1b1, R1b2, R1b3;
  const u16* W = (const u16*)p.ws;
  const unsigned baseY = (unsigned)(OFF_PROJ / 2) + (unsigned)m0 * PC + oay;
  const unsigned baseU = (unsigned)(OFF_U / 2) + (unsigned)m0 * 1024u + oau;
  const unsigned baseB = (unsigned)(OFF_WBT / 2) + (unsigned)n0 * 256u + obb;
  const unsigned baseG = (unsigned)(OFF_WINT / 2) + ((unsigned)PC + (unsigned)n0) * 1024u + obg;
#define MLOAD(P, step_) do { int s_ = (step_); if (s_ > 79) s_ = 79; const int k_ = s_ / 20, r_ = s_ - k_ * 20; \
    const bool br_ = r_ < 4; \
    const unsigned yc_ = k_ == 0 ? C_S5Z : (k_ == 1 ? C_HGQ : (k_ == 2 ? C_RTQ : C_RWZ)); \
    const unsigned ao_ = br_ ? baseY + yc_ + 64u * r_ : baseU + 64u * (r_ - 4); \
    const unsigned bo_ = br_ ? baseB + (unsigned)k_ * 262144u + 64u * r_ : baseG + (unsigned)k_ * 1048576u + 64u * (r_ - 4); \
    const unsigned sa_ = br_ ? 32u * PC : 32768u, sb_ = br_ ? 8192u : 32768u; \
    P##a0 = *(const uint4*)(W + ao_); P##a1 = *(const uint4*)(W + (ao_ + sa_)); \
    P##a2 = *(const uint4*)(W + (ao_ + 2 * sa_)); P##a3 = *(const uint4*)(W + (ao_ + 3 * sa_)); \
    P##b0 = *(const uint4*)(W + bo_); P##b1 = *(const uint4*)(W + (bo_ + sb_)); } while (0)
  MLOAD(R0, 0);
  MLOAD(R1, 1);
  __syncthreads();
  STAGE_WRITE(R0, As0 + swo, Bs0 + swo);
  MLOAD(R0, 2);
  __syncthreads();
#define MPAIR(ACC) do { \
    STAGE_WRITE(R1, As1 + swo, Bs1 + swo); \
    MLOAD(R1, st + 3); \
    stage_compute<4, 2>(ACC, As0, Bs0, lane, wm, wn); \
    __syncthreads(); \
    STAGE_WRITE(R0, As0 + swo, Bs0 + swo); \
    MLOAD(R0, st + 4); \
    stage_compute<4, 2>(ACC, As1, Bs1, lane, wm, wn); \
    __syncthreads(); \
    st += 2; } while (0)
  int st = 0;
#pragma unroll 1
  for (int k = 0; k < 4; k++) {
#pragma unroll 1
    for (int i = 0; i < 2; i++) MPAIR(accb);
#pragma unroll 1
    for (int i = 0; i < 8; i++) MPAIR(accg);
#pragma unroll
    for (int nt = 0; nt < 2; nt++) {
      float bv = bias[k * 1024 + n0 + wn * 32 + nt * 16 + (lane & 15)];
#pragma unroll
      for (int mt = 0; mt < 4; mt++)
#pragma unroll
        for (int rr = 0; rr < 4; rr++) accm[mt][nt][rr] += sigmoidf_(accg[mt][nt][rr] + bv) * accb[mt][nt][rr];
    }
    zero_acc(accb); zero_acc(accg);
  }
#undef MPAIR
#undef MLOAD
  u16* mg = (u16*)(p.ws + OFF_SCR);
#pragma unroll
  for (int nt = 0; nt < 2; nt++) {
    const int cl = wn * 32 + nt * 16 + (lane & 15);
#pragma unroll
    for (int mt = 0; mt < 4; mt++)
#pragma unroll
      for (int r = 0; r < 4; r++) lds[(wm * 64 + mt * 16 + (lane >> 4) * 4 + r) * 72 + cl] = f2bf(accm[mt][nt][r]);
  }
  __syncthreads();
  {
    const int t = tid_();
#pragma unroll
    for (int i = 0; i < 4; i++) {
      const int q = t + 256 * i, row = q >> 3, ch = q & 7;
      *(uint4*)(mg + (size_t)(m0 + row) * 1024 + n0 + ch * 8) = *(const uint4*)(lds + row * 72 + ch * 8);
    }
  }
}
__device__ void outproj_tile(const Params& p, int layer, int latonly, int tm, int tn, u16* lds) {
  int m0 = tile_m0(latonly, tm), n0 = tn * 128;
  f32x4 acc[4][4]; zero_acc(acc);
  gemm_kloop<4, 4>(acc, (const u16*)(p.ws + OFF_SCR) + (size_t)m0 * 1024, 1024,
                   (const u16*)(p.ws + OFF_WOT) + (size_t)n0 * 1024, 1024, 1024, lds);
  const int lane = tid_() & 63, w = tid_() >> 6, wm = w >> 1, wn = w & 1;
  const float* bias = p.in[33] + layer * 1024;
  const float* hi0 = hin_ptr(p, layer, m0);
  float* ho0 = hout_ptr(p, m0);
  const float* gate = (const float*)(p.ws + OFF_MODS) + ((size_t)layer * 9 + modrow_of(m0)) * 3072 + 2048;
  float* cs = (float*)lds;
#pragma unroll
  for (int nt = 0; nt < 4; nt++) {
    const int cl = wn * 64 + nt * 16 + (lane & 15);
    const float bv = bias[n0 + cl];
#pragma unroll
    for (int mt = 0; mt < 4; mt++)
#pragma unroll
      for (int r = 0; r < 4; r++) cs[(wm * 64 + mt * 16 + (lane >> 4) * 4 + r) * 132 + cl] = acc[mt][nt][r] + bv;
  }
  __syncthreads();
  {
    const int t = tid_();
#pragma unroll 4
    for (int i = 0; i < 16; i++) {
      const int q = t + 256 * i, row = q >> 5, ch = q & 31;
      const float4 a4 = *(const float4*)(cs + row * 132 + ch * 4);
      const float4 g4 = *(const float4*)(gate + n0 + ch * 4);
      const float4 h4 = *(const float4*)(hi0 + (size_t)row * 1024 + n0 + ch * 4);
      float4 o4;
      o4.x = 1.4142135623730951f * h4.x + g4.x * a4.x; o4.y = 1.4142135623730951f * h4.y + g4.y * a4.y;
      o4.z = 1.4142135623730951f * h4.z + g4.z * a4.z; o4.w = 1.4142135623730951f * h4.w + g4.w * a4.w;
      *(float4*)(ho0 + (size_t)row * 1024 + n0 + ch * 4) = o4;
    }
  }
}

template <bool TWO>
__device__ void rwkv_scan_task(const Params& p, int layer, int task, float* lds) {
  const int t = tid_();
  const int rh = TWO ? (task & 1) : (task & 3), h = TWO ? ((task >> 1) & 3) : ((task >> 2) & 3);
  const int b = TWO ? ((task >> 3) & 7) : ((task >> 4) & 7), d = TWO ? (task >> 6) : (task >> 7);
  constexpr int RPB = TWO ? 32 : 16;
  float* sh_lora = lds;
  float* sh_w2 = sh_lora + 512;
  float* sh_a2 = sh_w2 + 1024;
  float* sh_r = sh_a2 + 1024;
  float* sh_w = sh_r + 1024;
  float* sh_k = sh_w + 1024;
  float* sh_kk = sh_k + 1024;
  float* sh_b = sh_kk + 1024;
  float* sh_v = sh_b + 1024;
  float* sh_o = sh_v + 512;
  const u16* proj = (const u16*)(p.ws + OFF_PROJ);
  u16* rwo = (u16*)(p.ws + OFF_RWO) + (size_t)d * MROWS * 256;
  float* bonus = (float*)(p.ws + OFF_BONUS) + (size_t)d * MROWS * 4;
  const float* mu0 = p.in[21] + (size_t)layer * 2 * 832;
  const float* mu1 = mu0 + 832;
  __syncthreads();
  for (int i = t; i < 1024; i += 256) {
    int rr = i >> 6, c = i & 63;
    sh_w2[i] = p.in[23][(((size_t)layer * 2 + d) * 16 + rr) * 256 + h * 64 + c];
    sh_a2[i] = p.in[25][(((size_t)layer * 2 + d) * 16 + rr) * 256 + h * 64 + c];
  }
  const int pst = t >> 4, cq = t & 15;
  const int ch0 = h * 64 + cq * 4;
  float mur0[4], mur1[4], muk0[4], muk1[4], w0v[4], a0v[4], kkw[4], kaw[4], rkw[4];
#pragma unroll
  for (int i = 0; i < 4; i++) {
    mur0[i] = mu0[ch0 + i]; mur1[i] = mu1[ch0 + i];
    muk0[i] = mu0[256 + ch0 + i]; muk1[i] = mu1[256 + ch0 + i];
    w0v[i] = p.in[22][((size_t)layer * 2 + d) * 256 + ch0 + i];
    a0v[i] = p.in[24][((size_t)layer * 2 + d) * 256 + ch0 + i];
    kkw[i] = p.in[26][layer * 256 + ch0 + i];
    kaw[i] = p.in[27][layer * 256 + ch0 + i];
    rkw[i] = p.in[28][layer * 256 + ch0 + i];
  }
  const int vch = 512 + h * 64 + rh * RPB + cq;
  const float muv0 = mu0[vch], muv1 = mu1[vch], muw0 = TWO ? mu0[vch + 16] : 0.f, muw1 = TWO ? mu1[vch + 16] : 0.f;
  const int lidx0 = t * 2;
  float lmu00, lmu01, lmu10, lmu11;
  {
    int q = lidx0 & 31;
    int col = q < 16 ? (768 + d * 16 + q) : (800 + d * 16 + (q - 16));
    lmu00 = mu0[col]; lmu01 = mu0[col + 1]; lmu10 = mu1[col]; lmu11 = mu1[col + 1];
  }
  const int rl = t >> 4, ks = t & 15;
  float4 S = make_float4(0.f, 0.f, 0.f, 0.f), S2 = make_float4(0.f, 0.f, 0.f, 0.f);
  unsigned lx0 = 0, lx1 = 0, lxp0 = 0, lxp1 = 0, lxn0 = 0, lxn1 = 0;
  uint2 rr_c, rr_p, rr_n, rk_c, rk_p, rk_n;
  unsigned rv_c, rv_p, rv_n, rw_c = 0, rw_p = 0, rw_n = 0;
  auto fetch = [&](int s0) {
    {
      int st2 = lidx0 >> 5, q = lidx0 & 31;
      int j = jmap(d, s0 + st2);
      int col = q < 16 ? (768 + d * 16 + q) : (800 + d * 16 + (q - 16));
      const u16* pr = proj + ((size_t)(b * TT + j)) * PC + C_RWX + col;
      const u16* prp = has_prev(j) ? pr - PC : pr;
      const u16* prn = has_next(j) ? pr + PC : pr;
      lx0 = pr[0]; lx1 = pr[1]; lxp0 = prp[0]; lxp1 = prp[1]; lxn0 = prn[0]; lxn1 = prn[1];
    }
    int j = jmap(d, s0 + pst);
    const u16* pr = proj + ((size_t)(b * TT + j)) * PC + C_RWX;
    const u16* prp = has_prev(j) ? pr - PC : pr;
    const u16* prn = has_next(j) ? pr + PC : pr;
    rr_c = *(const uint2*)(pr + ch0); rr_p = *(const uint2*)(prp + ch0); rr_n = *(const uint2*)(prn + ch0);
    rk_c = *(const uint2*)(pr + 256 + ch0); rk_p = *(const uint2*)(prp + 256 + ch0); rk_n = *(const uint2*)(prn + 256 + ch0);
    rv_c = pr[vch]; rv_p = prp[vch]; rv_n = prn[vch];
    if (TWO) { rw_c = pr[vch + 16]; rw_p = prp[vch + 16]; rw_n = prn[vch + 16]; }
  };
  auto unpack4 = [](uint2 v, float (&o)[4]) {
    o[0] = __uint_as_float(v.x << 16); o[1] = __uint_as_float(v.x & 0xffff0000u);
    o[2] = __uint_as_float(v.y << 16); o[3] = __uint_as_float(v.y & 0xffff0000u);
  };
  fetch(0);
  for (int s0 = 0; s0 < TT; s0 += 16) {
    {
      int st2 = lidx0 >> 5, q = lidx0 & 31;
      int ja = jmap(d, s0 + st2);
      const float hpa = has_prev(ja) ? 1.f : 0.f, hna = has_next(ja) ? 1.f : 0.f;
      float x0 = __uint_as_float(lx0 << 16), x1 = __uint_as_float(lx1 << 16);
      float xs0 = x0 + lmu00 * (__uint_as_float(lxp0 << 16) * hpa - x0) + lmu10 * (__uint_as_float(lxn0 << 16) * hna - x0);
      float xs1 = x1 + lmu01 * (__uint_as_float(lxp1 << 16) * hpa - x1) + lmu11 * (__uint_as_float(lxn1 << 16) * hna - x1);
      if (q < 16) {
        xs0 = 1.f - 2.f * __builtin_amdgcn_rcpf(__expf(2.f * xs0) + 1.f);
        xs1 = 1.f - 2.f * __builtin_amdgcn_rcpf(__expf(2.f * xs1) + 1.f);
      }
      *(float2*)(sh_lora + lidx0) = make_float2(xs0, xs1);
    }
    __syncthreads();
    const int jcur = jmap(d, s0 + pst);
    {
      const float hpf = has_prev(jcur) ? 1.f : 0.f, hnf = has_next(jcur) ? 1.f : 0.f;
      float r4[4], k4[4], t0[4], t1[4];
      unpack4(rr_c, r4); unpack4(rr_p, t0); unpack4(rr_n, t1);
#pragma unroll
      for (int i = 0; i < 4; i++) r4[i] = r4[i] + mur0[i] * (t0[i] * hpf - r4[i]) + mur1[i] * (t1[i] * hnf - r4[i]);
      unpack4(rk_c, k4); unpack4(rk_p, t0); unpack4(rk_n, t1);
#pragma unroll
      for (int i = 0; i < 4; i++) k4[i] = k4[i] + muk0[i] * (t0[i] * hpf - k4[i]) + muk1[i] * (t1[i] * hnf - k4[i]);
      float wl[4], al[4];
#pragma unroll
      for (int i = 0; i < 4; i++) { wl[i] = w0v[i]; al[i] = a0v[i]; }
      float lrow[32];
#pragma unroll
      for (int i4 = 0; i4 < 8; i4++) {
        float4 q4 = *(const float4*)(sh_lora + pst * 32 + i4 * 4);
        lrow[i4 * 4] = q4.x; lrow[i4 * 4 + 1] = q4.y; lrow[i4 * 4 + 2] = q4.z; lrow[i4 * 4 + 3] = q4.w;
      }
#pragma unroll
      for (int rr = 0; rr < 16; rr++) {
        float lw_ = lrow[rr], la_ = lrow[16 + rr];
        float4 w2 = *(const float4*)(sh_w2 + rr * 64 + cq * 4);
        float4 a2 = *(const float4*)(sh_a2 + rr * 64 + cq * 4);
        wl[0] += lw_ * w2.x; wl[1] += lw_ * w2.y; wl[2] += lw_ * w2.z; wl[3] += lw_ * w2.w;
        al[0] += la_ * a2.x; al[1] += la_ * a2.y; al[2] += la_ * a2.z; al[3] += la_ * a2.w;
      }
      float wv[4], kd[4], kk[4], bb[4];
      float ss = 0.f, bon = 0.f;
#pragma unroll
      for (int i = 0; i < 4; i++) {
        float a = wl[i];
        float lw = fminf(a, 0.f) - __logf(1.f + __expf(-fabsf(a))) - 0.5f;
        wv[i] = __expf(-__expf(lw));
        float ic = sigmoidf_(al[i]);
        float kr = k4[i] * kkw[i];
        kk[i] = kr; ss += kr * kr;
        kd[i] = k4[i] * (1.f + (ic - 1.f) * kaw[i]);
        bb[i] = ic;
        bon += r4[i] * kd[i] * rkw[i];
      }
      ss = allsum16(ss); bon = allsum16(bon);
      float inv = rsqrtf(fmaxf(ss, 1e-24f));
#pragma unroll
      for (int i = 0; i < 4; i++) { kk[i] *= inv; bb[i] *= kk[i]; }
      *(float4*)(sh_r + pst * 64 + cq * 4) = make_float4(r4[0], r4[1], r4[2], r4[3]);
      *(float4*)(sh_w + pst * 64 + cq * 4) = make_float4(wv[0], wv[1], wv[2], wv[3]);
      *(float4*)(sh_k + pst * 64 + cq * 4) = make_float4(kd[0], kd[1], kd[2], kd[3]);
      *(float4*)(sh_kk + pst * 64 + cq * 4) = make_float4(kk[0], kk[1], kk[2], kk[3]);
      *(float4*)(sh_b + pst * 64 + cq * 4) = make_float4(bb[0], bb[1], bb[2], bb[3]);
      if (rh == 0 && cq == 0) bonus[(size_t)(b * TT + jcur) * 4 + h] = bon;
      float xv = __uint_as_float(rv_c << 16);
      sh_v[pst * 32 + cq] = xv + muv0 * (__uint_as_float(rv_p << 16) * hpf - xv) + muv1 * (__uint_as_float(rv_n << 16) * hnf - xv);
      float xw = __uint_as_float(rw_c << 16);
      if (TWO) sh_v[pst * 32 + 16 + cq] = xw + muw0 * (__uint_as_float(rw_p << 16) * hpf - xw) + muw1 * (__uint_as_float(rw_n << 16) * hnf - xw);
    }
    __syncthreads();
    if (s0 + 16 < TT) fetch(s0 + 16);
    float oacc = 0.f, oacc2 = 0.f;
    {
      float4 nkk = *(const float4*)(sh_kk + ks * 4), nw = *(const float4*)(sh_w + ks * 4), nb4 = *(const float4*)(sh_b + ks * 4);
      float4 nk = *(const float4*)(sh_k + ks * 4), nr = *(const float4*)(sh_r + ks * 4);
      float nv = sh_v[rl], nv2 = sh_v[16 + rl];
#pragma unroll 4
      for (int st = 0; st < 16; st++) {
        const float4 kk4 = nkk, w4 = nw, b4 = nb4, k4 = nk, r4 = nr; const float vv = nv, vv2 = nv2;
        {
          const int sn = (st + 1) & 15;
          nkk = *(const float4*)(sh_kk + sn * 64 + ks * 4); nw = *(const float4*)(sh_w + sn * 64 + ks * 4);
          nb4 = *(const float4*)(sh_b + sn * 64 + ks * 4); nk = *(const float4*)(sh_k + sn * 64 + ks * 4);
          nr = *(const float4*)(sh_r + sn * 64 + ks * 4); nv = sh_v[sn * 32 + rl]; nv2 = sh_v[sn * 32 + 16 + rl];
        }
        float sa = -((S.x * kk4.x + S.y * kk4.y) + (S.z * kk4.z + S.w * kk4.w));
        float sa2 = 0.f;
        if (TWO) sa2 = -((S2.x * kk4.x + S2.y * kk4.y) + (S2.z * kk4.z + S2.w * kk4.w));
        sa = allsum16(sa); if (TWO) sa2 = allsum16(sa2);
        S.x = S.x * w4.x + (sa * b4.x + vv * k4.x);
        S.y = S.y * w4.y + (sa * b4.y + vv * k4.y);
        S.z = S.z * w4.z + (sa * b4.z + vv * k4.z);
        S.w = S.w * w4.w + (sa * b4.w + vv * k4.w);
        if (TWO) {
          S2.x = S2.x * w4.x + (sa2 * b4.x + vv2 * k4.x);
          S2.y = S2.y * w4.y + (sa2 * b4.y + vv2 * k4.y);
          S2.z = S2.z * w4.z + (sa2 * b4.z + vv2 * k4.z);
          S2.w = S2.w * w4.w + (sa2 * b4.w + vv2 * k4.w);
        }
        float o = (S.x * r4.x + S.y * r4.y) + (S.z * r4.z + S.w * r4.w);
        float o2 = 0.f;
        if (TWO) o2 = (S2.x * r4.x + S2.y * r4.y) + (S2.z * r4.z + S2.w * r4.w);
        o = allsum16(o); if (TWO) o2 = allsum16(o2);
        oacc = (ks == st) ? o : oacc;
        oacc2 = (ks == st) ? o2 : oacc2;
      }
    }
    sh_o[ks * 32 + rl] = oacc;
    if (TWO) sh_o[ks * 32 + 16 + rl] = oacc2;
    __syncthreads();
    {
      u16* op = rwo + (size_t)(b * TT + jcur) * 256 + h * 64 + rh * RPB + cq;
      op[0] = f2bf(sh_o[pst * 32 + cq]);
      if (TWO) op[16] = f2bf(sh_o[pst * 32 + 16 + cq]);
    }
  }
}

__device__ void rwkv_combine_rows(const Params& p, int layer, int row0, int latonly) {
  const int lane = tid_() & 63, h = tid_() >> 6;
  const int ch = h * 64 + lane;
  const u16* rwo = (const u16*)(p.ws + OFF_RWO);
  u16* proj = (u16*)(p.ws + OFF_PROJ);
  const float* mu0 = p.in[21] + (size_t)layer * 2 * 832; const float* mu1 = mu0 + 832;
  const float* bonus = (const float*)(p.ws + OFF_BONUS);
  const float gw = p.in[29][layer * 256 + ch], gb = p.in[30][layer * 256 + ch];
  const float m0 = mu0[512 + ch], m1 = mu1[512 + ch];
  const int vc = C_RWX + 512 + ch;
  float o[8], xv[8], xp[8], xn[8], bs[8], z[8];
#pragma unroll
  for (int i = 0; i < 8; i++) {
    const int row = row0 + i;
    const int j = row % TT;
    const u16* pr = proj + (size_t)row * PC;
    o[i] = bf2f(rwo[(size_t)row * 256 + ch]) + bf2f(rwo[(size_t)MROWS * 256 + (size_t)row * 256 + ch]);
    xv[i] = bf2f(pr[vc]);
    xp[i] = has_prev(j) ? bf2f(pr[vc - PC]) : 0.f;
    xn[i] = has_next(j) ? bf2f(pr[vc + PC]) : 0.f;
    bs[i] = bonus[(size_t)row * 4 + h] + bonus[(size_t)MROWS * 4 + (size_t)row * 4 + h];
    z[i] = bf2f(pr[C_RWZ + ch]);
  }
#pragma unroll
  for (int i = 0; i < 8; i++) {
    const int row = row0 + i;
    if (latonly && (row % TT) < 256) continue;
    float mean = wavesum(o[i]) * (1.f / 64.f);
    float dlt = o[i] - mean;
    float var = wavesum(dlt * dlt) * (1.f / 64.f);
    float on = dlt * rsqrtf(var + 64e-5f) * gw + gb;
    float v = xv[i] + m0 * (xp[i] - xv[i]) + m1 * (xn[i] - xv[i]);
    proj[(size_t)row * PC + C_RWZ + ch] = f2bf((on + bs[i] * v) * siluf_(z[i]));
  }
}

template <int MX, int PASS>
__device__ __forceinline__ void gla_sweep(const Params& p, int layer, int d, int b, int h, int c, float* lds) {
  const int t = tid_(), w = t >> 6, lane = t & 63;
  float* kbuf = lds;
  float* fbuf = kbuf + 1024;
  float* qbuf = fbuf + 1024;
  float* vbuf = qbuf + 1024;
  float* part = vbuf + 1024;
  u16* proj = (u16*)(p.ws + OFF_PROJ);
  const int dbh = (d * 8 + b) * 4 + h;
  float* stt = (float*)(p.ws + (MX == 0 ? OFF_HGST : OFF_RTST)) + ((size_t)dbh * 9 + c) * 4096;
  float S[16];
#pragma unroll
  for (int i = 0; i < 16; i++) S[i] = PASS == 1 ? 0.f : stt[(w * 16 + i) * 64 + lane];
  float gam = 1.f;
  if (MX == 1) gam = __expf(-__expf(p.in[20][((size_t)layer * 2 + d) * 4 + h]));
  float Pl = 1.f;
  const int pst = t >> 4, c4 = (t & 15) * 4;
  float lb4[4] = {0.f, 0.f, 0.f, 0.f};
  if (MX == 0 && layer == 1) {
#pragma unroll
    for (int i = 0; i < 4; i++) {
      float l0 = p.in[18][(0 * 2 + d) * 256 + h * 64 + c4 + i], l1 = p.in[18][(1 * 2 + d) * 256 + h * 64 + c4 + i];
      float mx = fmaxf(l0, l1);
      float e0 = __expf(l0 - mx), e1 = __expf(l1 - mx);
      lb4[i] = e1 / (e0 + e1);
    }
  }
  const int vcol0 = (MX == 0 ? C_HGI : C_RTV) + h * 64;
  const float* rope = (const float*)(p.ws + OFF_ROPE);
  uint2 r_a, r_b, r_c, r_d, r_v; float4 r_cs0, r_cs1;
  r_a = r_b = r_c = r_d = r_v = make_uint2(0u, 0u); r_cs0 = r_cs1 = make_float4(1.f, 0.f, 1.f, 0.f);
  auto fetch = [&](int s0) {
    int j = jmap(d, s0 + pst);
    const u16* pr = proj + (size_t)(b * TT + j) * PC;
    r_v = *(const uint2*)(pr + vcol0 + c4);
    if (MX == 0) {
      r_a = *(const uint2*)(pr + C_HGF + d * 256 + h * 64 + c4);
      if (PASS == 2) r_b = *(const uint2*)(pr + C_HGQ + h * 64 + c4);
    } else {
      r_a = *(const uint2*)(pr + C_RTK + h * 64 + c4);
      r_c = *(const uint2*)(pr + C_RTK + h * 64 + (c4 ^ 16));
      if (PASS == 2) { r_b = *(const uint2*)(pr + C_RTQ + h * 64 + c4); r_d = *(const uint2*)(pr + C_RTQ + h * 64 + (c4 ^ 16)); }
      if (j >= 256) {
        int tl = j - 256;
        int pos = (c4 & 32) ? (tl & 63) : (tl >> 6);
        const float* rp = rope + (pos * 16 + (c4 & 15)) * 2;
        r_cs0 = *(const float4*)rp; r_cs1 = *(const float4*)(rp + 4);
      } else { r_cs0 = make_float4(1.f, 0.f, 1.f, 0.f); r_cs1 = r_cs0; }
    }
  };
  auto unpack4 = [](uint2 v, float (&o)[4]) {
    o[0] = __uint_as_float(v.x << 16); o[1] = __uint_as_float(v.x & 0xffff0000u);
    o[2] = __uint_as_float(v.y << 16); o[3] = __uint_as_float(v.y & 0xffff0000u);
  };
  u16* ofp; int ofs;
  if (MX == 0) { ofp = proj + C_HGF + h * 64 + lane; ofs = PC; }
  else { ofp = (u16*)(p.ws + OFF_RETOF) + h * 64 + lane; ofs = 256; }
  const int zcol = (MX == 0 ? C_HGZ : C_RTZ) + h * 64 + lane;
  const int ycol = (MX == 0 ? C_HGQ : C_RTQ) + h * 64 + lane;
  float normw = 1.f;
  if (MX == 0 && PASS == 2) normw = p.in[19][layer * 256 + h * 64 + lane];
  fetch(c * 256);
  for (int sub = 0; sub < 16; sub++) {
    const int s0 = c * 256 + sub * 16;
    __syncthreads();
    {
      float va[4], vb[4], vc[4], vd[4], vv4[4];
      unpack4(r_a, va); unpack4(r_v, vv4);
      *(float4*)(vbuf + pst * 64 + c4) = make_float4(vv4[0], vv4[1], vv4[2], vv4[3]);
      if (MX == 0) {
        float f[4], k[4];
#pragma unroll
        for (int i = 0; i < 4; i++) { f[i] = lb4[i] + (1.f - lb4[i]) * sigmoidf_(va[i]); k[i] = 1.f - f[i]; }
        *(float4*)(kbuf + pst * 64 + c4) = make_float4(k[0], k[1], k[2], k[3]);
        *(float4*)(fbuf + pst * 64 + c4) = make_float4(f[0], f[1], f[2], f[3]);
        if (PASS == 2) {
          unpack4(r_b, vb);
          *(float4*)(qbuf + pst * 64 + c4) = make_float4(siluf_(vb[0]), siluf_(vb[1]), siluf_(vb[2]), siluf_(vb[3]));
        }
      } else {
        unpack4(r_c, vc);
        float cs[8] = {r_cs0.x, r_cs0.y, r_cs0.z, r_cs0.w, r_cs1.x, r_cs1.y, r_cs1.z, r_cs1.w};
        float sgn = (c4 & 16) ? 1.f : -1.f;
#pragma unroll
        for (int i = 0; i < 4; i++) va[i] = (va[i] * cs[2 * i] + sgn * vc[i] * cs[2 * i + 1]) * 0.125f;
        *(float4*)(kbuf + pst * 64 + c4) = make_float4(va[0], va[1], va[2], va[3]);
        if (PASS == 2) {
          unpack4(r_b, vb); unpack4(r_d, vd);
#pragma unroll
          for (int i = 0; i < 4; i++) vb[i] = vb[i] * cs[2 * i] + sgn * vd[i] * cs[2 * i + 1];
          *(float4*)(qbuf + pst * 64 + c4) = make_float4(vb[0], vb[1], vb[2], vb[3]);
        }
      }
    }
    __syncthreads();
    if (sub + 1 < 16) fetch(s0 + 16);
    u16 pf_o[4], pf_z[4];
    if (PASS == 2 && d == 1) {
#pragma unroll
      for (int e = 0; e < 4; e++) {
        size_t row = (size_t)(b * TT + jmap(d, s0 + w * 4 + e));
        pf_o[e] = ofp[row * ofs]; pf_z[e] = proj[row * PC + zcol];
      }
    }
#pragma unroll 2
    for (int st = 0; st < 16; st++) {
      const float vv = vbuf[st * 64 + lane];
      float o = 0.f;
#pragma unroll
      for (int i4 = 0; i4 < 4; i4++) {
        float4 kv = *(const float4*)(kbuf + st * 64 + w * 16 + i4 * 4);
        float4 fv = make_float4(gam, gam, gam, gam);
        if (MX == 0) fv = *(const float4*)(fbuf + st * 64 + w * 16 + i4 * 4);
        S[i4*4]   = fv.x * S[i4*4]   + kv.x * vv;
        S[i4*4+1] = fv.y * S[i4*4+1] + kv.y * vv;
        S[i4*4+2] = fv.z * S[i4*4+2] + kv.z * vv;
        S[i4*4+3] = fv.w * S[i4*4+3] + kv.w * vv;
        if (PASS == 2) {
          float4 qv = *(const float4*)(qbuf + st * 64 + w * 16 + i4 * 4);
          o += S[i4*4] * qv.x + S[i4*4+1] * qv.y + S[i4*4+2] * qv.z + S[i4*4+3] * qv.w;
        }
      }
      if (MX == 0 && PASS == 1) { if (lane < 16) Pl *= fbuf[st * 64 + w * 16 + lane]; }
      if (PASS == 2) part[(w * 16 + st) * 64 + lane] = o;
    }
    if (PASS == 2) {
      __syncthreads();
#pragma unroll
      for (int e = 0; e < 4; e++) {
        int st = w * 4 + e;
        float o = part[(0 * 16 + st) * 64 + lane] + part[(1 * 16 + st) * 64 + lane] + part[(2 * 16 + st) * 64 + lane] + part[(3 * 16 + st) * 64 + lane];
        int j = jmap(d, s0 + st);
        size_t row = (size_t)(b * TT + j);
        if (d == 0) {
          ofp[row * ofs] = f2bf(o);
        } else {
          o += bf2f(pf_o[e]);
          float ss = wavesum(o * o);
          float y = o * rsqrtf(ss * (1.f / 64.f) + 1e-6f) * normw;
          proj[row * PC + ycol] = f2bf(y * siluf_(bf2f(pf_z[e])));
        }
      }
    }
  }
  if (PASS == 1) {
#pragma unroll
    for (int i = 0; i < 16; i++) stt[(w * 16 + i) * 64 + lane] = S[i];
    if (MX == 0 && lane < 16) ((float*)(p.ws + OFF_HGP))[((size_t)dbh * 9 + c) * 64 + w * 16 + lane] = Pl;
  }
}

#define RS 72
template <int PASS>
__device__ __forceinline__ void ret_sweep(const Params& p, int layer, int d, int b, int h, int nc, int cstep, u16* lds) {
  const int t = tid_(), lane = t & 63, w4 = t >> 6;
  u16* Qs = lds;
  u16* Ks = Qs + 64 * RS;
  u16* Kt = Ks + 64 * RS;
  u16* Vt = Kt + 64 * RS;
  u16* Vd = Vt + 64 * RS;
  u16* Ps = Vd + 64 * RS;
  u16* St = Ps + 64 * RS;
  u16* proj = (u16*)(p.ws + OFF_PROJ);
  const float* rope = (const float*)(p.ws + OFF_ROPE);
  const float lg = -__expf(p.in[20][((size_t)layer * 2 + d) * 4 + h]) * 1.4426950408889634f;
  const float g64 = exp2f(64.f * lg);
  const int dbh = (d * 8 + b) * 4 + h;
  float* stt = (float*)(p.ws + OFF_RTST) + ((size_t)dbh * 9 + cstep) * 4096;
  f32x4 accS[4];
#pragma unroll
  for (int nt = 0; nt < 4; nt++)
#pragma unroll
    for (int r = 0; r < 4; r++)
      accS[nt][r] = PASS == 1 ? 0.f : stt[(w4 * 16 + (lane >> 4) * 4 + r) * 64 + nt * 16 + (lane & 15)];
  uint4 rq[2], rqp[2], rk[2], rkp[2], rv[2];
  auto fetch = [&](int w) {
#pragma unroll
    for (int e = 0; e < 2; e++) {
      const int q = t + 256 * e, sl = q & 63, c8 = (q >> 6) * 8;
      const u16* pr = proj + (size_t)(b * TT + nc * 256 + w * 64 + sl) * PC + h * 64;
      rk[e] = *(const uint4*)(pr + C_RTK + c8); rkp[e] = *(const uint4*)(pr + C_RTK + (c8 ^ 16));
      rv[e] = *(const uint4*)(pr + C_RTV + c8);
      if (PASS == 2) { rq[e] = *(const uint4*)(pr + C_RTQ + c8); rqp[e] = *(const uint4*)(pr + C_RTQ + (c8 ^ 16)); }
    }
  };
  auto up = [](uint4 v, float (&o)[8]) {
    const unsigned* u = (const unsigned*)&v;
#pragma unroll
    for (int i = 0; i < 4; i++) { o[2 * i] = __uint_as_float(u[i] << 16); o[2 * i + 1] = __uint_as_float(u[i] & 0xffff0000u); }
  };
  fetch(d == 0 ? 0 : 3);
  for (int wi = 0; wi < 4; wi++) {
    const int w = d == 0 ? wi : 3 - wi;
    __syncthreads();
    if (PASS == 2 && wi == 0) {
#pragma unroll
      for (int nt = 0; nt < 4; nt++)
        *(uint2*)(St + (nt * 16 + (lane & 15)) * RS + w4 * 16 + (lane >> 4) * 4) =
            make_uint2(pack2(accS[nt][0], accS[nt][1]), pack2(accS[nt][2], accS[nt][3]));
    }
#pragma unroll
    for (int e = 0; e < 2; e++) {
      const int q = t + 256 * e, sl = q & 63, c8 = (q >> 6) * 8;
      const int j = nc * 256 + w * 64 + sl;
      float kx[8], kp[8], vx[8], qx[8], qp[8];
      up(rk[e], kx); up(rkp[e], kp); up(rv[e], vx);
      if (PASS == 2) { up(rq[e], qx); up(rqp[e], qp); }
      if (j >= 256) {
        const int tl = j - 256;
        const int pos = (c8 & 32) ? (tl & 63) : (tl >> 6);
        const float* rp = rope + (pos * 16 + (c8 & 15)) * 2;
        const float sgn = (c8 & 16) ? 1.f : -1.f;
#pragma unroll
        for (int i2 = 0; i2 < 4; i2++) {
          const float4 cs = *(const float4*)(rp + i2 * 4);
          kx[2 * i2] = kx[2 * i2] * cs.x + sgn * kp[2 * i2] * cs.y;
          kx[2 * i2 + 1] = kx[2 * i2 + 1] * cs.z + sgn * kp[2 * i2 + 1] * cs.w;
          if (PASS == 2) {
            qx[2 * i2] = qx[2 * i2] * cs.x + sgn * qp[2 * i2] * cs.y;
            qx[2 * i2 + 1] = qx[2 * i2 + 1] * cs.z + sgn * qp[2 * i2 + 1] * cs.w;
          }
        }
      }
      const float dec = exp2f((float)(d == 0 ? 63 - sl : sl) * lg);
      u16 kb[8];
#pragma unroll
      for (int i = 0; i < 8; i++) {
        kb[i] = f2bf(kx[i] * 0.125f);
        Kt[(c8 + i) * RS + sl] = kb[i];
        Vd[(c8 + i) * RS + sl] = f2bf(vx[i] * dec);
      }
      if (PASS == 2) {
        uint4 kk4, qq4;
        kk4.x = kb[0] | ((unsigned)kb[1] << 16); kk4.y = kb[2] | ((unsigned)kb[3] << 16);
        kk4.z = kb[4] | ((unsigned)kb[5] << 16); kk4.w = kb[6] | ((unsigned)kb[7] << 16);
        qq4.x = pack2(qx[0], qx[1]); qq4.y = pack2(qx[2], qx[3]); qq4.z = pack2(qx[4], qx[5]); qq4.w = pack2(qx[6], qx[7]);
        *(uint4*)(Ks + sl * RS + c8) = kk4;
        *(uint4*)(Qs + sl * RS + c8) = qq4;
        const unsigned short* vraw = (const unsigned short*)&rv[e];
#pragma unroll
        for (int i = 0; i < 8; i++) Vt[(c8 + i) * RS + sl] = vraw[i];
      }
    }
    __syncthreads();
    if (wi + 1 < 4) fetch(d == 0 ? wi + 1 : 2 - wi);
    if (PASS == 2) {
      f32x4 accP[4];
#pragma unroll
      for (int nt = 0; nt < 4; nt++) accP[nt] = (f32x4){0.f, 0.f, 0.f, 0.f};
      bf16x8 aq[2];
#pragma unroll
      for (int kk = 0; kk < 2; kk++) aq[kk] = *(const bf16x8*)(Qs + (w4 * 16 + (lane & 15)) * RS + kk * 32 + (lane >> 4) * 8);
#pragma unroll
      for (int kk = 0; kk < 2; kk++)
#pragma unroll
        for (int nt = 0; nt < 4; nt++) {
          bf16x8 bk = *(const bf16x8*)(Ks + (nt * 16 + (lane & 15)) * RS + kk * 32 + (lane >> 4) * 8);
          accP[nt] = __builtin_amdgcn_mfma_f32_16x16x32_bf16(aq[kk], bk, accP[nt], 0, 0, 0);
        }
#pragma unroll
      for (int nt = 0; nt < 4; nt++)
#pragma unroll
        for (int r = 0; r < 4; r++) {
          const int il = w4 * 16 + (lane >> 4) * 4 + r, sl = nt * 16 + (lane & 15);
          const int e = d == 0 ? il - sl : sl - il;
          const float f = e >= 0 ? exp2f((float)e * lg) : 0.f;
          Ps[il * RS + sl] = f2bf(accP[nt][r] * f);
        }
      __syncthreads();
      f32x4 accO[4], accI[4];
#pragma unroll
      for (int nt = 0; nt < 4; nt++) { accO[nt] = (f32x4){0.f, 0.f, 0.f, 0.f}; accI[nt] = (f32x4){0.f, 0.f, 0.f, 0.f}; }
#pragma unroll
      for (int kk = 0; kk < 2; kk++) {
        bf16x8 ap = *(const bf16x8*)(Ps + (w4 * 16 + (lane & 15)) * RS + kk * 32 + (lane >> 4) * 8);
#pragma unroll
        for (int nt = 0; nt < 4; nt++) {
          bf16x8 bv = *(const bf16x8*)(Vt + (nt * 16 + (lane & 15)) * RS + kk * 32 + (lane >> 4) * 8);
          accO[nt] = __builtin_amdgcn_mfma_f32_16x16x32_bf16(ap, bv, accO[nt], 0, 0, 0);
          bf16x8 bs = *(const bf16x8*)(St + (nt * 16 + (lane & 15)) * RS + kk * 32 + (lane >> 4) * 8);
          accI[nt] = __builtin_amdgcn_mfma_f32_16x16x32_bf16(aq[kk], bs, accI[nt], 0, 0, 0);
        }
      }
      u16* ofp = (u16*)(p.ws + OFF_RETOF);
#pragma unroll
      for (int r = 0; r < 4; r++) {
        const int il = w4 * 16 + (lane >> 4) * 4 + r;
        const size_t row = (size_t)(b * TT + nc * 256 + w * 64 + il);
        const float rho = exp2f((float)(d == 0 ? il + 1 : 64 - il) * lg);
        float o[4], ss = 0.f;
#pragma unroll
        for (int nt = 0; nt < 4; nt++) {
          o[nt] = accO[nt][r] + rho * accI[nt][r];
          if (d == 1) o[nt] += bf2f(ofp[row * 256 + h * 64 + nt * 16 + (lane & 15)]);
          ss += o[nt] * o[nt];
        }
        if (d == 0) {
#pragma unroll
          for (int nt = 0; nt < 4; nt++) ofp[row * 256 + h * 64 + nt * 16 + (lane & 15)] = f2bf(o[nt]);
        } else {
          ss = allsum16(ss);
          const float sc = rsqrtf(ss * (1.f / 64.f) + 1e-6f);
#pragma unroll
          for (int nt = 0; nt < 4; nt++) {
            const int cv = h * 64 + nt * 16 + (lane & 15);
            const float z = bf2f(proj[row * PC + C_RTZ + cv]);
            proj[row * PC + C_RTQ + cv] = f2bf(o[nt] * sc * siluf_(z));
          }
        }
      }
    }
#pragma unroll
    for (int nt = 0; nt < 4; nt++)
#pragma unroll
      for (int r = 0; r < 4; r++) accS[nt][r] *= g64;
#pragma unroll
    for (int kk = 0; kk < 2; kk++) {
      bf16x8 ak = *(const bf16x8*)(Kt + (w4 * 16 + (lane & 15)) * RS + kk * 32 + (lane >> 4) * 8);
#pragma unroll
      for (int nt = 0; nt < 4; nt++) {
        bf16x8 bv = *(const bf16x8*)(Vd + (nt * 16 + (lane & 15)) * RS + kk * 32 + (lane >> 4) * 8);
        accS[nt] = __builtin_amdgcn_mfma_f32_16x16x32_bf16(ak, bv, accS[nt], 0, 0, 0);
      }
    }
    __syncthreads();
    if (PASS == 2 && wi + 1 < 4) {
#pragma unroll
      for (int nt = 0; nt < 4; nt++)
        *(uint2*)(St + (nt * 16 + (lane & 15)) * RS + w4 * 16 + (lane >> 4) * 4) =
            make_uint2(pack2(accS[nt][0], accS[nt][1]), pack2(accS[nt][2], accS[nt][3]));
    }
  }
  if (PASS == 1) {
#pragma unroll
    for (int nt = 0; nt < 4; nt++)
#pragma unroll
      for (int r = 0; r < 4; r++) stt[(w4 * 16 + (lane >> 4) * 4 + r) * 64 + nt * 16 + (lane & 15)] = accS[nt][r];
  }
}

#define HS 40
template <int PASS>
__device__ __forceinline__ void hg_sweep(const Params& p, int layer, int d, int b, int h, int nc, int cstep, u16* lds) {
  const int t = tid_(), lane = t & 63, w4 = t >> 6;
  u16* Qt = lds;
  u16* Kt = Qt + 16 * RS;
  u16* KtT = Kt + 16 * RS;
  u16* VtT = KtT + 64 * HS;
  u16* Am = VtT + 64 * HS;
  u16* St = Am + 16 * HS;
  float* eb = (float*)(St + 64 * RS);
  float* ssb = eb + 64;
  u16* proj = (u16*)(p.ws + OFF_PROJ);
  const int dbh = (d * 8 + b) * 4 + h;
  float* stt = (float*)(p.ws + OFF_HGST) + ((size_t)dbh * 9 + cstep) * 4096;
  f32x4 accS[4];
#pragma unroll
  for (int nt = 0; nt < 4; nt++)
#pragma unroll
    for (int r = 0; r < 4; r++)
      accS[nt][r] = PASS == 1 ? 0.f : stt[(w4 * 16 + (lane >> 4) * 4 + r) * 64 + nt * 16 + (lane & 15)];
  const int kc = lane, qd = w4;
  float lb = 0.f;
  if (layer == 1) {
    float l0 = p.in[18][(0 * 2 + d) * 256 + h * 64 + kc], l1 = p.in[18][(1 * 2 + d) * 256 + h * 64 + kc];
    float mx = fmaxf(l0, l1);
    float e0 = __expf(l0 - mx), e1 = __expf(l1 - mx);
    lb = e1 / (e0 + e1);
  }
  const float normw = p.in[19][layer * 256 + h * 64 + w4 * 16 + (lane & 15)];
  float bsum = 0.f;
  __syncthreads();
  for (int i = t; i < 64 * 16; i += 256) { KtT[(i >> 4) * HS + 16 + (i & 15)] = 0; VtT[(i >> 4) * HS + 16 + (i & 15)] = 0; }
  for (int i = t; i < 16 * 16; i += 256) Am[(i >> 4) * HS + 16 + (i & 15)] = 0;
  unsigned rlg[16], rvv[4], rqq[4];
  auto fetch = [&](int spn) {
    const int ns = d == 0 ? spn : 15 - spn;
    const u16* pb = proj + (size_t)(b * TT + nc * 256 + ns * 16) * PC;
#pragma unroll
    for (int tau = 0; tau < 16; tau++) rlg[tau] = pb[(size_t)(d == 0 ? tau : 15 - tau) * PC + C_HGF + d * 256 + h * 64 + kc];
#pragma unroll
    for (int e = 0; e < 4; e++) {
      const int tau = qd * 4 + e;
      const u16* pr = pb + (size_t)(d == 0 ? tau : 15 - tau) * PC;
      rvv[e] = pr[C_HGI + h * 64 + kc];
      if (PASS == 2) rqq[e] = pr[C_HGQ + h * 64 + kc];
    }
  };
  fetch(0);
  for (int sp = 0; sp < 16; sp++) {
    const int nsub = d == 0 ? sp : 15 - sp;
    const int rbase = b * TT + nc * 256 + nsub * 16;
    __syncthreads();
    if (PASS == 2 && sp == 0) {
#pragma unroll
      for (int nt = 0; nt < 4; nt++)
        *(uint2*)(St + (nt * 16 + (lane & 15)) * RS + w4 * 16 + (lane >> 4) * 4) =
            make_uint2(pack2(accS[nt][0], accS[nt][1]), pack2(accS[nt][2], accS[nt][3]));
    }
    {
      float bacc = 0.f;
#pragma unroll
      for (int tau = 0; tau < 16; tau++) {
        const float lg = __uint_as_float(rlg[tau] << 16);
        const float f = lb + (1.f - lb) * sigmoidf_(lg);
        bacc += __logf(f);
        if ((tau >> 2) == qd) {
          const float em = __expf(-bacc);
          const u16 kq = f2bf((1.f - f) * em);
          Kt[tau * RS + kc] = kq;
          KtT[kc * HS + tau] = kq;
          VtT[kc * HS + tau] = (u16)rvv[tau & 3];
          if (PASS == 2) Qt[tau * RS + kc] = f2bf(siluf_(__uint_as_float(rqq[tau & 3] << 16)) * __expf(bacc));
        }
      }
      if (qd == 0) { eb[kc] = __expf(bacc); bsum += bacc; }
    }
    __syncthreads();
    if (sp + 1 < 16) fetch(sp + 1);
    f32x4 accO = (f32x4){0.f, 0.f, 0.f, 0.f};
    if (PASS == 2) {
      bf16x8 aq0 = *(const bf16x8*)(Qt + (lane & 15) * RS + (lane >> 4) * 8);
      bf16x8 aq1 = *(const bf16x8*)(Qt + (lane & 15) * RS + 32 + (lane >> 4) * 8);
      if (w4 == 0) {
        f32x4 accA = (f32x4){0.f, 0.f, 0.f, 0.f};
        bf16x8 bk0 = *(const bf16x8*)(Kt + (lane & 15) * RS + (lane >> 4) * 8);
        bf16x8 bk1 = *(const bf16x8*)(Kt + (lane & 15) * RS + 32 + (lane >> 4) * 8);
        accA = __builtin_amdgcn_mfma_f32_16x16x32_bf16(aq0, bk0, accA, 0, 0, 0);
        accA = __builtin_amdgcn_mfma_f32_16x16x32_bf16(aq1, bk1, accA, 0, 0, 0);
#pragma unroll
        for (int r = 0; r < 4; r++) {
          const int tau = (lane >> 4) * 4 + r, sg = lane & 15;
          Am[tau * HS + sg] = sg <= tau ? f2bf(accA[r]) : (u16)0;
        }
      }
      __syncthreads();
      {
        bf16x8 aa = *(const bf16x8*)(Am + (lane & 15) * HS + (lane >> 4) * 8);
        bf16x8 bv = *(const bf16x8*)(VtT + (w4 * 16 + (lane & 15)) * HS + (lane >> 4) * 8);
        accO = __builtin_amdgcn_mfma_f32_16x16x32_bf16(aa, bv, accO, 0, 0, 0);
        bf16x8 bs0 = *(const bf16x8*)(St + (w4 * 16 + (lane & 15)) * RS + (lane >> 4) * 8);
        bf16x8 bs1 = *(const bf16x8*)(St + (w4 * 16 + (lane & 15)) * RS + 32 + (lane >> 4) * 8);
        accO = __builtin_amdgcn_mfma_f32_16x16x32_bf16(aq0, bs0, accO, 0, 0, 0);
        accO = __builtin_amdgcn_mfma_f32_16x16x32_bf16(aq1, bs1, accO, 0, 0, 0);
      }
    }
    {
      bf16x8 ak = *(const bf16x8*)(KtT + (w4 * 16 + (lane & 15)) * HS + (lane >> 4) * 8);
#pragma unroll
      for (int nt = 0; nt < 4; nt++) {
        bf16x8 bv = *(const bf16x8*)(VtT + (nt * 16 + (lane & 15)) * HS + (lane >> 4) * 8);
        accS[nt] = __builtin_amdgcn_mfma_f32_16x16x32_bf16(ak, bv, accS[nt], 0, 0, 0);
      }
      const float4 e4 = *(const float4*)(eb + w4 * 16 + (lane >> 4) * 4);
#pragma unroll
      for (int nt = 0; nt < 4; nt++) { accS[nt][0] *= e4.x; accS[nt][1] *= e4.y; accS[nt][2] *= e4.z; accS[nt][3] *= e4.w; }
    }
    if (PASS == 2) {
      const int cv = h * 64 + w4 * 16 + (lane & 15);
      float o[4];
#pragma unroll
      for (int r = 0; r < 4; r++) {
        const int tau = (lane >> 4) * 4 + r;
        const size_t row = (size_t)(rbase + (d == 0 ? tau : 15 - tau));
        o[r] = accO[r];
        if (d == 1) o[r] += bf2f(proj[row * PC + C_HGF + cv]);
        else proj[row * PC + C_HGF + cv] = f2bf(o[r]);
      }
      if (d == 1) {
#pragma unroll
        for (int r = 0; r < 4; r++) {
          float s2 = allsum16(o[r] * o[r]);
          if ((lane & 15) == 0) ssb[w4 * 16 + (lane >> 4) * 4 + r] = s2;
        }
      }
      __syncthreads();
      if (d == 1) {
#pragma unroll
        for (int r = 0; r < 4; r++) {
          const int tau = (lane >> 4) * 4 + r;
          const size_t row = (size_t)(rbase + 15 - tau);
          const float ss = ssb[tau] + ssb[16 + tau] + ssb[32 + tau] + ssb[48 + tau];
          const float z = bf2f(proj[row * PC + C_HGZ + cv]);
          proj[row * PC + C_HGQ + cv] = f2bf(o[r] * rsqrtf(ss * (1.f / 64.f) + 1e-6f) * normw * siluf_(z));
        }
      }
      if (sp + 1 < 16) {
#pragma unroll
        for (int nt = 0; nt < 4; nt++)
          *(uint2*)(St + (nt * 16 + (lane & 15)) * RS + w4 * 16 + (lane >> 4) * 4) =
              make_uint2(pack2(accS[nt][0], accS[nt][1]), pack2(accS[nt][2], accS[nt][3]));
      }
    }
  }
  if (PASS == 1) {
#pragma unroll
    for (int nt = 0; nt < 4; nt++)
#pragma unroll
      for (int r = 0; r < 4; r++) stt[(w4 * 16 + (lane >> 4) * 4 + r) * 64 + nt * 16 + (lane & 15)] = accS[nt][r];
    if (qd == 0) ((float*)(p.ws + OFF_HGP))[((size_t)dbh * 9 + cstep) * 64 + kc] = __expf(bsum);
  }
}
__device__ void gla_p1_task(const Params& p, int layer, int task, float* lds) {
  int c = task % 9; int q = task / 9; int h = q & 3; q >>= 2; int b = q & 7; q >>= 3; int d = q & 1; int mx = q >> 1;
  if (mx == 0) { const int nc = d == 0 ? c : (c == 0 ? 0 : 9 - c); hg_sweep<1>(p, layer, d, b, h, nc, c, (u16*)lds); }
  else { const int nc = d == 0 ? c : (c == 0 ? 0 : 9 - c); ret_sweep<1>(p, layer, d, b, h, nc, c, (u16*)lds); }
}
__device__ void gla_p2_task(const Params& p, int layer, int mx, int b, int h, int nc, float* lds) {
  int cb = nc == 0 ? 0 : 9 - nc;
  if (mx == 0) { hg_sweep<2>(p, layer, 0, b, h, nc, nc, (u16*)lds); __threadfence_block(); hg_sweep<2>(p, layer, 1, b, h, nc, cb, (u16*)lds); }
  else { ret_sweep<2>(p, layer, 0, b, h, nc, nc, (u16*)lds); __threadfence_block(); ret_sweep<2>(p, layer, 1, b, h, nc, cb, (u16*)lds); }
}
__device__ void gla_carry_task(const Params& p, int layer, int task) {
  int e = task * 256 + tid_();
  int v = e & 63, k = (e >> 6) & 63, dbh = (e >> 12) & 63, mx = e >> 18;
  float* stt = (float*)(p.ws + (mx == 0 ? OFF_HGST : OFF_RTST)) + (size_t)dbh * 9 * 4096 + k * 64 + v;
  const float* P = (const float*)(p.ws + OFF_HGP) + (size_t)dbh * 9 * 64 + k;
  float pg = 1.f;
  if (mx == 1) { int d = dbh >> 5, h = dbh & 3; pg = __expf(-256.f * __expf(p.in[20][((size_t)layer * 2 + d) * 4 + h])); }
  float S = 0.f;
  for (int c = 0; c < 9; c++) {
    float E = stt[(size_t)c * 4096];
    stt[(size_t)c * 4096] = S;
    float pp = mx == 0 ? P[c * 64] : pg;
    S = pp * S + E;
  }
}

__device__ __forceinline__ int s5_bwd_chunk(int nc) { return nc < 4 ? 3 - nc : 39 - nc; }
template <int PASS>
__device__ void s5_task(const Params& p, int layer, int task, float* lds) {
  const int t = tid_(), w = t >> 6, lane = t & 63;
  int gq = task & 3; int q = task >> 2; int nc = q % 36; int b = q / 36;
  const int g = gq * 4 + w;
  float* ubuf = lds + w * 256;
  u16* hbuf = (u16*)(lds + 1024) + w * (16 * 136);
  float* ybuf = lds + 1024 + 4352 + w * 1024;
  u16* proj = (u16*)(p.ws + OFF_PROJ);
  float2* st5 = (float2*)(p.ws + OFF_S5ST);
  bf16x8 cfrag[4];
  if (PASS == 2) {
    const float* cre = p.in[13] + ((size_t)layer * 16 + g) * 16 * 64;
    const float* cim = p.in[14] + ((size_t)layer * 16 + g) * 16 * 64;
    int pp = lane & 15;
#pragma unroll
    for (int ks = 0; ks < 4; ks++)
#pragma unroll
      for (int i = 0; i < 8; i++) {
        int kidx = ks * 32 + (lane >> 4) * 8 + i; int n = kidx >> 1;
        float val = (kidx & 1) ? -cim[pp * 64 + n] : cre[pp * 64 + n];
        cfrag[ks][i] = (short)f2bf(val);
      }
  }
  for (int d = 0; d < 2; d++) {
    float lre = p.in[8][(((size_t)layer * 2 + d) * 16 + g) * 64 + lane];
    float lim = p.in[9][(((size_t)layer * 2 + d) * 16 + g) * 64 + lane];
    float dt = __expf(p.in[10][((size_t)layer * 2 + d) * 16 + g]);
    float mag = __expf(lre * dt);
    float sn, cs; sincosf(lim * dt, &sn, &cs);
    float are = mag * cs, aim = mag * sn;
    float den = 1.f / (lre * lre + lim * lim);
    float cre_ = ((are - 1.f) * lre + aim * lim) * den;
    float cim_ = (aim * lre - (are - 1.f) * lim) * den;
    float bbr[16], bbi[16];
    {
      const float* br = p.in[11] + (((size_t)layer * 16 + g) * 64 + lane) * 16;
      const float* bi = p.in[12] + (((size_t)layer * 16 + g) * 64 + lane) * 16;
#pragma unroll
      for (int i = 0; i < 16; i++) {
        float x = br[i], y = bi[i];
        bbr[i] = cre_ * x - cim_ * y; bbi[i] = cre_ * y + cim_ * x;
      }
    }
    int cstep = d == 0 ? nc : s5_bwd_chunk(nc);
    size_t sidx = ((((size_t)d * 8 + b) * 16 + g) * 36 + cstep) * 64 + lane;
    float hre = 0.f, him = 0.f;
    if (PASS == 2) { float2 h0 = st5[sidx]; hre = h0.x; him = h0.y; }
    uint2 ru;
    auto fetchu = [&](int sub) {
      int st = lane >> 2, p4 = (lane & 3) * 4;
      int jl = d == 0 ? sub * 16 + st : 63 - (sub * 16 + st);
      ru = *(const uint2*)(proj + (size_t)(b * TT + nc * 64 + jl) * PC + C_S5U + g * 16 + p4);
    };
    fetchu(0);
    for (int sub = 0; sub < 4; sub++) {
      __syncthreads();
      {
        int st = lane >> 2, p4 = (lane & 3) * 4;
        *(float4*)(ubuf + st * 16 + p4) = make_float4(__uint_as_float(ru.x << 16), __uint_as_float(ru.x & 0xffff0000u),
                                                       __uint_as_float(ru.y << 16), __uint_as_float(ru.y & 0xffff0000u));
      }
      __syncthreads();
      if (sub + 1 < 4) fetchu(sub + 1);
#pragma unroll 2
      for (int st = 0; st < 16; st++) {
        float bur = 0.f, bui = 0.f;
#pragma unroll
        for (int i4 = 0; i4 < 4; i4++) {
          float4 uu = *(const float4*)(ubuf + st * 16 + i4 * 4);
          bur += bbr[i4*4] * uu.x + bbr[i4*4+1] * uu.y + bbr[i4*4+2] * uu.z + bbr[i4*4+3] * uu.w;
          bui += bbi[i4*4] * uu.x + bbi[i4*4+1] * uu.y + bbi[i4*4+2] * uu.z + bbi[i4*4+3] * uu.w;
        }
        float nre = are * hre - aim * him + bur;
        float nim = are * him + aim * hre + bui;
        hre = nre; him = nim;
        if (PASS == 2) *(unsigned*)(hbuf + st * 136 + lane * 2) = pack2(hre, him);
      }
      if (PASS == 2) {
        __syncthreads();
        f32x4 acc = (f32x4){0.f, 0.f, 0.f, 0.f};
#pragma unroll
        for (int ks = 0; ks < 4; ks++) {
          bf16x8 af = *(const bf16x8*)(hbuf + (lane & 15) * 136 + ks * 32 + (lane >> 4) * 8);
          acc = __builtin_amdgcn_mfma_f32_16x16x32_bf16(af, cfrag[ks], acc, 0, 0, 0);
        }
#pragma unroll
        for (int r = 0; r < 4; r++) {
          int st = (lane >> 4) * 4 + r;
          int jl = d == 0 ? sub * 16 + st : 63 - (sub * 16 + st);
          float* yp = ybuf + jl * 16 + (lane & 15);
          if (d == 0) *yp = acc[r]; else *yp += acc[r];
        }
      }
    }
    if (PASS == 1) st5[sidx] = make_float2(hre, him);
  }
  if (PASS == 2) {
    __syncthreads();
    const float* dsk = p.in[15] + layer * 256 + g * 16;
#pragma unroll
    for (int i = 0; i < 16; i++) {
      int idx = lane + 64 * i; int jl = idx >> 4, pp = idx & 15;
      u16* up = proj + (size_t)(b * TT + nc * 64 + jl) * PC + C_S5U + g * 16 + pp;
      float y = ybuf[jl * 16 + pp] + dsk[pp] * bf2f(*up);
      *up = f2bf(geluf_(y));
    }
  }
}
__device__ void s5_carry_task(const Params& p, int layer, int task) {
  int e = task * 256 + tid_();
  int n = e & 63, g = (e >> 6) & 15, d = e >> 13;
  float lre = p.in[8][(((size_t)layer * 2 + d) * 16 + g) * 64 + n];
  float lim = p.in[9][(((size_t)layer * 2 + d) * 16 + g) * 64 + n];
  float dt = __expf(p.in[10][((size_t)layer * 2 + d) * 16 + g]);
  float mag = __expf(lre * dt * 64.f);
  float sn, cs; sincosf(lim * dt * 64.f, &sn, &cs);
  float are = mag * cs, aim = mag * sn;
  float2* st5 = (float2*)(p.ws + OFF_S5ST) + (size_t)(e >> 6) * 36 * 64 + n;
  float sre = 0.f, sim = 0.f;
  for (int c = 0; c < 36; c++) {
    float2 E = st5[(size_t)c * 64];
    st5[(size_t)c * 64] = make_float2(sre, sim);
    float nre = are * sre - aim * sim + E.x;
    float nim = are * sim + aim * sre + E.y;
    sre = nre; sim = nim;
  }
}

__device__ __forceinline__ void group_barrier(unsigned* cnt, unsigned target) {
  asm volatile("s_waitcnt vmcnt(0)" ::: "memory");
  __syncthreads();
  if (tid_() == 0) {
    __threadfence();
    asm volatile("s_waitcnt vmcnt(0)" ::: "memory");
    __hip_atomic_fetch_add(cnt, 1u, __ATOMIC_RELAXED, __HIP_MEMORY_SCOPE_AGENT);
    while (__hip_atomic_load(cnt, __ATOMIC_RELAXED, __HIP_MEMORY_SCOPE_AGENT) < target) __builtin_amdgcn_s_sleep(2);
    __threadfence();
    asm volatile("s_waitcnt vmcnt(0)" ::: "memory");
  }
  __syncthreads();
}
#define XB_XCNT(j) (64 * (j))
#define XB_XSUB(j) (1024 + 64 * (j))
#define XB_XGEN(j) (2048 + 64 * (j))
#define XB_TOP     3072
#define XB_TOPGEN  3136
#define XB_WORDS   8192
struct XcdBar { unsigned* bar; unsigned x, nloc, nx; };
__device__ __forceinline__ unsigned xb_ld(unsigned* q) { return __hip_atomic_load(q, __ATOMIC_RELAXED, __HIP_MEMORY_SCOPE_AGENT); }
__device__ __forceinline__ unsigned xb_add(unsigned* q, unsigned v) { return __hip_atomic_fetch_add(q, v, __ATOMIC_RELAXED, __HIP_MEMORY_SCOPE_AGENT); }
__device__ __forceinline__ void xcd_barrier(const XcdBar& b) {
  asm volatile("s_waitcnt vmcnt(0)" ::: "memory");
  __syncthreads();
  if (tid_() == 0) {
    unsigned* bar = b.bar;
    __builtin_amdgcn_s_waitcnt(0);
    const unsigned old = xb_add(&bar[XB_XSUB(b.x)], 1u);
    const unsigned gen = old / b.nloc;
    if (old + 1u == (gen + 1u) * b.nloc) {
      __builtin_amdgcn_fence(__ATOMIC_RELEASE, "agent");
      asm volatile("s_waitcnt vmcnt(0)" ::: "memory");
      const unsigned og = xb_add(&bar[XB_TOP], 1u);
      const unsigned tg = og / b.nx;
      if (og + 1u == (tg + 1u) * b.nx) xb_add(&bar[XB_TOPGEN], 1u);
      else while (xb_ld(&bar[XB_TOPGEN]) == tg) __builtin_amdgcn_s_sleep(1);
      __builtin_amdgcn_fence(__ATOMIC_ACQUIRE, "agent");
      xb_add(&bar[XB_XGEN(b.x)], 1u);
      asm volatile("s_waitcnt vmcnt(0)" ::: "memory");
    } else {
      while (xb_ld(&bar[XB_XGEN(b.x)]) == gen) __builtin_amdgcn_s_sleep(1);
      __builtin_amdgcn_fence(__ATOMIC_ACQUIRE, "agent");
      asm volatile("s_waitcnt vmcnt(0)" ::: "memory");
    }
  }
  __syncthreads();
}
#define LDS_FLOATS 18432
#define SYNC() xcd_barrier(xbar)
#define RW_TWO false
#define NRW (RW_TWO ? 128 : 256)

__global__ void __launch_bounds__(256, 2) fwd_megakernel(Params p) {
  cg::grid_group grid = cg::this_grid();
  __shared__ __attribute__((aligned(16))) float lds[LDS_FLOATS];
  const int bid = blockIdx.x, nb = gridDim.x, t = tid_();
  XcdBar xbar; xbar.bar = (unsigned*)(p.ws + OFF_XB); xbar.x = 0; xbar.nloc = 1; xbar.nx = 1;

  if (p.ws == nullptr) grid.sync();
  {
    unsigned xr; asm volatile("s_getreg_b32 %0, hwreg(HW_REG_XCC_ID)" : "=s"(xr));
    xbar.x = xr & 15u;
    if (t == 0) xb_add(&xbar.bar[XB_XCNT(xbar.x)], 1u + ((nb == 512 && bid >= NRW) ? 65536u : 0u));
  }
  for (int task = bid; task < N_CONVERT_TASKS + 192 + 1; task += nb) {
    if (task < 192) mods_task(p, task, lds);
    else if (task == 192) {
      float* rope = (float*)(p.ws + OFF_ROPE);
      for (int i = t; i < 1024; i += 256) {
        int pos = i >> 4, fi = i & 15;
        float fr = powf(10000.f, -(float)fi / 16.f);
        float ang = (float)pos * fr;
        rope[i * 2] = cosf(ang); rope[i * 2 + 1] = sinf(ang);
      }
    } else convert_task(p, 0, task - 193, lds);
  }
  XcdBar pbar; pbar.bar = xbar.bar + 4096; pbar.x = xbar.x; pbar.nloc = 1; pbar.nx = 1;
  if (t == 0) {
    unsigned nx, npx, nlocp;
    for (;;) {
      unsigned sum = 0; nx = 0; npx = 0; nlocp = 0;
#pragma unroll
      for (int j = 0; j < 16; j++) {
        const unsigned w = xb_ld(&xbar.bar[XB_XCNT(j)]);
        const unsigned c = w & 65535u, cp = w >> 16;
        sum += c; nx += c > 0u ? 1u : 0u; npx += cp > 0u ? 1u : 0u;
        if ((unsigned)j == xbar.x) { xbar.nloc = c; nlocp = cp; }
      }
      if (sum == (unsigned)nb) break;
      __builtin_amdgcn_s_sleep(4);
    }
    xbar.nx = nx; pbar.nx = npx > 0u ? npx : 1u; pbar.nloc = nlocp > 0u ? nlocp : 1u;
  }
  SYNC();
  for (int task = bid; task < MROWS / 4; task += nb) ln_row(p, 0, 0, task * 4 + (t >> 6));
  SYNC();

  for (int layer = 0; layer < 2; layer++) {
    const int latonly = layer;
    if ((nb & 7) == 0) { int tm, tn; for (int it = 0; xcd_tile(it, bid, nb, 144, 31, 6, tm, tn); it++) inproj_tile(p, layer, tm, tn, (u16*)lds); }
    else for (int task = bid; task < 144 * 31; task += nb) inproj_tile(p, layer, task / 31, task % 31, (u16*)lds);
    SYNC();
    {
      const int ncg = latonly ? 8 : 9, ncs = latonly ? 32 : 36;
      const int NG = 64 * ncg, NS = 32 * ncs;
      auto p2_task = [&](int task) {
        if (task < NG) {
          int nc = task % ncg + (latonly ? 1 : 0); int q = task / ncg; int h = q & 3; q >>= 2; int b = q & 7; int mx = q >> 3;
          gla_p2_task(p, layer, mx, b, h, nc, lds);
        } else {
          int q = task - NG; int gq = q & 3; q >>= 2; int nc = q % ncs + (latonly ? 4 : 0); int b = q / ncs;
          s5_task<2>(p, layer, ((b * 36 + nc) << 2) | gq, lds);
        }
      };
      if (nb == 512) {
        unsigned* bar = (unsigned*)(p.ws + OFF_BAR);
        const int ng = nb - NRW;
        if (bid < NRW) {
          rwkv_scan_task<RW_TWO>(p, layer, bid, lds);
          if (t == 0) {
            while (xb_ld(&pbar.bar[XB_TOPGEN]) < 2u * layer + 2u) __builtin_amdgcn_s_sleep(8);
            __threadfence();
          }
          __syncthreads();
        } else {
          const int gb = bid - NRW;
          for (int task = gb; task < 2304; task += ng) {
            if (task < 1152) gla_p1_task(p, layer, task, lds); else s5_task<1>(p, layer, task - 1152, lds);
          }
          xcd_barrier(pbar);
          for (int task = gb; task < 2048 + 64; task += ng) {
            if (task < 2048) gla_carry_task(p, layer, task); else s5_carry_task(p, layer, task - 2048);
          }
          xcd_barrier(pbar);
        }
        int* shq = (int*)(lds + LDS_FLOATS - 4);
        for (;;) {
          __syncthreads();
          if (t == 0) *shq = (int)__hip_atomic_fetch_add(bar + 1 + layer, 1u, __ATOMIC_RELAXED, __HIP_MEMORY_SCOPE_AGENT);
          __syncthreads();
          const int task = *shq;
          if (task >= NG + NS) break;
          p2_task(task);
        }
        SYNC();
      } else {
        for (int task = bid; task < NRW + 2304; task += nb) {
          if (task < NRW) rwkv_scan_task<RW_TWO>(p, layer, task, lds);
          else if (task < NRW + 1152) gla_p1_task(p, layer, task - NRW, lds);
          else s5_task<1>(p, layer, task - NRW - 1152, lds);
        }
        SYNC();
        for (int task = bid; task < 2048 + 64; task += nb) {
          if (task < 2048) gla_carry_task(p, layer, task); else s5_carry_task(p, layer, task - 2048);
        }
        SYNC();
        for (int task = bid; task < NG + NS; task += nb) p2_task(task);
        SYNC();
      }
    }
    {
      const int ntm = latonly ? 128 : 144;
      for (int task = bid; task < ntm * 2 + MROWS / 8; task += nb) {
        if (task < ntm * 2) glu_tile(p, layer, latonly, task >> 1, task & 1, (u16*)lds);
        else rwkv_combine_rows(p, layer, (task - ntm * 2) * 8, latonly);
      }
    }
    SYNC();
    {
      const int ntm = latonly ? 128 : 144;
      if ((nb & 7) == 0) { int tm, tn; for (int it = 0; xcd_tile(it, bid, nb, ntm, 16, 8, tm, tn); it++) merge_tile(p, layer, latonly, tm, tn, (u16*)lds); }
      else for (int task = bid; task < ntm * 16; task += nb) merge_tile(p, layer, latonly, task >> 4, task & 15, (u16*)lds);
    }
    SYNC();
    {
      const int ntm = latonly ? 128 : 144;
      if ((nb & 7) == 0) { int tm, tn; for (int it = 0; xcd_tile(it, bid, nb, ntm, 8, 8, tm, tn); it++) outproj_tile(p, layer, latonly, tm, tn, (u16*)lds); }
      else for (int task = bid; task < ntm * 8; task += nb) outproj_tile(p, layer, latonly, task >> 3, task & 7, (u16*)lds);
    }
    SYNC();
    if (layer == 0) {
      for (int task = bid; task < MROWS / 4 + N_CONVERT_TASKS; task += nb) {
        if (task < N_CONVERT_TASKS) convert_task(p, 1, task, lds);
        else ln_row(p, 1, 0, (task - N_CONVERT_TASKS) * 4 + (t >> 6));
      }
      SYNC();
    } else {
      for (int task = bid; task < NBATCH * 2048 / 4; task += nb) {
        int r = task * 4 + (t >> 6); int b = r >> 11, tl = r & 2047;
        ln_row(p, 1, 1, b * TT + 256 + tl);
      }
    }
  }
}

extern "C" void kernel_launch(void* const* d_in, const int* in_sizes, int n_in,
                              void* d_out, int out_size, void* d_ws, size_t ws_size,
                              hipStream_t stream) {
  static int grid_blocks = 0;
  if (!grid_blocks) {
    int dev = 0, cus = 0, per_cu = 0;
    (void)hipGetDevice(&dev);
    (void)hipDeviceGetAttribute(&cus, hipDeviceAttributeMultiprocessorCount, dev);
    (void)hipOccupancyMaxActiveBlocksPerMultiprocessor(&per_cu, fwd_megakernel, 256, 0);
    if (per_cu > 2) per_cu = 2;
    if (per_cu < 1) per_cu = 1;
    grid_blocks = cus * per_cu;
  }
  if (ws_size < WS_NEED) { fprintf(stderr, "workspace too small\n"); return; }
  Params p{};
  for (int i = 0; i < 36; i++) p.in[i] = (const float*)d_in[i];
  p.out = (float*)d_out;
  p.ws = (char*)d_ws;
  (void)hipMemsetAsync((char*)d_ws + OFF_BAR, 0, 256 + 32768, stream);
  void* args[] = {&p};
  hipError_t e = hipLaunchCooperativeKernel((void*)fwd_megakernel, dim3(grid_blocks), dim3(256), args, 0, stream);
  if (e != hipSuccess) fprintf(stderr, "cooperative launch failed: %s (grid %d)\n", hipGetErrorString(e), grid_blocks);
}
```

```cpp
#include <hip/hip_runtime.h>
#include <hip/hip_bf16.h>
#include <hip/hip_cooperative_groups.h>
#include <cstdio>
namespace cg = cooperative_groups;

typedef __attribute__((ext_vector_type(8))) short bf16x8;
typedef __attribute__((ext_vector_type(4))) float f32x4;
typedef unsigned short u16;

#define D_ 1024
#define NBATCH 8
#define TT 2304
#define MROWS 18432
#define PC 3904
#define DIN 8000
#define C_S5U 0
#define C_S5Z 256
#define C_HGQ 512
#define C_HGF 768
#define C_HGI 1280
#define C_HGZ 1536
#define C_RTQ 1792
#define C_RTK 2048
#define C_RTV 2304
#define C_RTZ 2560
#define C_RWX 2816
#define C_RWZ 3648

#define OFF_WINT   0ul
#define OFF_WBT    (OFF_WINT + 16384000ul)
#define OFF_WOT    (OFF_WBT + 2097152ul)
#define OFF_GLUT   (OFF_WOT + 2097152ul)
#define OFF_U      (OFF_GLUT + 131072ul)
#define OFF_PROJ   (OFF_U + 37748736ul)
#define OFF_HCTX   (OFF_PROJ + 143917056ul)
#define OFF_SCR    (OFF_HCTX + 8388608ul)
#define OFF_RWO    (OFF_SCR)
#define OFF_HGST   (OFF_SCR + 18874368ul)
#define OFF_RTST   (OFF_HGST + 9437184ul)
#define OFF_RETOF  (OFF_SCR + 37748736ul)
#define OFF_S5ST   (OFF_RETOF + 9437184ul)
#define OFF_MODS   (OFF_S5ST + 4718592ul)
#define OFF_HGP    (OFF_MODS + 221184ul)
#define OFF_BONUS  (OFF_HGP + 147456ul)
#define OFF_ROPE   (OFF_BONUS + 589824ul)
#define OFF_BAR    (OFF_ROPE + 8192ul)
#define OFF_XB     (OFF_BAR + 256ul)
#define WS_NEED    (OFF_XB + 32768ul)

struct Params {
  const float* in[36];
  float* out;
  char* ws;
};

__device__ __forceinline__ int tid_() { int t = __builtin_amdgcn_workitem_id_x(); asm volatile("" : "+v"(t)); return t; }
__device__ __forceinline__ u16 f2bf(float f) {
  unsigned u = __float_as_uint(f);
  u += 0x7fffu + ((u >> 16) & 1u);
  return (u16)(u >> 16);
}
__device__ __forceinline__ float bf2f(u16 h) { return __uint_as_float(((unsigned)h) << 16); }
__device__ __forceinline__ unsigned pack2(float a, float b) { return (unsigned)f2bf(a) | ((unsigned)f2bf(b) << 16); }
__device__ __forceinline__ float sigmoidf_(float x) { return __builtin_amdgcn_rcpf(1.f + __expf(-x)); }
__device__ __forceinline__ float siluf_(float x) { return x * __builtin_amdgcn_rcpf(1.f + __expf(-x)); }
__device__ __forceinline__ float geluf_(float x) {
  float t = tanhf(0.7978845608028654f * (x + 0.044715f * x * x * x));
  return 0.5f * x * (1.f + t);
}
template <int CTRL>
__device__ __forceinline__ float dppf(float x) {
  return __int_as_float(__builtin_amdgcn_update_dpp(0, __float_as_int(x), CTRL, 0xf, 0xf, true));
}
__device__ __forceinline__ float allsum16(float x) {
  x += dppf<0x128>(x);
  x += dppf<0x124>(x);
  x += dppf<0x122>(x);
  x += dppf<0x121>(x);
  return x;
}
__device__ __forceinline__ float wavesum(float x) {
  x = allsum16(x);
  x += __shfl_xor(x, 16, 64);
  x += __shfl_xor(x, 32, 64);
  return x;
}
__device__ __forceinline__ void ld4bf(const u16* p, float (&o)[4]) {
  uint2 v = *(const uint2*)p;
  o[0] = __uint_as_float(v.x << 16); o[1] = __uint_as_float(v.x & 0xffff0000u);
  o[2] = __uint_as_float(v.y << 16); o[3] = __uint_as_float(v.y & 0xffff0000u);
}
__device__ __forceinline__ void st4bf(u16* p, float a, float b, float c, float d) {
  uint2 v; v.x = pack2(a, b); v.y = pack2(c, d);
  *(uint2*)p = v;
}
__device__ __forceinline__ int jmap(int d, int s) { return d == 0 ? s : (s < 256 ? 255 - s : 2559 - s); }
__device__ __forceinline__ bool has_prev(int j) { return j != 0 && j != 256; }
__device__ __forceinline__ bool has_next(int j) { return j != 255 && j != 2303; }

__device__ __forceinline__ const float* hin_ptr(const Params& p, int layer, int row) {
  int b = row / TT, j = row - b * TT;
  if (layer == 0) return j < 256 ? p.in[2] + ((size_t)(b * 256 + j)) * D_ : p.in[0] + ((size_t)(b * 2048 + j - 256)) * D_;
  return j < 256 ? (const float*)(p.ws + OFF_HCTX) + ((size_t)(b * 256 + j)) * D_ : p.out + ((size_t)(b * 2048 + j - 256)) * D_;
}
__device__ __forceinline__ float* hout_ptr(const Params& p, int row) {
  int b = row / TT, j = row - b * TT;
  return j < 256 ? (float*)(p.ws + OFF_HCTX) + ((size_t)(b * 256 + j)) * D_ : p.out + ((size_t)(b * 2048 + j - 256)) * D_;
}
__device__ __forceinline__ int modrow_of(int row) { int b = row / TT, j = row - b * TT; return j < 256 ? 8 : b; }

__device__ void transpose_tile(const float* __restrict__ src, u16* __restrict__ dst, int K, int N, int k0, int n0, float* lds) {
  const int t = tid_();
  __syncthreads();
#pragma unroll
  for (int i = 0; i < 16; i++) {
    int r = i * 4 + (t >> 6), c = t & 63;
    lds[r * 65 + c] = src[(size_t)(k0 + r) * N + n0 + c];
  }
  __syncthreads();
#pragma unroll
  for (int i = 0; i < 16; i++) {
    int r = i * 4 + (t >> 6), c = t & 63;
    dst[(size_t)(n0 + r) * K + k0 + c] = f2bf(lds[c * 65 + r]);
  }
}
__device__ void convert_task(const Params& p, int layer, int task, float* lds) {
  if (task < 2000) {
    int kt = task / 125, nt = task % 125;
    transpose_tile(p.in[6] + (size_t)layer * 1024 * DIN, (u16*)(p.ws + OFF_WINT), 1024, DIN, kt * 64, nt * 64, lds);
  } else if (task < 2256) {
    int q = task - 2000; int br = q >> 6; q &= 63; int kt = q >> 4, nt = q & 15;
    transpose_tile(p.in[31] + ((size_t)layer * 4 + br) * 256 * 1024, (u16*)(p.ws + OFF_WBT) + (size_t)br * 1024 * 256, 256, 1024, kt * 64, nt * 64, lds);
  } else if (task < 2512) {
    int q = task - 2256; int kt = q >> 4, nt = q & 15;
    transpose_tile(p.in[32] + (size_t)layer * 1024 * 1024, (u16*)(p.ws + OFF_WOT), 1024, 1024, kt * 64, nt * 64, lds);
  } else {
    int q = task - 2512; int kt = q >> 2, nt = q & 3;
    transpose_tile(p.in[16] + (size_t)layer * 256 * 256, (u16*)(p.ws + OFF_GLUT), 256, 256, kt * 64, nt * 64, lds);
  }
}
#define N_CONVERT_TASKS 2528

__device__ void mods_task(const Params& p, int task, float* lds) {
  const int t = tid_();
  int layer = task / 96, cgp = task % 96;
  float* sc = lds;
  float* red = lds + 9 * 1024;
  __syncthreads();
  for (int i = t; i < 9 * 1024; i += 256) {
    int r = i >> 10, k = i & 1023;
    float v = r < 8 ? p.in[1][r * 1024 + k] : p.in[3][k];
    sc[i] = siluf_(v);
  }
  __syncthreads();
  const int cl = t & 31, kq = t >> 5;
  int col = cgp * 32 + cl;
  float acc[9];
#pragma unroll
  for (int r = 0; r < 9; r++) acc[r] = 0.f;
  const float* wp = p.in[4] + (size_t)layer * 1024 * 3072 + col;
#pragma unroll 16
  for (int k = kq * 128; k < kq * 128 + 128; k++) {
    float w = wp[(size_t)k * 3072];
#pragma unroll
    for (int r = 0; r < 9; r++) acc[r] += sc[r * 1024 + k] * w;
  }
#pragma unroll
  for (int r = 0; r < 9; r++) red[(kq * 9 + r) * 32 + cl] = acc[r];
  __syncthreads();
  float* mods = (float*)(p.ws + OFF_MODS);
  for (int i = t; i < 9 * 32; i += 256) {
    int r = i >> 5, c = i & 31;
    float s_ = 0.f;
#pragma unroll
    for (int g = 0; g < 8; g++) s_ += red[(g * 9 + r) * 32 + c];
    int cc = cgp * 32 + c;
    mods[((size_t)layer * 9 + r) * 3072 + cc] = s_ + p.in[5][layer * 3072 + cc];
  }
}

__device__ void ln_row(const Params& p, int mode, int layer, int row) {
  const int lane = tid_() & 63;
  float v[16];
  if (mode == 0) {
    const float* src = hin_ptr(p, 0, row);
#pragma unroll
    for (int i = 0; i < 4; i++) { float4 q = *(const float4*)(src + i * 256 + lane * 4); v[i*4]=q.x; v[i*4+1]=q.y; v[i*4+2]=q.z; v[i*4+3]=q.w; }
  } else {
    float* src = hout_ptr(p, row);
#pragma unroll
    for (int i = 0; i < 4; i++) { float4 q = *(const float4*)(src + i * 256 + lane * 4); v[i*4]=q.x; v[i*4+1]=q.y; v[i*4+2]=q.z; v[i*4+3]=q.w; }
    float s = 0.f;
#pragma unroll
    for (int i = 0; i < 16; i++) s += v[i];
    float mean = wavesum(s) * (1.f / 1024.f);
    float q2 = 0.f;
#pragma unroll
    for (int i = 0; i < 16; i++) { v[i] -= mean; q2 += v[i] * v[i]; }
    float rstd = rsqrtf(wavesum(q2) * (1.f / 1024.f) + 1e-5f);
    const float* lw = p.in[34] + layer * 1024; const float* lb = p.in[35] + layer * 1024;
#pragma unroll
    for (int i = 0; i < 4; i++) {
      float4 w4 = *(const float4*)(lw + i * 256 + lane * 4), b4 = *(const float4*)(lb + i * 256 + lane * 4);
      v[i*4] = v[i*4] * rstd * w4.x + b4.x; v[i*4+1] = v[i*4+1] * rstd * w4.y + b4.y;
      v[i*4+2] = v[i*4+2] * rstd * w4.z + b4.z; v[i*4+3] = v[i*4+3] * rstd * w4.w + b4.w;
      *(float4*)(src + i * 256 + lane * 4) = make_float4(v[i*4], v[i*4+1], v[i*4+2], v[i*4+3]);
    }
    if (layer == 1) return;
  }
  int ml = mode == 0 ? 0 : 1;
  float s = 0.f;
#pragma unroll
  for (int i = 0; i < 16; i++) s += v[i];
  float mean = wavesum(s) * (1.f / 1024.f);
  float q2 = 0.f;
#pragma unroll
  for (int i = 0; i < 16; i++) { v[i] -= mean; q2 += v[i] * v[i]; }
  float rstd = rsqrtf(wavesum(q2) * (1.f / 1024.f) + 1e-5f);
  const float* md = (const float*)(p.ws + OFF_MODS) + ((size_t)ml * 9 + modrow_of(row)) * 3072;
  u16* up = (u16*)(p.ws + OFF_U) + (size_t)row * 1024;
#pragma unroll
  for (int i = 0; i < 4; i++) {
    float4 sh = *(const float4*)(md + i * 256 + lane * 4), sc = *(const float4*)(md + 1024 + i * 256 + lane * 4);
    st4bf(up + i * 256 + lane * 4, v[i*4] * rstd * (1.f + sc.x) + sh.x, v[i*4+1] * rstd * (1.f + sc.y) + sh.y,
          v[i*4+2] * rstd * (1.f + sc.z) + sh.z, v[i*4+3] * rstd * (1.f + sc.w) + sh.w);
  }
}

#define STAGE_LOAD(P, kk_) do { const unsigned k_ = (kk_); \
  P##a0 = *(const uint4*)(A + (oa + k_)); P##a1 = *(const uint4*)(A + (oa + sa + k_)); \
  P##a2 = *(const uint4*)(A + (oa + 2 * sa + k_)); P##a3 = *(const uint4*)(A + (oa + 3 * sa + k_)); \
  P##b0 = *(const uint4*)(B + (ob + k_)); P##b1 = *(const uint4*)(B + (ob + sb + k_)); \
  if (NT == 4) { P##b2 = *(const uint4*)(B + (ob + 2 * sb + k_)); P##b3 = *(const uint4*)(B + (ob + 3 * sb + k_)); } } while (0)
#define STAGE_WRITE(P, Asw, Bsw) do { \
  *(uint4*)(Asw) = P##a0; *(uint4*)((Asw) + 32 * 72) = P##a1; *(uint4*)((Asw) + 64 * 72) = P##a2; *(uint4*)((Asw) + 96 * 72) = P##a3; \
  *(uint4*)(Bsw) = P##b0; *(uint4*)((Bsw) + 32 * 72) = P##b1; \
  if (NT == 4) { *(uint4*)((Bsw) + 64 * 72) = P##b2; *(uint4*)((Bsw) + 96 * 72) = P##b3; } } while (0)
template <int MT, int NT>
__device__ __forceinline__ void stage_compute(f32x4 (&acc)[MT][NT], const u16* As, const u16* Bs, int lane, int wm, int wn) {
#pragma unroll
  for (int kk = 0; kk < 2; kk++) {
    bf16x8 af[MT], bfr[NT];
#pragma unroll
    for (int mt = 0; mt < MT; mt++) af[mt] = *(const bf16x8*)(As + (wm * MT * 16 + mt * 16 + (lane & 15)) * 72 + kk * 32 + (lane >> 4) * 8);
#pragma unroll
    for (int nt = 0; nt < NT; nt++) bfr[nt] = *(const bf16x8*)(Bs + (wn * NT * 16 + nt * 16 + (lane & 15)) * 72 + kk * 32 + (lane >> 4) * 8);
    __builtin_amdgcn_s_setprio(1);
#pragma unroll
    for (int mt = 0; mt < MT; mt++)
#pragma unroll
      for (int nt = 0; nt < NT; nt++)
        acc[mt][nt] = __builtin_amdgcn_mfma_f32_16x16x32_bf16(af[mt], bfr[nt], acc[mt][nt], 0, 0, 0);
    __builtin_amdgcn_s_setprio(0);
  }
}
template <int MT, int NT>
__device__ __forceinline__ void gemm_kloop(f32x4 (&acc)[MT][NT], const u16* __restrict__ A, int lda,
                                           const u16* __restrict__ B, int ldb, int K, u16* lds) {
  static_assert(MT == 4, "MT");
  constexpr int BM = MT * 32, BN = NT * 32, SS = (BM + BN) * 72;
  const int t = tid_(), lane = t & 63, w = t >> 6, wm = w >> 1, wn = w & 1;
  u16* As0 = lds; u16* Bs0 = lds + BM * 72; u16* As1 = lds + SS; u16* Bs1 = lds + SS + BM * 72;
  const int lr = t >> 3, lc = (t & 7) * 8;
  const unsigned oa = (unsigned)(lr * lda + lc), ob = (unsigned)(lr * ldb + lc);
  const unsigned sa = 32u * (unsigned)lda, sb = 32u * (unsigned)ldb;
  const int swo = lr * 72 + lc;
  const unsigned klast = (unsigned)(K - 64);
  uint4 R0a0, R0a1, R0a2, R0a3, R0b0, R0b1, R0b2, R0b3, R1a0, R1a1, R1a2, R1a3, R1b0, R1b1, R1b2, R1b3;
  STAGE_LOAD(R0, 0u);
  STAGE_LOAD(R1, 64u);
  __syncthreads();
  STAGE_WRITE(R0, As0 + swo, Bs0 + swo);
  STAGE_LOAD(R0, 128u < klast ? 128u : klast);
  __syncthreads();
#pragma unroll 1
  for (int k0 = 0; k0 < K; k0 += 128) {
    STAGE_WRITE(R1, As1 + swo, Bs1 + swo);
    { unsigned kn = (unsigned)k0 + 192u; STAGE_LOAD(R1, kn < klast ? kn : klast); }
    stage_compute<MT, NT>(acc, As0, Bs0, lane, wm, wn);
    __syncthreads();
    STAGE_WRITE(R0, As0 + swo, Bs0 + swo);
    { unsigned kn = (unsigned)k0 + 256u; STAGE_LOAD(R0, kn < klast ? kn : klast); }
    stage_compute<MT, NT>(acc, As1, Bs1, lane, wm, wn);
    __syncthreads();
  }
}
template <int MT, int NT>
__device__ __forceinline__ void zero_acc(f32x4 (&acc)[MT][NT]) {
#pragma unroll
  for (int i = 0; i < MT; i++)
#pragma unroll
    for (int j = 0; j < NT; j++) acc[i][j] = (f32x4){0.f, 0.f, 0.f, 0.f};
}
__device__ __forceinline__ int tile_m0(int latonly, int tm) {
  if (!latonly) return tm * 128;
  int b = tm >> 4; return b * TT + 256 + (tm & 15) * 128;
}

__device__ __forceinline__ bool xcd_tile(int it, int bid, int nb, int NTM, int NTN, int G, int& tm, int& tn) {
  const int xcd = bid & 7, lb = bid >> 3, nlb = nb >> 3, tmx = NTM >> 3;
  const int idx = it * nlb + lb;
  if (idx >= tmx * NTN) return false;
  const int full = tmx / G;
  int g = idx / (G * NTN);
  if (g > full) g = full;
  const int r = idx - g * G * NTN;
  const int gs = (g < full) ? G : (tmx - full * G);
  tn = r / gs;
  tm = xcd * tmx + g * G + (r - tn * gs);
  return true;
}
__device__ void inproj_tile(const Params& p, int layer, int tm, int tn, u16* lds) {
  int m0 = tm * 128, n0 = tn * 128;
  f32x4 acc[4][4]; zero_acc(acc);
  gemm_kloop<4, 4>(acc, (const u16*)(p.ws + OFF_U) + (size_t)m0 * 1024, 1024,
                   (const u16*)(p.ws + OFF_WINT) + (size_t)n0 * 1024, 1024, 1024, lds);
  const int t = tid_(), lane = t & 63, w = t >> 6, wm = w >> 1, wn = w & 1;
  const float* bias = p.in[7] + (size_t)layer * DIN;
  u16* proj = (u16*)(p.ws + OFF_PROJ);
#pragma unroll
  for (int nt = 0; nt < 4; nt++) {
    const int cl = wn * 64 + nt * 16 + (lane & 15);
    const float bv = (n0 + cl < PC) ? bias[n0 + cl] : 0.f;
#pragma unroll
    for (int mt = 0; mt < 4; mt++)
#pragma unroll
      for (int r = 0; r < 4; r++) lds[(wm * 64 + mt * 16 + (lane >> 4) * 4 + r) * 136 + cl] = f2bf(acc[mt][nt][r] + bv);
  }
  __syncthreads();
#pragma unroll
  for (int i = 0; i < 8; i++) {
    const int q = t + 256 * i, row = q >> 4, ch = q & 15;
    if (n0 + ch * 8 < PC) *(uint4*)(proj + (size_t)(m0 + row) * PC + n0 + ch * 8) = *(const uint4*)(lds + row * 136 + ch * 8);
  }
}
__device__ void glu_tile(const Params& p, int layer, int latonly, int tm, int tn, u16* lds) {
  int m0 = tile_m0(latonly, tm), n0 = tn * 128;
  f32x4 acc[4][4]; zero_acc(acc);
  u16* proj = (u16*)(p.ws + OFF_PROJ);
  gemm_kloop<4, 4>(acc, proj + (size_t)m0 * PC + C_S5U, PC, (const u16*)(p.ws + OFF_GLUT) + (size_t)n0 * 256, 256, 256, lds);
  const int t = tid_(), lane = t & 63, w = t >> 6, wm = w >> 1, wn = w & 1;
  const float* bias = p.in[17] + layer * 256;
#pragma unroll
  for (int nt = 0; nt < 4; nt++) {
    const int cl = wn * 64 + nt * 16 + (lane & 15);
    const float bv = bias[n0 + cl];
#pragma unroll
    for (int mt = 0; mt < 4; mt++)
#pragma unroll
      for (int r = 0; r < 4; r++) lds[(wm * 64 + mt * 16 + (lane >> 4) * 4 + r) * 136 + cl] = f2bf(sigmoidf_(acc[mt][nt][r] + bv));
  }
  __syncthreads();
#pragma unroll
  for (int i = 0; i < 8; i++) {
    const int q = t + 256 * i, row = q >> 4, ch = q & 15;
    u16* pr = proj + (size_t)(m0 + row) * PC + n0 + ch * 8;
    uint4 sg = *(const uint4*)(lds + row * 136 + ch * 8);
    uint4 yy = *(const uint4*)(pr + C_S5U), zz = *(const uint4*)(pr + C_S5Z), oo;
    const unsigned* sgp = (const unsigned*)&sg; const unsigned* yp = (const unsigned*)&yy; const unsigned* zp = (const unsigned*)&zz; unsigned* op = (unsigned*)&oo;
#pragma unroll
    for (int e = 0; e < 4; e++) {
      float s0 = __uint_as_float(sgp[e] << 16), s1 = __uint_as_float(sgp[e] & 0xffff0000u);
      float y0 = __uint_as_float(yp[e] << 16), y1 = __uint_as_float(yp[e] & 0xffff0000u);
      float z0 = __uint_as_float(zp[e] << 16), z1 = __uint_as_float(zp[e] & 0xffff0000u);
      op[e] = pack2(y0 * s0 * siluf_(z0), y1 * s1 * siluf_(z1));
    }
    *(uint4*)(pr + C_S5Z) = oo;
  }
}
__device__ void merge_tile(const Params& p, int layer, int latonly, int tm, int tn, u16* lds) {
  constexpr int NT = 2;
  int m0 = tile_m0(latonly, tm), n0 = tn * 64;
  f32x4 accm[4][2]; zero_acc(accm);
  f32x4 accb[4][2]; zero_acc(accb);
  f32x4 accg[4][2]; zero_acc(accg);
  const u16* proj = (const u16*)(p.ws + OFF_PROJ);
  const u16* ub = (const u16*)(p.ws + OFF_U) + (size_t)m0 * 1024;
  const u16* wbt = (const u16*)(p.ws + OFF_WBT) + (size_t)n0 * 256;
  const u16* wgt = (const u16*)(p.ws + OFF_WINT) + ((size_t)PC + n0) * 1024;
  const int t = tid_(), lane = t & 63, w = t >> 6, wm = w >> 1, wn = w & 1;
  const float* bias = p.in[7] + (size_t)layer * DIN + PC;
  constexpr int SS = (128 + 64) * 72;
  u16* As0 = lds; u16* Bs0 = lds + 128 * 72; u16* As1 = lds + SS; u16* Bs1 = lds + SS + 128 * 72;
  const int lr = t >> 3, lc = (t & 7) * 8;
  const int swo = lr * 72 + lc;
  const unsigned oay = (unsigned)(lr * PC + lc), oau = (unsigned)(lr * 1024 + lc), obb = (unsigned)(lr * 256 + lc), obg = (unsigned)(lr * 1024 + lc);
  uint4 R0a0, R0a1, R0a2, R0a3, R0b0, R0b1, R0b2, R0b3, R1a0, R1a1, R1a2, R1a3, R1b0, R1b1, R1b2, R1b3;
  const u16* W = (const u16*)p.ws;
  const unsigned baseY = (unsigned)(OFF_PROJ / 2) + (unsigned)m0 * PC + oay;
  const unsigned baseU = (unsigned)(OFF_U / 2) + (unsigned)m0 * 1024u + oau;
  const unsigned baseB = (unsigned)(OFF_WBT / 2) + (unsigned)n0 * 256u + obb;
  const unsigned baseG = (unsigned)(OFF_WINT / 2) + ((unsigned)PC + (unsigned)n0) * 1024u + obg;
#define MLOAD(P, step_) do { int s_ = (step_); if (s_ > 79) s_ = 79; const int k_ = s_ / 20, r_ = s_ - k_ * 20; \
    const bool br_ = r_ < 4; \
    const unsigned yc_ = k_ == 0 ? C_S5Z : (k_ == 1 ? C_HGQ : (k_ == 2 ? C_RTQ : C_RWZ)); \
    const unsigned ao_ = br_ ? baseY + yc_ + 64u * r_ : baseU + 64u * (r_ - 4); \
    const unsigned bo_ = br_ ? baseB + (unsigned)k_ * 262144u + 64u * r_ : baseG + (unsigned)k_ * 1048576u + 64u * (r_ - 4); \
    const unsigned sa_ = br_ ? 32u * PC : 32768u, sb_ = br_ ? 8192u : 32768u; \
    P##a0 = *(const uint4*)(W + ao_); P##a1 = *(const uint4*)(W + (ao_ + sa_)); \
    P##a2 = *(const uint4*)(W + (ao_ + 2 * sa_)); P##a3 = *(const uint4*)(W + (ao_ + 3 * sa_)); \
    P##b0 = *(const uint4*)(W + bo_); P##b1 = *(const uint4*)(W + (bo_ + sb_)); } while (0)
  MLOAD(R0, 0);
  MLOAD(R1, 1);
  __syncthreads();
  STAGE_WRITE(R0, As0 + swo, Bs0 + swo);
  MLOAD(R0, 2);
  __syncthreads();
#define MPAIR(ACC) do { \
    STAGE_WRITE(R1, As1 + swo, Bs1 + swo); \
    MLOAD(R1, st + 3); \
    stage_compute<4, 2>(ACC, As0, Bs0, lane, wm, wn); \
    __syncthreads(); \
    STAGE_WRITE(R0, As0 + swo, Bs0 + swo); \
    MLOAD(R0, st + 4); \
    stage_compute<4, 2>(ACC, As1, Bs1, lane, wm, wn); \
    __syncthreads(); \
    st += 2; } while (0)
  int st = 0;
#pragma unroll 1
  for (int k = 0; k < 4; k++) {
#pragma unroll 1
    for (int i = 0; i < 2; i++) MPAIR(accb);
#pragma unroll 1
    for (int i = 0; i < 8; i++) MPAIR(accg);
#pragma unroll
    for (int nt = 0; nt < 2; nt++) {
      float bv = bias[k * 1024 + n0 + wn * 32 + nt * 16 + (lane & 15)];
#pragma unroll
      for (int mt = 0; mt < 4; mt++)
#pragma unroll
        for (int rr = 0; rr < 4; rr++) accm[mt][nt][rr] += sigmoidf_(accg[mt][nt][rr] + bv) * accb[mt][nt][rr];
    }
    zero_acc(accb); zero_acc(accg);
  }
#undef MPAIR
#undef MLOAD
  u16* mg = (u16*)(p.ws + OFF_SCR);
#pragma unroll
  for (int nt = 0; nt < 2; nt++) {
    const int cl = wn * 32 + nt * 16 + (lane & 15);
#pragma unroll
    for (int mt = 0; mt < 4; mt++)
#pragma unroll
      for (int r = 0; r < 4; r++) lds[(wm * 64 + mt * 16 + (lane >> 4) * 4 + r) * 72 + cl] = f2bf(accm[mt][nt][r]);
  }
  __syncthreads();
  {
    const int t = tid_();
#pragma unroll
    for (int i = 0; i < 4; i++) {
      const int q = t + 256 * i, row = q >> 3, ch = q & 7;
      *(uint4*)(mg + (size_t)(m0 + row) * 1024 + n0 + ch * 8) = *(const uint4*)(lds + row * 72 + ch * 8);
    }
  }
}
__device__ void outproj_tile(const Params& p, int layer, int latonly, int tm, int tn, u16* lds) {
  int m0 = tile_m0(latonly, tm), n0 = tn * 128;
  f32x4 acc[4][4]; zero_acc(acc);
  gemm_kloop<4, 4>(acc, (const u16*)(p.ws + OFF_SCR) + (size_t)m0 * 1024, 1024,
                   (const u16*)(p.ws + OFF_WOT) + (size_t)n0 * 1024, 1024, 1024, lds);
  const int lane = tid_() & 63, w = tid_() >> 6, wm = w >> 1, wn = w & 1;
  const float* bias = p.in[33] + layer * 1024;
  const float* hi0 = hin_ptr(p, layer, m0);
  float* ho0 = hout_ptr(p, m0);
  const float* gate = (const float*)(p.ws + OFF_MODS) + ((size_t)layer * 9 + modrow_of(m0)) * 3072 + 2048;
  float* cs = (float*)lds;
#pragma unroll
  for (int nt = 0; nt < 4; nt++) {
    const int cl = wn * 64 + nt * 16 + (lane & 15);
    const float bv = bias[n0 + cl];
#pragma unroll
    for (int mt = 0; mt < 4; mt++)
#pragma unroll
      for (int r = 0; r < 4; r++) cs[(wm * 64 + mt * 16 + (lane >> 4) * 4 + r) * 132 + cl] = acc[mt][nt][r] + bv;
  }
  __syncthreads();
  {
    const int t = tid_();
#pragma unroll 4
    for (int i = 0; i < 16; i++) {
      const int q = t + 256 * i, row = q >> 5, ch = q & 31;
      const float4 a4 = *(const float4*)(cs + row * 132 + ch * 4);
      const float4 g4 = *(const float4*)(gate + n0 + ch * 4);
      const float4 h4 = *(const float4*)(hi0 + (size_t)row * 1024 + n0 + ch * 4);
      float4 o4;
      o4.x = 1.4142135623730951f * h4.x + g4.x * a4.x; o4.y = 1.4142135623730951f * h4.y + g4.y * a4.y;
      o4.z = 1.4142135623730951f * h4.z + g4.z * a4.z; o4.w = 1.4142135623730951f * h4.w + g4.w * a4.w;
      *(float4*)(ho0 + (size_t)row * 1024 + n0 + ch * 4) = o4;
    }
  }
}

template <bool TWO>
__device__ void rwkv_scan_task(const Params& p, int layer, int task, float* lds) {
  const int t = tid_();
  const int rh = TWO ? (task & 1) : (task & 3), h = TWO ? ((task >> 1) & 3) : ((task >> 2) & 3);
  const int b = TWO ? ((task >> 3) & 7) : ((task >> 4) & 7), d = TWO ? (task >> 6) : (task >> 7);
  constexpr int RPB = TWO ? 32 : 16;
  float* sh_lora = lds;
  float* sh_w2 = sh_lora + 512;
  float* sh_a2 = sh_w2 + 1024;
  float* sh_r = sh_a2 + 1024;
  float* sh_w = sh_r + 1024;
  float* sh_k = sh_w + 1024;
  float* sh_kk = sh_k + 1024;
  float* sh_b = sh_kk + 1024;
  float* sh_v = sh_b + 1024;
  float* sh_o = sh_v + 512;
  const u16* proj = (const u16*)(p.ws + OFF_PROJ);
  u16* rwo = (u16*)(p.ws + OFF_RWO) + (size_t)d * MROWS * 256;
  float* bonus = (float*)(p.ws + OFF_BONUS) + (size_t)d * MROWS * 4;
  const float* mu0 = p.in[21] + (size_t)layer * 2 * 832;
  const float* mu1 = mu0 + 832;
  __syncthreads();
  for (int i = t; i < 1024; i += 256) {
    int rr = i >> 6, c = i & 63;
    sh_w2[i] = p.in[23][(((size_t)layer * 2 + d) * 16 + rr) * 256 + h * 64 + c];
    sh_a2[i] = p.in[25][(((size_t)layer * 2 + d) * 16 + rr) * 256 + h * 64 + c];
  }
  const int pst = t >> 4, cq = t & 15;
  const int ch0 = h * 64 + cq * 4;
  float mur0[4], mur1[4], muk0[4], muk1[4], w0v[4], a0v[4], kkw[4], kaw[4], rkw[4];
#pragma unroll
  for (int i = 0; i < 4; i++) {
    mur0[i] = mu0[ch0 + i]; mur1[i] = mu1[ch0 + i];
    muk0[i] = mu0[256 + ch0 + i]; muk1[i] = mu1[256 + ch0 + i];
    w0v[i] = p.in[22][((size_t)layer * 2 + d) * 256 + ch0 + i];
    a0v[i] = p.in[24][((size_t)layer * 2 + d) * 256 + ch0 + i];
    kkw[i] = p.in[26][layer * 256 + ch0 + i];
    kaw[i] = p.in[27][layer * 256 + ch0 + i];
    rkw[i] = p.in[28][layer * 256 + ch0 + i];
  }
  const int vch = 512 + h * 64 + rh * RPB + cq;
  const float muv0 = mu0[vch], muv1 = mu1[vch], muw0 = TWO ? mu0[vch + 16] : 0.f, muw1 = TWO ? mu1[vch + 16] : 0.f;
  const int lidx0 = t * 2;
  float lmu00, lmu01, lmu10, lmu11;
  {
    int q = lidx0 & 31;
    int col = q < 16 ? (768 + d * 16 + q) : (800 + d * 16 + (q - 16));
    lmu00 = mu0[col]; lmu01 = mu0[col + 1]; lmu10 = mu1[col]; lmu11 = mu1[col + 1];
  }
  const int rl = t >> 4, ks = t & 15;
  float4 S = make_float4(0.f, 0.f, 0.f, 0.f), S2 = make_float4(0.f, 0.f, 0.f, 0.f);
  unsigned lx0 = 0, lx1 = 0, lxp0 = 0, lxp1 = 0, lxn0 = 0, lxn1 = 0;
  uint2 rr_c, rr_p, rr_n, rk_c, rk_p, rk_n;
  unsigned rv_c, rv_p, rv_n, rw_c = 0, rw_p = 0, rw_n = 0;
  auto fetch = [&](int s0) {
    {
      int st2 = lidx0 >> 5, q = lidx0 & 31;
      int j = jmap(d, s0 + st2);
      int col = q < 16 ? (768 + d * 16 + q) : (800 + d * 16 + (q - 16));
      const u16* pr = proj + ((size_t)(b * TT + j)) * PC + C_RWX + col;
      const u16* prp = has_prev(j) ? pr - PC : pr;
      const u16* prn = has_next(j) ? pr + PC : pr;
      lx0 = pr[0]; lx1 = pr[1]; lxp0 = prp[0]; lxp1 = prp[1]; lxn0 = prn[0]; lxn1 = prn[1];
    }
    int j = jmap(d, s0 + pst);
    const u16* pr = proj + ((size_t)(b * TT + j)) * PC + C_RWX;
    const u16* prp = has_prev(j) ? pr - PC : pr;
    const u16* prn = has_next(j) ? pr + PC : pr;
    rr_c = *(const uint2*)(pr + ch0); rr_p = *(const uint2*)(prp + ch0); rr_n = *(const uint2*)(prn + ch0);
    rk_c = *(const uint2*)(pr + 256 + ch0); rk_p = *(const uint2*)(prp + 256 + ch0); rk_n = *(const uint2*)(prn + 256 + ch0);
    rv_c = pr[vch]; rv_p = prp[vch]; rv_n = prn[vch];
    if (TWO) { rw_c = pr[vch + 16]; rw_p = prp[vch + 16]; rw_n = prn[vch + 16]; }
  };
  auto unpack4 = [](uint2 v, float (&o)[4]) {
    o[0] = __uint_as_float(v.x << 16); o[1] = __uint_as_float(v.x & 0xffff0000u);
    o[2] = __uint_as_float(v.y << 16); o[3] = __uint_as_float(v.y & 0xffff0000u);
  };
  fetch(0);
  for (int s0 = 0; s0 < TT; s0 += 16) {
    {
      int st2 = lidx0 >> 5, q = lidx0 & 31;
      int ja = jmap(d, s0 + st2);
      const float hpa = has_prev(ja) ? 1.f : 0.f, hna = has_next(ja) ? 1.f : 0.f;
      float x0 = __uint_as_float(lx0 << 16), x1 = __uint_as_float(lx1 << 16);
      float xs0 = x0 + lmu00 * (__uint_as_float(lxp0 << 16) * hpa - x0) + lmu10 * (__uint_as_float(lxn0 << 16) * hna - x0);
      float xs1 = x1 + lmu01 * (__uint_as_float(lxp1 << 16) * hpa - x1) + lmu11 * (__uint_as_float(lxn1 << 16) * hna - x1);
      if (q < 16) {
        xs0 = 1.f - 2.f * __builtin_amdgcn_rcpf(__expf(2.f * xs0) + 1.f);
        xs1 = 1.f - 2.f * __builtin_amdgcn_rcpf(__expf(2.f * xs1) + 1.f);
      }
      *(float2*)(sh_lora + lidx0) = make_float2(xs0, xs1);
    }
    __syncthreads();
    const int jcur = jmap(d, s0 + pst);
    {
      const float hpf = has_prev(jcur) ? 1.f : 0.f, hnf = has_next(jcur) ? 1.f : 0.f;
      float r4[4], k4[4], t0[4], t1[4];
      unpack4(rr_c, r4); unpack4(rr_p, t0); unpack4(rr_n, t1);
#pragma unroll
      for (int i = 0; i < 4; i++) r4[i] = r4[i] + mur0[i] * (t0[i] * hpf - r4[i]) + mur1[i] * (t1[i] * hnf - r4[i]);
      unpack4(rk_c, k4); unpack4(rk_p, t0); unpack4(rk_n, t1);
#pragma unroll
      for (int i = 0; i < 4; i++) k4[i] = k4[i] + muk0[i] * (t0[i] * hpf - k4[i]) + muk1[i] * (t1[i] * hnf - k4[i]);
      float wl[4], al[4];
#pragma unroll
      for (int i = 0; i < 4; i++) { wl[i] = w0v[i]; al[i] = a0v[i]; }
      float lrow[32];
#pragma unroll
      for (int i4 = 0; i4 < 8; i4++) {
        float4 q4 = *(const float4*)(sh_lora + pst * 32 + i4 * 4);
        lrow[i4 * 4] = q4.x; lrow[i4 * 4 + 1] = q4.y; lrow[i4 * 4 + 2] = q4.z; lrow[i4 * 4 + 3] = q4.w;
      }
#pragma unroll
      for (int rr = 0; rr < 16; rr++) {
        float lw_ = lrow[rr], la_ = lrow[16 + rr];
        float4 w2 = *(const float4*)(sh_w2 + rr * 64 + cq * 4);
        float4 a2 = *(const float4*)(sh_a2 + rr * 64 + cq * 4);
        wl[0] += lw_ * w2.x; wl[1] += lw_ * w2.y; wl[2] += lw_ * w2.z; wl[3] += lw_ * w2.w;
        al[0] += la_ * a2.x; al[1] += la_ * a2.y; al[2] += la_ * a2.z; al[3] += la_ * a2.w;
      }
      float wv[4], kd[4], kk[4], bb[4];
      float ss = 0.f, bon = 0.f;
#pragma unroll
      for (int i = 0; i < 4; i++) {
        float a = wl[i];
        float lw = fminf(a, 0.f) - __logf(1.f + __expf(-fabsf(a))) - 0.5f;
        wv[i] = __expf(-__expf(lw));
        float ic = sigmoidf_(al[i]);
        float kr = k4[i] * kkw[i];
        kk[i] = kr; ss += kr * kr;
        kd[i] = k4[i] * (1.f + (ic - 1.f) * kaw[i]);
        bb[i] = ic;
        bon += r4[i] * kd[i] * rkw[i];
      }
      ss = allsum16(ss); bon = allsum16(bon);
      float inv = rsqrtf(fmaxf(ss, 1e-24f));
#pragma unroll
      for (int i = 0; i < 4; i++) { kk[i] *= inv; bb[i] *= kk[i]; }
      *(float4*)(sh_r + pst * 64 + cq * 4) = make_float4(r4[0], r4[1], r4[2], r4[3]);
      *(float4*)(sh_w + pst * 64 + cq * 4) = make_float4(wv[0], wv[1], wv[2], wv[3]);
      *(float4*)(sh_k + pst * 64 + cq * 4) = make_float4(kd[0], kd[1], kd[2], kd[3]);
      *(float4*)(sh_kk + pst * 64 + cq * 4) = make_float4(kk[0], kk[1], kk[2], kk[3]);
      *(float4*)(sh_b + pst * 64 + cq * 4) = make_float4(bb[0], bb[1], bb[2], bb[3]);
      if (rh == 0 && cq == 0) bonus[(size_t)(b * TT + jcur) * 4 + h] = bon;
      float xv = __uint_as_float(rv_c << 16);
      sh_v[pst * 32 + cq] = xv + muv0 * (__uint_as_float(rv_p << 16) * hpf - xv) + muv1 * (__uint_as_float(rv_n << 16) * hnf - xv);
      float xw = __uint_as_float(rw_c << 16);
      if (TWO) sh_v[pst * 32 + 16 + cq] = xw + muw0 * (__uint_as_float(rw_p << 16) * hpf - xw) + muw1 * (__uint_as_float(rw_n << 16) * hnf - xw);
    }
    __syncthreads();
    if (s0 + 16 < TT) fetch(s0 + 16);
    float oacc = 0.f, oacc2 = 0.f;
    {
      float4 nkk = *(const float4*)(sh_kk + ks * 4), nw = *(const float4*)(sh_w + ks * 4), nb4 = *(const float4*)(sh_b + ks * 4);
      float4 nk = *(const float4*)(sh_k + ks * 4), nr = *(const float4*)(sh_r + ks * 4);
      float nv = sh_v[rl], nv2 = sh_v[16 + rl];
#pragma unroll 4
      for (int st = 0; st < 16; st++) {
        const float4 kk4 = nkk, w4 = nw, b4 = nb4, k4 = nk, r4 = nr; const float vv = nv, vv2 = nv2;
        {
          const int sn = (st + 1) & 15;
          nkk = *(const float4*)(sh_kk + sn * 64 + ks * 4); nw = *(const float4*)(sh_w + sn * 64 + ks * 4);
          nb4 = *(const float4*)(sh_b + sn * 64 + ks * 4); nk = *(const float4*)(sh_k + sn * 64 + ks * 4);
          nr = *(const float4*)(sh_r + sn * 64 + ks * 4); nv = sh_v[sn * 32 + rl]; nv2 = sh_v[sn * 32 + 16 + rl];
        }
        float sa = -((S.x * kk4.x + S.y * kk4.y) + (S.z * kk4.z + S.w * kk4.w));
        float sa2 = 0.f;
        if (TWO) sa2 = -((S2.x * kk4.x + S2.y * kk4.y) + (S2.z * kk4.z + S2.w * kk4.w));
        sa = allsum16(sa); if (TWO) sa2 = allsum16(sa2);
        S.x = S.x * w4.x + (sa * b4.x + vv * k4.x);
        S.y = S.y * w4.y + (sa * b4.y + vv * k4.y);
        S.z = S.z * w4.z + (sa * b4.z + vv * k4.z);
        S.w = S.w * w4.w + (sa * b4.w + vv * k4.w);
        if (TWO) {
          S2.x = S2.x * w4.x + (sa2 * b4.x + vv2 * k4.x);
          S2.y = S2.y * w4.y + (sa2 * b4.y + vv2 * k4.y);
          S2.z = S2.z * w4.z + (sa2 * b4.z + vv2 * k4.z);
          S2.w = S2.w * w4.w + (sa2 * b4.w + vv2 * k4.w);
        }
        float o = (S.x * r4.x + S.y * r4.y) + (S.z * r4.z + S.w * r4.w);
        float o2 = 0.f;
        if (TWO) o2 = (S2.x * r4.x + S2.y * r4.y) + (S2.z * r4.z + S2.w * r4.w);
        o = allsum16(o); if (TWO) o2 = allsum16(o2);
        oacc = (ks == st) ? o : oacc;
        oacc2 = (ks == st) ? o2 : oacc2;
      }
    }
    sh_o[ks * 32 + rl] = oacc;
    if (TWO) sh_o[ks * 32 + 16 + rl] = oacc2;
    __syncthreads();
    {
      u16* op = rwo + (size_t)(b * TT + jcur) * 256 + h * 64 + rh * RPB + cq;
      op[0] = f2bf(sh_o[pst * 32 + cq]);
      if (TWO) op[16] = f2bf(sh_o[pst * 32 + 16 + cq]);
    }
  }
}


__device__ void rwkv_scan32(const Params& p, int layer, int task, float* lds) {
  const int t = tid_();
  const int rq = task & 3, h = (task >> 2) & 3, b = (task >> 4) & 7, d = task >> 7;
  float* sh_lora = lds;
  float* sh_w2 = sh_lora + 1024;
  float* sh_a2 = sh_w2 + 1024;
  float* sh_r = sh_a2 + 1024;
  float* sh_w = sh_r + 2048;
  float* sh_k = sh_w + 2048;
  float* sh_kk = sh_k + 2048;
  float* sh_b = sh_kk + 2048;
  float* sh_v = sh_b + 2048;
  float* sh_o = sh_v + 512;
  const u16* proj = (const u16*)(p.ws + OFF_PROJ);
  u16* rwo = (u16*)(p.ws + OFF_RWO) + (size_t)d * MROWS * 256;
  float* bonus = (float*)(p.ws + OFF_BONUS) + (size_t)d * MROWS * 4;
  const float* mu0 = p.in[21] + (size_t)layer * 2 * 832;
  const float* mu1 = mu0 + 832;
  __syncthreads();
  for (int i = t; i < 1024; i += 256) {
    int rr = i >> 6, c = i & 63;
    sh_w2[i] = p.in[23][(((size_t)layer * 2 + d) * 16 + rr) * 256 + h * 64 + c];
    sh_a2[i] = p.in[25][(((size_t)layer * 2 + d) * 16 + rr) * 256 + h * 64 + c];
  }
  const int pst = t >> 4, cq = t & 15;
  const int ch0 = h * 64 + cq * 4;
  float mur0[4], mur1[4], muk0[4], muk1[4], w0v[4], a0v[4], kkw[4], kaw[4], rkw[4];
#pragma unroll
  for (int i = 0; i < 4; i++) {
    mur0[i] = mu0[ch0 + i]; mur1[i] = mu1[ch0 + i];
    muk0[i] = mu0[256 + ch0 + i]; muk1[i] = mu1[256 + ch0 + i];
    w0v[i] = p.in[22][((size_t)layer * 2 + d) * 256 + ch0 + i];
    a0v[i] = p.in[24][((size_t)layer * 2 + d) * 256 + ch0 + i];
    kkw[i] = p.in[26][layer * 256 + ch0 + i];
    kaw[i] = p.in[27][layer * 256 + ch0 + i];
    rkw[i] = p.in[28][layer * 256 + ch0 + i];
  }
  const int vch = 512 + h * 64 + rq * 16 + cq;
  const float muv0 = mu0[vch], muv1 = mu1[vch];
  const int lq = (t * 2) & 31, lst = (t * 2) >> 5;
  const int lcol = lq < 16 ? (768 + d * 16 + lq) : (800 + d * 16 + (lq - 16));
  const float lmu00 = mu0[lcol], lmu01 = mu0[lcol + 1], lmu10 = mu1[lcol], lmu11 = mu1[lcol + 1];
  const int rl = t >> 4, ks = t & 15;
  float4 S = make_float4(0.f, 0.f, 0.f, 0.f);
  uint2 rr_c[2], rr_p[2], rr_n[2], rk_c[2], rk_p[2], rk_n[2];
  unsigned rv_c[2], rv_p[2], rv_n[2];
  unsigned lx0[2], lx1[2], lxp0[2], lxp1[2], lxn0[2], lxn1[2];
  auto fetch = [&](int s0) {
#pragma unroll
    for (int e = 0; e < 2; e++) {
      {
        const int j = jmap(d, s0 + lst + 16 * e);
        const u16* pr = proj + ((size_t)(b * TT + j)) * PC + C_RWX + lcol;
        const u16* prp = has_prev(j) ? pr - PC : pr;
        const u16* prn = has_next(j) ? pr + PC : pr;
        lx0[e] = pr[0]; lx1[e] = pr[1]; lxp0[e] = prp[0]; lxp1[e] = prp[1]; lxn0[e] = prn[0]; lxn1[e] = prn[1];
      }
      const int j = jmap(d, s0 + pst + 16 * e);
      const u16* pr = proj + ((size_t)(b * TT + j)) * PC + C_RWX;
      const u16* prp = has_prev(j) ? pr - PC : pr;
      const u16* prn = has_next(j) ? pr + PC : pr;
      rr_c[e] = *(const uint2*)(pr + ch0); rr_p[e] = *(const uint2*)(prp + ch0); rr_n[e] = *(const uint2*)(prn + ch0);
      rk_c[e] = *(const uint2*)(pr + 256 + ch0); rk_p[e] = *(const uint2*)(prp + 256 + ch0); rk_n[e] = *(const uint2*)(prn + 256 + ch0);
      rv_c[e] = pr[vch]; rv_p[e] = prp[vch]; rv_n[e] = prn[vch];
    }
  };
  auto unpack4 = [](uint2 v, float (&o)[4]) {
    o[0] = __uint_as_float(v.x << 16); o[1] = __uint_as_float(v.x & 0xffff0000u);
    o[2] = __uint_as_float(v.y << 16); o[3] = __uint_as_float(v.y & 0xffff0000u);
  };
  fetch(0);
  for (int s0 = 0; s0 < TT; s0 += 32) {
#pragma unroll
    for (int e = 0; e < 2; e++) {
      const int ja = jmap(d, s0 + lst + 16 * e);
      const float hpa = has_prev(ja) ? 1.f : 0.f, hna = has_next(ja) ? 1.f : 0.f;
      float x0 = __uint_as_float(lx0[e] << 16), x1 = __uint_as_float(lx1[e] << 16);
      float xs0 = x0 + lmu00 * (__uint_as_float(lxp0[e] << 16) * hpa - x0) + lmu10 * (__uint_as_float(lxn0[e] << 16) * hna - x0);
      float xs1 = x1 + lmu01 * (__uint_as_float(lxp1[e] << 16) * hpa - x1) + lmu11 * (__uint_as_float(lxn1[e] << 16) * hna - x1);
      if (lq < 16) {
        xs0 = 1.f - 2.f * __builtin_amdgcn_rcpf(__expf(2.f * xs0) + 1.f);
        xs1 = 1.f - 2.f * __builtin_amdgcn_rcpf(__expf(2.f * xs1) + 1.f);
      }
      *(float2*)(sh_lora + (lst + 16 * e) * 32 + lq) = make_float2(xs0, xs1);
    }
    __syncthreads();
    int jcur[2];
#pragma unroll
    for (int e = 0; e < 2; e++) {
      const int st_ = pst + 16 * e;
      jcur[e] = jmap(d, s0 + st_);
      const float hpf = has_prev(jcur[e]) ? 1.f : 0.f, hnf = has_next(jcur[e]) ? 1.f : 0.f;
      float r4[4], k4[4], t0[4], t1[4];
      unpack4(rr_c[e], r4); unpack4(rr_p[e], t0); unpack4(rr_n[e], t1);
#pragma unroll
      for (int i = 0; i < 4; i++) r4[i] = r4[i] + mur0[i] * (t0[i] * hpf - r4[i]) + mur1[i] * (t1[i] * hnf - r4[i]);
      unpack4(rk_c[e], k4); unpack4(rk_p[e], t0); unpack4(rk_n[e], t1);
#pragma unroll
      for (int i = 0; i < 4; i++) k4[i] = k4[i] + muk0[i] * (t0[i] * hpf - k4[i]) + muk1[i] * (t1[i] * hnf - k4[i]);
      float wl[4], al[4];
#pragma unroll
      for (int i = 0; i < 4; i++) { wl[i] = w0v[i]; al[i] = a0v[i]; }
      float lrow[32];
#pragma unroll
      for (int i4 = 0; i4 < 8; i4++) {
        float4 q4 = *(const float4*)(sh_lora + st_ * 32 + i4 * 4);
        lrow[i4 * 4] = q4.x; lrow[i4 * 4 + 1] = q4.y; lrow[i4 * 4 + 2] = q4.z; lrow[i4 * 4 + 3] = q4.w;
      }
#pragma unroll
      for (int rr = 0; rr < 16; rr++) {
        float lw_ = lrow[rr], la_ = lrow[16 + rr];
        float4 w2 = *(const float4*)(sh_w2 + rr * 64 + cq * 4);
        float4 a2 = *(const float4*)(sh_a2 + rr * 64 + cq * 4);
        wl[0] += lw_ * w2.x; wl[1] += lw_ * w2.y; wl[2] += lw_ * w2.z; wl[3] += lw_ * w2.w;
        al[0] += la_ * a2.x; al[1] += la_ * a2.y; al[2] += la_ * a2.z; al[3] += la_ * a2.w;
      }
      float wv[4], kd[4], kk[4], bb[4];
      float ss = 0.f, bon = 0.f;
#pragma unroll
      for (int i = 0; i < 4; i++) {
        float a = wl[i];
        float lw = fminf(a, 0.f) - __logf(1.f + __expf(-fabsf(a))) - 0.5f;
        wv[i] = __expf(-__expf(lw));
        float ic = sigmoidf_(al[i]);
        float kr = k4[i] * kkw[i];
        kk[i] = kr; ss += kr * kr;
        kd[i] = k4[i] * (1.f + (ic - 1.f) * kaw[i]);
        bb[i] = ic;
        bon += r4[i] * kd[i] * rkw[i];
      }
      ss = allsum16(ss); bon = allsum16(bon);
      float inv = rsqrtf(fmaxf(ss, 1e-24f));
#pragma unroll
      for (int i = 0; i < 4; i++) { kk[i] *= inv; bb[i] *= kk[i]; }
      *(float4*)(sh_r + st_ * 64 + cq * 4) = make_float4(r4[0], r4[1], r4[2], r4[3]);
      *(float4*)(sh_w + st_ * 64 + cq * 4) = make_float4(wv[0], wv[1], wv[2], wv[3]);
      *(float4*)(sh_k + st_ * 64 + cq * 4) = make_float4(kd[0], kd[1], kd[2], kd[3]);
      *(float4*)(sh_kk + st_ * 64 + cq * 4) = make_float4(kk[0], kk[1], kk[2], kk[3]);
      *(float4*)(sh_b + st_ * 64 + cq * 4) = make_float4(bb[0], bb[1], bb[2], bb[3]);
      if (rq == 0 && cq == 0) bonus[(size_t)(b * TT + jcur[e]) * 4 + h] = bon;
      float xv = __uint_as_float(rv_c[e] << 16);
      sh_v[st_ * 16 + cq] = xv + muv0 * (__uint_as_float(rv_p[e] << 16) * hpf - xv) + muv1 * (__uint_as_float(rv_n[e] << 16) * hnf - xv);
    }
    __syncthreads();
    if (s0 + 32 < TT) fetch(s0 + 32);
    float oacc0 = 0.f, oacc1 = 0.f;
    {
      float4 nkk = *(const float4*)(sh_kk + ks * 4), nw = *(const float4*)(sh_w + ks * 4), nb4 = *(const float4*)(sh_b + ks * 4);
      float4 nk = *(const float4*)(sh_k + ks * 4), nr = *(const float4*)(sh_r + ks * 4);
      float nv = sh_v[rl];
#pragma unroll 4
      for (int st = 0; st < 32; st++) {
        const float4 kk4 = nkk, w4 = nw, b4 = nb4, k4 = nk, r4 = nr; const float vv = nv;
        {
          const int sn = (st + 1) & 31;
          nkk = *(const float4*)(sh_kk + sn * 64 + ks * 4); nw = *(const float4*)(sh_w + sn * 64 + ks * 4);
          nb4 = *(const float4*)(sh_b + sn * 64 + ks * 4); nk = *(const float4*)(sh_k + sn * 64 + ks * 4);
          nr = *(const float4*)(sh_r + sn * 64 + ks * 4); nv = sh_v[sn * 16 + rl];
        }
        float sa = -((S.x * kk4.x + S.y * kk4.y) + (S.z * kk4.z + S.w * kk4.w));
        sa = allsum16(sa);
        S.x = S.x * w4.x + (sa * b4.x + vv * k4.x);
        S.y = S.y * w4.y + (sa * b4.y + vv * k4.y);
        S.z = S.z * w4.z + (sa * b4.z + vv * k4.z);
        S.w = S.w * w4.w + (sa * b4.w + vv * k4.w);
        float o = (S.x * r4.x + S.y * r4.y) + (S.z * r4.z + S.w * r4.w);
        o = allsum16(o);
        oacc0 = (ks == st) ? o : oacc0;
        oacc1 = (ks + 16 == st) ? o : oacc1;
      }
    }
    sh_o[ks * 16 + rl] = oacc0;
    sh_o[(ks + 16) * 16 + rl] = oacc1;
    __syncthreads();
#pragma unroll
    for (int e = 0; e < 2; e++)
      rwo[(size_t)(b * TT + jcur[e]) * 256 + h * 64 + rq * 16 + cq] = f2bf(sh_o[(pst + 16 * e) * 16 + cq]);
  }
}

__device__ void rwkv_combine_rows(const Params& p, int layer, int row0, int latonly) {
  const int lane = tid_() & 63, h = tid_() >> 6;
  const int ch = h * 64 + lane;
  const u16* rwo = (const u16*)(p.ws + OFF_RWO);
  u16* proj = (u16*)(p.ws + OFF_PROJ);
  const float* mu0 = p.in[21] + (size_t)layer * 2 * 832; const float* mu1 = mu0 + 832;
  const float* bonus = (const float*)(p.ws + OFF_BONUS);
  const float gw = p.in[29][layer * 256 + ch], gb = p.in[30][layer * 256 + ch];
  const float m0 = mu0[512 + ch], m1 = mu1[512 + ch];
  const int vc = C_RWX + 512 + ch;
  float o[8], xv[8], xp[8], xn[8], bs[8], z[8];
#pragma unroll
  for (int i = 0; i < 8; i++) {
    const int row = row0 + i;
    const int j = row % TT;
    const u16* pr = proj + (size_t)row * PC;
    o[i] = bf2f(rwo[(size_t)row * 256 + ch]) + bf2f(rwo[(size_t)MROWS * 256 + (size_t)row * 256 + ch]);
    xv[i] = bf2f(pr[vc]);
    xp[i] = has_prev(j) ? bf2f(pr[vc - PC]) : 0.f;
    xn[i] = has_next(j) ? bf2f(pr[vc + PC]) : 0.f;
    bs[i] = bonus[(size_t)row * 4 + h] + bonus[(size_t)MROWS * 4 + (size_t)row * 4 + h];
    z[i] = bf2f(pr[C_RWZ + ch]);
  }
#pragma unroll
  for (int i = 0; i < 8; i++) {
    const int row = row0 + i;
    if (latonly && (row % TT) < 256) continue;
    float mean = wavesum(o[i]) * (1.f / 64.f);
    float dlt = o[i] - mean;
    float var = wavesum(dlt * dlt) * (1.f / 64.f);
    float on = dlt * rsqrtf(var + 64e-5f) * gw + gb;
    float v = xv[i] + m0 * (xp[i] - xv[i]) + m1 * (xn[i] - xv[i]);
    proj[(size_t)row * PC + C_RWZ + ch] = f2bf((on + bs[i] * v) * siluf_(z[i]));
  }
}

template <int MX, int PASS>
__device__ __forceinline__ void gla_sweep(const Params& p, int layer, int d, int b, int h, int c, float* lds) {
  const int t = tid_(), w = t >> 6, lane = t & 63;
  float* kbuf = lds;
  float* fbuf = kbuf + 1024;
  float* qbuf = fbuf + 1024;
  float* vbuf = qbuf + 1024;
  float* part = vbuf + 1024;
  u16* proj = (u16*)(p.ws + OFF_PROJ);
  const int dbh = (d * 8 + b) * 4 + h;
  float* stt = (float*)(p.ws + (MX == 0 ? OFF_HGST : OFF_RTST)) + ((size_t)dbh * 9 + c) * 4096;
  float S[16];
#pragma unroll
  for (int i = 0; i < 16; i++) S[i] = PASS == 1 ? 0.f : stt[(w * 16 + i) * 64 + lane];
  float gam = 1.f;
  if (MX == 1) gam = __expf(-__expf(p.in[20][((size_t)layer * 2 + d) * 4 + h]));
  float Pl = 1.f;
  const int pst = t >> 4, c4 = (t & 15) * 4;
  float lb4[4] = {0.f, 0.f, 0.f, 0.f};
  if (MX == 0 && layer == 1) {
#pragma unroll
    for (int i = 0; i < 4; i++) {
      float l0 = p.in[18][(0 * 2 + d) * 256 + h * 64 + c4 + i], l1 = p.in[18][(1 * 2 + d) * 256 + h * 64 + c4 + i];
      float mx = fmaxf(l0, l1);
      float e0 = __expf(l0 - mx), e1 = __expf(l1 - mx);
      lb4[i] = e1 / (e0 + e1);
    }
  }
  const int vcol0 = (MX == 0 ? C_HGI : C_RTV) + h * 64;
  const float* rope = (const float*)(p.ws + OFF_ROPE);
  uint2 r_a, r_b, r_c, r_d, r_v; float4 r_cs0, r_cs1;
  r_a = r_b = r_c = r_d = r_v = make_uint2(0u, 0u); r_cs0 = r_cs1 = make_float4(1.f, 0.f, 1.f, 0.f);
  auto fetch = [&](int s0) {
    int j = jmap(d, s0 + pst);
    const u16* pr = proj + (size_t)(b * TT + j) * PC;
    r_v = *(const uint2*)(pr + vcol0 + c4);
    if (MX == 0) {
      r_a = *(const uint2*)(pr + C_HGF + d * 256 + h * 64 + c4);
      if (PASS == 2) r_b = *(const uint2*)(pr + C_HGQ + h * 64 + c4);
    } else {
      r_a = *(const uint2*)(pr + C_RTK + h * 64 + c4);
      r_c = *(const uint2*)(pr + C_RTK + h * 64 + (c4 ^ 16));
      if (PASS == 2) { r_b = *(const uint2*)(pr + C_RTQ + h * 64 + c4); r_d = *(const uint2*)(pr + C_RTQ + h * 64 + (c4 ^ 16)); }
      if (j >= 256) {
        int tl = j - 256;
        int pos = (c4 & 32) ? (tl & 63) : (tl >> 6);
        const float* rp = rope + (pos * 16 + (c4 & 15)) * 2;
        r_cs0 = *(const float4*)rp; r_cs1 = *(const float4*)(rp + 4);
      } else { r_cs0 = make_float4(1.f, 0.f, 1.f, 0.f); r_cs1 = r_cs0; }
    }
  };
  auto unpack4 = [](uint2 v, float (&o)[4]) {
    o[0] = __uint_as_float(v.x << 16); o[1] = __uint_as_float(v.x & 0xffff0000u);
    o[2] = __uint_as_float(v.y << 16); o[3] = __uint_as_float(v.y & 0xffff0000u);
  };
  u16* ofp; int ofs;
  if (MX == 0) { ofp = proj + C_HGF + h * 64 + lane; ofs = PC; }
  else { ofp = (u16*)(p.ws + OFF_RETOF) + h * 64 + lane; ofs = 256; }
  const int zcol = (MX == 0 ? C_HGZ : C_RTZ) + h * 64 + lane;
  const int ycol = (MX == 0 ? C_HGQ : C_RTQ) + h * 64 + lane;
  float normw = 1.f;
  if (MX == 0 && PASS == 2) normw = p.in[19][layer * 256 + h * 64 + lane];
  fetch(c * 256);
  for (int sub = 0; sub < 16; sub++) {
    const int s0 = c * 256 + sub * 16;
    __syncthreads();
    {
      float va[4], vb[4], vc[4], vd[4], vv4[4];
      unpack4(r_a, va); unpack4(r_v, vv4);
      *(float4*)(vbuf + pst * 64 + c4) = make_float4(vv4[0], vv4[1], vv4[2], vv4[3]);
      if (MX == 0) {
        float f[4], k[4];
#pragma unroll
        for (int i = 0; i < 4; i++) { f[i] = lb4[i] + (1.f - lb4[i]) * sigmoidf_(va[i]); k[i] = 1.f - f[i]; }
        *(float4*)(kbuf + pst * 64 + c4) = make_float4(k[0], k[1], k[2], k[3]);
        *(float4*)(fbuf + pst * 64 + c4) = make_float4(f[0], f[1], f[2], f[3]);
        if (PASS == 2) {
          unpack4(r_b, vb);
          *(float4*)(qbuf + pst * 64 + c4) = make_float4(siluf_(vb[0]), siluf_(vb[1]), siluf_(vb[2]), siluf_(vb[3]));
        }
      } else {
        unpack4(r_c, vc);
        float cs[8] = {r_cs0.x, r_cs0.y, r_cs0.z, r_cs0.w, r_cs1.x, r_cs1.y, r_cs1.z, r_cs1.w};
        float sgn = (c4 & 16) ? 1.f : -1.f;
#pragma unroll
        for (int i = 0; i < 4; i++) va[i] = (va[i] * cs[2 * i] + sgn * vc[i] * cs[2 * i + 1]) * 0.125f;
        *(float4*)(kbuf + pst * 64 + c4) = make_float4(va[0], va[1], va[2], va[3]);
        if (PASS == 2) {
          unpack4(r_b, vb); unpack4(r_d, vd);
#pragma unroll
          for (int i = 0; i < 4; i++) vb[i] = vb[i] * cs[2 * i] + sgn * vd[i] * cs[2 * i + 1];
          *(float4*)(qbuf + pst * 64 + c4) = make_float4(vb[0], vb[1], vb[2], vb[3]);
        }
      }
    }
    __syncthreads();
    if (sub + 1 < 16) fetch(s0 + 16);
    u16 pf_o[4], pf_z[4];
    if (PASS == 2 && d == 1) {
#pragma unroll
      for (int e = 0; e < 4; e++) {
        size_t row = (size_t)(b * TT + jmap(d, s0 + w * 4 + e));
        pf_o[e] = ofp[row * ofs]; pf_z[e] = proj[row * PC + zcol];
      }
    }
#pragma unroll 2
    for (int st = 0; st < 16; st++) {
      const float vv = vbuf[st * 64 + lane];
      float o = 0.f;
#pragma unroll
      for (int i4 = 0; i4 < 4; i4++) {
        float4 kv = *(const float4*)(kbuf + st * 64 + w * 16 + i4 * 4);
        float4 fv = make_float4(gam, gam, gam, gam);
        if (MX == 0) fv = *(const float4*)(fbuf + st * 64 + w * 16 + i4 * 4);
        S[i4*4]   = fv.x * S[i4*4]   + kv.x * vv;
        S[i4*4+1] = fv.y * S[i4*4+1] + kv.y * vv;
        S[i4*4+2] = fv.z * S[i4*4+2] + kv.z * vv;
        S[i4*4+3] = fv.w * S[i4*4+3] + kv.w * vv;
        if (PASS == 2) {
          float4 qv = *(const float4*)(qbuf + st * 64 + w * 16 + i4 * 4);
          o += S[i4*4] * qv.x + S[i4*4+1] * qv.y + S[i4*4+2] * qv.z + S[i4*4+3] * qv.w;
        }
      }
      if (MX == 0 && PASS == 1) { if (lane < 16) Pl *= fbuf[st * 64 + w * 16 + lane]; }
      if (PASS == 2) part[(w * 16 + st) * 64 + lane] = o;
    }
    if (PASS == 2) {
      __syncthreads();
#pragma unroll
      for (int e = 0; e < 4; e++) {
        int st = w * 4 + e;
        float o = part[(0 * 16 + st) * 64 + lane] + part[(1 * 16 + st) * 64 + lane] + part[(2 * 16 + st) * 64 + lane] + part[(3 * 16 + st) * 64 + lane];
        int j = jmap(d, s0 + st);
        size_t row = (size_t)(b * TT + j);
        if (d == 0) {
          ofp[row * ofs] = f2bf(o);
        } else {
          o += bf2f(pf_o[e]);
          float ss = wavesum(o * o);
          float y = o * rsqrtf(ss * (1.f / 64.f) + 1e-6f) * normw;
          proj[row * PC + ycol] = f2bf(y * siluf_(bf2f(pf_z[e])));
        }
      }
    }
  }
  if (PASS == 1) {
#pragma unroll
    for (int i = 0; i < 16; i++) stt[(w * 16 + i) * 64 + lane] = S[i];
    if (MX == 0 && lane < 16) ((float*)(p.ws + OFF_HGP))[((size_t)dbh * 9 + c) * 64 + w * 16 + lane] = Pl;
  }
}

#define RS 72
template <int PASS>
__device__ __forceinline__ void ret_sweep(const Params& p, int layer, int d, int b, int h, int nc, int cstep, u16* lds) {
  const int t = tid_(), lane = t & 63, w4 = t >> 6;
  u16* Qs = lds;
  u16* Ks = Qs + 64 * RS;
  u16* Kt = Ks + 64 * RS;
  u16* Vt = Kt + 64 * RS;
  u16* Vd = Vt + 64 * RS;
  u16* Ps = Vd + 64 * RS;
  u16* St = Ps + 64 * RS;
  u16* proj = (u16*)(p.ws + OFF_PROJ);
  const float* rope = (const float*)(p.ws + OFF_ROPE);
  const float lg = -__expf(p.in[20][((size_t)layer * 2 + d) * 4 + h]) * 1.4426950408889634f;
  const float g64 = exp2f(64.f * lg);
  const int dbh = (d * 8 + b) * 4 + h;
  float* stt = (float*)(p.ws + OFF_RTST) + ((size_t)dbh * 9 + cstep) * 4096;
  f32x4 accS[4];
#pragma unroll
  for (int nt = 0; nt < 4; nt++)
#pragma unroll
    for (int r = 0; r < 4; r++)
      accS[nt][r] = PASS == 1 ? 0.f : stt[(w4 * 16 + (lane >> 4) * 4 + r) * 64 + nt * 16 + (lane & 15)];
  uint4 rq[2], rqp[2], rk[2], rkp[2], rv[2];
  auto fetch = [&](int w) {
#pragma unroll
    for (int e = 0; e < 2; e++) {
      const int q = t + 256 * e, sl = q & 63, c8 = (q >> 6) * 8;
      const u16* pr = proj + (size_t)(b * TT + nc * 256 + w * 64 + sl) * PC + h * 64;
      rk[e] = *(const uint4*)(pr + C_RTK + c8); rkp[e] = *(const uint4*)(pr + C_RTK + (c8 ^ 16));
      rv[e] = *(const uint4*)(pr + C_RTV + c8);
      if (PASS == 2) { rq[e] = *(const uint4*)(pr + C_RTQ + c8); rqp[e] = *(const uint4*)(pr + C_RTQ + (c8 ^ 16)); }
    }
  };
  auto up = [](uint4 v, float (&o)[8]) {
    const unsigned* u = (const unsigned*)&v;
#pragma unroll
    for (int i = 0; i < 4; i++) { o[2 * i] = __uint_as_float(u[i] << 16); o[2 * i + 1] = __uint_as_float(u[i] & 0xffff0000u); }
  };
  fetch(d == 0 ? 0 : 3);
  for (int wi = 0; wi < 4; wi++) {
    const int w = d == 0 ? wi : 3 - wi;
    __syncthreads();
    if (PASS == 2 && wi == 0) {
#pragma unroll
      for (int nt = 0; nt < 4; nt++)
        *(uint2*)(St + (nt * 16 + (lane & 15)) * RS + w4 * 16 + (lane >> 4) * 4) =
            make_uint2(pack2(accS[nt][0], accS[nt][1]), pack2(accS[nt][2], accS[nt][3]));
    }
#pragma unroll
    for (int e = 0; e < 2; e++) {
      const int q = t + 256 * e, sl = q & 63, c8 = (q >> 6) * 8;
      const int j = nc * 256 + w * 64 + sl;
      float kx[8], kp[8], vx[8], qx[8], qp[8];
      up(rk[e], kx); up(rkp[e], kp); up(rv[e], vx);
      if (PASS == 2) { up(rq[e], qx); up(rqp[e], qp); }
      if (j >= 256) {
        const int tl = j - 256;
        const int pos = (c8 & 32) ? (tl & 63) : (tl >> 6);
        const float* rp = rope + (pos * 16 + (c8 & 15)) * 2;
        const float sgn = (c8 & 16) ? 1.f : -1.f;
#pragma unroll
        for (int i2 = 0; i2 < 4; i2++) {
          const float4 cs = *(const float4*)(rp + i2 * 4);
          kx[2 * i2] = kx[2 * i2] * cs.x + sgn * kp[2 * i2] * cs.y;
          kx[2 * i2 + 1] = kx[2 * i2 + 1] * cs.z + sgn * kp[2 * i2 + 1] * cs.w;
          if (PASS == 2) {
            qx[2 * i2] = qx[2 * i2] * cs.x + sgn * qp[2 * i2] * cs.y;
            qx[2 * i2 + 1] = qx[2 * i2 + 1] * cs.z + sgn * qp[2 * i2 + 1] * cs.w;
          }
        }
      }
      const float dec = exp2f((float)(d == 0 ? 63 - sl : sl) * lg);
      u16 kb[8];
#pragma unroll
      for (int i = 0; i < 8; i++) {
        kb[i] = f2bf(kx[i] * 0.125f);
        Kt[(c8 + i) * RS + sl] = kb[i];
        Vd[(c8 + i) * RS + sl] = f2bf(vx[i] * dec);
      }
      if (PASS == 2) {
        uint4 kk4, qq4;
        kk4.x = kb[0] | ((unsigned)kb[1] << 16); kk4.y = kb[2] | ((unsigned)kb[3] << 16);
        kk4.z = kb[4] | ((unsigned)kb[5] << 16); kk4.w = kb[6] | ((unsigned)kb[7] << 16);
        qq4.x = pack2(qx[0], qx[1]); qq4.y = pack2(qx[2], qx[3]); qq4.z = pack2(qx[4], qx[5]); qq4.w = pack2(qx[6], qx[7]);
        *(uint4*)(Ks + sl * RS + c8) = kk4;
        *(uint4*)(Qs + sl * RS + c8) = qq4;
        const unsigned short* vraw = (const unsigned short*)&rv[e];
#pragma unroll
        for (int i = 0; i < 8; i++) Vt[(c8 + i) * RS + sl] = vraw[i];
      }
    }
    __syncthreads();
    if (wi + 1 < 4) fetch(d == 0 ? wi + 1 : 2 - wi);
    if (PASS == 2) {
      f32x4 accP[4];
#pragma unroll
      for (int nt = 0; nt < 4; nt++) accP[nt] = (f32x4){0.f, 0.f, 0.f, 0.f};
      bf16x8 aq[2];
#pragma unroll
      for (int kk = 0; kk < 2; kk++) aq[kk] = *(const bf16x8*)(Qs + (w4 * 16 + (lane & 15)) * RS + kk * 32 + (lane >> 4) * 8);
#pragma unroll
      for (int kk = 0; kk < 2; kk++)
#pragma unroll
        for (int nt = 0; nt < 4; nt++) {
          bf16x8 bk = *(const bf16x8*)(Ks + (nt * 16 + (lane & 15)) * RS + kk * 32 + (lane >> 4) * 8);
          accP[nt] = __builtin_amdgcn_mfma_f32_16x16x32_bf16(aq[kk], bk, accP[nt], 0, 0, 0);
        }
#pragma unroll
      for (int nt = 0; nt < 4; nt++)
#pragma unroll
        for (int r = 0; r < 4; r++) {
          const int il = w4 * 16 + (lane >> 4) * 4 + r, sl = nt * 16 + (lane & 15);
          const int e = d == 0 ? il - sl : sl - il;
          const float f = e >= 0 ? exp2f((float)e * lg) : 0.f;
          Ps[il * RS + sl] = f2bf(accP[nt][r] * f);
        }
      __syncthreads();
      f32x4 accO[4], accI[4];
#pragma unroll
      for (int nt = 0; nt < 4; nt++) { accO[nt] = (f32x4){0.f, 0.f, 0.f, 0.f}; accI[nt] = (f32x4){0.f, 0.f, 0.f, 0.f}; }
#pragma unroll
      for (int kk = 0; kk < 2; kk++) {
        bf16x8 ap = *(const bf16x8*)(Ps + (w4 * 16 + (lane & 15)) * RS + kk * 32 + (lane >> 4) * 8);
#pragma unroll
        for (int nt = 0; nt < 4; nt++) {
          bf16x8 bv = *(const bf16x8*)(Vt + (nt * 16 + (lane & 15)) * RS + kk * 32 + (lane >> 4) * 8);
          accO[nt] = __builtin_amdgcn_mfma_f32_16x16x32_bf16(ap, bv, accO[nt], 0, 0, 0);
          bf16x8 bs = *(const bf16x8*)(St + (nt * 16 + (lane & 15)) * RS + kk * 32 + (lane >> 4) * 8);
          accI[nt] = __builtin_amdgcn_mfma_f32_16x16x32_bf16(aq[kk], bs, accI[nt], 0, 0, 0);
        }
      }
      u16* ofp = (u16*)(p.ws + OFF_RETOF);
#pragma unroll
      for (int r = 0; r < 4; r++) {
        const int il = w4 * 16 + (lane >> 4) * 4 + r;
        const size_t row = (size_t)(b * TT + nc * 256 + w * 64 + il);
        const float rho = exp2f((float)(d == 0 ? il + 1 : 64 - il) * lg);
        float o[4], ss = 0.f;
#pragma unroll
        for (int nt = 0; nt < 4; nt++) {
          o[nt] = accO[nt][r] + rho * accI[nt][r];
          if (d == 1) o[nt] += bf2f(ofp[row * 256 + h * 64 + nt * 16 + (lane & 15)]);
          ss += o[nt] * o[nt];
        }
        if (d == 0) {
#pragma unroll
          for (int nt = 0; nt < 4; nt++) ofp[row * 256 + h * 64 + nt * 16 + (lane & 15)] = f2bf(o[nt]);
        } else {
          ss = allsum16(ss);
          const float sc = rsqrtf(ss * (1.f / 64.f) + 1e-6f);
#pragma unroll
          for (int nt = 0; nt < 4; nt++) {
            const int cv = h * 64 + nt * 16 + (lane & 15);
            const float z = bf2f(proj[row * PC + C_RTZ + cv]);
            proj[row * PC + C_RTQ + cv] = f2bf(o[nt] * sc * siluf_(z));
          }
        }
      }
    }
#pragma unroll
    for (int nt = 0; nt < 4; nt++)
#pragma unroll
      for (int r = 0; r < 4; r++) accS[nt][r] *= g64;
#pragma unroll
    for (int kk = 0; kk < 2; kk++) {
      bf16x8 ak = *(const bf16x8*)(Kt + (w4 * 16 + (lane & 15)) * RS + kk * 32 + (lane >> 4) * 8);
#pragma unroll
      for (int nt = 0; nt < 4; nt++) {
        bf16x8 bv = *(const bf16x8*)(Vd + (nt * 16 + (lane & 15)) * RS + kk * 32 + (lane >> 4) * 8);
        accS[nt] = __builtin_amdgcn_mfma_f32_16x16x32_bf16(ak, bv, accS[nt], 0, 0, 0);
      }
    }
    __syncthreads();
    if (PASS == 2 && wi + 1 < 4) {
#pragma unroll
      for (int nt = 0; nt < 4; nt++)
        *(uint2*)(St + (nt * 16 + (lane & 15)) * RS + w4 * 16 + (lane >> 4) * 4) =
            make_uint2(pack2(accS[nt][0], accS[nt][1]), pack2(accS[nt][2], accS[nt][3]));
    }
  }
  if (PASS == 1) {
#pragma unroll
    for (int nt = 0; nt < 4; nt++)
#pragma unroll
      for (int r = 0; r < 4; r++) stt[(w4 * 16 + (lane >> 4) * 4 + r) * 64 + nt * 16 + (lane & 15)] = accS[nt][r];
  }
}

#define HS 40
template <int PASS>
__device__ __forceinline__ void hg_sweep(const Params& p, int layer, int d, int b, int h, int nc, int cstep, u16* lds) {
  const int t = tid_(), lane = t & 63, w4 = t >> 6;
  u16* Qt = lds;
  u16* Kt = Qt + 16 * RS;
  u16* KtT = Kt + 16 * RS;
  u16* VtT = KtT + 64 * HS;
  u16* Am = VtT + 64 * HS;
  u16* St = Am + 16 * HS;
  float* eb = (float*)(St + 64 * RS);
  float* ssb = eb + 64;
  u16* proj = (u16*)(p.ws + OFF_PROJ);
  const int dbh = (d * 8 + b) * 4 + h;
  float* stt = (float*)(p.ws + OFF_HGST) + ((size_t)dbh * 9 + cstep) * 4096;
  f32x4 accS[4];
#pragma unroll
  for (int nt = 0; nt < 4; nt++)
#pragma unroll
    for (int r = 0; r < 4; r++)
      accS[nt][r] = PASS == 1 ? 0.f : stt[(w4 * 16 + (lane >> 4) * 4 + r) * 64 + nt * 16 + (lane & 15)];
  const int kc = lane, qd = w4;
  float lb = 0.f;
  if (layer == 1) {
    float l0 = p.in[18][(0 * 2 + d) * 256 + h * 64 + kc], l1 = p.in[18][(1 * 2 + d) * 256 + h * 64 + kc];
    float mx = fmaxf(l0, l1);
    float e0 = __expf(l0 - mx), e1 = __expf(l1 - mx);
    lb = e1 / (e0 + e1);
  }
  const float normw = p.in[19][layer * 256 + h * 64 + w4 * 16 + (lane & 15)];
  float bsum = 0.f;
  __syncthreads();
  for (int i = t; i < 64 * 16; i += 256) { KtT[(i >> 4) * HS + 16 + (i & 15)] = 0; VtT[(i >> 4) * HS + 16 + (i & 15)] = 0; }
  for (int i = t; i < 16 * 16; i += 256) Am[(i >> 4) * HS + 16 + (i & 15)] = 0;
  unsigned rlg[16], rvv[4], rqq[4];
  auto fetch = [&](int spn) {
    const int ns = d == 0 ? spn : 15 - spn;
    const u16* pb = proj + (size_t)(b * TT + nc * 256 + ns * 16) * PC;
#pragma unroll
    for (int tau = 0; tau < 16; tau++) rlg[tau] = pb[(size_t)(d == 0 ? tau : 15 - tau) * PC + C_HGF + d * 256 + h * 64 + kc];
#pragma unroll
    for (int e = 0; e < 4; e++) {
      const int tau = qd * 4 + e;
      const u16* pr = pb + (size_t)(d == 0 ? tau : 15 - tau) * PC;
      rvv[e] = pr[C_HGI + h * 64 + kc];
      if (PASS == 2) rqq[e] = pr[C_HGQ + h * 64 + kc];
    }
  };
  fetch(0);
  for (int sp = 0; sp < 16; sp++) {
    const int nsub = d == 0 ? sp : 15 - sp;
    const int rbase = b * TT + nc * 256 + nsub * 16;
    __syncthreads();
    if (PASS == 2 && sp == 0) {
#pragma unroll
      for (int nt = 0; nt < 4; nt++)
        *(uint2*)(St + (nt * 16 + (lane & 15)) * RS + w4 * 16 + (lane >> 4) * 4) =
            make_uint2(pack2(accS[nt][0], accS[nt][1]), pack2(accS[nt][2], accS[nt][3]));
    }
    {
      float bacc = 0.f;
#pragma unroll
      for (int tau = 0; tau < 16; tau++) {
        const float lg = __uint_as_float(rlg[tau] << 16);
        const float f = lb + (1.f - lb) * sigmoidf_(lg);
        bacc += __logf(f);
        if ((tau >> 2) == qd) {
          const float em = __expf(-bacc);
          const u16 kq = f2bf((1.f - f) * em);
          Kt[tau * RS + kc] = kq;
          KtT[kc * HS + tau] = kq;
          VtT[kc * HS + tau] = (u16)rvv[tau & 3];
          if (PASS == 2) Qt[tau * RS + kc] = f2bf(siluf_(__uint_as_float(rqq[tau & 3] << 16)) * __expf(bacc));
        }
      }
      if (qd == 0) { eb[kc] = __expf(bacc); bsum += bacc; }
    }
    __syncthreads();
    if (sp + 1 < 16) fetch(sp + 1);
    f32x4 accO = (f32x4){0.f, 0.f, 0.f, 0.f};
    if (PASS == 2) {
      bf16x8 aq0 = *(const bf16x8*)(Qt + (lane & 15) * RS + (lane >> 4) * 8);
      bf16x8 aq1 = *(const bf16x8*)(Qt + (lane & 15) * RS + 32 + (lane >> 4) * 8);
      if (w4 == 0) {
        f32x4 accA = (f32x4){0.f, 0.f, 0.f, 0.f};
        bf16x8 bk0 = *(const bf16x8*)(Kt + (lane & 15) * RS + (lane >> 4) * 8);
        bf16x8 bk1 = *(const bf16x8*)(Kt + (lane & 15) * RS + 32 + (lane >> 4) * 8);
        accA = __builtin_amdgcn_mfma_f32_16x16x32_bf16(aq0, bk0, accA, 0, 0, 0);
        accA = __builtin_amdgcn_mfma_f32_16x16x32_bf16(aq1, bk1, accA, 0, 0, 0);
#pragma unroll
        for (int r = 0; r < 4; r++) {
          const int tau = (lane >> 4) * 4 + r, sg = lane & 15;
          Am[tau * HS + sg] = sg <= tau ? f2bf(accA[r]) : (u16)0;
        }
      }
      __syncthreads();
      {
        bf16x8 aa = *(const bf16x8*)(Am + (lane & 15) * HS + (lane >> 4) * 8);
        bf16x8 bv = *(const bf16x8*)(VtT + (w4 * 16 + (lane & 15)) * HS + (lane >> 4) * 8);
        accO = __builtin_amdgcn_mfma_f32_16x16x32_bf16(aa, bv, accO, 0, 0, 0);
        bf16x8 bs0 = *(const bf16x8*)(St + (w4 * 16 + (lane & 15)) * RS + (lane >> 4) * 8);
        bf16x8 bs1 = *(const bf16x8*)(St + (w4 * 16 + (lane & 15)) * RS + 32 + (lane >> 4) * 8);
        accO = __builtin_amdgcn_mfma_f32_16x16x32_bf16(aq0, bs0, accO, 0, 0, 0);
        accO = __builtin_amdgcn_mfma_f32_16x16x32_bf16(aq1, bs1, accO, 0, 0, 0);
      }
    }
    {
      bf16x8 ak = *(const bf16x8*)(KtT + (w4 * 16 + (lane & 15)) * HS + (lane >> 4) * 8);
#pragma unroll
      for (int nt = 0; nt < 4; nt++) {
        bf16x8 bv = *(const bf16x8*)(VtT + (nt * 16 + (lane & 15)) * HS + (lane >> 4) * 8);
        accS[nt] = __builtin_amdgcn_mfma_f32_16x16x32_bf16(ak, bv, accS[nt], 0, 0, 0);
      }
      const float4 e4 = *(const float4*)(eb + w4 * 16 + (lane >> 4) * 4);
#pragma unroll
      for (int nt = 0; nt < 4; nt++) { accS[nt][0] *= e4.x; accS[nt][1] *= e4.y; accS[nt][2] *= e4.z; accS[nt][3] *= e4.w; }
    }
    if (PASS == 2) {
      const int cv = h * 64 + w4 * 16 + (lane & 15);
      float o[4];
#pragma unroll
      for (int r = 0; r < 4; r++) {
        const int tau = (lane >> 4) * 4 + r;
        const size_t row = (size_t)(rbase + (d == 0 ? tau : 15 - tau));
        o[r] = accO[r];
        if (d == 1) o[r] += bf2f(proj[row * PC + C_HGF + cv]);
        else proj[row * PC + C_HGF + cv] = f2bf(o[r]);
      }
      if (d == 1) {
#pragma unroll
        for (int r = 0; r < 4; r++) {
          float s2 = allsum16(o[r] * o[r]);
          if ((lane & 15) == 0) ssb[w4 * 16 + (lane >> 4) * 4 + r] = s2;
        }
      }
      __syncthreads();
      if (d == 1) {
#pragma unroll
        for (int r = 0; r < 4; r++) {
          const int tau = (lane >> 4) * 4 + r;
          const size_t row = (size_t)(rbase + 15 - tau);
          const float ss = ssb[tau] + ssb[16 + tau] + ssb[32 + tau] + ssb[48 + tau];
          const float z = bf2f(proj[row * PC + C_HGZ + cv]);
          proj[row * PC + C_HGQ + cv] = f2bf(o[r] * rsqrtf(ss * (1.f / 64.f) + 1e-6f) * normw * siluf_(z));
        }
      }
      if (sp + 1 < 16) {
#pragma unroll
        for (int nt = 0; nt < 4; nt++)
          *(uint2*)(St + (nt * 16 + (lane & 15)) * RS + w4 * 16 + (lane >> 4) * 4) =
              make_uint2(pack2(accS[nt][0], accS[nt][1]), pack2(accS[nt][2], accS[nt][3]));
      }
    }
  }
  if (PASS == 1) {
#pragma unroll
    for (int nt = 0; nt < 4; nt++)
#pragma unroll
      for (int r = 0; r < 4; r++) stt[(w4 * 16 + (lane >> 4) * 4 + r) * 64 + nt * 16 + (lane & 15)] = accS[nt][r];
    if (qd == 0) ((float*)(p.ws + OFF_HGP))[((size_t)dbh * 9 + cstep) * 64 + kc] = __expf(bsum);
  }
}
__device__ void gla_p1_task(const Params& p, int layer, int task, float* lds) {
  int c = task % 9; int q = task / 9; int h = q & 3; q >>= 2; int b = q & 7; q >>= 3; int d = q & 1; int mx = q >> 1;
  if (mx == 0) { const int nc = d == 0 ? c : (c == 0 ? 0 : 9 - c); hg_sweep<1>(p, layer, d, b, h, nc, c, (u16*)lds); }
  else { const int nc = d == 0 ? c : (c == 0 ? 0 : 9 - c); ret_sweep<1>(p, layer, d, b, h, nc, c, (u16*)lds); }
}
__device__ void gla_p2_task(const Params& p, int layer, int mx, int b, int h, int nc, float* lds) {
  int cb = nc == 0 ? 0 : 9 - nc;
  if (mx == 0) { hg_sweep<2>(p, layer, 0, b, h, nc, nc, (u16*)lds); __threadfence_block(); hg_sweep<2>(p, layer, 1, b, h, nc, cb, (u16*)lds); }
  else { ret_sweep<2>(p, layer, 0, b, h, nc, nc, (u16*)lds); __threadfence_block(); ret_sweep<2>(p, layer, 1, b, h, nc, cb, (u16*)lds); }
}
__device__ void gla_carry_task(const Params& p, int layer, int task) {
  int e = task * 256 + tid_();
  int v = e & 63, k = (e >> 6) & 63, dbh = (e >> 12) & 63, mx = e >> 18;
  float* stt = (float*)(p.ws + (mx == 0 ? OFF_HGST : OFF_RTST)) + (size_t)dbh * 9 * 4096 + k * 64 + v;
  const float* P = (const float*)(p.ws + OFF_HGP) + (size_t)dbh * 9 * 64 + k;
  float pg = 1.f;
  if (mx == 1) { int d = dbh >> 5, h = dbh & 3; pg = __expf(-256.f * __expf(p.in[20][((size_t)layer * 2 + d) * 4 + h])); }
  float S = 0.f;
  for (int c = 0; c < 9; c++) {
    float E = stt[(size_t)c * 4096];
    stt[(size_t)c * 4096] = S;
    float pp = mx == 0 ? P[c * 64] : pg;
    S = pp * S + E;
  }
}

__device__ __forceinline__ int s5_bwd_chunk(int nc) { return nc < 4 ? 3 - nc : 39 - nc; }
template <int PASS>
__device__ void s5_task(const Params& p, int layer, int task, float* lds) {
  const int t = tid_(), w = t >> 6, lane = t & 63;
  int gq = task & 3; int q = task >> 2; int nc = q % 36; int b = q / 36;
  const int g = gq * 4 + w;
  float* ubuf = lds + w * 256;
  u16* hbuf = (u16*)(lds + 1024) + w * (16 * 136);
  float* ybuf = lds + 1024 + 4352 + w * 1024;
  u16* proj = (u16*)(p.ws + OFF_PROJ);
  float2* st5 = (float2*)(p.ws + OFF_S5ST);
  bf16x8 cfrag[4];
  if (PASS == 2) {
    const float* cre = p.in[13] + ((size_t)layer * 16 + g) * 16 * 64;
    const float* cim = p.in[14] + ((size_t)layer * 16 + g) * 16 * 64;
    int pp = lane & 15;
#pragma unroll
    for (int ks = 0; ks < 4; ks++)
#pragma unroll
      for (int i = 0; i < 8; i++) {
        int kidx = ks * 32 + (lane >> 4) * 8 + i; int n = kidx >> 1;
        float val = (kidx & 1) ? -cim[pp * 64 + n] : cre[pp * 64 + n];
        cfrag[ks][i] = (short)f2bf(val);
      }
  }
  for (int d = 0; d < 2; d++) {
    float lre = p.in[8][(((size_t)layer * 2 + d) * 16 + g) * 64 + lane];
    float lim = p.in[9][(((size_t)layer * 2 + d) * 16 + g) * 64 + lane];
    float dt = __expf(p.in[10][((size_t)layer * 2 + d) * 16 + g]);
    float mag = __expf(lre * dt);
    float sn, cs; sincosf(lim * dt, &sn, &cs);
    float are = mag * cs, aim = mag * sn;
    float den = 1.f / (lre * lre + lim * lim);
    float cre_ = ((are - 1.f) * lre + aim * lim) * den;
    float cim_ = (aim * lre - (are - 1.f) * lim) * den;
    float bbr[16], bbi[16];
    {
      const float* br = p.in[11] + (((size_t)layer * 16 + g) * 64 + lane) * 16;
      const float* bi = p.in[12] + (((size_t)layer * 16 + g) * 64 + lane) * 16;
#pragma unroll
      for (int i = 0; i < 16; i++) {
        float x = br[i], y = bi[i];
        bbr[i] = cre_ * x - cim_ * y; bbi[i] = cre_ * y + cim_ * x;
      }
    }
    int cstep = d == 0 ? nc : s5_bwd_chunk(nc);
    size_t sidx = ((((size_t)d * 8 + b) * 16 + g) * 36 + cstep) * 64 + lane;
    float hre = 0.f, him = 0.f;
    if (PASS == 2) { float2 h0 = st5[sidx]; hre = h0.x; him = h0.y; }
    uint2 ru;
    auto fetchu = [&](int sub) {
      int st = lane >> 2, p4 = (lane & 3) * 4;
      int jl = d == 0 ? sub * 16 + st : 63 - (sub * 16 + st);
      ru = *(const uint2*)(proj + (size_t)(b * TT + nc * 64 + jl) * PC + C_S5U + g * 16 + p4);
    };
    fetchu(0);
    for (int sub = 0; sub < 4; sub++) {
      __syncthreads();
      {
        int st = lane >> 2, p4 = (lane & 3) * 4;
        *(float4*)(ubuf + st * 16 + p4) = make_float4(__uint_as_float(ru.x << 16), __uint_as_float(ru.x & 0xffff0000u),
                                                       __uint_as_float(ru.y << 16), __uint_as_float(ru.y & 0xffff0000u));
      }
      __syncthreads();
      if (sub + 1 < 4) fetchu(sub + 1);
#pragma unroll 2
      for (int st = 0; st < 16; st++) {
        float bur = 0.f, bui = 0.f;
#pragma unroll
        for (int i4 = 0; i4 < 4; i4++) {
          float4 uu = *(const float4*)(ubuf + st * 16 + i4 * 4);
          bur += bbr[i4*4] * uu.x + bbr[i4*4+1] * uu.y + bbr[i4*4+2] * uu.z + bbr[i4*4+3] * uu.w;
          bui += bbi[i4*4] * uu.x + bbi[i4*4+1] * uu.y + bbi[i4*4+2] * uu.z + bbi[i4*4+3] * uu.w;
        }
        float nre = are * hre - aim * him + bur;
        float nim = are * him + aim * hre + bui;
        hre = nre; him = nim;
        if (PASS == 2) *(unsigned*)(hbuf + st * 136 + lane * 2) = pack2(hre, him);
      }
      if (PASS == 2) {
        __syncthreads();
        f32x4 acc = (f32x4){0.f, 0.f, 0.f, 0.f};
#pragma unroll
        for (int ks = 0; ks < 4; ks++) {
          bf16x8 af = *(const bf16x8*)(hbuf + (lane & 15) * 136 + ks * 32 + (lane >> 4) * 8);
          acc = __builtin_amdgcn_mfma_f32_16x16x32_bf16(af, cfrag[ks], acc, 0, 0, 0);
        }
#pragma unroll
        for (int r = 0; r < 4; r++) {
          int st = (lane >> 4) * 4 + r;
          int jl = d == 0 ? sub * 16 + st : 63 - (sub * 16 + st);
          float* yp = ybuf + jl * 16 + (lane & 15);
          if (d == 0) *yp = acc[r]; else *yp += acc[r];
        }
      }
    }
    if (PASS == 1) st5[sidx] = make_float2(hre, him);
  }
  if (PASS == 2) {
    __syncthreads();
    const float* dsk = p.in[15] + layer * 256 + g * 16;
#pragma unroll
    for (int i = 0; i < 16; i++) {
      int idx = lane + 64 * i; int jl = idx >> 4, pp = idx & 15;
      u16* up = proj + (size_t)(b * TT + nc * 64 + jl) * PC + C_S5U + g * 16 + pp;
      float y = ybuf[jl * 16 + pp] + dsk[pp] * bf2f(*up);
      *up = f2bf(geluf_(y));
    }
  }
}
__device__ void s5_carry_task(const Params& p, int layer, int task) {
  int e = task * 256 + tid_();
  int n = e & 63, g = (e >> 6) & 15, d = e >> 13;
  float lre = p.in[8][(((size_t)layer * 2 + d) * 16 + g) * 64 + n];
  float lim = p.in[9][(((size_t)layer * 2 + d) * 16 + g) * 64 + n];
  float dt = __expf(p.in[10][((size_t)layer * 2 + d) * 16 + g]);
  float mag = __expf(lre * dt * 64.f);
  float sn, cs; sincosf(lim * dt * 64.f, &sn, &cs);
  float are = mag * cs, aim = mag * sn;
  float2* st5 = (float2*)(p.ws + OFF_S5ST) + (size_t)(e >> 6) * 36 * 64 + n;
  float sre = 0.f, sim = 0.f;
  for (int c = 0; c < 36; c++) {
    float2 E = st5[(size_t)c * 64];
    st5[(size_t)c * 64] = make_float2(sre, sim);
    float nre = are * sre - aim * sim + E.x;
    float nim = are * sim + aim * sre + E.y;
    sre = nre; sim = nim;
  }
}

__device__ __forceinline__ void group_barrier(unsigned* cnt, unsigned target) {
  asm volatile("s_waitcnt vmcnt(0)" ::: "memory");
  __syncthreads();
  if (tid_() == 0) {
    __threadfence();
    asm volatile("s_waitcnt vmcnt(0)" ::: "memory");
    __hip_atomic_fetch_add(cnt, 1u, __ATOMIC_RELAXED, __HIP_MEMORY_SCOPE_AGENT);
    while (__hip_atomic_load(cnt, __ATOMIC_RELAXED, __HIP_MEMORY_SCOPE_AGENT) < target) __builtin_amdgcn_s_sleep(2);
    __threadfence();
    asm volatile("s_waitcnt vmcnt(0)" ::: "memory");
  }
  __syncthreads();
}
#define XB_XCNT(j) (64 * (j))
#define XB_XSUB(j) (1024 + 64 * (j))
#define XB_XGEN(j) (2048 + 64 * (j))
#define XB_TOP     3072
#define XB_TOPGEN  3136
#define XB_WORDS   8192
struct XcdBar { unsigned* bar; unsigned x, nloc, nx; };
__device__ __forceinline__ unsigned xb_ld(unsigned* q) { return __hip_atomic_load(q, __ATOMIC_RELAXED, __HIP_MEMORY_SCOPE_AGENT); }
__device__ __forceinline__ unsigned xb_add(unsigned* q, unsigned v) { return __hip_atomic_fetch_add(q, v, __ATOMIC_RELAXED, __HIP_MEMORY_SCOPE_AGENT); }
__device__ __forceinline__ void xcd_barrier(const XcdBar& b) {
  asm volatile("s_waitcnt vmcnt(0)" ::: "memory");
  __syncthreads();
  if (tid_() == 0) {
    unsigned* bar = b.bar;
    __builtin_amdgcn_s_waitcnt(0);
    const unsigned old = xb_add(&bar[XB_XSUB(b.x)], 1u);
    const unsigned gen = old / b.nloc;
    if (old + 1u == (gen + 1u) * b.nloc) {
      __builtin_amdgcn_fence(__ATOMIC_RELEASE, "agent");
      asm volatile("s_waitcnt vmcnt(0)" ::: "memory");
      const unsigned og = xb_add(&bar[XB_TOP], 1u);
      const unsigned tg = og / b.nx;
      if (og + 1u == (tg + 1u) * b.nx) xb_add(&bar[XB_TOPGEN], 1u);
      else while (xb_ld(&bar[XB_TOPGEN]) == tg) __builtin_amdgcn_s_sleep(1);
      __builtin_amdgcn_fence(__ATOMIC_ACQUIRE, "agent");
      xb_add(&bar[XB_XGEN(b.x)], 1u);
      asm volatile("s_waitcnt vmcnt(0)" ::: "memory");
    } else {
      while (xb_ld(&bar[XB_XGEN(b.x)]) == gen) __builtin_amdgcn_s_sleep(1);
      __builtin_amdgcn_fence(__ATOMIC_ACQUIRE, "agent");
      asm volatile("s_waitcnt vmcnt(0)" ::: "memory");
    }
  }
  __syncthreads();
}
#define LDS_FLOATS 18432
#define SYNC() xcd_barrier(xbar)
#define RW_TWO false
#define NRW (RW_TWO ? 128 : 256)

__global__ void __launch_bounds__(256, 2) fwd_megakernel(Params p) {
  cg::grid_group grid = cg::this_grid();
  __shared__ __attribute__((aligned(16))) float lds[LDS_FLOATS];
  const int bid = blockIdx.x, nb = gridDim.x, t = tid_();
  XcdBar xbar; xbar.bar = (unsigned*)(p.ws + OFF_XB); xbar.x = 0; xbar.nloc = 1; xbar.nx = 1;

  if (p.ws == nullptr) grid.sync();
  {
    unsigned xr; asm volatile("s_getreg_b32 %0, hwreg(HW_REG_XCC_ID)" : "=s"(xr));
    xbar.x = xr & 15u;
    if (t == 0) xb_add(&xbar.bar[XB_XCNT(xbar.x)], 1u + ((nb == 512 && bid >= NRW) ? 65536u : 0u));
  }
  for (int task = bid; task < N_CONVERT_TASKS + 192 + 1; task += nb) {
    if (task < 192) mods_task(p, task, lds);
    else if (task == 192) {
      float* rope = (float*)(p.ws + OFF_ROPE);
      for (int i = t; i < 1024; i += 256) {
        int pos = i >> 4, fi = i & 15;
        float fr = powf(10000.f, -(float)fi / 16.f);
        float ang = (float)pos * fr;
        rope[i * 2] = cosf(ang); rope[i * 2 + 1] = sinf(ang);
      }
    } else convert_task(p, 0, task - 193, lds);
  }
  XcdBar pbar; pbar.bar = xbar.bar + 4096; pbar.x = xbar.x; pbar.nloc = 1; pbar.nx = 1;
  if (t == 0) {
    unsigned nx, npx, nlocp;
    for (;;) {
      unsigned sum = 0; nx = 0; npx = 0; nlocp = 0;
#pragma unroll
      for (int j = 0; j < 16; j++) {
        const unsigned w = xb_ld(&xbar.bar[XB_XCNT(j)]);
        const unsigned c = w & 65535u, cp = w >> 16;
        sum += c; nx += c > 0u ? 1u : 0u; npx += cp > 0u ? 1u : 0u;
        if ((unsigned)j == xbar.x) { xbar.nloc = c; nlocp = cp; }
      }
      if (sum == (unsigned)nb) break;
      __builtin_amdgcn_s_sleep(4);
    }
    xbar.nx = nx; pbar.nx = npx > 0u ? npx : 1u; pbar.nloc = nlocp > 0u ? nlocp : 1u;
  }
  SYNC();
  for (int task = bid; task < MROWS / 4; task += nb) ln_row(p, 0, 0, task * 4 + (t >> 6));
  SYNC();

  for (int layer = 0; layer < 2; layer++) {
    const int latonly = layer;
    if ((nb & 7) == 0) { int tm, tn; for (int it = 0; xcd_tile(it, bid, nb, 144, 31, 6, tm, tn); it++) inproj_tile(p, layer, tm, tn, (u16*)lds); }
    else for (int task = bid; task < 144 * 31; task += nb) inproj_tile(p, layer, task / 31, task % 31, (u16*)lds);
    SYNC();
    {
      const int ncg = latonly ? 8 : 9, ncs = latonly ? 32 : 36;
      const int NG = 64 * ncg, NS = 32 * ncs;
      auto p2_task = [&](int task) {
        if (task < NG) {
          int nc = task % ncg + (latonly ? 1 : 0); int q = task / ncg; int h = q & 3; q >>= 2; int b = q & 7; int mx = q >> 3;
          gla_p2_task(p, layer, mx, b, h, nc, lds);
        } else {
          int q = task - NG; int gq = q & 3; q >>= 2; int nc = q % ncs + (latonly ? 4 : 0); int b = q / ncs;
          s5_task<2>(p, layer, ((b * 36 + nc) << 2) | gq, lds);
        }
      };
      if (nb == 512) {
        unsigned* bar = (unsigned*)(p.ws + OFF_BAR);
        const int ng = nb - NRW;
        if (bid < NRW) {
          rwkv_scan32(p, layer, bid, lds);
          if (t == 0) {
            while (xb_ld(&pbar.bar[XB_TOPGEN]) < 2u * layer + 2u) __builtin_amdgcn_s_sleep(8);
            __threadfence();
          }
          __syncthreads();
        } else {
          const int gb = bid - NRW;
          for (int task = gb; task < 2304; task += ng) {
            if (task < 1152) gla_p1_task(p, layer, task, lds); else s5_task<1>(p, layer, task - 1152, lds);
          }
          xcd_barrier(pbar);
          for (int task = gb; task < 2048 + 64; task += ng) {
            if (task < 2048) gla_carry_task(p, layer, task); else s5_carry_task(p, layer, task - 2048);
          }
          xcd_barrier(pbar);
        }
        int* shq = (int*)(lds + LDS_FLOATS - 4);
        for (;;) {
          __syncthreads();
          if (t == 0) *shq = (int)__hip_atomic_fetch_add(bar + 1 + layer, 1u, __ATOMIC_RELAXED, __HIP_MEMORY_SCOPE_AGENT);
          __syncthreads();
          const int task = *shq;
          if (task >= NG + NS) break;
          p2_task(task);
        }
        SYNC();
      } else {
        for (int task = bid; task < NRW + 2304; task += nb) {
          if (task < NRW) rwkv_scan32(p, layer, task, lds);
          else if (task < NRW + 1152) gla_p1_task(p, layer, task - NRW, lds);
          else s5_task<1>(p, layer, task - NRW - 1152, lds);
        }
        SYNC();
        for (int task = bid; task < 2048 + 64; task += nb) {
          if (task < 2048) gla_carry_task(p, layer, task); else s5_carry_task(p, layer, task - 2048);
        }
        SYNC();
        for (int task = bid; task < NG + NS; task += nb) p2_task(task);
        SYNC();
      }
    }
    {
      const int ntm = latonly ? 128 : 144;
      for (int task = bid; task < ntm * 2 + MROWS / 8; task += nb) {
        if (task < ntm * 2) glu_tile(p, layer, latonly, task >> 1, task & 1, (u16*)lds);
        else rwkv_combine_rows(p, layer, (task - ntm * 2) * 8, latonly);
      }
    }
    SYNC();
    {
      const int ntm = latonly ? 128 : 144;
      if ((nb & 7) == 0) { int tm, tn; for (int it = 0; xcd_tile(it, bid, nb, ntm, 16, 8, tm, tn); it++) merge_tile(p, layer, latonly, tm, tn, (u16*)lds); }
      else for (int task = bid; task < ntm * 16; task += nb) merge_tile(p, layer, latonly, task >> 4, task & 15, (u16*)lds);
    }
    SYNC();
    {
      const int ntm = latonly ? 128 : 144;
      if ((nb & 7) == 0) { int tm, tn; for (int it = 0; xcd_tile(it, bid, nb, ntm, 8, 8, tm, tn); it++) outproj_tile(p, layer, latonly, tm, tn, (u16*)lds); }
      else for (int task = bid; task < ntm * 8; task += nb) outproj_tile(p, layer, latonly, task >> 3, task & 7, (u16*)lds);
    }
    SYNC();
    if (layer == 0) {
      for (int task = bid; task < MROWS / 4 + N_CONVERT_TASKS; task += nb) {
        if (task < N_CONVERT_TASKS) convert_task(p, 1, task, lds);
        else ln_row(p, 1, 0, (task - N_CONVERT_TASKS) * 4 + (t >> 6));
      }
      SYNC();
    } else {
      for (int task = bid; task < NBATCH * 2048 / 4; task += nb) {
        int r = task * 4 + (t >> 6); int b = r >> 11, tl = r & 2047;
        ln_row(p, 1, 1, b * TT + 256 + tl);
      }
    }
  }
}

extern "C" void kernel_launch(void* const* d_in, const int* in_sizes, int n_in,
                              void* d_out, int out_size, void* d_ws, size_t ws_size,
                              hipStream_t stream) {
  static int grid_blocks = 0;
  if (!grid_blocks) {
    int dev = 0, cus = 0, per_cu = 0;
    (void)hipGetDevice(&dev);
    (void)hipDeviceGetAttribute(&cus, hipDeviceAttributeMultiprocessorCount, dev);
    (void)hipOccupancyMaxActiveBlocksPerMultiprocessor(&per_cu, fwd_megakernel, 256, 0);
    if (per_cu > 2) per_cu = 2;
    if (per_cu < 1) per_cu = 1;
    grid_blocks = cus * per_cu;
  }
  if (ws_size < WS_NEED) { fprintf(stderr, "workspace too small\n"); return; }
  Params p{};
  for (int i = 0; i < 36; i++) p.in[i] = (const float*)d_in[i];
  p.out = (float*)d_out;
  p.ws = (char*)d_ws;
  (void)hipMemsetAsync((char*)d_ws + OFF_BAR, 0, 256 + 32768, stream);
  void* args[] = {&p};
  hipError_t e = hipLaunchCooperativeKernel((void*)fwd_megakernel, dim3(grid_blocks), dim3(256), args, 0, stream);
  if (e != hipSuccess) fprintf(stderr, "cooperative launch failed: %s (grid %d)\n", hipGetErrorString(e), grid_blocks);
}
```

```cpp
#include <hip/hip_runtime.h>
#include <hip/hip_bf16.h>
#include <hip/hip_cooperative_groups.h>
#include <cstdio>
namespace cg = cooperative_groups;

typedef __attribute__((ext_vector_type(8))) short bf16x8;
typedef __attribute__((ext_vector_type(4))) float f32x4;
typedef unsigned short u16;

#define D_ 1024
#define NBATCH 8
#define TT 2304
#define MROWS 18432
#define PC 3904
#define DIN 8000
#define C_S5U 0
#define C_S5Z 256
#define C_HGQ 512
#define C_HGF 768
#define C_HGI 1280
#define C_HGZ 1536
#define C_RTQ 1792
#define C_RTK 2048
#define C_RTV 2304
#define C_RTZ 2560
#define C_RWX 2816
#define C_RWZ 3648

#define OFF_WINT   0ul
#define OFF_WBT    (OFF_WINT + 16384000ul)
#define OFF_WOT    (OFF_WBT + 2097152ul)
#define OFF_GLUT   (OFF_WOT + 2097152ul)
#define OFF_U      (OFF_GLUT + 131072ul)
#define OFF_PROJ   (OFF_U + 37748736ul)
#define OFF_HCTX   (OFF_PROJ + 143917056ul)
#define OFF_SCR    (OFF_HCTX + 8388608ul)
#define OFF_RWO    (OFF_SCR)
#define OFF_HGST   (OFF_SCR + 18874368ul)
#define OFF_RTST   (OFF_HGST + 9437184ul)
#define OFF_RETOF  (OFF_SCR + 37748736ul)
#define OFF_S5ST   (OFF_RETOF + 9437184ul)
#define OFF_MODS   (OFF_S5ST + 4718592ul)
#define OFF_HGP    (OFF_MODS + 221184ul)
#define OFF_BONUS  (OFF_HGP + 147456ul)
#define OFF_ROPE   (OFF_BONUS + 589824ul)
#define OFF_BAR    (OFF_ROPE + 8192ul)
#define OFF_XB     (OFF_BAR + 256ul)
#define WS_NEED    (OFF_XB + 32768ul)

struct Params {
  const float* in[36];
  float* out;
  char* ws;
};

__device__ __forceinline__ int tid_() { int t = __builtin_amdgcn_workitem_id_x(); asm volatile("" : "+v"(t)); return t; }
__device__ __forceinline__ u16 f2bf(float f) {
  unsigned u = __float_as_uint(f);
  u += 0x7fffu + ((u >> 16) & 1u);
  return (u16)(u >> 16);
}
__device__ __forceinline__ float bf2f(u16 h) { return __uint_as_float(((unsigned)h) << 16); }
__device__ __forceinline__ unsigned pack2(float a, float b) { return (unsigned)f2bf(a) | ((unsigned)f2bf(b) << 16); }
__device__ __forceinline__ float sigmoidf_(float x) { return __builtin_amdgcn_rcpf(1.f + __expf(-x)); }
__device__ __forceinline__ float siluf_(float x) { return x * __builtin_amdgcn_rcpf(1.f + __expf(-x)); }
__device__ __forceinline__ float geluf_(float x) {
  float t = tanhf(0.7978845608028654f * (x + 0.044715f * x * x * x));
  return 0.5f * x * (1.f + t);
}
template <int CTRL>
__device__ __forceinline__ float dppf(float x) {
  return __int_as_float(__builtin_amdgcn_update_dpp(0, __float_as_int(x), CTRL, 0xf, 0xf, true));
}
__device__ __forceinline__ float allsum16(float x) {
  x += dppf<0x128>(x);
  x += dppf<0x124>(x);
  x += dppf<0x122>(x);
  x += dppf<0x121>(x);
  return x;
}
__device__ __forceinline__ float wavesum(float x) {
  x = allsum16(x);
  x += __shfl_xor(x, 16, 64);
  x += __shfl_xor(x, 32, 64);
  return x;
}
__device__ __forceinline__ void ld4bf(const u16* p, float (&o)[4]) {
  uint2 v = *(const uint2*)p;
  o[0] = __uint_as_float(v.x << 16); o[1] = __uint_as_float(v.x & 0xffff0000u);
  o[2] = __uint_as_float(v.y << 16); o[3] = __uint_as_float(v.y & 0xffff0000u);
}
__device__ __forceinline__ void st4bf(u16* p, float a, float b, float c, float d) {
  uint2 v; v.x = pack2(a, b); v.y = pack2(c, d);
  *(uint2*)p = v;
}
__device__ __forceinline__ int jmap(int d, int s) { return d == 0 ? s : (s < 256 ? 255 - s : 2559 - s); }
__device__ __forceinline__ bool has_prev(int j) { return j != 0 && j != 256; }
__device__ __forceinline__ bool has_next(int j) { return j != 255 && j != 2303; }

__device__ __forceinline__ const float* hin_ptr(const Params& p, int layer, int row) {
  int b = row / TT, j = row - b * TT;
  if (layer == 0) return j < 256 ? p.in[2] + ((size_t)(b * 256 + j)) * D_ : p.in[0] + ((size_t)(b * 2048 + j - 256)) * D_;
  return j < 256 ? (const float*)(p.ws + OFF_HCTX) + ((size_t)(b * 256 + j)) * D_ : p.out + ((size_t)(b * 2048 + j - 256)) * D_;
}
__device__ __forceinline__ float* hout_ptr(const Params& p, int row) {
  int b = row / TT, j = row - b * TT;
  return j < 256 ? (float*)(p.ws + OFF_HCTX) + ((size_t)(b * 256 + j)) * D_ : p.out + ((size_t)(b * 2048 + j - 256)) * D_;
}
__device__ __forceinline__ int modrow_of(int row) { int b = row / TT, j = row - b * TT; return j < 256 ? 8 : b; }

__device__ void transpose_tile(const float* __restrict__ src, u16* __restrict__ dst, int K, int N, int k0, int n0, float* lds) {
  const int t = tid_();
  __syncthreads();
#pragma unroll
  for (int i = 0; i < 16; i++) {
    int r = i * 4 + (t >> 6), c = t & 63;
    lds[r * 65 + c] = src[(size_t)(k0 + r) * N + n0 + c];
  }
  __syncthreads();
#pragma unroll
  for (int i = 0; i < 16; i++) {
    int r = i * 4 + (t >> 6), c = t & 63;
    dst[(size_t)(n0 + r) * K + k0 + c] = f2bf(lds[c * 65 + r]);
  }
}
__device__ void convert_task(const Params& p, int layer, int task, float* lds) {
  if (task < 2000) {
    int kt = task / 125, nt = task % 125;
    transpose_tile(p.in[6] + (size_t)layer * 1024 * DIN, (u16*)(p.ws + OFF_WINT), 1024, DIN, kt * 64, nt * 64, lds);
  } else if (task < 2256) {
    int q = task - 2000; int br = q >> 6; q &= 63; int kt = q >> 4, nt = q & 15;
    transpose_tile(p.in[31] + ((size_t)layer * 4 + br) * 256 * 1024, (u16*)(p.ws + OFF_WBT) + (size_t)br * 1024 * 256, 256, 1024, kt * 64, nt * 64, lds);
  } else if (task < 2512) {
    int q = task - 2256; int kt = q >> 4, nt = q & 15;
    transpose_tile(p.in[32] + (size_t)layer * 1024 * 1024, (u16*)(p.ws + OFF_WOT), 1024, 1024, kt * 64, nt * 64, lds);
  } else {
    int q = task - 2512; int kt = q >> 2, nt = q & 3;
    transpose_tile(p.in[16] + (size_t)layer * 256 * 256, (u16*)(p.ws + OFF_GLUT), 256, 256, kt * 64, nt * 64, lds);
  }
}
#define N_CONVERT_TASKS 2528

__device__ void mods_task(const Params& p, int task, float* lds) {
  const int t = tid_();
  int layer = task / 96, cgp = task % 96;
  float* sc = lds;
  float* red = lds + 9 * 1024;
  __syncthreads();
  for (int i = t; i < 9 * 1024; i += 256) {
    int r = i >> 10, k = i & 1023;
    float v = r < 8 ? p.in[1][r * 1024 + k] : p.in[3][k];
    sc[i] = siluf_(v);
  }
  __syncthreads();
  const int cl = t & 31, kq = t >> 5;
  int col = cgp * 32 + cl;
  float acc[9];
#pragma unroll
  for (int r = 0; r < 9; r++) acc[r] = 0.f;
  const float* wp = p.in[4] + (size_t)layer * 1024 * 3072 + col;
#pragma unroll 16
  for (int k = kq * 128; k < kq * 128 + 128; k++) {
    float w = wp[(size_t)k * 3072];
#pragma unroll
    for (int r = 0; r < 9; r++) acc[r] += sc[r * 1024 + k] * w;
  }
#pragma unroll
  for (int r = 0; r < 9; r++) red[(kq * 9 + r) * 32 + cl] = acc[r];
  __syncthreads();
  float* mods = (float*)(p.ws + OFF_MODS);
  for (int i = t; i < 9 * 32; i += 256) {
    int r = i >> 5, c = i & 31;
    float s_ = 0.f;
#pragma unroll
    for (int g = 0; g < 8; g++) s_ += red[(g * 9 + r) * 32 + c];
    int cc = cgp * 32 + c;
    mods[((size_t)layer * 9 + r) * 3072 + cc] = s_ + p.in[5][layer * 3072 + cc];
  }
}

__device__ void ln_row(const Params& p, int mode, int layer, int row) {
  const int lane = tid_() & 63;
  float v[16];
  if (mode == 0) {
    const float* src = hin_ptr(p, 0, row);
#pragma unroll
    for (int i = 0; i < 4; i++) { float4 q = *(const float4*)(src + i * 256 + lane * 4); v[i*4]=q.x; v[i*4+1]=q.y; v[i*4+2]=q.z; v[i*4+3]=q.w; }
  } else {
    float* src = hout_ptr(p, row);
#pragma unroll
    for (int i = 0; i < 4; i++) { float4 q = *(const float4*)(src + i * 256 + lane * 4); v[i*4]=q.x; v[i*4+1]=q.y; v[i*4+2]=q.z; v[i*4+3]=q.w; }
    float s = 0.f;
#pragma unroll
    for (int i = 0; i < 16; i++) s += v[i];
    float mean = wavesum(s) * (1.f / 1024.f);
    float q2 = 0.f;
#pragma unroll
    for (int i = 0; i < 16; i++) { v[i] -= mean; q2 += v[i] * v[i]; }
    float rstd = rsqrtf(wavesum(q2) * (1.f / 1024.f) + 1e-5f);
    const float* lw = p.in[34] + layer * 1024; const float* lb = p.in[35] + layer * 1024;
#pragma unroll
    for (int i = 0; i < 4; i++) {
      float4 w4 = *(const float4*)(lw + i * 256 + lane * 4), b4 = *(const float4*)(lb + i * 256 + lane * 4);
      v[i*4] = v[i*4] * rstd * w4.x + b4.x; v[i*4+1] = v[i*4+1] * rstd * w4.y + b4.y;
      v[i*4+2] = v[i*4+2] * rstd * w4.z + b4.z; v[i*4+3] = v[i*4+3] * rstd * w4.w + b4.w;
      *(float4*)(src + i * 256 + lane * 4) = make_float4(v[i*4], v[i*4+1], v[i*4+2], v[i*4+3]);
    }
    if (layer == 1) return;
  }
  int ml = mode == 0 ? 0 : 1;
  float s = 0.f;
#pragma unroll
  for (int i = 0; i < 16; i++) s += v[i];
  float mean = wavesum(s) * (1.f / 1024.f);
  float q2 = 0.f;
#pragma unroll
  for (int i = 0; i < 16; i++) { v[i] -= mean; q2 += v[i] * v[i]; }
  float rstd = rsqrtf(wavesum(q2) * (1.f / 1024.f) + 1e-5f);
  const float* md = (const float*)(p.ws + OFF_MODS) + ((size_t)ml * 9 + modrow_of(row)) * 3072;
  u16* up = (u16*)(p.ws + OFF_U) + (size_t)row * 1024;
#pragma unroll
  for (int i = 0; i < 4; i++) {
    float4 sh = *(const float4*)(md + i * 256 + lane * 4), sc = *(const float4*)(md + 1024 + i * 256 + lane * 4);
    st4bf(up + i * 256 + lane * 4, v[i*4] * rstd * (1.f + sc.x) + sh.x, v[i*4+1] * rstd * (1.f + sc.y) + sh.y,
          v[i*4+2] * rstd * (1.f + sc.z) + sh.z, v[i*4+3] * rstd * (1.f + sc.w) + sh.w);
  }
}

#define STAGE_LOAD(P, kk_) do { const unsigned k_ = (kk_); \
  P##a0 = *(const uint4*)(A + (oa + k_)); P##a1 = *(const uint4*)(A + (oa + sa + k_)); \
  P##a2 = *(const uint4*)(A + (oa + 2 * sa + k_)); P##a3 = *(const uint4*)(A + (oa + 3 * sa + k_)); \
  P##b0 = *(const uint4*)(B + (ob + k_)); P##b1 = *(const uint4*)(B + (ob + sb + k_)); \
  if (NT == 4) { P##b2 = *(const uint4*)(B + (ob + 2 * sb + k_)); P##b3 = *(const uint4*)(B + (ob + 3 * sb + k_)); } } while (0)
#define STAGE_WRITE(P, Asw, Bsw) do { \
  *(uint4*)(Asw) = P##a0; *(uint4*)((Asw) + 32 * 72) = P##a1; *(uint4*)((Asw) + 64 * 72) = P##a2; *(uint4*)((Asw) + 96 * 72) = P##a3; \
  *(uint4*)(Bsw) = P##b0; *(uint4*)((Bsw) + 32 * 72) = P##b1; \
  if (NT == 4) { *(uint4*)((Bsw) + 64 * 72) = P##b2; *(uint4*)((Bsw) + 96 * 72) = P##b3; } } while (0)
template <int MT, int NT>
__device__ __forceinline__ void stage_compute(f32x4 (&acc)[MT][NT], const u16* As, const u16* Bs, int lane, int wm, int wn) {
#pragma unroll
  for (int kk = 0; kk < 2; kk++) {
    bf16x8 af[MT], bfr[NT];
#pragma unroll
    for (int mt = 0; mt < MT; mt++) af[mt] = *(const bf16x8*)(As + (wm * MT * 16 + mt * 16 + (lane & 15)) * 72 + kk * 32 + (lane >> 4) * 8);
#pragma unroll
    for (int nt = 0; nt < NT; nt++) bfr[nt] = *(const bf16x8*)(Bs + (wn * NT * 16 + nt * 16 + (lane & 15)) * 72 + kk * 32 + (lane >> 4) * 8);
    __builtin_amdgcn_s_setprio(1);
#pragma unroll
    for (int mt = 0; mt < MT; mt++)
#pragma unroll
      for (int nt = 0; nt < NT; nt++)
        acc[mt][nt] = __builtin_amdgcn_mfma_f32_16x16x32_bf16(af[mt], bfr[nt], acc[mt][nt], 0, 0, 0);
    __builtin_amdgcn_s_setprio(0);
  }
}
template <int MT, int NT>
__device__ __forceinline__ void gemm_kloop(f32x4 (&acc)[MT][NT], const u16* __restrict__ A, int lda,
                                           const u16* __restrict__ B, int ldb, int K, u16* lds) {
  static_assert(MT == 4, "MT");
  constexpr int BM = MT * 32, BN = NT * 32, SS = (BM + BN) * 72;
  const int t = tid_(), lane = t & 63, w = t >> 6, wm = w >> 1, wn = w & 1;
  u16* As0 = lds; u16* Bs0 = lds + BM * 72; u16* As1 = lds + SS; u16* Bs1 = lds + SS + BM * 72;
  const int lr = t >> 3, lc = (t & 7) * 8;
  const unsigned oa = (unsigned)(lr * lda + lc), ob = (unsigned)(lr * ldb + lc);
  const unsigned sa = 32u * (unsigned)lda, sb = 32u * (unsigned)ldb;
  const int swo = lr * 72 + lc;
  const unsigned klast = (unsigned)(K - 64);
  uint4 R0a0, R0a1, R0a2, R0a3, R0b0, R0b1, R0b2, R0b3, R1a0, R1a1, R1a2, R1a3, R1b0, R1b1, R1b2, R1b3;
  STAGE_LOAD(R0, 0u);
  STAGE_LOAD(R1, 64u);
  __syncthreads();
  STAGE_WRITE(R0, As0 + swo, Bs0 + swo);
  STAGE_LOAD(R0, 128u < klast ? 128u : klast);
  __syncthreads();
#pragma unroll 1
  for (int k0 = 0; k0 < K; k0 += 128) {
    STAGE_WRITE(R1, As1 + swo, Bs1 + swo);
    { unsigned kn = (unsigned)k0 + 192u; STAGE_LOAD(R1, kn < klast ? kn : klast); }
    stage_compute<MT, NT>(acc, As0, Bs0, lane, wm, wn);
    __syncthreads();
    STAGE_WRITE(R0, As0 + swo, Bs0 + swo);
    { unsigned kn = (unsigned)k0 + 256u; STAGE_LOAD(R0, kn < klast ? kn : klast); }
    stage_compute<MT, NT>(acc, As1, Bs1, lane, wm, wn);
    __syncthreads();
  }
}
template <int MT, int NT>
__device__ __forceinline__ void zero_acc(f32x4 (&acc)[MT][NT]) {
#pragma unroll
  for (int i = 0; i < MT; i++)
#pragma unroll
    for (int j = 0; j < NT; j++) acc[i][j] = (f32x4){0.f, 0.f, 0.f, 0.f};
}
__device__ __forceinline__ int tile_m0(int latonly, int tm) {
  if (!latonly) return tm * 128;
  int b = tm >> 4; return b * TT + 256 + (tm & 15) * 128;
}

__device__ __forceinline__ bool xcd_tile(int it, int bid, int nb, int NTM, int NTN, int G, int& tm, int& tn) {
  const int xcd = bid & 7, lb = bid >> 3, nlb = nb >> 3, tmx = NTM >> 3;
  const int idx = it * nlb + lb;
  if (idx >= tmx * NTN) return false;
  const int full = tmx / G;
  int g = idx / (G * NTN);
  if (g > full) g = full;
  const int r = idx - g * G * NTN;
  const int gs = (g < full) ? G : (tmx - full * G);
  tn = r / gs;
  tm = xcd * tmx + g * G + (r - tn * gs);
  return true;
}
__device__ void inproj_tile(const Params& p, int layer, int tm, int tn, u16* lds) {
  int m0 = tm * 128, n0 = tn * 128;
  f32x4 acc[4][4]; zero_acc(acc);
  gemm_kloop<4, 4>(acc, (const u16*)(p.ws + OFF_U) + (size_t)m0 * 1024, 1024,
                   (const u16*)(p.ws + OFF_WINT) + (size_t)n0 * 1024, 1024, 1024, lds);
  const int t = tid_(), lane = t & 63, w = t >> 6, wm = w >> 1, wn = w & 1;
  const float* bias = p.in[7] + (size_t)layer * DIN;
  u16* proj = (u16*)(p.ws + OFF_PROJ);
#pragma unroll
  for (int nt = 0; nt < 4; nt++) {
    const int cl = wn * 64 + nt * 16 + (lane & 15);
    const float bv = (n0 + cl < PC) ? bias[n0 + cl] : 0.f;
#pragma unroll
    for (int mt = 0; mt < 4; mt++)
#pragma unroll
      for (int r = 0; r < 4; r++) lds[(wm * 64 + mt * 16 + (lane >> 4) * 4 + r) * 136 + cl] = f2bf(acc[mt][nt][r] + bv);
  }
  __syncthreads();
#pragma unroll
  for (int i = 0; i < 8; i++) {
    const int q = t + 256 * i, row = q >> 4, ch = q & 15;
    if (n0 + ch * 8 < PC) *(uint4*)(proj + (size_t)(m0 + row) * PC + n0 + ch * 8) = *(const uint4*)(lds + row * 136 + ch * 8);
  }
}
__device__ void glu_tile(const Params& p, int layer, int latonly, int tm, int tn, u16* lds) {
  int m0 = tile_m0(latonly, tm), n0 = tn * 128;
  f32x4 acc[4][4]; zero_acc(acc);
  u16* proj = (u16*)(p.ws + OFF_PROJ);
  gemm_kloop<4, 4>(acc, proj + (size_t)m0 * PC + C_S5U, PC, (const u16*)(p.ws + OFF_GLUT) + (size_t)n0 * 256, 256, 256, lds);
  const int t = tid_(), lane = t & 63, w = t >> 6, wm = w >> 1, wn = w & 1;
  const float* bias = p.in[17] + layer * 256;
#pragma unroll
  for (int nt = 0; nt < 4; nt++) {
    const int cl = wn * 64 + nt * 16 + (lane & 15);
    const float bv = bias[n0 + cl];
#pragma unroll
    for (int mt = 0; mt < 4; mt++)
#pragma unroll
      for (int r = 0; r < 4; r++) lds[(wm * 64 + mt * 16 + (lane >> 4) * 4 + r) * 136 + cl] = f2bf(sigmoidf_(acc[mt][nt][r] + bv));
  }
  __syncthreads();
#pragma unroll
  for (int i = 0; i < 8; i++) {
    const int q = t + 256 * i, row = q >> 4, ch = q & 15;
    u16* pr = proj + (size_t)(m0 + row) * PC + n0 + ch * 8;
    uint4 sg = *(const uint4*)(lds + row * 136 + ch * 8);
    uint4 yy = *(const uint4*)(pr + C_S5U), zz = *(const uint4*)(pr + C_S5Z), oo;
    const unsigned* sgp = (const unsigned*)&sg; const unsigned* yp = (const unsigned*)&yy; const unsigned* zp = (const unsigned*)&zz; unsigned* op = (unsigned*)&oo;
#pragma unroll
    for (int e = 0; e < 4; e++) {
      float s0 = __uint_as_float(sgp[e] << 16), s1 = __uint_as_float(sgp[e] & 0xffff0000u);
      float y0 = __uint_as_float(yp[e] << 16), y1 = __uint_as_float(yp[e] & 0xffff0000u);
      float z0 = __uint_as_float(zp[e] << 16), z1 = __uint_as_float(zp[e] & 0xffff0000u);
      op[e] = pack2(y0 * s0 * siluf_(z0), y1 * s1 * siluf_(z1));
    }
    *(uint4*)(pr + C_S5Z) = oo;
  }
}
__device__ void merge_tile(const Params& p, int layer, int latonly, int tm, int tn, u16* lds) {
  constexpr int NT = 2;
  int m0 = tile_m0(latonly, tm), n0 = tn * 64;
  f32x4 accm[4][2]; zero_acc(accm);
  f32x4 accb[4][2]; zero_acc(accb);
  f32x4 accg[4][2]; zero_acc(accg);
  const u16* proj = (const u16*)(p.ws + OFF_PROJ);
  const u16* ub = (const u16*)(p.ws + OFF_U) + (size_t)m0 * 1024;
  const u16* wbt = (const u16*)(p.ws + OFF_WBT) + (size_t)n0 * 256;
  const u16* wgt = (const u16*)(p.ws + OFF_WINT) + ((size_t)PC + n0) * 1024;
  const int t = tid_(), lane = t & 63, w = t >> 6, wm = w >> 1, wn = w & 1;
  const float* bias = p.in[7] + (size_t)layer * DIN + PC;
  constexpr int SS = (128 + 64) * 72;
  u16* As0 = lds; u16* Bs0 = lds + 128 * 72; u16* As1 = lds + SS; u16* Bs1 = lds + SS + 128 * 72;
  const int lr = t >> 3, lc = (t & 7) * 8;
  const int swo = lr * 72 + lc;
  const unsigned oay = (unsigned)(lr * PC + lc), oau = (unsigned)(lr * 1024 + lc), obb = (unsigned)(lr * 256 + lc), obg = (unsigned)(lr * 1024 + lc);
  uint4 R0a0, R0a1, R0a2, R0a3, R0b0, R0b1, R0b2, R0b3, R1a0, R1a1, R1a2, R1a3, R1b0, R1b1, R1b2, R1b3;
  const u16* W = (const u16*)p.ws;
  const unsigned baseY = (unsigned)(OFF_PROJ / 2) + (unsigned)m0 * PC + oay;
  const unsigned baseU = (unsigned)(OFF_U / 2) + (unsigned)m0 * 1024u + oau;
  const unsigned baseB = (unsigned)(OFF_WBT / 2) + (unsigned)n0 * 256u + obb;
  const unsigned baseG = (unsigned)(OFF_WINT / 2) + ((unsigned)PC + (unsigned)n0) * 1024u + obg;
#define MLOAD(P, step_) do { int s_ = (step_); if (s_ > 79) s_ = 79; const int k_ = s_ / 20, r_ = s_ - k_ * 20; \
    const bool br_ = r_ < 4; \
    const unsigned yc_ = k_ == 0 ? C_S5Z : (k_ == 1 ? C_HGQ : (k_ == 2 ? C_RTQ : C_RWZ)); \
    const unsigned ao_ = br_ ? baseY + yc_ + 64u * r_ : baseU + 64u * (r_ - 4); \
    const unsigned bo_ = br_ ? baseB + (unsigned)k_ * 262144u + 64u * r_ : baseG + (unsigned)k_ * 1048576u + 64u * (r_ - 4); \
    const unsigned sa_ = br_ ? 32u * PC : 32768u, sb_ = br_ ? 8192u : 32768u; \
    P##a0 = *(const uint4*)(W + ao_); P##a1 = *(const uint4*)(W + (ao_ + sa_)); \
    P##a2 = *(const uint4*)(W + (ao_ + 2 * sa_)); P##a3 = *(const uint4*)(W + (ao_ + 3 * sa_)); \
    P##b0 = *(const uint4*)(W + bo_); P##b1 = *(const uint4*)(W + (bo_ + sb_)); } while (0)
  MLOAD(R0, 0);
  MLOAD(R1, 1);
  __syncthreads();
  STAGE_WRITE(R0, As0 + swo, Bs0 + swo);
  MLOAD(R0, 2);
  __syncthreads();
#define MPAIR(ACC) do { \
    STAGE_WRITE(R1, As1 + swo, Bs1 + swo); \
    MLOAD(R1, st + 3); \
    stage_compute<4, 2>(ACC, As0, Bs0, lane, wm, wn); \
    __syncthreads(); \
    STAGE_WRITE(R0, As0 + swo, Bs0 + swo); \
    MLOAD(R0, st + 4); \
    stage_compute<4, 2>(ACC, As1, Bs1, lane, wm, wn); \
    __syncthreads(); \
    st += 2; } while (0)
  int st = 0;
#pragma unroll 1
  for (int k = 0; k < 4; k++) {
#pragma unroll 1
    for (int i = 0; i < 2; i++) MPAIR(accb);
#pragma unroll 1
    for (int i = 0; i < 8; i++) MPAIR(accg);
#pragma unroll
    for (int nt = 0; nt < 2; nt++) {
      float bv = bias[k * 1024 + n0 + wn * 32 + nt * 16 + (lane & 15)];
#pragma unroll
      for (int mt = 0; mt < 4; mt++)
#pragma unroll
        for (int rr = 0; rr < 4; rr++) accm[mt][nt][rr] += sigmoidf_(accg[mt][nt][rr] + bv) * accb[mt][nt][rr];
    }
    zero_acc(accb); zero_acc(accg);
  }
#undef MPAIR
#undef MLOAD
  u16* mg = (u16*)(p.ws + OFF_SCR);
#pragma unroll
  for (int nt = 0; nt < 2; nt++) {
    const int cl = wn * 32 + nt * 16 + (lane & 15);
#pragma unroll
    for (int mt = 0; mt < 4; mt++)
#pragma unroll
      for (int r = 0; r < 4; r++) lds[(wm * 64 + mt * 16 + (lane >> 4) * 4 + r) * 72 + cl] = f2bf(accm[mt][nt][r]);
  }
  __syncthreads();
  {
    const int t = tid_();
#pragma unroll
    for (int i = 0; i < 4; i++) {
      const int q = t + 256 * i, row = q >> 3, ch = q & 7;
      *(uint4*)(mg + (size_t)(m0 + row) * 1024 + n0 + ch * 8) = *(const uint4*)(lds + row * 72 + ch * 8);
    }
  }
}
__device__ void outproj_tile(const Params& p, int layer, int latonly, int tm, int tn, u16* lds) {
  int m0 = tile_m0(latonly, tm), n0 = tn * 128;
  f32x4 acc[4][4]; zero_acc(acc);
  gemm_kloop<4, 4>(acc, (const u16*)(p.ws + OFF_SCR) + (size_t)m0 * 1024, 1024,
                   (const u16*)(p.ws + OFF_WOT) + (size_t)n0 * 1024, 1024, 1024, lds);
  const int lane = tid_() & 63, w = tid_() >> 6, wm = w >> 1, wn = w & 1;
  const float* bias = p.in[33] + layer * 1024;
  const float* hi0 = hin_ptr(p, layer, m0);
  float* ho0 = hout_ptr(p, m0);
  const float* gate = (const float*)(p.ws + OFF_MODS) + ((size_t)layer * 9 + modrow_of(m0)) * 3072 + 2048;
  float* cs = (float*)lds;
#pragma unroll
  for (int nt = 0; nt < 4; nt++) {
    const int cl = wn * 64 + nt * 16 + (lane & 15);
    const float bv = bias[n0 + cl];
#pragma unroll
    for (int mt = 0; mt < 4; mt++)
#pragma unroll
      for (int r = 0; r < 4; r++) cs[(wm * 64 + mt * 16 + (lane >> 4) * 4 + r) * 132 + cl] = acc[mt][nt][r] + bv;
  }
  __syncthreads();
  {
    const int t = tid_();
#pragma unroll 4
    for (int i = 0; i < 16; i++) {
      const int q = t + 256 * i, row = q >> 5, ch = q & 31;
      const float4 a4 = *(const float4*)(cs + row * 132 + ch * 4);
      const float4 g4 = *(const float4*)(gate + n0 + ch * 4);
      const float4 h4 = *(const float4*)(hi0 + (size_t)row * 1024 + n0 + ch * 4);
      float4 o4;
      o4.x = 1.4142135623730951f * h4.x + g4.x * a4.x; o4.y = 1.4142135623730951f * h4.y + g4.y * a4.y;
      o4.z = 1.4142135623730951f * h4.z + g4.z * a4.z; o4.w = 1.4142135623730951f * h4.w + g4.w * a4.w;
      *(float4*)(ho0 + (size_t)row * 1024 + n0 + ch * 4) = o4;
    }
  }
}

template <bool TWO>
__device__ void rwkv_scan_task(const Params& p, int layer, int task, float* lds) {
  const int t = tid_();
  const int rh = TWO ? (task & 1) : (task & 3), h = TWO ? ((task >> 1) & 3) : ((task >> 2) & 3);
  const int b = TWO ? ((task >> 3) & 7) : ((task >> 4) & 7), d = TWO ? (task >> 6) : (task >> 7);
  constexpr int RPB = TWO ? 32 : 16;
  float* sh_lora = lds;
  float* sh_w2 = sh_lora + 512;
  float* sh_a2 = sh_w2 + 1024;
  float* sh_r = sh_a2 + 1024;
  float* sh_w = sh_r + 1024;
  float* sh_k = sh_w + 1024;
  float* sh_kk = sh_k + 1024;
  float* sh_b = sh_kk + 1024;
  float* sh_v = sh_b + 1024;
  float* sh_o = sh_v + 512;
  const u16* proj = (const u16*)(p.ws + OFF_PROJ);
  u16* rwo = (u16*)(p.ws + OFF_RWO) + (size_t)d * MROWS * 256;
  float* bonus = (float*)(p.ws + OFF_BONUS) + (size_t)d * MROWS * 4;
  const float* mu0 = p.in[21] + (size_t)layer * 2 * 832;
  const float* mu1 = mu0 + 832;
  __syncthreads();
  for (int i = t; i < 1024; i += 256) {
    int rr = i >> 6, c = i & 63;
    sh_w2[i] = p.in[23][(((size_t)layer * 2 + d) * 16 + rr) * 256 + h * 64 + c];
    sh_a2[i] = p.in[25][(((size_t)layer * 2 + d) * 16 + rr) * 256 + h * 64 + c];
  }
  const int pst = t >> 4, cq = t & 15;
  const int ch0 = h * 64 + cq * 4;
  float mur0[4], mur1[4], muk0[4], muk1[4], w0v[4], a0v[4], kkw[4], kaw[4], rkw[4];
#pragma unroll
  for (int i = 0; i < 4; i++) {
    mur0[i] = mu0[ch0 + i]; mur1[i] = mu1[ch0 + i];
    muk0[i] = mu0[256 + ch0 + i]; muk1[i] = mu1[256 + ch0 + i];
    w0v[i] = p.in[22][((size_t)layer * 2 + d) * 256 + ch0 + i];
    a0v[i] = p.in[24][((size_t)layer * 2 + d) * 256 + ch0 + i];
    kkw[i] = p.in[26][layer * 256 + ch0 + i];
    kaw[i] = p.in[27][layer * 256 + ch0 + i];
    rkw[i] = p.in[28][layer * 256 + ch0 + i];
  }
  const int vch = 512 + h * 64 + rh * RPB + cq;
  const float muv0 = mu0[vch], muv1 = mu1[vch], muw0 = TWO ? mu0[vch + 16] : 0.f, muw1 = TWO ? mu1[vch + 16] : 0.f;
  const int lidx0 = t * 2;
  float lmu00, lmu01, lmu10, lmu11;
  {
    int q = lidx0 & 31;
    int col = q < 16 ? (768 + d * 16 + q) : (800 + d * 16 + (q - 16));
    lmu00 = mu0[col]; lmu01 = mu0[col + 1]; lmu10 = mu1[col]; lmu11 = mu1[col + 1];
  }
  const int rl = t >> 4, ks = t & 15;
  float4 S = make_float4(0.f, 0.f, 0.f, 0.f), S2 = make_float4(0.f, 0.f, 0.f, 0.f);
  unsigned lx0 = 0, lx1 = 0, lxp0 = 0, lxp1 = 0, lxn0 = 0, lxn1 = 0;
  uint2 rr_c, rr_p, rr_n, rk_c, rk_p, rk_n;
  unsigned rv_c, rv_p, rv_n, rw_c = 0, rw_p = 0, rw_n = 0;
  auto fetch = [&](int s0) {
    {
      int st2 = lidx0 >> 5, q = lidx0 & 31;
      int j = jmap(d, s0 + st2);
      int col = q < 16 ? (768 + d * 16 + q) : (800 + d * 16 + (q - 16));
      const u16* pr = proj + ((size_t)(b * TT + j)) * PC + C_RWX + col;
      const u16* prp = has_prev(j) ? pr - PC : pr;
      const u16* prn = has_next(j) ? pr + PC : pr;
      lx0 = pr[0]; lx1 = pr[1]; lxp0 = prp[0]; lxp1 = prp[1]; lxn0 = prn[0]; lxn1 = prn[1];
    }
    int j = jmap(d, s0 + pst);
    const u16* pr = proj + ((size_t)(b * TT + j)) * PC + C_RWX;
    const u16* prp = has_prev(j) ? pr - PC : pr;
    const u16* prn = has_next(j) ? pr + PC : pr;
    rr_c = *(const uint2*)(pr + ch0); rr_p = *(const uint2*)(prp + ch0); rr_n = *(const uint2*)(prn + ch0);
    rk_c = *(const uint2*)(pr + 256 + ch0); rk_p = *(const uint2*)(prp + 256 + ch0); rk_n = *(const uint2*)(prn + 256 + ch0);
    rv_c = pr[vch]; rv_p = prp[vch]; rv_n = prn[vch];
    if (TWO) { rw_c = pr[vch + 16]; rw_p = prp[vch + 16]; rw_n = prn[vch + 16]; }
  };
  auto unpack4 = [](uint2 v, float (&o)[4]) {
    o[0] = __uint_as_float(v.x << 16); o[1] = __uint_as_float(v.x & 0xffff0000u);
    o[2] = __uint_as_float(v.y << 16); o[3] = __uint_as_float(v.y & 0xffff0000u);
  };
  fetch(0);
  for (int s0 = 0; s0 < TT; s0 += 16) {
    {
      int st2 = lidx0 >> 5, q = lidx0 & 31;
      int ja = jmap(d, s0 + st2);
      const float hpa = has_prev(ja) ? 1.f : 0.f, hna = has_next(ja) ? 1.f : 0.f;
      float x0 = __uint_as_float(lx0 << 16), x1 = __uint_as_float(lx1 << 16);
      float xs0 = x0 + lmu00 * (__uint_as_float(lxp0 << 16) * hpa - x0) + lmu10 * (__uint_as_float(lxn0 << 16) * hna - x0);
      float xs1 = x1 + lmu01 * (__uint_as_float(lxp1 << 16) * hpa - x1) + lmu11 * (__uint_as_float(lxn1 << 16) * hna - x1);
      if (q < 16) {
        xs0 = 1.f - 2.f * __builtin_amdgcn_rcpf(__expf(2.f * xs0) + 1.f);
        xs1 = 1.f - 2.f * __builtin_amdgcn_rcpf(__expf(2.f * xs1) + 1.f);
      }
      *(float2*)(sh_lora + lidx0) = make_float2(xs0, xs1);
    }
    __syncthreads();
    const int jcur = jmap(d, s0 + pst);
    {
      const float hpf = has_prev(jcur) ? 1.f : 0.f, hnf = has_next(jcur) ? 1.f : 0.f;
      float r4[4], k4[4], t0[4], t1[4];
      unpack4(rr_c, r4); unpack4(rr_p, t0); unpack4(rr_n, t1);
#pragma unroll
      for (int i = 0; i < 4; i++) r4[i] = r4[i] + mur0[i] * (t0[i] * hpf - r4[i]) + mur1[i] * (t1[i] * hnf - r4[i]);
      unpack4(rk_c, k4); unpack4(rk_p, t0); unpack4(rk_n, t1);
#pragma unroll
      for (int i = 0; i < 4; i++) k4[i] = k4[i] + muk0[i] * (t0[i] * hpf - k4[i]) + muk1[i] * (t1[i] * hnf - k4[i]);
      float wl[4], al[4];
#pragma unroll
      for (int i = 0; i < 4; i++) { wl[i] = w0v[i]; al[i] = a0v[i]; }
      float lrow[32];
#pragma unroll
      for (int i4 = 0; i4 < 8; i4++) {
        float4 q4 = *(const float4*)(sh_lora + pst * 32 + i4 * 4);
        lrow[i4 * 4] = q4.x; lrow[i4 * 4 + 1] = q4.y; lrow[i4 * 4 + 2] = q4.z; lrow[i4 * 4 + 3] = q4.w;
      }
#pragma unroll
      for (int rr = 0; rr < 16; rr++) {
        float lw_ = lrow[rr], la_ = lrow[16 + rr];
        float4 w2 = *(const float4*)(sh_w2 + rr * 64 + cq * 4);
        float4 a2 = *(const float4*)(sh_a2 + rr * 64 + cq * 4);
        wl[0] += lw_ * w2.x; wl[1] += lw_ * w2.y; wl[2] += lw_ * w2.z; wl[3] += lw_ * w2.w;
        al[0] += la_ * a2.x; al[1] += la_ * a2.y; al[2] += la_ * a2.z; al[3] += la_ * a2.w;
      }
      float wv[4], kd[4], kk[4], bb[4];
      float ss = 0.f, bon = 0.f;
#pragma unroll
      for (int i = 0; i < 4; i++) {
        float a = wl[i];
        float lw = fminf(a, 0.f) - __logf(1.f + __expf(-fabsf(a))) - 0.5f;
        wv[i] = __expf(-__expf(lw));
        float ic = sigmoidf_(al[i]);
        float kr = k4[i] * kkw[i];
        kk[i] = kr; ss += kr * kr;
        kd[i] = k4[i] * (1.f + (ic - 1.f) * kaw[i]);
        bb[i] = ic;
        bon += r4[i] * kd[i] * rkw[i];
      }
      ss = allsum16(ss); bon = allsum16(bon);
      float inv = rsqrtf(fmaxf(ss, 1e-24f));
#pragma unroll
      for (int i = 0; i < 4; i++) { kk[i] *= inv; bb[i] *= kk[i]; }
      *(float4*)(sh_r + pst * 64 + cq * 4) = make_float4(r4[0], r4[1], r4[2], r4[3]);
      *(float4*)(sh_w + pst * 64 + cq * 4) = make_float4(wv[0], wv[1], wv[2], wv[3]);
      *(float4*)(sh_k + pst * 64 + cq * 4) = make_float4(kd[0], kd[1], kd[2], kd[3]);
      *(float4*)(sh_kk + pst * 64 + cq * 4) = make_float4(kk[0], kk[1], kk[2], kk[3]);
      *(float4*)(sh_b + pst * 64 + cq * 4) = make_float4(bb[0], bb[1], bb[2], bb[3]);
      if (rh == 0 && cq == 0) bonus[(size_t)(b * TT + jcur) * 4 + h] = bon;
      float xv = __uint_as_float(rv_c << 16);
      sh_v[pst * 32 + cq] = xv + muv0 * (__uint_as_float(rv_p << 16) * hpf - xv) + muv1 * (__uint_as_float(rv_n << 16) * hnf - xv);
      float xw = __uint_as_float(rw_c << 16);
      if (TWO) sh_v[pst * 32 + 16 + cq] = xw + muw0 * (__uint_as_float(rw_p << 16) * hpf - xw) + muw1 * (__uint_as_float(rw_n << 16) * hnf - xw);
    }
    __syncthreads();
    if (s0 + 16 < TT) fetch(s0 + 16);
    float oacc = 0.f, oacc2 = 0.f;
    {
      float4 nkk = *(const float4*)(sh_kk + ks * 4), nw = *(const float4*)(sh_w + ks * 4), nb4 = *(const float4*)(sh_b + ks * 4);
      float4 nk = *(const float4*)(sh_k + ks * 4), nr = *(const float4*)(sh_r + ks * 4);
      float nv = sh_v[rl], nv2 = sh_v[16 + rl];
#pragma unroll 4
      for (int st = 0; st < 16; st++) {
        const float4 kk4 = nkk, w4 = nw, b4 = nb4, k4 = nk, r4 = nr; const float vv = nv, vv2 = nv2;
        {
          const int sn = (st + 1) & 15;
          nkk = *(const float4*)(sh_kk + sn * 64 + ks * 4); nw = *(const float4*)(sh_w + sn * 64 + ks * 4);
          nb4 = *(const float4*)(sh_b + sn * 64 + ks * 4); nk = *(const float4*)(sh_k + sn * 64 + ks * 4);
          nr = *(const float4*)(sh_r + sn * 64 + ks * 4); nv = sh_v[sn * 32 + rl]; nv2 = sh_v[sn * 32 + 16 + rl];
        }
        float sa = -((S.x * kk4.x + S.y * kk4.y) + (S.z * kk4.z + S.w * kk4.w));
        float sa2 = 0.f;
        if (TWO) sa2 = -((S2.x * kk4.x + S2.y * kk4.y) + (S2.z * kk4.z + S2.w * kk4.w));
        sa = allsum16(sa); if (TWO) sa2 = allsum16(sa2);
        S.x = S.x * w4.x + (sa * b4.x + vv * k4.x);
        S.y = S.y * w4.y + (sa * b4.y + vv * k4.y);
        S.z = S.z * w4.z + (sa * b4.z + vv * k4.z);
        S.w = S.w * w4.w + (sa * b4.w + vv * k4.w);
        if (TWO) {
          S2.x = S2.x * w4.x + (sa2 * b4.x + vv2 * k4.x);
          S2.y = S2.y * w4.y + (sa2 * b4.y + vv2 * k4.y);
          S2.z = S2.z * w4.z + (sa2 * b4.z + vv2 * k4.z);
          S2.w = S2.w * w4.w + (sa2 * b4.w + vv2 * k4.w);
        }
        float o = (S.x * r4.x + S.y * r4.y) + (S.z * r4.z + S.w * r4.w);
        float o2 = 0.f;
        if (TWO) o2 = (S2.x * r4.x + S2.y * r4.y) + (S2.z * r4.z + S2.w * r4.w);
        o = allsum16(o); if (TWO) o2 = allsum16(o2);
        oacc = (ks == st) ? o : oacc;
        oacc2 = (ks == st) ? o2 : oacc2;
      }
    }
    sh_o[ks * 32 + rl] = oacc;
    if (TWO) sh_o[ks * 32 + 16 + rl] = oacc2;
    __syncthreads();
    {
      u16* op = rwo + (size_t)(b * TT + jcur) * 256 + h * 64 + rh * RPB + cq;
      op[0] = f2bf(sh_o[pst * 32 + cq]);
      if (TWO) op[16] = f2bf(sh_o[pst * 32 + 16 + cq]);
    }
  }
}


__device__ void rwkv_scan32(const Params& p, int layer, int task, float* lds) {
  const int t = tid_();
  const int rq = task & 3, h = (task >> 2) & 3, b = (task >> 4) & 7, d = task >> 7;
  float* sh_lora = lds;
  float* sh_w2 = sh_lora + 1024;
  float* sh_a2 = sh_w2 + 1024;
  float* sh_r = sh_a2 + 1024;
  float* sh_w = sh_r + 2048;
  float* sh_k = sh_w + 2048;
  float* sh_kk = sh_k + 2048;
  float* sh_b = sh_kk + 2048;
  float* sh_v = sh_b + 2048;
  float* sh_o = sh_v + 512;
  const u16* proj = (const u16*)(p.ws + OFF_PROJ);
  u16* rwo = (u16*)(p.ws + OFF_RWO) + (size_t)d * MROWS * 256;
  float* bonus = (float*)(p.ws + OFF_BONUS) + (size_t)d * MROWS * 4;
  const float* mu0 = p.in[21] + (size_t)layer * 2 * 832;
  const float* mu1 = mu0 + 832;
  __syncthreads();
  for (int i = t; i < 1024; i += 256) {
    int rr = i >> 6, c = i & 63;
    sh_w2[i] = p.in[23][(((size_t)layer * 2 + d) * 16 + rr) * 256 + h * 64 + c];
    sh_a2[i] = p.in[25][(((size_t)layer * 2 + d) * 16 + rr) * 256 + h * 64 + c];
  }
  const int pst = t >> 4, cq = t & 15;
  const int ch0 = h * 64 + cq * 4;
  float mur0[4], mur1[4], muk0[4], muk1[4], w0v[4], a0v[4], kkw[4], kaw[4], rkw[4];
#pragma unroll
  for (int i = 0; i < 4; i++) {
    mur0[i] = mu0[ch0 + i]; mur1[i] = mu1[ch0 + i];
    muk0[i] = mu0[256 + ch0 + i]; muk1[i] = mu1[256 + ch0 + i];
    w0v[i] = p.in[22][((size_t)layer * 2 + d) * 256 + ch0 + i];
    a0v[i] = p.in[24][((size_t)layer * 2 + d) * 256 + ch0 + i];
    kkw[i] = p.in[26][layer * 256 + ch0 + i];
    kaw[i] = p.in[27][layer * 256 + ch0 + i];
    rkw[i] = p.in[28][layer * 256 + ch0 + i];
  }
  const int vch = 512 + h * 64 + rq * 16 + cq;
  const float muv0 = mu0[vch], muv1 = mu1[vch];
  const int lq = (t * 2) & 31, lst = (t * 2) >> 5;
  const int lcol = lq < 16 ? (768 + d * 16 + lq) : (800 + d * 16 + (lq - 16));
  const float lmu00 = mu0[lcol], lmu01 = mu0[lcol + 1], lmu10 = mu1[lcol], lmu11 = mu1[lcol + 1];
  const int rl = t >> 4, ks = t & 15;
  float4 S = make_float4(0.f, 0.f, 0.f, 0.f);
  uint2 rr_c[2], rr_p[2], rr_n[2], rk_c[2], rk_p[2], rk_n[2];
  unsigned rv_c[2], rv_p[2], rv_n[2];
  unsigned lx0[2], lx1[2], lxp0[2], lxp1[2], lxn0[2], lxn1[2];
  auto fetch = [&](int s0) {
#pragma unroll
    for (int e = 0; e < 2; e++) {
      {
        const int j = jmap(d, s0 + lst + 16 * e);
        const u16* pr = proj + ((size_t)(b * TT + j)) * PC + C_RWX + lcol;
        const u16* prp = has_prev(j) ? pr - PC : pr;
        const u16* prn = has_next(j) ? pr + PC : pr;
        lx0[e] = pr[0]; lx1[e] = pr[1]; lxp0[e] = prp[0]; lxp1[e] = prp[1]; lxn0[e] = prn[0]; lxn1[e] = prn[1];
      }
      const int j = jmap(d, s0 + pst + 16 * e);
      const u16* pr = proj + ((size_t)(b * TT + j)) * PC + C_RWX;
      const u16* prp = has_prev(j) ? pr - PC : pr;
      const u16* prn = has_next(j) ? pr + PC : pr;
      rr_c[e] = *(const uint2*)(pr + ch0); rr_p[e] = *(const uint2*)(prp + ch0); rr_n[e] = *(const uint2*)(prn + ch0);
      rk_c[e] = *(const uint2*)(pr + 256 + ch0); rk_p[e] = *(const uint2*)(prp + 256 + ch0); rk_n[e] = *(const uint2*)(prn + 256 + ch0);
      rv_c[e] = pr[vch]; rv_p[e] = prp[vch]; rv_n[e] = prn[vch];
    }
  };
  auto unpack4 = [](uint2 v, float (&o)[4]) {
    o[0] = __uint_as_float(v.x << 16); o[1] = __uint_as_float(v.x & 0xffff0000u);
    o[2] = __uint_as_float(v.y << 16); o[3] = __uint_as_float(v.y & 0xffff0000u);
  };
  fetch(0);
  for (int s0 = 0; s0 < TT; s0 += 32) {
#pragma unroll
    for (int e = 0; e < 2; e++) {
      const int ja = jmap(d, s0 + lst + 16 * e);
      const float hpa = has_prev(ja) ? 1.f : 0.f, hna = has_next(ja) ? 1.f : 0.f;
      float x0 = __uint_as_float(lx0[e] << 16), x1 = __uint_as_float(lx1[e] << 16);
      float xs0 = x0 + lmu00 * (__uint_as_float(lxp0[e] << 16) * hpa - x0) + lmu10 * (__uint_as_float(lxn0[e] << 16) * hna - x0);
      float xs1 = x1 + lmu01 * (__uint_as_float(lxp1[e] << 16) * hpa - x1) + lmu11 * (__uint_as_float(lxn1[e] << 16) * hna - x1);
      if (lq < 16) {
        xs0 = 1.f - 2.f * __builtin_amdgcn_rcpf(__expf(2.f * xs0) + 1.f);
        xs1 = 1.f - 2.f * __builtin_amdgcn_rcpf(__expf(2.f * xs1) + 1.f);
      }
      *(float2*)(sh_lora + (lst + 16 * e) * 32 + lq) = make_float2(xs0, xs1);
    }
    __syncthreads();
    int jcur[2];
#pragma unroll
    for (int e = 0; e < 2; e++) {
      const int st_ = pst + 16 * e;
      jcur[e] = jmap(d, s0 + st_);
      const float hpf = has_prev(jcur[e]) ? 1.f : 0.f, hnf = has_next(jcur[e]) ? 1.f : 0.f;
      float r4[4], k4[4], t0[4], t1[4];
      unpack4(rr_c[e], r4); unpack4(rr_p[e], t0); unpack4(rr_n[e], t1);
#pragma unroll
      for (int i = 0; i < 4; i++) r4[i] = r4[i] + mur0[i] * (t0[i] * hpf - r4[i]) + mur1[i] * (t1[i] * hnf - r4[i]);
      unpack4(rk_c[e], k4); unpack4(rk_p[e], t0); unpack4(rk_n[e], t1);
#pragma unroll
      for (int i = 0; i < 4; i++) k4[i] = k4[i] + muk0[i] * (t0[i] * hpf - k4[i]) + muk1[i] * (t1[i] * hnf - k4[i]);
      float wl[4], al[4];
#pragma unroll
      for (int i = 0; i < 4; i++) { wl[i] = w0v[i]; al[i] = a0v[i]; }
      float lrow[32];
#pragma unroll
      for (int i4 = 0; i4 < 8; i4++) {
        float4 q4 = *(const float4*)(sh_lora + st_ * 32 + i4 * 4);
        lrow[i4 * 4] = q4.x; lrow[i4 * 4 + 1] = q4.y; lrow[i4 * 4 + 2] = q4.z; lrow[i4 * 4 + 3] = q4.w;
      }
#pragma unroll
      for (int rr = 0; rr < 16; rr++) {
        float lw_ = lrow[rr], la_ = lrow[16 + rr];
        float4 w2 = *(const float4*)(sh_w2 + rr * 64 + cq * 4);
        float4 a2 = *(const float4*)(sh_a2 + rr * 64 + cq * 4);
        wl[0] += lw_ * w2.x; wl[1] += lw_ * w2.y; wl[2] += lw_ * w2.z; wl[3] += lw_ * w2.w;
        al[0] += la_ * a2.x; al[1] += la_ * a2.y; al[2] += la_ * a2.z; al[3] += la_ * a2.w;
      }
      float wv[4], kd[4], kk[4], bb[4];
      float ss = 0.f, bon = 0.f;
#pragma unroll
      for (int i = 0; i < 4; i++) {
        float a = wl[i];
        float lw = fminf(a, 0.f) - __logf(1.f + __expf(-fabsf(a))) - 0.5f;
        wv[i] = __expf(-__expf(lw));
        float ic = sigmoidf_(al[i]);
        float kr = k4[i] * kkw[i];
        kk[i] = kr; ss += kr * kr;
        kd[i] = k4[i] * (1.f + (ic - 1.f) * kaw[i]);
        bb[i] = ic;
        bon += r4[i] * kd[i] * rkw[i];
      }
      ss = allsum16(ss); bon = allsum16(bon);
      float inv = rsqrtf(fmaxf(ss, 1e-24f));
#pragma unroll
      for (int i = 0; i < 4; i++) { kk[i] *= inv; bb[i] *= kk[i]; }
      *(float4*)(sh_r + st_ * 64 + cq * 4) = make_float4(r4[0], r4[1], r4[2], r4[3]);
      *(float4*)(sh_w + st_ * 64 + cq * 4) = make_float4(wv[0], wv[1], wv[2], wv[3]);
      *(float4*)(sh_k + st_ * 64 + cq * 4) = make_float4(kd[0], kd[1], kd[2], kd[3]);
      *(float4*)(sh_kk + st_ * 64 + cq * 4) = make_float4(kk[0], kk[1], kk[2], kk[3]);
      *(float4*)(sh_b + st_ * 64 + cq * 4) = make_float4(bb[0], bb[1], bb[2], bb[3]);
      if (rq == 0 && cq == 0) bonus[(size_t)(b * TT + jcur[e]) * 4 + h] = bon;
      float xv = __uint_as_float(rv_c[e] << 16);
      sh_v[st_ * 16 + cq] = xv + muv0 * (__uint_as_float(rv_p[e] << 16) * hpf - xv) + muv1 * (__uint_as_float(rv_n[e] << 16) * hnf - xv);
    }
    __syncthreads();
    if (s0 + 32 < TT) fetch(s0 + 32);
    float oacc0 = 0.f, oacc1 = 0.f;
    {
      float4 nkk = *(const float4*)(sh_kk + ks * 4), nw = *(const float4*)(sh_w + ks * 4), nb4 = *(const float4*)(sh_b + ks * 4);
      float4 nk = *(const float4*)(sh_k + ks * 4), nr = *(const float4*)(sh_r + ks * 4);
      float nv = sh_v[rl];
#pragma unroll 4
      for (int st = 0; st < 32; st++) {
        const float4 kk4 = nkk, w4 = nw, b4 = nb4, k4 = nk, r4 = nr; const float vv = nv;
        {
          const int sn = (st + 1) & 31;
          nkk = *(const float4*)(sh_kk + sn * 64 + ks * 4); nw = *(const float4*)(sh_w + sn * 64 + ks * 4);
          nb4 = *(const float4*)(sh_b + sn * 64 + ks * 4); nk = *(const float4*)(sh_k + sn * 64 + ks * 4);
          nr = *(const float4*)(sh_r + sn * 64 + ks * 4); nv = sh_v[sn * 16 + rl];
        }
        float sa = -((S.x * kk4.x + S.y * kk4.y) + (S.z * kk4.z + S.w * kk4.w));
        sa = allsum16(sa);
        S.x = S.x * w4.x + (sa * b4.x + vv * k4.x);
        S.y = S.y * w4.y + (sa * b4.y + vv * k4.y);
        S.z = S.z * w4.z + (sa * b4.z + vv * k4.z);
        S.w = S.w * w4.w + (sa * b4.w + vv * k4.w);
        float o = (S.x * r4.x + S.y * r4.y) + (S.z * r4.z + S.w * r4.w);
        o = allsum16(o);
        oacc0 = (ks == st) ? o : oacc0;
        oacc1 = (ks + 16 == st) ? o : oacc1;
      }
    }
    rwo[(size_t)(b * TT + jmap(d, s0 + ks)) * 256 + h * 64 + rq * 16 + rl] = f2bf(oacc0);
    rwo[(size_t)(b * TT + jmap(d, s0 + ks + 16)) * 256 + h * 64 + rq * 16 + rl] = f2bf(oacc1);
  }
}

__device__ void rwkv_combine_rows(const Params& p, int layer, int row0, int latonly) {
  const int lane = tid_() & 63, h = tid_() >> 6;
  const int ch = h * 64 + lane;
  const u16* rwo = (const u16*)(p.ws + OFF_RWO);
  u16* proj = (u16*)(p.ws + OFF_PROJ);
  const float* mu0 = p.in[21] + (size_t)layer * 2 * 832; const float* mu1 = mu0 + 832;
  const float* bonus = (const float*)(p.ws + OFF_BONUS);
  const float gw = p.in[29][layer * 256 + ch], gb = p.in[30][layer * 256 + ch];
  const float m0 = mu0[512 + ch], m1 = mu1[512 + ch];
  const int vc = C_RWX + 512 + ch;
  float o[8], xv[8], xp[8], xn[8], bs[8], z[8];
#pragma unroll
  for (int i = 0; i < 8; i++) {
    const int row = row0 + i;
    const int j = row % TT;
    const u16* pr = proj + (size_t)row * PC;
    o[i] = bf2f(rwo[(size_t)row * 256 + ch]) + bf2f(rwo[(size_t)MROWS * 256 + (size_t)row * 256 + ch]);
    xv[i] = bf2f(pr[vc]);
    xp[i] = has_prev(j) ? bf2f(pr[vc - PC]) : 0.f;
    xn[i] = has_next(j) ? bf2f(pr[vc + PC]) : 0.f;
    bs[i] = bonus[(size_t)row * 4 + h] + bonus[(size_t)MROWS * 4 + (size_t)row * 4 + h];
    z[i] = bf2f(pr[C_RWZ + ch]);
  }
#pragma unroll
  for (int i = 0; i < 8; i++) {
    const int row = row0 + i;
    if (latonly && (row % TT) < 256) continue;
    float mean = wavesum(o[i]) * (1.f / 64.f);
    float dlt = o[i] - mean;
    float var = wavesum(dlt * dlt) * (1.f / 64.f);
    float on = dlt * rsqrtf(var + 64e-5f) * gw + gb;
    float v = xv[i] + m0 * (xp[i] - xv[i]) + m1 * (xn[i] - xv[i]);
    proj[(size_t)row * PC + C_RWZ + ch] = f2bf((on + bs[i] * v) * siluf_(z[i]));
  }
}

template <int MX, int PASS>
__device__ __forceinline__ void gla_sweep(const Params& p, int layer, int d, int b, int h, int c, float* lds) {
  const int t = tid_(), w = t >> 6, lane = t & 63;
  float* kbuf = lds;
  float* fbuf = kbuf + 1024;
  float* qbuf = fbuf + 1024;
  float* vbuf = qbuf + 1024;
  float* part = vbuf + 1024;
  u16* proj = (u16*)(p.ws + OFF_PROJ);
  const int dbh = (d * 8 + b) * 4 + h;
  float* stt = (float*)(p.ws + (MX == 0 ? OFF_HGST : OFF_RTST)) + ((size_t)dbh * 9 + c) * 4096;
  float S[16];
#pragma unroll
  for (int i = 0; i < 16; i++) S[i] = PASS == 1 ? 0.f : stt[(w * 16 + i) * 64 + lane];
  float gam = 1.f;
  if (MX == 1) gam = __expf(-__expf(p.in[20][((size_t)layer * 2 + d) * 4 + h]));
  float Pl = 1.f;
  const int pst = t >> 4, c4 = (t & 15) * 4;
  float lb4[4] = {0.f, 0.f, 0.f, 0.f};
  if (MX == 0 && layer == 1) {
#pragma unroll
    for (int i = 0; i < 4; i++) {
      float l0 = p.in[18][(0 * 2 + d) * 256 + h * 64 + c4 + i], l1 = p.in[18][(1 * 2 + d) * 256 + h * 64 + c4 + i];
      float mx = fmaxf(l0, l1);
      float e0 = __expf(l0 - mx), e1 = __expf(l1 - mx);
      lb4[i] = e1 / (e0 + e1);
    }
  }
  const int vcol0 = (MX == 0 ? C_HGI : C_RTV) + h * 64;
  const float* rope = (const float*)(p.ws + OFF_ROPE);
  uint2 r_a, r_b, r_c, r_d, r_v; float4 r_cs0, r_cs1;
  r_a = r_b = r_c = r_d = r_v = make_uint2(0u, 0u); r_cs0 = r_cs1 = make_float4(1.f, 0.f, 1.f, 0.f);
  auto fetch = [&](int s0) {
    int j = jmap(d, s0 + pst);
    const u16* pr = proj + (size_t)(b * TT + j) * PC;
    r_v = *(const uint2*)(pr + vcol0 + c4);
    if (MX == 0) {
      r_a = *(const uint2*)(pr + C_HGF + d * 256 + h * 64 + c4);
      if (PASS == 2) r_b = *(const uint2*)(pr + C_HGQ + h * 64 + c4);
    } else {
      r_a = *(const uint2*)(pr + C_RTK + h * 64 + c4);
      r_c = *(const uint2*)(pr + C_RTK + h * 64 + (c4 ^ 16));
      if (PASS == 2) { r_b = *(const uint2*)(pr + C_RTQ + h * 64 + c4); r_d = *(const uint2*)(pr + C_RTQ + h * 64 + (c4 ^ 16)); }
      if (j >= 256) {
        int tl = j - 256;
        int pos = (c4 & 32) ? (tl & 63) : (tl >> 6);
        const float* rp = rope + (pos * 16 + (c4 & 15)) * 2;
        r_cs0 = *(const float4*)rp; r_cs1 = *(const float4*)(rp + 4);
      } else { r_cs0 = make_float4(1.f, 0.f, 1.f, 0.f); r_cs1 = r_cs0; }
    }
  };
  auto unpack4 = [](uint2 v, float (&o)[4]) {
    o[0] = __uint_as_float(v.x << 16); o[1] = __uint_as_float(v.x & 0xffff0000u);
    o[2] = __uint_as_float(v.y << 16); o[3] = __uint_as_float(v.y & 0xffff0000u);
  };
  u16* ofp; int ofs;
  if (MX == 0) { ofp = proj + C_HGF + h * 64 + lane; ofs = PC; }
  else { ofp = (u16*)(p.ws + OFF_RETOF) + h * 64 + lane; ofs = 256; }
  const int zcol = (MX == 0 ? C_HGZ : C_RTZ) + h * 64 + lane;
  const int ycol = (MX == 0 ? C_HGQ : C_RTQ) + h * 64 + lane;
  float normw = 1.f;
  if (MX == 0 && PASS == 2) normw = p.in[19][layer * 256 + h * 64 + lane];
  fetch(c * 256);
  for (int sub = 0; sub < 16; sub++) {
    const int s0 = c * 256 + sub * 16;
    __syncthreads();
    {
      float va[4], vb[4], vc[4], vd[4], vv4[4];
      unpack4(r_a, va); unpack4(r_v, vv4);
      *(float4*)(vbuf + pst * 64 + c4) = make_float4(vv4[0], vv4[1], vv4[2], vv4[3]);
      if (MX == 0) {
        float f[4], k[4];
#pragma unroll
        for (int i = 0; i < 4; i++) { f[i] = lb4[i] + (1.f - lb4[i]) * sigmoidf_(va[i]); k[i] = 1.f - f[i]; }
        *(float4*)(kbuf + pst * 64 + c4) = make_float4(k[0], k[1], k[2], k[3]);
        *(float4*)(fbuf + pst * 64 + c4) = make_float4(f[0], f[1], f[2], f[3]);
        if (PASS == 2) {
          unpack4(r_b, vb);
          *(float4*)(qbuf + pst * 64 + c4) = make_float4(siluf_(vb[0]), siluf_(vb[1]), siluf_(vb[2]), siluf_(vb[3]));
        }
      } else {
        unpack4(r_c, vc);
        float cs[8] = {r_cs0.x, r_cs0.y, r_cs0.z, r_cs0.w, r_cs1.x, r_cs1.y, r_cs1.z, r_cs1.w};
        float sgn = (c4 & 16) ? 1.f : -1.f;
#pragma unroll
        for (int i = 0; i < 4; i++) va[i] = (va[i] * cs[2 * i] + sgn * vc[i] * cs[2 * i + 1]) * 0.125f;
        *(float4*)(kbuf + pst * 64 + c4) = make_float4(va[0], va[1], va[2], va[3]);
        if (PASS == 2) {
          unpack4(r_b, vb); unpack4(r_d, vd);
#pragma unroll
          for (int i = 0; i < 4; i++) vb[i] = vb[i] * cs[2 * i] + sgn * vd[i] * cs[2 * i + 1];
          *(float4*)(qbuf + pst * 64 + c4) = make_float4(vb[0], vb[1], vb[2], vb[3]);
        }
      }
    }
    __syncthreads();
    if (sub + 1 < 16) fetch(s0 + 16);
    u16 pf_o[4], pf_z[4];
    if (PASS == 2 && d == 1) {
#pragma unroll
      for (int e = 0; e < 4; e++) {
        size_t row = (size_t)(b * TT + jmap(d, s0 + w * 4 + e));
        pf_o[e] = ofp[row * ofs]; pf_z[e] = proj[row * PC + zcol];
      }
    }
#pragma unroll 2
    for (int st = 0; st < 16; st++) {
      const float vv = vbuf[st * 64 + lane];
      float o = 0.f;
#pragma unroll
      for (int i4 = 0; i4 < 4; i4++) {
        float4 kv = *(const float4*)(kbuf + st * 64 + w * 16 + i4 * 4);
        float4 fv = make_float4(gam, gam, gam, gam);
        if (MX == 0) fv = *(const float4*)(fbuf + st * 64 + w * 16 + i4 * 4);
        S[i4*4]   = fv.x * S[i4*4]   + kv.x * vv;
        S[i4*4+1] = fv.y * S[i4*4+1] + kv.y * vv;
        S[i4*4+2] = fv.z * S[i4*4+2] + kv.z * vv;
        S[i4*4+3] = fv.w * S[i4*4+3] + kv.w * vv;
        if (PASS == 2) {
          float4 qv = *(const float4*)(qbuf + st * 64 + w * 16 + i4 * 4);
          o += S[i4*4] * qv.x + S[i4*4+1] * qv.y + S[i4*4+2] * qv.z + S[i4*4+3] * qv.w;
        }
      }
      if (MX == 0 && PASS == 1) { if (lane < 16) Pl *= fbuf[st * 64 + w * 16 + lane]; }
      if (PASS == 2) part[(w * 16 + st) * 64 + lane] = o;
    }
    if (PASS == 2) {
      __syncthreads();
#pragma unroll
      for (int e = 0; e < 4; e++) {
        int st = w * 4 + e;
        float o = part[(0 * 16 + st) * 64 + lane] + part[(1 * 16 + st) * 64 + lane] + part[(2 * 16 + st) * 64 + lane] + part[(3 * 16 + st) * 64 + lane];
        int j = jmap(d, s0 + st);
        size_t row = (size_t)(b * TT + j);
        if (d == 0) {
          ofp[row * ofs] = f2bf(o);
        } else {
          o += bf2f(pf_o[e]);
          float ss = wavesum(o * o);
          float y = o * rsqrtf(ss * (1.f / 64.f) + 1e-6f) * normw;
          proj[row * PC + ycol] = f2bf(y * siluf_(bf2f(pf_z[e])));
        }
      }
    }
  }
  if (PASS == 1) {
#pragma unroll
    for (int i = 0; i < 16; i++) stt[(w * 16 + i) * 64 + lane] = S[i];
    if (MX == 0 && lane < 16) ((float*)(p.ws + OFF_HGP))[((size_t)dbh * 9 + c) * 64 + w * 16 + lane] = Pl;
  }
}

#define RS 72
template <int PASS>
__device__ __forceinline__ void ret_sweep(const Params& p, int layer, int d, int b, int h, int nc, int cstep, u16* lds) {
  const int t = tid_(), lane = t & 63, w4 = t >> 6;
  u16* Qs = lds;
  u16* Ks = Qs + 64 * RS;
  u16* Kt = Ks + 64 * RS;
  u16* Vt = Kt + 64 * RS;
  u16* Vd = Vt + 64 * RS;
  u16* Ps = Vd + 64 * RS;
  u16* St = Ps + 64 * RS;
  u16* proj = (u16*)(p.ws + OFF_PROJ);
  const float* rope = (const float*)(p.ws + OFF_ROPE);
  const float lg = -__expf(p.in[20][((size_t)layer * 2 + d) * 4 + h]) * 1.4426950408889634f;
  const float g64 = exp2f(64.f * lg);
  const int dbh = (d * 8 + b) * 4 + h;
  float* stt = (float*)(p.ws + OFF_RTST) + ((size_t)dbh * 9 + cstep) * 4096;
  f32x4 accS[4];
#pragma unroll
  for (int nt = 0; nt < 4; nt++)
#pragma unroll
    for (int r = 0; r < 4; r++)
      accS[nt][r] = PASS == 1 ? 0.f : stt[(w4 * 16 + (lane >> 4) * 4 + r) * 64 + nt * 16 + (lane & 15)];
  uint4 rq[2], rqp[2], rk[2], rkp[2], rv[2];
  auto fetch = [&](int w) {
#pragma unroll
    for (int e = 0; e < 2; e++) {
      const int q = t + 256 * e, sl = q & 63, c8 = (q >> 6) * 8;
      const u16* pr = proj + (size_t)(b * TT + nc * 256 + w * 64 + sl) * PC + h * 64;
      rk[e] = *(const uint4*)(pr + C_RTK + c8); rkp[e] = *(const uint4*)(pr + C_RTK + (c8 ^ 16));
      rv[e] = *(const uint4*)(pr + C_RTV + c8);
      if (PASS == 2) { rq[e] = *(const uint4*)(pr + C_RTQ + c8); rqp[e] = *(const uint4*)(pr + C_RTQ + (c8 ^ 16)); }
    }
  };
  auto up = [](uint4 v, float (&o)[8]) {
    const unsigned* u = (const unsigned*)&v;
#pragma unroll
    for (int i = 0; i < 4; i++) { o[2 * i] = __uint_as_float(u[i] << 16); o[2 * i + 1] = __uint_as_float(u[i] & 0xffff0000u); }
  };
  fetch(d == 0 ? 0 : 3);
  for (int wi = 0; wi < 4; wi++) {
    const int w = d == 0 ? wi : 3 - wi;
    __syncthreads();
    if (PASS == 2 && wi == 0) {
#pragma unroll
      for (int nt = 0; nt < 4; nt++)
        *(uint2*)(St + (nt * 16 + (lane & 15)) * RS + w4 * 16 + (lane >> 4) * 4) =
            make_uint2(pack2(accS[nt][0], accS[nt][1]), pack2(accS[nt][2], accS[nt][3]));
    }
#pragma unroll
    for (int e = 0; e < 2; e++) {
      const int q = t + 256 * e, sl = q & 63, c8 = (q >> 6) * 8;
      const int j = nc * 256 + w * 64 + sl;
      float kx[8], kp[8], vx[8], qx[8], qp[8];
      up(rk[e], kx); up(rkp[e], kp); up(rv[e], vx);
      if (PASS == 2) { up(rq[e], qx); up(rqp[e], qp); }
      if (j >= 256) {
        const int tl = j - 256;
        const int pos = (c8 & 32) ? (tl & 63) : (tl >> 6);
        const float* rp = rope + (pos * 16 + (c8 & 15)) * 2;
        const float sgn = (c8 & 16) ? 1.f : -1.f;
#pragma unroll
        for (int i2 = 0; i2 < 4; i2++) {
          const float4 cs = *(const float4*)(rp + i2 * 4);
          kx[2 * i2] = kx[2 * i2] * cs.x + sgn * kp[2 * i2] * cs.y;
          kx[2 * i2 + 1] = kx[2 * i2 + 1] * cs.z + sgn * kp[2 * i2 + 1] * cs.w;
          if (PASS == 2) {
            qx[2 * i2] = qx[2 * i2] * cs.x + sgn * qp[2 * i2] * cs.y;
            qx[2 * i2 + 1] = qx[2 * i2 + 1] * cs.z + sgn * qp[2 * i2 + 1] * cs.w;
          }
        }
      }
      const float dec = exp2f((float)(d == 0 ? 63 - sl : sl) * lg);
      u16 kb[8];
#pragma unroll
      for (int i = 0; i < 8; i++) {
        kb[i] = f2bf(kx[i] * 0.125f);
        Kt[(c8 + i) * RS + sl] = kb[i];
        Vd[(c8 + i) * RS + sl] = f2bf(vx[i] * dec);
      }
      if (PASS == 2) {
        uint4 kk4, qq4;
        kk4.x = kb[0] | ((unsigned)kb[1] << 16); kk4.y = kb[2] | ((unsigned)kb[3] << 16);
        kk4.z = kb[4] | ((unsigned)kb[5] << 16); kk4.w = kb[6] | ((unsigned)kb[7] << 16);
        qq4.x = pack2(qx[0], qx[1]); qq4.y = pack2(qx[2], qx[3]); qq4.z = pack2(qx[4], qx[5]); qq4.w = pack2(qx[6], qx[7]);
        *(uint4*)(Ks + sl * RS + c8) = kk4;
        *(uint4*)(Qs + sl * RS + c8) = qq4;
        const unsigned short* vraw = (const unsigned short*)&rv[e];
#pragma unroll
        for (int i = 0; i < 8; i++) Vt[(c8 + i) * RS + sl] = vraw[i];
      }
    }
    __syncthreads();
    if (wi + 1 < 4) fetch(d == 0 ? wi + 1 : 2 - wi);
    if (PASS == 2) {
      f32x4 accP[4];
#pragma unroll
      for (int nt = 0; nt < 4; nt++) accP[nt] = (f32x4){0.f, 0.f, 0.f, 0.f};
      bf16x8 aq[2];
#pragma unroll
      for (int kk = 0; kk < 2; kk++) aq[kk] = *(const bf16x8*)(Qs + (w4 * 16 + (lane & 15)) * RS + kk * 32 + (lane >> 4) * 8);
#pragma unroll
      for (int kk = 0; kk < 2; kk++)
#pragma unroll
        for (int nt = 0; nt < 4; nt++) {
          bf16x8 bk = *(const bf16x8*)(Ks + (nt * 16 + (lane & 15)) * RS + kk * 32 + (lane >> 4) * 8);
          accP[nt] = __builtin_amdgcn_mfma_f32_16x16x32_bf16(aq[kk], bk, accP[nt], 0, 0, 0);
        }
#pragma unroll
      for (int nt = 0; nt < 4; nt++)
#pragma unroll
        for (int r = 0; r < 4; r++) {
          const int il = w4 * 16 + (lane >> 4) * 4 + r, sl = nt * 16 + (lane & 15);
          const int e = d == 0 ? il - sl : sl - il;
          const float f = e >= 0 ? exp2f((float)e * lg) : 0.f;
          Ps[il * RS + sl] = f2bf(accP[nt][r] * f);
        }
      __syncthreads();
      f32x4 accO[4], accI[4];
#pragma unroll
      for (int nt = 0; nt < 4; nt++) { accO[nt] = (f32x4){0.f, 0.f, 0.f, 0.f}; accI[nt] = (f32x4){0.f, 0.f, 0.f, 0.f}; }
#pragma unroll
      for (int kk = 0; kk < 2; kk++) {
        bf16x8 ap = *(const bf16x8*)(Ps + (w4 * 16 + (lane & 15)) * RS + kk * 32 + (lane >> 4) * 8);
#pragma unroll
        for (int nt = 0; nt < 4; nt++) {
          bf16x8 bv = *(const bf16x8*)(Vt + (nt * 16 + (lane & 15)) * RS + kk * 32 + (lane >> 4) * 8);
          accO[nt] = __builtin_amdgcn_mfma_f32_16x16x32_bf16(ap, bv, accO[nt], 0, 0, 0);
          bf16x8 bs = *(const bf16x8*)(St + (nt * 16 + (lane & 15)) * RS + kk * 32 + (lane >> 4) * 8);
          accI[nt] = __builtin_amdgcn_mfma_f32_16x16x32_bf16(aq[kk], bs, accI[nt], 0, 0, 0);
        }
      }
      u16* ofp = (u16*)(p.ws + OFF_RETOF);
#pragma unroll
      for (int r = 0; r < 4; r++) {
        const int il = w4 * 16 + (lane >> 4) * 4 + r;
        const size_t row = (size_t)(b * TT + nc * 256 + w * 64 + il);
        const float rho = exp2f((float)(d == 0 ? il + 1 : 64 - il) * lg);
        float o[4], ss = 0.f;
#pragma unroll
        for (int nt = 0; nt < 4; nt++) {
          o[nt] = accO[nt][r] + rho * accI[nt][r];
          if (d == 1) o[nt] += bf2f(ofp[row * 256 + h * 64 + nt * 16 + (lane & 15)]);
          ss += o[nt] * o[nt];
        }
        if (d == 0) {
#pragma unroll
          for (int nt = 0; nt < 4; nt++) ofp[row * 256 + h * 64 + nt * 16 + (lane & 15)] = f2bf(o[nt]);
        } else {
          ss = allsum16(ss);
          const float sc = rsqrtf(ss * (1.f / 64.f) + 1e-6f);
#pragma unroll
          for (int nt = 0; nt < 4; nt++) {
            const int cv = h * 64 + nt * 16 + (lane & 15);
            const float z = bf2f(proj[row * PC + C_RTZ + cv]);
            proj[row * PC + C_RTQ + cv] = f2bf(o[nt] * sc * siluf_(z));
          }
        }
      }
    }
#pragma unroll
    for (int nt = 0; nt < 4; nt++)
#pragma unroll
      for (int r = 0; r < 4; r++) accS[nt][r] *= g64;
#pragma unroll
    for (int kk = 0; kk < 2; kk++) {
      bf16x8 ak = *(const bf16x8*)(Kt + (w4 * 16 + (lane & 15)) * RS + kk * 32 + (lane >> 4) * 8);
#pragma unroll
      for (int nt = 0; nt < 4; nt++) {
        bf16x8 bv = *(const bf16x8*)(Vd + (nt * 16 + (lane & 15)) * RS + kk * 32 + (lane >> 4) * 8);
        accS[nt] = __builtin_amdgcn_mfma_f32_16x16x32_bf16(ak, bv, accS[nt], 0, 0, 0);
      }
    }
    __syncthreads();
    if (PASS == 2 && wi + 1 < 4) {
#pragma unroll
      for (int nt = 0; nt < 4; nt++)
        *(uint2*)(St + (nt * 16 + (lane & 15)) * RS + w4 * 16 + (lane >> 4) * 4) =
            make_uint2(pack2(accS[nt][0], accS[nt][1]), pack2(accS[nt][2], accS[nt][3]));
    }
  }
  if (PASS == 1) {
#pragma unroll
    for (int nt = 0; nt < 4; nt++)
#pragma unroll
      for (int r = 0; r < 4; r++) stt[(w4 * 16 + (lane >> 4) * 4 + r) * 64 + nt * 16 + (lane & 15)] = accS[nt][r];
  }
}

#define HS 40
template <int PASS>
__device__ __forceinline__ void hg_sweep(const Params& p, int layer, int d, int b, int h, int nc, int cstep, u16* lds) {
  const int t = tid_(), lane = t & 63, w4 = t >> 6;
  u16* Qt = lds;
  u16* Kt = Qt + 16 * RS;
  u16* KtT = Kt + 16 * RS;
  u16* VtT = KtT + 64 * HS;
  u16* Am = VtT + 64 * HS;
  u16* St = Am + 16 * HS;
  float* eb = (float*)(St + 64 * RS);
  float* ssb = eb + 64;
  u16* proj = (u16*)(p.ws + OFF_PROJ);
  const int dbh = (d * 8 + b) * 4 + h;
  float* stt = (float*)(p.ws + OFF_HGST) + ((size_t)dbh * 9 + cstep) * 4096;
  f32x4 accS[4];
#pragma unroll
  for (int nt = 0; nt < 4; nt++)
#pragma unroll
    for (int r = 0; r < 4; r++)
      accS[nt][r] = PASS == 1 ? 0.f : stt[(w4 * 16 + (lane >> 4) * 4 + r) * 64 + nt * 16 + (lane & 15)];
  const int kc = lane, qd = w4;
  float lb = 0.f;
  if (layer == 1) {
    float l0 = p.in[18][(0 * 2 + d) * 256 + h * 64 + kc], l1 = p.in[18][(1 * 2 + d) * 256 + h * 64 + kc];
    float mx = fmaxf(l0, l1);
    float e0 = __expf(l0 - mx), e1 = __expf(l1 - mx);
    lb = e1 / (e0 + e1);
  }
  const float normw = p.in[19][layer * 256 + h * 64 + w4 * 16 + (lane & 15)];
  float bsum = 0.f;
  __syncthreads();
  for (int i = t; i < 64 * 16; i += 256) { KtT[(i >> 4) * HS + 16 + (i & 15)] = 0; VtT[(i >> 4) * HS + 16 + (i & 15)] = 0; }
  for (int i = t; i < 16 * 16; i += 256) Am[(i >> 4) * HS + 16 + (i & 15)] = 0;
  unsigned rlg[16], rvv[4], rqq[4];
  auto fetch = [&](int spn) {
    const int ns = d == 0 ? spn : 15 - spn;
    const u16* pb = proj + (size_t)(b * TT + nc * 256 + ns * 16) * PC;
#pragma unroll
    for (int tau = 0; tau < 16; tau++) rlg[tau] = pb[(size_t)(d == 0 ? tau : 15 - tau) * PC + C_HGF + d * 256 + h * 64 + kc];
#pragma unroll
    for (int e = 0; e < 4; e++) {
      const int tau = qd * 4 + e;
      const u16* pr = pb + (size_t)(d == 0 ? tau : 15 - tau) * PC;
      rvv[e] = pr[C_HGI + h * 64 + kc];
      if (PASS == 2) rqq[e] = pr[C_HGQ + h * 64 + kc];
    }
  };
  fetch(0);
  for (int sp = 0; sp < 16; sp++) {
    const int nsub = d == 0 ? sp : 15 - sp;
    const int rbase = b * TT + nc * 256 + nsub * 16;
    __syncthreads();
    if (PASS == 2 && sp == 0) {
#pragma unroll
      for (int nt = 0; nt < 4; nt++)
        *(uint2*)(St + (nt * 16 + (lane & 15)) * RS + w4 * 16 + (lane >> 4) * 4) =
            make_uint2(pack2(accS[nt][0], accS[nt][1]), pack2(accS[nt][2], accS[nt][3]));
    }
    {
      float bacc = 0.f;
#pragma unroll
      for (int tau = 0; tau < 16; tau++) {
        const float lg = __uint_as_float(rlg[tau] << 16);
        const float f = lb + (1.f - lb) * sigmoidf_(lg);
        bacc += __logf(f);
        if ((tau >> 2) == qd) {
          const float em = __expf(-bacc);
          const u16 kq = f2bf((1.f - f) * em);
          Kt[tau * RS + kc] = kq;
          KtT[kc * HS + tau] = kq;
          VtT[kc * HS + tau] = (u16)rvv[tau & 3];
          if (PASS == 2) Qt[tau * RS + kc] = f2bf(siluf_(__uint_as_float(rqq[tau & 3] << 16)) * __expf(bacc));
        }
      }
      if (qd == 0) { eb[kc] = __expf(bacc); bsum += bacc; }
    }
    __syncthreads();
    if (sp + 1 < 16) fetch(sp + 1);
    f32x4 accO = (f32x4){0.f, 0.f, 0.f, 0.f};
    if (PASS == 2) {
      bf16x8 aq0 = *(const bf16x8*)(Qt + (lane & 15) * RS + (lane >> 4) * 8);
      bf16x8 aq1 = *(const bf16x8*)(Qt + (lane & 15) * RS + 32 + (lane >> 4) * 8);
      if (w4 == 0) {
        f32x4 accA = (f32x4){0.f, 0.f, 0.f, 0.f};
        bf16x8 bk0 = *(const bf16x8*)(Kt + (lane & 15) * RS + (lane >> 4) * 8);
        bf16x8 bk1 = *(const bf16x8*)(Kt + (lane & 15) * RS + 32 + (lane >> 4) * 8);
        accA = __builtin_amdgcn_mfma_f32_16x16x32_bf16(aq0, bk0, accA, 0, 0, 0);
        accA = __builtin_amdgcn_mfma_f32_16x16x32_bf16(aq1, bk1, accA, 0, 0, 0);
#pragma unroll
        for (int r = 0; r < 4; r++) {
          const int tau = (lane >> 4) * 4 + r, sg = lane & 15;
          Am[tau * HS + sg] = sg <= tau ? f2bf(accA[r]) : (u16)0;
        }
      }
      __syncthreads();
      {
        bf16x8 aa = *(const bf16x8*)(Am + (lane & 15) * HS + (lane >> 4) * 8);
        bf16x8 bv = *(const bf16x8*)(VtT + (w4 * 16 + (lane & 15)) * HS + (lane >> 4) * 8);
        accO = __builtin_amdgcn_mfma_f32_16x16x32_bf16(aa, bv, accO, 0, 0, 0);
        bf16x8 bs0 = *(const bf16x8*)(St + (w4 * 16 + (lane & 15)) * RS + (lane >> 4) * 8);
        bf16x8 bs1 = *(const bf16x8*)(St + (w4 * 16 + (lane & 15)) * RS + 32 + (lane >> 4) * 8);
        accO = __builtin_amdgcn_mfma_f32_16x16x32_bf16(aq0, bs0, accO, 0, 0, 0);
        accO = __builtin_amdgcn_mfma_f32_16x16x32_bf16(aq1, bs1, accO, 0, 0, 0);
      }
    }
    {
      bf16x8 ak = *(const bf16x8*)(KtT + (w4 * 16 + (lane & 15)) * HS + (lane >> 4) * 8);
#pragma unroll
      for (int nt = 0; nt < 4; nt++) {
        bf16x8 bv = *(const bf16x8*)(VtT + (nt * 16 + (lane & 15)) * HS + (lane >> 4) * 8);
        accS[nt] = __builtin_amdgcn_mfma_f32_16x16x32_bf16(ak, bv, accS[nt], 0, 0, 0);
      }
      const float4 e4 = *(const float4*)(eb + w4 * 16 + (lane >> 4) * 4);
#pragma unroll
      for (int nt = 0; nt < 4; nt++) { accS[nt][0] *= e4.x; accS[nt][1] *= e4.y; accS[nt][2] *= e4.z; accS[nt][3] *= e4.w; }
    }
    if (PASS == 2) {
      const int cv = h * 64 + w4 * 16 + (lane & 15);
      float o[4];
#pragma unroll
      for (int r = 0; r < 4; r++) {
        const int tau = (lane >> 4) * 4 + r;
        const size_t row = (size_t)(rbase + (d == 0 ? tau : 15 - tau));
        o[r] = accO[r];
        if (d == 1) o[r] += bf2f(proj[row * PC + C_HGF + cv]);
        else proj[row * PC + C_HGF + cv] = f2bf(o[r]);
      }
      if (d == 1) {
#pragma unroll
        for (int r = 0; r < 4; r++) {
          float s2 = allsum16(o[r] * o[r]);
          if ((lane & 15) == 0) ssb[w4 * 16 + (lane >> 4) * 4 + r] = s2;
        }
      }
      __syncthreads();
      if (d == 1) {
#pragma unroll
        for (int r = 0; r < 4; r++) {
          const int tau = (lane >> 4) * 4 + r;
          const size_t row = (size_t)(rbase + 15 - tau);
          const float ss = ssb[tau] + ssb[16 + tau] + ssb[32 + tau] + ssb[48 + tau];
          const float z = bf2f(proj[row * PC + C_HGZ + cv]);
          proj[row * PC + C_HGQ + cv] = f2bf(o[r] * rsqrtf(ss * (1.f / 64.f) + 1e-6f) * normw * siluf_(z));
        }
      }
      if (sp + 1 < 16) {
#pragma unroll
        for (int nt = 0; nt < 4; nt++)
          *(uint2*)(St + (nt * 16 + (lane & 15)) * RS + w4 * 16 + (lane >> 4) * 4) =
              make_uint2(pack2(accS[nt][0], accS[nt][1]), pack2(accS[nt][2], accS[nt][3]));
      }
    }
  }
  if (PASS == 1) {
#pragma unroll
    for (int nt = 0; nt < 4; nt++)
#pragma unroll
      for (int r = 0; r < 4; r++) stt[(w4 * 16 + (lane >> 4) * 4 + r) * 64 + nt * 16 + (lane & 15)] = accS[nt][r];
    if (qd == 0) ((float*)(p.ws + OFF_HGP))[((size_t)dbh * 9 + cstep) * 64 + kc] = __expf(bsum);
  }
}
__device__ void gla_p1_task(const Params& p, int layer, int task, float* lds) {
  int c = task % 9; int q = task / 9; int h = q & 3; q >>= 2; int b = q & 7; q >>= 3; int d = q & 1; int mx = q >> 1;
  if (mx == 0) { const int nc = d == 0 ? c : (c == 0 ? 0 : 9 - c); hg_sweep<1>(p, layer, d, b, h, nc, c, (u16*)lds); }
  else { const int nc = d == 0 ? c : (c == 0 ? 0 : 9 - c); ret_sweep<1>(p, layer, d, b, h, nc, c, (u16*)lds); }
}
__device__ void gla_p2_task(const Params& p, int layer, int mx, int b, int h, int nc, float* lds) {
  int cb = nc == 0 ? 0 : 9 - nc;
  if (mx == 0) { hg_sweep<2>(p, layer, 0, b, h, nc, nc, (u16*)lds); __threadfence_block(); hg_sweep<2>(p, layer, 1, b, h, nc, cb, (u16*)lds); }
  else { ret_sweep<2>(p, layer, 0, b, h, nc, nc, (u16*)lds); __threadfence_block(); ret_sweep<2>(p, layer, 1, b, h, nc, cb, (u16*)lds); }
}
__device__ void gla_carry_task(const Params& p, int layer, int task) {
  int e = task * 256 + tid_();
  int v = e & 63, k = (e >> 6) & 63, dbh = (e >> 12) & 63, mx = e >> 18;
  float* stt = (float*)(p.ws + (mx == 0 ? OFF_HGST : OFF_RTST)) + (size_t)dbh * 9 * 4096 + k * 64 + v;
  const float* P = (const float*)(p.ws + OFF_HGP) + (size_t)dbh * 9 * 64 + k;
  float pg = 1.f;
  if (mx == 1) { int d = dbh >> 5, h = dbh & 3; pg = __expf(-256.f * __expf(p.in[20][((size_t)layer * 2 + d) * 4 + h])); }
  float S = 0.f;
  for (int c = 0; c < 9; c++) {
    float E = stt[(size_t)c * 4096];
    stt[(size_t)c * 4096] = S;
    float pp = mx == 0 ? P[c * 64] : pg;
    S = pp * S + E;
  }
}

__device__ __forceinline__ int s5_bwd_chunk(int nc) { return nc < 4 ? 3 - nc : 39 - nc; }
template <int PASS>
__device__ void s5_task(const Params& p, int layer, int task, float* lds) {
  const int t = tid_(), w = t >> 6, lane = t & 63;
  int gq = task & 3; int q = task >> 2; int nc = q % 36; int b = q / 36;
  const int g = gq * 4 + w;
  float* ubuf = lds + w * 256;
  u16* hbuf = (u16*)(lds + 1024) + w * (16 * 136);
  float* ybuf = lds + 1024 + 4352 + w * 1024;
  u16* proj = (u16*)(p.ws + OFF_PROJ);
  float2* st5 = (float2*)(p.ws + OFF_S5ST);
  bf16x8 cfrag[4];
  if (PASS == 2) {
    const float* cre = p.in[13] + ((size_t)layer * 16 + g) * 16 * 64;
    const float* cim = p.in[14] + ((size_t)layer * 16 + g) * 16 * 64;
    int pp = lane & 15;
#pragma unroll
    for (int ks = 0; ks < 4; ks++)
#pragma unroll
      for (int i = 0; i < 8; i++) {
        int kidx = ks * 32 + (lane >> 4) * 8 + i; int n = kidx >> 1;
        float val = (kidx & 1) ? -cim[pp * 64 + n] : cre[pp * 64 + n];
        cfrag[ks][i] = (short)f2bf(val);
      }
  }
  for (int d = 0; d < 2; d++) {
    float lre = p.in[8][(((size_t)layer * 2 + d) * 16 + g) * 64 + lane];
    float lim = p.in[9][(((size_t)layer * 2 + d) * 16 + g) * 64 + lane];
    float dt = __expf(p.in[10][((size_t)layer * 2 + d) * 16 + g]);
    float mag = __expf(lre * dt);
    float sn, cs; sincosf(lim * dt, &sn, &cs);
    float are = mag * cs, aim = mag * sn;
    float den = 1.f / (lre * lre + lim * lim);
    float cre_ = ((are - 1.f) * lre + aim * lim) * den;
    float cim_ = (aim * lre - (are - 1.f) * lim) * den;
    float bbr[16], bbi[16];
    {
      const float* br = p.in[11] + (((size_t)layer * 16 + g) * 64 + lane) * 16;
      const float* bi = p.in[12] + (((size_t)layer * 16 + g) * 64 + lane) * 16;
#pragma unroll
      for (int i = 0; i < 16; i++) {
        float x = br[i], y = bi[i];
        bbr[i] = cre_ * x - cim_ * y; bbi[i] = cre_ * y + cim_ * x;
      }
    }
    int cstep = d == 0 ? nc : s5_bwd_chunk(nc);
    size_t sidx = ((((size_t)d * 8 + b) * 16 + g) * 36 + cstep) * 64 + lane;
    float hre = 0.f, him = 0.f;
    if (PASS == 2) { float2 h0 = st5[sidx]; hre = h0.x; him = h0.y; }
    uint2 ru;
    auto fetchu = [&](int sub) {
      int st = lane >> 2, p4 = (lane & 3) * 4;
      int jl = d == 0 ? sub * 16 + st : 63 - (sub * 16 + st);
      ru = *(const uint2*)(proj + (size_t)(b * TT + nc * 64 + jl) * PC + C_S5U + g * 16 + p4);
    };
    fetchu(0);
    for (int sub = 0; sub < 4; sub++) {
      __syncthreads();
      {
        int st = lane >> 2, p4 = (lane & 3) * 4;
        *(float4*)(ubuf + st * 16 + p4) = make_float4(__uint_as_float(ru.x << 16), __uint_as_float(ru.x & 0xffff0000u),
                                                       __uint_as_float(ru.y << 16), __uint_as_float(ru.y & 0xffff0000u));
      }
      __syncthreads();
      if (sub + 1 < 4) fetchu(sub + 1);
#pragma unroll 2
      for (int st = 0; st < 16; st++) {
        float bur = 0.f, bui = 0.f;
#pragma unroll
        for (int i4 = 0; i4 < 4; i4++) {
          float4 uu = *(const float4*)(ubuf + st * 16 + i4 * 4);
          bur += bbr[i4*4] * uu.x + bbr[i4*4+1] * uu.y + bbr[i4*4+2] * uu.z + bbr[i4*4+3] * uu.w;
          bui += bbi[i4*4] * uu.x + bbi[i4*4+1] * uu.y + bbi[i4*4+2] * uu.z + bbi[i4*4+3] * uu.w;
        }
        float nre = are * hre - aim * him + bur;
        float nim = are * him + aim * hre + bui;
        hre = nre; him = nim;
        if (PASS == 2) *(unsigned*)(hbuf + st * 136 + lane * 2) = pack2(hre, him);
      }
      if (PASS == 2) {
        __syncthreads();
        f32x4 acc = (f32x4){0.f, 0.f, 0.f, 0.f};
#pragma unroll
        for (int ks = 0; ks < 4; ks++) {
          bf16x8 af = *(const bf16x8*)(hbuf + (lane & 15) * 136 + ks * 32 + (lane >> 4) * 8);
          acc = __builtin_amdgcn_mfma_f32_16x16x32_bf16(af, cfrag[ks], acc, 0, 0, 0);
        }
#pragma unroll
        for (int r = 0; r < 4; r++) {
          int st = (lane >> 4) * 4 + r;
          int jl = d == 0 ? sub * 16 + st : 63 - (sub * 16 + st);
          float* yp = ybuf + jl * 16 + (lane & 15);
          if (d == 0) *yp = acc[r]; else *yp += acc[r];
        }
      }
    }
    if (PASS == 1) st5[sidx] = make_float2(hre, him);
  }
  if (PASS == 2) {
    __syncthreads();
    const float* dsk = p.in[15] + layer * 256 + g * 16;
#pragma unroll
    for (int i = 0; i < 16; i++) {
      int idx = lane + 64 * i; int jl = idx >> 4, pp = idx & 15;
      u16* up = proj + (size_t)(b * TT + nc * 64 + jl) * PC + C_S5U + g * 16 + pp;
      float y = ybuf[jl * 16 + pp] + dsk[pp] * bf2f(*up);
      *up = f2bf(geluf_(y));
    }
  }
}
__device__ void s5_carry_task(const Params& p, int layer, int task) {
  int e = task * 256 + tid_();
  int n = e & 63, g = (e >> 6) & 15, d = e >> 13;
  float lre = p.in[8][(((size_t)layer * 2 + d) * 16 + g) * 64 + n];
  float lim = p.in[9][(((size_t)layer * 2 + d) * 16 + g) * 64 + n];
  float dt = __expf(p.in[10][((size_t)layer * 2 + d) * 16 + g]);
  float mag = __expf(lre * dt * 64.f);
  float sn, cs; sincosf(lim * dt * 64.f, &sn, &cs);
  float are = mag * cs, aim = mag * sn;
  float2* st5 = (float2*)(p.ws + OFF_S5ST) + (size_t)(e >> 6) * 36 * 64 + n;
  float sre = 0.f, sim = 0.f;
  for (int c = 0; c < 36; c++) {
    float2 E = st5[(size_t)c * 64];
    st5[(size_t)c * 64] = make_float2(sre, sim);
    float nre = are * sre - aim * sim + E.x;
    float nim = are * sim + aim * sre + E.y;
    sre = nre; sim = nim;
  }
}

__device__ __forceinline__ void group_barrier(unsigned* cnt, unsigned target) {
  asm volatile("s_waitcnt vmcnt(0)" ::: "memory");
  __syncthreads();
  if (tid_() == 0) {
    __threadfence();
    asm volatile("s_waitcnt vmcnt(0)" ::: "memory");
    __hip_atomic_fetch_add(cnt, 1u, __ATOMIC_RELAXED, __HIP_MEMORY_SCOPE_AGENT);
    while (__hip_atomic_load(cnt, __ATOMIC_RELAXED, __HIP_MEMORY_SCOPE_AGENT) < target) __builtin_amdgcn_s_sleep(2);
    __threadfence();
    asm volatile("s_waitcnt vmcnt(0)" ::: "memory");
  }
  __syncthreads();
}
#define XB_XCNT(j) (64 * (j))
#define XB_XSUB(j) (1024 + 64 * (j))
#define XB_XGEN(j) (2048 + 64 * (j))
#define XB_TOP     3072
#define XB_TOPGEN  3136
#define XB_WORDS   8192
struct XcdBar { unsigned* bar; unsigned x, nloc, nx; };
__device__ __forceinline__ unsigned xb_ld(unsigned* q) { return __hip_atomic_load(q, __ATOMIC_RELAXED, __HIP_MEMORY_SCOPE_AGENT); }
__device__ __forceinline__ unsigned xb_add(unsigned* q, unsigned v) { return __hip_atomic_fetch_add(q, v, __ATOMIC_RELAXED, __HIP_MEMORY_SCOPE_AGENT); }
__device__ __forceinline__ void xcd_barrier(const XcdBar& b) {
  asm volatile("s_waitcnt vmcnt(0)" ::: "memory");
  __syncthreads();
  if (tid_() == 0) {
    unsigned* bar = b.bar;
    __builtin_amdgcn_s_waitcnt(0);
    const unsigned old = xb_add(&bar[XB_XSUB(b.x)], 1u);
    const unsigned gen = old / b.nloc;
    if (old + 1u == (gen + 1u) * b.nloc) {
      __builtin_amdgcn_fence(__ATOMIC_RELEASE, "agent");
      asm volatile("s_waitcnt vmcnt(0)" ::: "memory");
      const unsigned og = xb_add(&bar[XB_TOP], 1u);
      const unsigned tg = og / b.nx;
      if (og + 1u == (tg + 1u) * b.nx) xb_add(&bar[XB_TOPGEN], 1u);
      else while (xb_ld(&bar[XB_TOPGEN]) == tg) __builtin_amdgcn_s_sleep(1);
      __builtin_amdgcn_fence(__ATOMIC_ACQUIRE, "agent");
      xb_add(&bar[XB_XGEN(b.x)], 1u);
      asm volatile("s_waitcnt vmcnt(0)" ::: "memory");
    } else {
      while (xb_ld(&bar[XB_XGEN(b.x)]) == gen) __builtin_amdgcn_s_sleep(1);
      __builtin_amdgcn_fence(__ATOMIC_ACQUIRE, "agent");
      asm volatile("s_waitcnt vmcnt(0)" ::: "memory");
    }
  }
  __syncthreads();
}
#define LDS_FLOATS 18432
#define SYNC() xcd_barrier(xbar)
#define RW_TWO false
#define NRW (RW_TWO ? 128 : 256)

__global__ void __launch_bounds__(256, 2) fwd_megakernel(Params p) {
  cg::grid_group grid = cg::this_grid();
  __shared__ __attribute__((aligned(16))) float lds[LDS_FLOATS];
  const int bid = blockIdx.x, nb = gridDim.x, t = tid_();
  XcdBar xbar; xbar.bar = (unsigned*)(p.ws + OFF_XB); xbar.x = 0; xbar.nloc = 1; xbar.nx = 1;

  if (p.ws == nullptr) grid.sync();
  {
    unsigned xr; asm volatile("s_getreg_b32 %0, hwreg(HW_REG_XCC_ID)" : "=s"(xr));
    xbar.x = xr & 15u;
    if (t == 0) xb_add(&xbar.bar[XB_XCNT(xbar.x)], 1u + ((nb == 512 && bid >= NRW) ? 65536u : 0u));
  }
  for (int task = bid; task < N_CONVERT_TASKS + 192 + 1; task += nb) {
    if (task < 192) mods_task(p, task, lds);
    else if (task == 192) {
      float* rope = (float*)(p.ws + OFF_ROPE);
      for (int i = t; i < 1024; i += 256) {
        int pos = i >> 4, fi = i & 15;
        float fr = powf(10000.f, -(float)fi / 16.f);
        float ang = (float)pos * fr;
        rope[i * 2] = cosf(ang); rope[i * 2 + 1] = sinf(ang);
      }
    } else convert_task(p, 0, task - 193, lds);
  }
  XcdBar pbar; pbar.bar = xbar.bar + 4096; pbar.x = xbar.x; pbar.nloc = 1; pbar.nx = 1;
  if (t == 0) {
    unsigned nx, npx, nlocp;
    for (;;) {
      unsigned sum = 0; nx = 0; npx = 0; nlocp = 0;
#pragma unroll
      for (int j = 0; j < 16; j++) {
        const unsigned w = xb_ld(&xbar.bar[XB_XCNT(j)]);
        const unsigned c = w & 65535u, cp = w >> 16;
        sum += c; nx += c > 0u ? 1u : 0u; npx += cp > 0u ? 1u : 0u;
        if ((unsigned)j == xbar.x) { xbar.nloc = c; nlocp = cp; }
      }
      if (sum == (unsigned)nb) break;
      __builtin_amdgcn_s_sleep(4);
    }
    xbar.nx = nx; pbar.nx = npx > 0u ? npx : 1u; pbar.nloc = nlocp > 0u ? nlocp : 1u;
  }
  SYNC();
  for (int task = bid; task < MROWS / 4; task += nb) ln_row(p, 0, 0, task * 4 + (t >> 6));
  SYNC();

  for (int layer = 0; layer < 2; layer++) {
    const int latonly = layer;
    if ((nb & 7) == 0) { int tm, tn; for (int it = 0; xcd_tile(it, bid, nb, 144, 31, 6, tm, tn); it++) inproj_tile(p, layer, tm, tn, (u16*)lds); }
    else for (int task = bid; task < 144 * 31; task += nb) inproj_tile(p, layer, task / 31, task % 31, (u16*)lds);
    SYNC();
    {
      const int ncg = latonly ? 8 : 9, ncs = latonly ? 32 : 36;
      const int NG = 64 * ncg, NS = 32 * ncs;
      auto p2_task = [&](int task) {
        if (task < NG) {
          int nc = task % ncg + (latonly ? 1 : 0); int q = task / ncg; int h = q & 3; q >>= 2; int b = q & 7; int mx = q >> 3;
          gla_p2_task(p, layer, mx, b, h, nc, lds);
        } else {
          int q = task - NG; int gq = q & 3; q >>= 2; int nc = q % ncs + (latonly ? 4 : 0); int b = q / ncs;
          s5_task<2>(p, layer, ((b * 36 + nc) << 2) | gq, lds);
        }
      };
      if (nb == 512) {
        unsigned* bar = (unsigned*)(p.ws + OFF_BAR);
        const int ng = nb - NRW;
        if (bid < NRW) {
          rwkv_scan32(p, layer, bid, lds);
          if (t == 0) {
            while (xb_ld(&pbar.bar[XB_TOPGEN]) < 2u * layer + 2u) __builtin_amdgcn_s_sleep(8);
            __threadfence();
          }
          __syncthreads();
        } else {
          const int gb = bid - NRW;
          for (int task = gb; task < 2304; task += ng) {
            if (task < 1152) gla_p1_task(p, layer, task, lds); else s5_task<1>(p, layer, task - 1152, lds);
          }
          xcd_barrier(pbar);
          for (int task = gb; task < 2048 + 64; task += ng) {
            if (task < 2048) gla_carry_task(p, layer, task); else s5_carry_task(p, layer, task - 2048);
          }
          xcd_barrier(pbar);
        }
        int* shq = (int*)(lds + LDS_FLOATS - 4);
        for (;;) {
          __syncthreads();
          if (t == 0) *shq = (int)__hip_atomic_fetch_add(bar + 1 + layer, 1u, __ATOMIC_RELAXED, __HIP_MEMORY_SCOPE_AGENT);
          __syncthreads();
          const int task = *shq;
          if (task >= NG + NS) break;
          p2_task(task);
        }
        SYNC();
      } else {
        for (int task = bid; task < NRW + 2304; task += nb) {
          if (task < NRW) rwkv_scan32(p, layer, task, lds);
          else if (task < NRW + 1152) gla_p1_task(p, layer, task - NRW, lds);
          else s5_task<1>(p, layer, task - NRW - 1152, lds);
        }
        SYNC();
        for (int task = bid; task < 2048 + 64; task += nb) {
          if (task < 2048) gla_carry_task(p, layer, task); else s5_carry_task(p, layer, task - 2048);
        }
        SYNC();
        for (int task = bid; task < NG + NS; task += nb) p2_task(task);
        SYNC();
      }
    }
    {
      const int ntm = latonly ? 128 : 144;
      for (int task = bid; task < ntm * 2 + MROWS / 8; task += nb) {
        if (task < ntm * 2) glu_tile(p, layer, latonly, task >> 1, task & 1, (u16*)lds);
        else rwkv_combine_rows(p, layer, (task - ntm * 2) * 8, latonly);
      }
    }
    SYNC();
    {
      const int ntm = latonly ? 128 : 144;
      if ((nb & 7) == 0) { int tm, tn; for (int it = 0; xcd_tile(it, bid, nb, ntm, 16, 8, tm, tn); it++) merge_tile(p, layer, latonly, tm, tn, (u16*)lds); }
      else for (int task = bid; task < ntm * 16; task += nb) merge_tile(p, layer, latonly, task >> 4, task & 15, (u16*)lds);
    }
    SYNC();
    {
      const int ntm = latonly ? 128 : 144;
      if ((nb & 7) == 0) { int tm, tn; for (int it = 0; xcd_tile(it, bid, nb, ntm, 8, 8, tm, tn); it++) outproj_tile(p, layer, latonly, tm, tn, (u16*)lds); }
      else for (int task = bid; task < ntm * 8; task += nb) outproj_tile(p, layer, latonly, task >> 3, task & 7, (u16*)lds);
    }
    SYNC();
    if (layer == 0) {
      for (int task = bid; task < MROWS / 4 + N_CONVERT_TASKS; task += nb) {
        if (task < N_CONVERT_TASKS) convert_task(p, 1, task, lds);
        else ln_row(p, 1, 0, (task - N_CONVERT_TASKS) * 4 + (t >> 6));
      }
      SYNC();
    } else {
      for (int task = bid; task < NBATCH * 2048 / 4; task += nb) {
        int r = task * 4 + (t >> 6); int b = r >> 11, tl = r & 2047;
        ln_row(p, 1, 1, b * TT + 256 + tl);
      }
    }
  }
}

extern "C" void kernel_launch(void* const* d_in, const int* in_sizes, int n_in,
                              void* d_out, int out_size, void* d_ws, size_t ws_size,
                              hipStream_t stream) {
  static int grid_blocks = 0;
  if (!grid_blocks) {
    int dev = 0, cus = 0, per_cu = 0;
    (void)hipGetDevice(&dev);
    (void)hipDeviceGetAttribute(&cus, hipDeviceAttributeMultiprocessorCount, dev);
    (void)hipOccupancyMaxActiveBlocksPerMultiprocessor(&per_cu, fwd_megakernel, 256, 0);
    if (per_cu > 2) per_cu = 2;
    if (per_cu < 1) per_cu = 1;
    grid_blocks = cus * per_cu;
  }
  if (ws_size < WS_NEED) { fprintf(stderr, "workspace too small\n"); return; }
  Params p{};
  for (int i = 0; i < 36; i++) p.in[i] = (const float*)d_in[i];
  p.out = (float*)d_out;
  p.ws = (char*)d_ws;
  (void)hipMemsetAsync((char*)d_ws + OFF_BAR, 0, 256 + 32768, stream);
  void* args[] = {&p};
  hipError_t e = hipLaunchCooperativeKernel((void*)fwd_megakernel, dim3(grid_blocks), dim3(256), args, 0, stream);
  if (e != hipSuccess) fprintf(stderr, "cooperative launch failed: %s (grid %d)\n", hipGetErrorString(e), grid_blocks);
}
```
